# Optimizing an MI355X kernel written in HIP

```python
import jax, jax.numpy as jnp
from jax import lax
import numpy as np

D_MODEL = 1024
BATCH = 8
SEQ = 2048
DEPTH = 2

GRID_W = 64
CTX_LEN = 256
LN_EPS = 1e-5
D_CONV = 512
CONV_WIDTH = 31
N_Q_HEADS = 8
N_KV_HEADS = 2
HEAD_DIM = 64
WINDOW = 128
BLOCK = 128
ROPE_BASE = 10000.0
D_ATTN = N_Q_HEADS * HEAD_DIM
D_KV = N_KV_HEADS * HEAD_DIM
N_MLSTM_HEADS = 4
MLSTM_HEAD_DIM = 128
D_MLSTM = N_MLSTM_HEADS * MLSTM_HEAD_DIM
CHUNK = 64
N_GATE_COLS = 2 * 2 * N_MLSTM_HEADS
N_BRANCHES = 3
IN_SPLITS = (2 * D_CONV, D_ATTN, D_KV, D_KV, D_MLSTM, D_MLSTM, D_MLSTM, D_MLSTM, N_GATE_COLS, N_BRANCHES * D_MODEL)
D_IN = 2 * D_CONV + D_ATTN + 2 * D_KV + 4 * D_MLSTM + N_GATE_COLS + N_BRANCHES * D_MODEL
N_EXPERTS = 16
N_GROUPS = 4
EXPERTS_PER_GROUP = N_EXPERTS // N_GROUPS
TOP_K = 2
D_EXPERT = 512

kernel_name = "hybrid_conv_swa_mlstm_moe_dit"


def layer_norm(x, g, b):
    xf = x.astype(jnp.float32)
    mu = xf.mean(-1, keepdims=True)
    var = jnp.square(xf - mu).mean(-1, keepdims=True)
    y = (xf - mu) * lax.rsqrt(var + LN_EPS)
    return (y * g.astype(jnp.float32) + b.astype(jnp.float32)).astype(x.dtype)


def split_in(p):
    offs, acc = [], 0
    for s in IN_SPLITS[:-1]:
        acc += s
        offs.append(acc)
    return jnp.split(p, offs, axis=-1)


def conv_module(a_in, w, b, g, beta):
    val, gate = jnp.split(a_in, 2, axis=-1)
    u = val * jax.nn.sigmoid(gate)
    pad = CONV_WIDTH // 2
    y = lax.conv_general_dilated(u, w[:, None, :], window_strides=(1,), padding=[(pad, pad)],
                                 dimension_numbers=("NWC", "WIO", "NWC"), feature_group_count=D_CONV) + b
    return jax.nn.silu(layer_norm(y, g, b * 0 + beta) if False else layer_norm(y, g, beta))


def rope_half(u, pos):
    nf = u.shape[-1] // 2
    inv = ROPE_BASE ** (-jnp.arange(nf, dtype=jnp.float32) / nf)
    ang = pos.astype(jnp.float32)[:, None] * inv[None, :]
    cos = jnp.cos(ang)[None, :, None, :]
    sin = jnp.sin(ang)[None, :, None, :]
    u1 = u[..., :nf].astype(jnp.float32)
    u2 = u[..., nf:].astype(jnp.float32)
    return jnp.concatenate([u1 * cos - u2 * sin, u1 * sin + u2 * cos], axis=-1).astype(u.dtype)


def axial_rope(t, row_pos, col_pos):
    half = t.shape[-1] // 2
    return jnp.concatenate([rope_half(t[..., :half], row_pos), rope_half(t[..., half:], col_pos)], axis=-1)


def sink_softmax(scores, sink):
    m = sink
    for s in scores:
        m = jnp.maximum(m, s.max(-1, keepdims=True))
    ex = [jnp.exp(s - m) for s in scores]
    denom = jnp.exp(sink - m)
    for e in ex:
        denom = denom + e.sum(-1, keepdims=True)
    return [e / denom for e in ex]


def banded_attention(q, k, v, kc, vc, sink):
    B, S, H, Dh = q.shape
    G = H // N_KV_HEADS
    nb = S // BLOCK
    scale = Dh ** -0.5
    qb = q.reshape(B, nb, BLOCK, N_KV_HEADS, G, Dh)

    def band(t):
        tb = t.reshape(B, nb, BLOCK, N_KV_HEADS, Dh)
        tp = jnp.pad(tb, ((0, 0), (1, 1), (0, 0), (0, 0), (0, 0)))
        return jnp.concatenate([tp[:, :-2], tp[:, 1:-1], tp[:, 2:]], axis=2)

    kb, vb = band(k), band(v)
    s_loc = jnp.einsum("bnqhgd,bnkhd->bnhgqk", qb, kb).astype(jnp.float32) * scale
    blk = jnp.arange(nb)[:, None]
    qpos = blk * BLOCK + jnp.arange(BLOCK)[None, :]
    kpos = blk * BLOCK - BLOCK + jnp.arange(3 * BLOCK)[None, :]
    valid = ((jnp.abs(qpos[:, :, None] - kpos[:, None, :]) <= WINDOW)
             & (kpos[:, None, :] >= 0) & (kpos[:, None, :] < S))
    s_loc = jnp.where(valid[None, :, None, None], s_loc, -jnp.inf)
    s_ctx = jnp.einsum("bnqhgd,blhd->bnhgql", qb, kc).astype(jnp.float32) * scale
    sink_l = jnp.broadcast_to(sink.astype(jnp.float32).reshape(1, 1, N_KV_HEADS, G, 1, 1), s_loc.shape[:-1] + (1,))
    p_loc, p_ctx = sink_softmax([s_loc, s_ctx], sink_l)
    o = (jnp.einsum("bnhgqk,bnkhd->bnqhgd", p_loc.astype(v.dtype), vb)
         + jnp.einsum("bnhgql,blhd->bnqhgd", p_ctx.astype(vc.dtype), vc))
    return o.reshape(B, S, H * Dh)


def context_attention(qc, kc, vc, sink):
    B, L, H, Dh = qc.shape
    G = H // N_KV_HEADS
    qg = qc.reshape(B, L, N_KV_HEADS, G, Dh)
    s = jnp.einsum("bqhgd,bkhd->bhgqk", qg, kc).astype(jnp.float32) * (Dh ** -0.5)
    sink_l = jnp.broadcast_to(sink.astype(jnp.float32).reshape(1, N_KV_HEADS, G, 1, 1), s.shape[:-1] + (1,))
    (p,) = sink_softmax([s], sink_l)
    o = jnp.einsum("bhgqk,bkhd->bqhgd", p.astype(vc.dtype), vc)
    return o.reshape(B, L, H * Dh)


def mlstm_scan(q, k, v, ig, lf, state):
    B, T, H, dh = q.shape
    nc = T // CHUNK
    tril = jnp.tril(jnp.ones((CHUNK, CHUNK), dtype=bool))

    def to_chunks(t):
        return jnp.moveaxis(t.reshape((B, nc, CHUNK) + t.shape[2:]), 1, 0)

    def step(carry, inp):
        C, n, m = carry
        qc, kc, vc, igc, lfc = inp
        b = jnp.cumsum(lfc, axis=1)
        log_d = b[:, :, None, :] - b[:, None, :, :] + igc[:, None, :, :]
        log_d = jnp.where(tril[None, :, :, None], log_d, -jnp.inf)
        inter = b + m[:, None, :]
        m_out = jnp.maximum(inter, log_d.max(axis=2))
        w_intra = jnp.exp(log_d - m_out[:, :, None, :])
        w_inter = jnp.exp(inter - m_out)
        qk = jnp.einsum("bjhd,bshd->bjsh", qc, kc) * w_intra
        num = jnp.einsum("bjsh,bshe->bjhe", qk, vc) + w_inter[..., None] * jnp.einsum("bjhd,bhde->bjhe", qc, C)
        den = qk.sum(axis=2) + w_inter * jnp.einsum("bjhd,bhd->bjh", qc, n)
        h = num / jnp.maximum(jnp.abs(den), jnp.exp(-m_out))[..., None]
        b_last = b[:, -1, :]
        log_w = b_last[:, None, :] - b + igc
        m_new = jnp.maximum(b_last + m, log_w.max(axis=1))
        w_s = jnp.exp(log_w - m_new[:, None, :])
        decay = jnp.exp(b_last + m - m_new)
        C_new = decay[..., None, None] * C + jnp.einsum("bsh,bshd,bshe->bhde", w_s, kc, vc)
        n_new = decay[..., None] * n + jnp.einsum("bsh,bshd->bhd", w_s, kc)
        return (C_new, n_new, m_new), h

    xs = (to_chunks(q), to_chunks(k), to_chunks(v), to_chunks(ig), to_chunks(lf))
    state, h = lax.scan(step, state, xs)
    h = jnp.moveaxis(h, 0, 1).reshape(B, T, H, dh)
    return h, state


def mlstm_bidir(q, k, v, gates, init_fwd, init_bwd):
    ig_f, lf_f = gates[:, :, 0, 0], jax.nn.log_sigmoid(gates[:, :, 0, 1])
    ig_b, lf_b = gates[:, :, 1, 0], jax.nn.log_sigmoid(gates[:, :, 1, 1])
    h_f, st_f = mlstm_scan(q, k, v, ig_f, lf_f, init_fwd)
    fl = lambda t: jnp.flip(t, axis=1)
    h_b, st_b = mlstm_scan(fl(q), fl(k), fl(v), fl(ig_b), fl(lf_b), init_bwd)
    return h_f + fl(h_b), st_f, st_b


def head_norm(h, g):
    mu = h.mean(-1, keepdims=True)
    var = jnp.square(h - mu).mean(-1, keepdims=True)
    y = (h - mu) * lax.rsqrt(var + LN_EPS)
    return y.reshape(h.shape[:2] + (-1,)) * g.astype(jnp.float32)


def token_mixer(u, uc, row_pos, col_pos, w_in, conv_w, conv_b, conv_ln_g, conv_ln_b, w_a_out, attn_sink,
                w_b_out, mlstm_gate_b, mlstm_norm_g, w_c_out, w_out, need_ctx_out):
    B, S, _ = u.shape
    L = uc.shape[1]
    a_in, q, k, v, mq, mk, mv, mo, mg, bg = split_in(u @ w_in)
    a_in_c, q_c, k_c, v_c, mq_c, mk_c, mv_c, mo_c, mg_c, bg_c = split_in(uc @ w_in)

    qh = axial_rope(q.reshape(B, S, N_Q_HEADS, HEAD_DIM), row_pos, col_pos)
    kh = axial_rope(k.reshape(B, S, N_KV_HEADS, HEAD_DIM), row_pos, col_pos)
    vh = v.reshape(B, S, N_KV_HEADS, HEAD_DIM)
    kch = k_c.reshape(B, L, N_KV_HEADS, HEAD_DIM)
    vch = v_c.reshape(B, L, N_KV_HEADS, HEAD_DIM)
    y_b = banded_attention(qh, kh, vh, kch, vch, attn_sink)

    def heads(t, T):
        return t.reshape(B, T, N_MLSTM_HEADS, MLSTM_HEAD_DIM).astype(jnp.float32)
    k_scale = MLSTM_HEAD_DIM ** -0.5
    gb = mlstm_gate_b.astype(jnp.float32)
    g_lat = mg.astype(jnp.float32).reshape(B, S, 2, 2, N_MLSTM_HEADS) + gb
    g_ctx = mg_c.astype(jnp.float32).reshape(B, L, 2, 2, N_MLSTM_HEADS) + gb
    zero = (jnp.zeros((B, N_MLSTM_HEADS, MLSTM_HEAD_DIM, MLSTM_HEAD_DIM), jnp.float32),
            jnp.zeros((B, N_MLSTM_HEADS, MLSTM_HEAD_DIM), jnp.float32),
            jnp.zeros((B, N_MLSTM_HEADS), jnp.float32))
    h_ctx, st_f, st_b = mlstm_bidir(heads(mq_c, L), heads(mk_c, L) * k_scale, heads(mv_c, L), g_ctx, zero, zero)
    h_lat, _, _ = mlstm_bidir(heads(mq, S), heads(mk, S) * k_scale, heads(mv, S), g_lat, st_f, st_b)
    y_c = (jax.nn.sigmoid(mo.astype(jnp.float32)) * head_norm(h_lat, mlstm_norm_g)).astype(u.dtype)

    def merge(ya, yb, yc, gates):
        ga, gbr, gc = jnp.split(jax.nn.sigmoid(gates), N_BRANCHES, axis=-1)
        return (ga * (ya @ w_a_out) + gbr * (yb @ w_b_out) + gc * (yc @ w_c_out)) @ w_out

    y_a = conv_module(a_in, conv_w, conv_b, conv_ln_g, conv_ln_b)
    y = merge(y_a, y_b, y_c, bg)
    if need_ctx_out:
        y_a_c = conv_module(a_in_c, conv_w, conv_b, conv_ln_g, conv_ln_b)
        y_b_c = context_attention(q_c.reshape(B, L, N_Q_HEADS, HEAD_DIM), kch, vch, attn_sink)
        y_c_c = (jax.nn.sigmoid(mo_c.astype(jnp.float32)) * head_norm(h_ctx, mlstm_norm_g)).astype(uc.dtype)
        y_ctx = merge(y_a_c, y_b_c, y_c_c, bg_c)
    else:
        y_ctx = None
    return y, y_ctx


def grouped_moe(t, w_router, b_router, w_gu, w_dn):
    N, D = t.shape
    scores = jax.nn.sigmoid((t @ w_router).astype(jnp.float32))
    sel = (scores + b_router.astype(jnp.float32)).reshape(N, N_GROUPS, EXPERTS_PER_GROUP)
    group_score = lax.top_k(sel, TOP_K)[0].sum(-1)
    g_idx = jnp.argmax(group_score, axis=-1)
    idx = jnp.broadcast_to(g_idx[:, None, None], (N, 1, EXPERTS_PER_GROUP))
    in_group = jnp.take_along_axis(sel, idx, axis=1)[:, 0]
    _, loc = lax.top_k(in_group, TOP_K)
    e_idx = g_idx[:, None] * EXPERTS_PER_GROUP + loc
    w = jnp.take_along_axis(scores, e_idx, axis=1)
    w = w / w.sum(-1, keepdims=True)
    gates = jnp.sum(jax.nn.one_hot(e_idx, N_EXPERTS, dtype=jnp.float32) * w[..., None], axis=1)
    out = jnp.zeros((N, D), jnp.float32)
    for e in range(N_EXPERTS):
        g_, u_ = jnp.split(t @ w_gu[e], 2, axis=-1)
        out = out + gates[:, e:e + 1] * ((jax.nn.silu(g_) * u_) @ w_dn[e]).astype(jnp.float32)
    return out.astype(t.dtype)


def setup_inputs(seed: int = 0) -> dict:
    key = jax.random.key(seed)
    ks = iter(jax.random.split(key, 40))
    f32 = jnp.float32

    def nrm(shape, scale):
        return jax.random.normal(next(ks), shape, f32) * scale

    D = D_MODEL
    beta = (8.0 * DEPTH) ** -0.25
    f_bias = jnp.linspace(3.0, 6.0, N_MLSTM_HEADS, dtype=f32)
    ig_b = nrm((DEPTH, 2, N_MLSTM_HEADS), 0.1)
    fg_b = f_bias + nrm((DEPTH, 2, N_MLSTM_HEADS), 0.1)
    return {
        "x": nrm((BATCH, SEQ, D), 1.0),
        "c": nrm((BATCH, D), 1.0),
        "ctx": nrm((BATCH, CTX_LEN, D), 1.0),
        "c_ctx": nrm((D,), 1.0),
        "ln_in_g": 1.0 + nrm((D,), 0.02),
        "ln_in_b": nrm((D,), 0.02),
        "w_router": nrm((D, N_EXPERTS), D ** -0.5),
        "b_router": nrm((N_EXPERTS,), 0.01),
        "w_mod": nrm((DEPTH, D, 6 * D), D ** -0.5),
        "b_mod": nrm((DEPTH, 6 * D), 0.02),
        "w_in": nrm((DEPTH, D, D_IN), D ** -0.5),
        "conv_w": nrm((DEPTH, CONV_WIDTH, D_CONV), CONV_WIDTH ** -0.5),
        "conv_b": nrm((DEPTH, D_CONV), 0.02),
        "conv_ln_g": 1.0 + nrm((DEPTH, D_CONV), 0.02),
        "conv_ln_b": nrm((DEPTH, D_CONV), 0.02),
        "w_a_out": nrm((DEPTH, D_CONV, D), D_CONV ** -0.5),
        "attn_sink": nrm((DEPTH, N_Q_HEADS), 0.5),
        "w_b_out": nrm((DEPTH, D_ATTN, D), D_ATTN ** -0.5),
        "mlstm_gate_b": jnp.stack([ig_b, fg_b], axis=2),
        "mlstm_norm_g": 1.0 + nrm((DEPTH, D_MLSTM), 0.02),
        "w_c_out": nrm((DEPTH, D_MLSTM, D), D_MLSTM ** -0.5),
        "w_out": nrm((DEPTH, D, D), beta * D ** -0.5),
        "ln1_g": 1.0 + nrm((DEPTH, D), 0.02),
        "ln1_b": nrm((DEPTH, D), 0.02),
        "moe_w_gu": nrm((DEPTH, N_EXPERTS, D, 2 * D_EXPERT), D ** -0.5),
        "moe_w_dn": nrm((DEPTH, N_EXPERTS, D_EXPERT, D), beta * D_EXPERT ** -0.5),
        "ln2_g": 1.0 + nrm((DEPTH, D), 0.02),
        "ln2_b": nrm((DEPTH, D), 0.02),
    }


def reference(x, c, ctx, c_ctx, ln_in_g, ln_in_b, w_router, b_router, w_mod, b_mod, w_in, conv_w, conv_b,
              conv_ln_g, conv_ln_b, w_a_out, attn_sink, w_b_out, mlstm_gate_b, mlstm_norm_g, w_c_out, w_out,
              ln1_g, ln1_b, moe_w_gu, moe_w_dn, ln2_g, ln2_b):
    B, S, D = x.shape
    L = ctx.shape[1]
    alpha = (2.0 * DEPTH) ** 0.25
    rows = S // GRID_W
    row_pos = jnp.repeat(jnp.arange(rows), GRID_W)
    col_pos = jnp.arange(rows * GRID_W) % GRID_W

    h = layer_norm(x, ln_in_g, ln_in_b)
    hc = layer_norm(ctx, ln_in_g, ln_in_b)
    silu_c = jax.nn.silu(c)
    silu_cc = jax.nn.silu(c_ctx)
    for l in range(DEPTH):
        need_ctx = l < DEPTH - 1
        sh1, sc1, g1, sh2, sc2, g2 = [t[:, None, :] for t in jnp.split(silu_c @ w_mod[l] + b_mod[l], 6, axis=-1)]
        csh1, csc1, cg1, csh2, csc2, cg2 = jnp.split(silu_cc @ w_mod[l] + b_mod[l], 6, axis=-1)

        u = h * (1 + sc1) + sh1
        uc = hc * (1 + csc1) + csh1
        y, y_ctx = token_mixer(u, uc, row_pos, col_pos, w_in[l], conv_w[l], conv_b[l], conv_ln_g[l], conv_ln_b[l],
                               w_a_out[l], attn_sink[l], w_b_out[l], mlstm_gate_b[l], mlstm_norm_g[l], w_c_out[l],
                               w_out[l], need_ctx)
        h = layer_norm(alpha * h + g1 * y, ln1_g[l], ln1_b[l])

        u2 = h * (1 + sc2) + sh2
        if need_ctx:
            hc = layer_norm(alpha * hc + cg1 * y_ctx, ln1_g[l], ln1_b[l])
            uc2 = hc * (1 + csc2) + csh2
            tokens = jnp.concatenate([u2.reshape(B * S, D), uc2.reshape(B * L, D)], axis=0)
            f = grouped_moe(tokens, w_router, b_router, moe_w_gu[l], moe_w_dn[l])
            f_lat = f[:B * S].reshape(B, S, D)
            f_ctx = f[B * S:].reshape(B, L, D)
            hc = layer_norm(alpha * hc + cg2 * f_ctx, ln2_g[l], ln2_b[l])
        else:
            f_lat = grouped_moe(u2.reshape(B * S, D), w_router, b_router, moe_w_gu[l], moe_w_dn[l]).reshape(B, S, D)
        h = layer_norm(alpha * h + g2 * f_lat, ln2_g[l], ln2_b[l])
    return h
```

```cpp
#include <hip/hip_runtime.h>
#include <cstdio>
#include <cstdint>
#ifndef MK_PER_PHASE
#define MK_PER_PHASE 1
#endif
namespace pg8 {
#define PG8_LAS __attribute__((address_space(3)))
typedef unsigned short bf16_t;
typedef short bf16x8 __attribute__((ext_vector_type(8)));
typedef float f32x4 __attribute__((ext_vector_type(4)));
typedef unsigned u32x4 __attribute__((ext_vector_type(4)));
constexpr int BM = 256, BK = 64, HALF = 128, HTB = HALF * BK * 2  , STAGE_BYTES = 8 * HTB, NXCD = 8, WGM = 8;

__host__ __device__ __forceinline__ int lds_byte(int r, int c) { const int st = (r >> 4) * 2 + (c >> 5), rr = r & 15, cc = c & 31, ob = rr * 64 + cc * 2; return st * 1024 + (ob ^ (((ob >> 9) & 1) << 5)); }
__host__ __device__ __forceinline__ void stage_rc(int b, int& R, int& C) { const int st = b / 1024, sb = b % 1024, swz = sb ^ (((sb >> 9) & 1) << 5); R = (st >> 1) * 16 + swz / 64; C = (st & 1) * 32 + (swz % 64) / 2; }
__host__ __device__ __forceinline__ int perm32(int rho) { const int n = rho >> 4, i = rho & 15; return 8 * (i >> 2) + 4 * n + (i & 3); }

struct Unit { int pm, pn; };
struct Gemm { const bf16_t* A; const bf16_t* Bt; int M, N, K; };

struct StaticOrder {
    int nM, nN, nwg, G, c;
    __host__ __device__ void init(int M, int N, int G_, int c_) { nM = M / BM; nN = N / BM; nwg = nM * nN; G = G_; c = c_; }
    __host__ __device__ bool next(int i, Unit& u) const {
        const long L = (long)i * G + c; if (L >= nwg) return false;
        int wgid = (int)L; { const int q = nwg / NXCD, r = nwg % NXCD, xcd = wgid % NXCD, off = wgid / NXCD; wgid = (xcd < r ? xcd * (q + 1) : r * (q + 1) + (xcd - r) * q) + off; }
        const int nig = WGM * nN, gid = wgid / nig, fm = gid * WGM, gsz = (nM - fm) < WGM ? (nM - fm) : WGM;
        u.pm = fm + ((wgid % nig) % gsz); u.pn = (wgid % nig) / gsz; return true;
    }
    __device__ __forceinline__ void a_ready(const Unit&) const {}
    __device__ __forceinline__ void done(const Unit&) const {}
};

__device__ __forceinline__ unsigned cvt_pk_bf16(float lo, float hi) { unsigned r; asm volatile("v_cvt_pk_bf16_f32 %0, %1, %2" : "=v"(r) : "v"(lo), "v"(hi)); return r; }
typedef float f32x2 __attribute__((ext_vector_type(2)));
template <class Epi, class Sched, bool ALIGN_EPI = false, bool SP2 = false>
__device__ __forceinline__ void gemm_phase(PG8_LAS unsigned char* lds, const Gemm g, const Sched& S, const Epi& E, const int wid_in) {
    int lid_; asm volatile("v_mbcnt_lo_u32_b32 %0, -1, 0\n\tv_mbcnt_hi_u32_b32 %0, -1, %0" : "=v"(lid_)); const int tid_ = wid_in * 64 + lid_;
    const int tid = tid_, wid = __builtin_amdgcn_readfirstlane(tid >> 6), lane = tid & 63, wr = wid >> 2, wc = wid & 3, fr = lane & 15, fq = lane >> 4;
    const int K = g.K, nt = K / BK;
    unsigned voffA[2], voffB[2];
#pragma unroll
    for (int i = 0; i < 2; ++i) { int R, C; stage_rc(tid * 16 + i * 8192, R, C); const int Rb = Epi::PERM ? ((R & ~31) + perm32(R & 31)) : R;
        voffA[i] = (unsigned)(R * K + C) * 2u; voffB[i] = (unsigned)(Rb * K + C) * 2u; }
    const size_t kstep = (size_t)(BK * 2);
    const size_t hstep = (size_t)HALF * K * 2;
    const size_t tstep = 2 * hstep;
    const unsigned ldsw = (unsigned)wid * 1024u;
    const int aoff = lds_byte(wr * 64 + fr, fq * 8), boff = lds_byte(wc * 32 + fr, fq * 8);
#define PG8_SA(b, h) (((b) * 2 + (h)) * HTB)
#define PG8_SB(b, h) ((4 + (b) * 2 + (h)) * HTB)
#define PG8_STAGE(bufoff, gbase, voff) do { _Pragma("unroll") for (int _i = 0; _i < 2; ++_i) \
        __builtin_amdgcn_global_load_lds((const unsigned*)((const char*)(gbase) + (voff)[_i]), (PG8_LAS unsigned*)(lds + (bufoff) + ldsw + _i * 8192), 16, 0, 0); } while (0)
#define PG8_LDA(dst, b, h) do { _Pragma("unroll") for (int m = 0; m < 4; ++m) _Pragma("unroll") for (int k = 0; k < 2; ++k) dst[m][k] = *(const PG8_LAS bf16x8*)(lds + PG8_SA(b, h) + aoff + m * 2048 + k * 1024); } while (0)
#define PG8_LDB(dst, b, h) do { _Pragma("unroll") for (int n = 0; n < 2; ++n) _Pragma("unroll") for (int k = 0; k < 2; ++k) dst[n][k] = *(const PG8_LAS bf16x8*)(lds + PG8_SB(b, h) + boff + n * 2048 + k * 1024); } while (0)
#define PG8_MMA(ai, bj, At, Bt) do { __builtin_amdgcn_s_setprio(1); _Pragma("unroll") for (int m = 0; m < 4; ++m) _Pragma("unroll") for (int n = 0; n < 2; ++n) _Pragma("unroll") for (int k = 0; k < 2; ++k) \
        acc[ai][bj][m][n] = __builtin_amdgcn_mfma_f32_16x16x32_bf16(Bt[n][k], At[m][k], acc[ai][bj][m][n], 0, 0, 0); __builtin_amdgcn_s_setprio(0); } while (0)
#define PG8_WAIT_V(n) asm volatile("s_waitcnt vmcnt(" #n ")" ::: "memory")
#define PG8_WAIT_L(n) asm volatile("s_waitcnt lgkmcnt(" #n ")" ::: "memory")
#define PG8_BAR __builtin_amdgcn_s_barrier()
#define PG8_SCHED __builtin_amdgcn_sched_barrier(0)
    Unit cur, nxt; int ui = 0;
    if (!S.next(0, cur)) return;
    f32x4 acc[2][2][4][2];
#pragma unroll
    for (int a = 0; a < 2; ++a)
#pragma unroll
        for (int b = 0; b < 2; ++b)
#pragma unroll
            for (int m = 0; m < 4; ++m)
#pragma unroll
                for (int n = 0; n < 2; ++n) acc[a][b][m][n] = (f32x4){0.f, 0.f, 0.f, 0.f};
    bf16x8 At[4][2], B0[2][2], B1[2][2];
    const char* cA = (const char*)g.A + (size_t)cur.pm * tstep; const char* cB = (const char*)g.Bt + (size_t)cur.pn * tstep;
    S.a_ready(cur);
    if constexpr (SP2) {
        PG8_STAGE(PG8_SB(0, 0), cB, voffB); PG8_STAGE(PG8_SB(0, 1), cB + hstep, voffB); PG8_STAGE(PG8_SA(0, 0), cA, voffA); PG8_STAGE(PG8_SA(0, 1), cA + hstep, voffA);
        if (wr == 1) PG8_BAR;
        PG8_WAIT_V(2); PG8_BAR;
        PG8_STAGE(PG8_SB(1, 0), cB + kstep, voffB); PG8_STAGE(PG8_SA(1, 0), cA + kstep, voffA); PG8_STAGE(PG8_SB(1, 1), cB + hstep + kstep, voffB);
        PG8_WAIT_V(6); PG8_BAR;
    } else {
        PG8_STAGE(PG8_SB(0, 0), cB, voffB); PG8_STAGE(PG8_SA(0, 0), cA, voffA); PG8_STAGE(PG8_SB(0, 1), cB + hstep, voffB); PG8_STAGE(PG8_SA(0, 1), cA + hstep, voffA);
        if (wr == 1) PG8_BAR;
        PG8_WAIT_V(4); PG8_BAR;
        PG8_STAGE(PG8_SB(1, 0), cB + kstep, voffB); PG8_STAGE(PG8_SA(1, 0), cA + kstep, voffA); PG8_STAGE(PG8_SB(1, 1), cB + hstep + kstep, voffB);
        PG8_WAIT_V(6); PG8_BAR;
    }
    for (;;) {
        const bool has_next = S.next(ui + 1, nxt);
        const char* nA = has_next ? (const char*)g.A + (size_t)nxt.pm * tstep : cA; const char* nB = has_next ? (const char*)g.Bt + (size_t)nxt.pn * tstep : cB;
        for (int t = 0; t < nt; t += 2) {
            const bool last = (t == nt - 2);
            if constexpr (Epi::RESCALE) { if (t == 8 || t == 16) E.rescale(acc, cur, t >> 3, wr, wc, fr, fq); }
            const char* a1 = cA + (size_t)(t + 1) * kstep;
            const char* a2 = last ? nA : cA + (size_t)(t + 2) * kstep; const char* b2 = last ? nB : cB + (size_t)(t + 2) * kstep;
            const char* a3 = a2 + kstep; const char* b3 = b2 + kstep;
            if (last && has_next) S.a_ready(nxt);
            if constexpr (SP2) {
            PG8_LDB(B0, 0, 0); PG8_LDB(B1, 0, 1); PG8_SCHED; PG8_LDA(At, 0, 0); PG8_STAGE(PG8_SA(1, 1), a1 + hstep, voffA);
            PG8_WAIT_V(8); PG8_WAIT_L(0); PG8_BAR; PG8_MMA(0, 0, At, B0); PG8_MMA(0, 1, At, B1); PG8_BAR; PG8_SCHED;
            PG8_LDA(At, 0, 1); PG8_STAGE(PG8_SB(0, 0), b2, voffB); PG8_STAGE(PG8_SB(0, 1), b2 + hstep, voffB); PG8_STAGE(PG8_SA(0, 0), a2, voffA);
            PG8_WAIT_V(8); PG8_WAIT_L(0); PG8_BAR; PG8_MMA(1, 0, At, B0); PG8_MMA(1, 1, At, B1); PG8_BAR; PG8_SCHED;
            PG8_LDB(B0, 1, 0); PG8_LDB(B1, 1, 1); PG8_SCHED; PG8_LDA(At, 1, 0); PG8_STAGE(PG8_SA(0, 1), a2 + hstep, voffA);
            PG8_WAIT_V(8); PG8_WAIT_L(0); PG8_BAR; PG8_MMA(0, 0, At, B0); PG8_MMA(0, 1, At, B1); PG8_BAR; PG8_SCHED;
            PG8_LDA(At, 1, 1); PG8_STAGE(PG8_SB(1, 0), b3, voffB); PG8_STAGE(PG8_SB(1, 1), b3 + hstep, voffB); PG8_STAGE(PG8_SA(1, 0), a3, voffA);
            PG8_WAIT_V(8); PG8_WAIT_L(0); PG8_BAR; PG8_MMA(1, 0, At, B0); PG8_MMA(1, 1, At, B1); PG8_BAR; PG8_SCHED;
            } else {
            PG8_LDB(B0, 0, 0); PG8_SCHED; PG8_LDA(At, 0, 0); PG8_STAGE(PG8_SA(1, 1), a1 + hstep, voffA);
            PG8_WAIT_L(8); PG8_BAR; PG8_WAIT_L(0); PG8_MMA(0, 0, At, B0); PG8_BAR; PG8_SCHED;
            PG8_LDB(B1, 0, 1); PG8_STAGE(PG8_SB(0, 0), b2, voffB);
            PG8_BAR; PG8_WAIT_L(0); PG8_MMA(0, 1, At, B1); PG8_BAR;
            PG8_LDA(At, 0, 1); PG8_STAGE(PG8_SA(0, 0), a2, voffA);
            PG8_BAR; PG8_WAIT_L(0); PG8_MMA(1, 0, At, B0); PG8_BAR; PG8_SCHED;
            PG8_STAGE(PG8_SB(0, 1), b2 + hstep, voffB);
            PG8_WAIT_V(6); PG8_BAR; PG8_MMA(1, 1, At, B1); PG8_BAR;
            PG8_LDB(B0, 1, 0); PG8_SCHED; PG8_LDA(At, 1, 0); PG8_STAGE(PG8_SA(0, 1), a2 + hstep, voffA);
            PG8_WAIT_L(8); PG8_BAR; PG8_WAIT_L(0); PG8_MMA(0, 0, At, B0); PG8_BAR; PG8_SCHED;
            PG8_LDB(B1, 1, 1); PG8_STAGE(PG8_SB(1, 0), b3, voffB);
            PG8_BAR; PG8_WAIT_L(0); PG8_MMA(0, 1, At, B1); PG8_BAR;
            PG8_LDA(At, 1, 1); PG8_STAGE(PG8_SA(1, 0), a3, voffA);
            PG8_BAR; PG8_WAIT_L(0); PG8_MMA(1, 0, At, B0); PG8_BAR; PG8_SCHED;
            PG8_STAGE(PG8_SB(1, 1), b3 + hstep, voffB);
            PG8_WAIT_V(6); PG8_BAR; PG8_MMA(1, 1, At, B1); PG8_BAR;
            }
        }
        if constexpr (ALIGN_EPI) { if (wr == 0) PG8_BAR; }
        if constexpr (!Epi::AFTER_DRAIN) { E(acc, cur, wr, wc, fr, fq); S.done(cur); }
        if (!has_next) break;
#pragma unroll
        for (int a = 0; a < 2; ++a)
#pragma unroll
            for (int b = 0; b < 2; ++b)
#pragma unroll
                for (int m = 0; m < 4; ++m)
#pragma unroll
                    for (int n = 0; n < 2; ++n) acc[a][b][m][n] = (f32x4){0.f, 0.f, 0.f, 0.f};
        cur = nxt; cA = nA; cB = nB; ++ui;
        if constexpr (ALIGN_EPI) { if (wr == 1) PG8_BAR; }
    }
    PG8_WAIT_V(0);
    if constexpr (!ALIGN_EPI) { if (wr == 0) PG8_BAR; }
    PG8_BAR;
    if constexpr (Epi::AFTER_DRAIN) { E.fused(acc, cur, wr, wc, fr, fq, lds, wid, lane); S.done(cur); }
#undef PG8_SA
#undef PG8_SB
#undef PG8_STAGE
#undef PG8_LDA
#undef PG8_LDB
#undef PG8_MMA
#undef PG8_WAIT_V
#undef PG8_WAIT_L
#undef PG8_BAR
#undef PG8_SCHED
}
}

#ifndef MK_ABL_A
#define MK_ABL_A 1.0f
#endif
#ifndef MK_ABL_B
#define MK_ABL_B 1.0f
#endif
#ifndef MK_ABL_C
#define MK_ABL_C 1.0f
#endif
#ifndef MK_ABL_F
#define MK_ABL_F 1.0f
#endif
constexpr int NWAVES = 8;
constexpr int D = 1024, NBATCH = 8, SEQ = 2048, LCTX = 256, DEPTH = 2;
constexpr int M_LAT = NBATCH * SEQ, M_CTX = NBATCH * LCTX, M_ALL = M_LAT + M_CTX;
constexpr int D_IN = 6928, NP = 6912;
constexpr int PA_VAL = 0, PA_GATE = 512, PQ = 1024, PK = 1536, PV = 1664, PMQ = 1792, PMK = 2304, PMV = 2816, PMO = 3328, PBG = 3840;
constexpr int SRC_MG = 3840;
constexpr int NE = 16, DEXP = 512, NY = 1536;
constexpr float LN_EPS = 1e-5f, ALPHA = 1.41421356237309515f;
constexpr float KSCALE = 0.08838834764831845f;
enum { I_X = 0, I_C, I_CTX, I_CCTX, I_LNIN_G, I_LNIN_B, I_WROUTER, I_BROUTER, I_WMOD, I_BMOD, I_WIN, I_CONVW, I_CONVB, I_CONVLN_G, I_CONVLN_B, I_WA, I_SINK, I_WB, I_GATEB, I_NORMG, I_WC, I_WOUT,
       I_LN1G, I_LN1B, I_WGU, I_WDN, I_LN2G, I_LN2B, N_IN };
static_assert(N_IN == 28, "inputs");

constexpr size_t MiB = 1u << 20;
constexpr size_t WS_CTL = 0, CTL_ZERO_BYTES = 1 * MiB;
constexpr size_t WS_MOD = 1 * MiB;
constexpr size_t WS_ROPE = 1 * MiB + 512 * 1024;
constexpr size_t WS_G = 2 * MiB;
constexpr size_t WS_ROUTE = 4 * MiB;
constexpr size_t WS_BCNT = 4 * MiB + 768 * 1024;
constexpr size_t WS_ROWMAP = 5 * MiB;
constexpr size_t WS_ROWW = 5 * MiB + 256 * 1024;
constexpr size_t WS_HC = 6 * MiB;
constexpr size_t WS_W = 14 * MiB;
constexpr size_t W_IN = 0, W_ABC = W_IN + (size_t)NP * D * 2, W_OUT = W_ABC + (size_t)D * NY * 2, W_GU = W_OUT + (size_t)D * D * 2, W_DN = W_GU + (size_t)NE * D * D * 2, W_LAYER = W_DN + (size_t)NE * D * DEXP * 2;
constexpr size_t WS_P = WS_W + 2 * W_LAYER;
constexpr size_t WS_U = WS_P + (size_t)M_ALL * NP * 2;
constexpr size_t WS_Y = WS_U + (size_t)M_ALL * D * 2;
constexpr size_t WS_END = WS_Y + (size_t)M_ALL * NY * 2;
constexpr int AS_ROWS = 40960;
constexpr size_t WS_AS = WS_P;
constexpr size_t WS_ACT = WS_AS + (size_t)AS_ROWS * D * 2;
constexpr size_t WS_F = WS_ACT + (size_t)AS_ROWS * DEXP * 2;
static_assert(WS_F + (size_t)M_ALL * 2 * D * 2 <= WS_U, "MoE buffers overlay P");
static_assert(W_LAYER == 69730304 && WS_W % 256 == 0 && WS_P % 256 == 0 && WS_U % 256 == 0 && WS_Y % 256 == 0, "map");
constexpr size_t WS_HF = WS_U, WS_HB = WS_U + (size_t)M_ALL * 512 * 2;
constexpr int CW_TMO = 0, CW_CODE = 1;
constexpr int CW_CNT = 256;
constexpr int CW_BAR = 4096;

constexpr int RING_BYTES = 131072, LDSCTL_OFF = RING_BYTES, MISC_OFF = LDSCTL_OFF + 320, LDS_BYTES = 147456;

#define GAS __attribute__((address_space(1)))
#define LAS __attribute__((address_space(3)))
typedef unsigned short bf16;
typedef unsigned v4u __attribute__((ext_vector_type(4)));
typedef unsigned v2u __attribute__((ext_vector_type(2)));
typedef float f32x4 __attribute__((ext_vector_type(4)));
typedef float f32x16 __attribute__((ext_vector_type(16)));
typedef short bf16x8 __attribute__((ext_vector_type(8)));
typedef GAS unsigned gu32;
#define RLX_AGENT __ATOMIC_RELAXED, __HIP_MEMORY_SCOPE_AGENT
#define LDS_WAIT() asm volatile("s_waitcnt lgkmcnt(0)" ::: "memory")
#define VM_WAIT() asm volatile("s_waitcnt vmcnt(0)" ::: "memory")
__device__ __forceinline__ unsigned f2bf(float f) { unsigned u = __builtin_bit_cast(unsigned, f); return (u + 0x7fffu + ((u >> 16) & 1u)) >> 16; }
typedef float f32x2_t __attribute__((ext_vector_type(2)));
typedef __bf16 bf16x2_t __attribute__((ext_vector_type(2)));
__device__ __forceinline__ unsigned pk2(float lo, float hi) { const f32x2_t v = {lo, hi}; const bf16x2_t b = __builtin_convertvector(v, bf16x2_t); return __builtin_bit_cast(unsigned, b); }
__device__ __forceinline__ float bflo(unsigned w) { return __builtin_bit_cast(float, w << 16); }
__device__ __forceinline__ float bfhi(unsigned w) { return __builtin_bit_cast(float, w & 0xffff0000u); }
__device__ __forceinline__ float bf1(bf16 v) { return __builtin_bit_cast(float, (unsigned)v << 16); }
__device__ __forceinline__ float sigmoidf_(float x) { return 1.0f / (1.0f + __expf(-x)); }
__device__ __forceinline__ int lane_id() { int l; asm volatile("v_mbcnt_lo_u32_b32 %0, -1, 0\n\tv_mbcnt_hi_u32_b32 %0, -1, %0" : "=v"(l)); return l; }
__device__ __forceinline__ float shidx(float v, int src) { return __builtin_bit_cast(float, __builtin_amdgcn_ds_bpermute(src << 2, __builtin_bit_cast(int, v))); }
__device__ __forceinline__ float shx(float v, int mask, int lane) { return shidx(v, lane ^ mask); }
__device__ __forceinline__ float shup(float v, int o, int lane) { return shidx(v, lane >= o ? lane - o : lane); }
__device__ __forceinline__ float wave_sum(float v, int lane) {
#pragma unroll
    for (int o = 1; o < 64; o <<= 1) v += shx(v, o, lane);
    return v;
}
__device__ __forceinline__ void unpack8(v4u w, float (&f)[8]) { f[0] = bflo(w.x); f[1] = bfhi(w.x); f[2] = bflo(w.y); f[3] = bfhi(w.y); f[4] = bflo(w.z); f[5] = bfhi(w.z); f[6] = bflo(w.w); f[7] = bfhi(w.w); }
__device__ __forceinline__ v4u pack8(const float (&f)[8]) { v4u w; w.x = pk2(f[0], f[1]); w.y = pk2(f[2], f[3]); w.z = pk2(f[4], f[5]); w.w = pk2(f[6], f[7]); return w; }

#define XB_TMO      128
#define XB_XCNT(j)  (256  + 64 * (j))
#define XB_XSUB(j)  (1280 + 64 * (j))
#define XB_XGEN(j)  (2304 + 64 * (j))
#define XB_TOP      3328
#define XB_TOPGEN   3392
#define XCD_BAR_WORDS 3456
#define XB_SPIN_CAP (1u << 18)

__device__ __forceinline__ unsigned xb_ld(unsigned* p)              { return __hip_atomic_load(p, __ATOMIC_RELAXED, __HIP_MEMORY_SCOPE_AGENT); }
__device__ __forceinline__ unsigned xb_add(unsigned* p, unsigned) { unsigned one; asm volatile("v_mov_b32 %0, 1" : "=v"(one));
    return __hip_atomic_fetch_add(p, one, __ATOMIC_RELAXED, __HIP_MEMORY_SCOPE_AGENT); }
__device__ __forceinline__ unsigned xb_xcc_id() { return (unsigned)__builtin_amdgcn_s_getreg((3 << 11) | 20) & 0xFu; }
#define XB_SPIN(cond, bar) do { unsigned _sp = 0; while (cond) { __builtin_amdgcn_s_sleep(1); \
    if ((++_sp & 255u) == 0u) { if (xb_ld(&(bar)[XB_TMO])) break; if (_sp > XB_SPIN_CAP) { (void)xb_add(&(bar)[XB_TMO], 1u); break; } } } } while (0)

struct XcdBarrier {
    bool w0;
    unsigned* bar; unsigned x;
    volatile LAS unsigned* st;
};

__device__ __forceinline__ XcdBarrier xcd_barrier_post(unsigned* bar, volatile LAS unsigned* st) {
    XcdBarrier b; b.w0 = false; b.bar = bar; b.x = xb_xcc_id(); b.st = st;
    if (threadIdx.x == 0) (void)xb_add(&bar[XB_XCNT(b.x)], 1u);
    return b;
}
__device__ __forceinline__ void xcd_barrier_complete(unsigned* bar, unsigned x, unsigned& nloc, unsigned& nx) {
    const unsigned G = gridDim.x * gridDim.y * gridDim.z;
    unsigned sum, cnt, mine, sp = 0u;
    for (;;) {
        sum = 0u; cnt = 0u; mine = 0u;
#pragma unroll
        for (unsigned j = 0; j < 16; ++j) { const unsigned c = xb_ld(&bar[XB_XCNT(j)]); sum += c; cnt += (c > 0u) ? 1u : 0u; mine = (j == x) ? c : mine; }
        if (sum == G) break;
        __builtin_amdgcn_s_sleep(1);
        if ((++sp & 255u) == 0u) { if (xb_ld(&bar[XB_TMO])) break; if (sp > XB_SPIN_CAP) { (void)xb_add(&bar[XB_TMO], 1u); break; } }
    }
    nloc = mine > 0u ? mine : 1u; nx = cnt > 0u ? cnt : 1u;
}

__device__ __forceinline__ void xcd_barrier(const XcdBarrier& b) {
    asm volatile("s_waitcnt vmcnt(0)" ::: "memory");
    __syncthreads();
    if (b.w0 && lane_id() == 0) {
        unsigned* bar = b.bar;
        __builtin_amdgcn_s_waitcnt(0);
        unsigned nloc = b.st[0], nx = b.st[1];
        if (nloc == 0u) { xcd_barrier_complete(bar, b.x, nloc, nx); b.st[0] = nloc; b.st[1] = nx; }
        const unsigned old = xb_add(&bar[XB_XSUB(b.x)], 1u);
        const unsigned gen = old / nloc;
        if (old + 1u == (gen + 1u) * nloc) {
            __builtin_amdgcn_fence(__ATOMIC_RELEASE, "agent");
            asm volatile("s_waitcnt vmcnt(0)" ::: "memory");
            const unsigned og = xb_add(&bar[XB_TOP], 1u);
            const unsigned tg = og / nx;
            if (og + 1u == (tg + 1u) * nx) xb_add(&bar[XB_TOPGEN], 1u);
            else XB_SPIN(xb_ld(&bar[XB_TOPGEN]) == tg, bar);
            __builtin_amdgcn_fence(__ATOMIC_ACQUIRE, "agent");
            xb_add(&bar[XB_XGEN(b.x)], 1u);
            asm volatile("s_waitcnt vmcnt(0)" ::: "memory");
        } else {
            XB_SPIN(xb_ld(&bar[XB_XGEN(b.x)]) == gen, bar);
            __builtin_amdgcn_fence(__ATOMIC_ACQUIRE, "agent");
            asm volatile("s_waitcnt vmcnt(0)" ::: "memory");
        }
    }
    __syncthreads();
}

struct Ctx {
    LAS unsigned char* lds;
    volatile LAS unsigned* MISC;
    unsigned* ctl;
    int tid, lane, wave, vcu, G;
    const float* const* in; float* out; unsigned char* ws;
};
__device__ __forceinline__ bf16* wt(const Ctx& F, int l, size_t off) { return (bf16*)(F.ws + WS_W + (size_t)l * W_LAYER + off); }
__device__ __forceinline__ float* hrow(const Ctx& F, int r) { return r < M_LAT ? F.out + (size_t)r * D : (float*)(F.ws + WS_HC) + (size_t)(r - M_LAT) * D; }
__device__ __forceinline__ const float* xrow(const Ctx& F, int r) { return r < M_LAT ? F.in[I_X] + (size_t)r * D : F.in[I_CTX] + (size_t)(r - M_LAT) * D; }
__device__ __forceinline__ int modrow(int r) { return r < M_LAT ? (r >> 11) : 8; }
__device__ __forceinline__ const float* modp(const Ctx& F, int l, int mr) { return (const float*)(F.ws + WS_MOD) + (size_t)(l * 9 + mr) * 6144; }

__device__ __forceinline__ void load_row(const float* p, int lane, f32x4 (&v)[4]) {
#pragma unroll
    for (int j = 0; j < 4; ++j) v[j] = *(const f32x4*)(p + 4 * lane + 256 * j);
}
__device__ __forceinline__ void store_row(float* p, int lane, const f32x4 (&v)[4]) {
#pragma unroll
    for (int j = 0; j < 4; ++j) *(f32x4*)(p + 4 * lane + 256 * j) = v[j];
}
__device__ __forceinline__ void ln_row(f32x4 (&v)[4], const float* g, const float* b, int lane) {
    float s = 0.f;
#pragma unroll
    for (int j = 0; j < 4; ++j) s += (v[j].x + v[j].y) + (v[j].z + v[j].w);
    const float mean = wave_sum(s, lane) * (1.f / D); float s2 = 0.f;
#pragma unroll
    for (int j = 0; j < 4; ++j) { v[j] = v[j] - mean; s2 += (v[j].x * v[j].x + v[j].y * v[j].y) + (v[j].z * v[j].z + v[j].w * v[j].w); }
    const float rstd = 1.f / sqrtf(wave_sum(s2, lane) * (1.f / D) + LN_EPS);
#pragma unroll
    for (int j = 0; j < 4; ++j) { const f32x4 gg = *(const f32x4*)(g + 4 * lane + 256 * j), bb = *(const f32x4*)(b + 4 * lane + 256 * j); v[j] = v[j] * rstd * gg + bb; }
}
__device__ __forceinline__ void emit_u(const f32x4 (&h)[4], const float* sh, const float* sc, bf16* urow, int lane, f32x4 (&u)[4]) {
#pragma unroll
    for (int j = 0; j < 4; ++j) { const f32x4 s1 = *(const f32x4*)(sc + 4 * lane + 256 * j), s0 = *(const f32x4*)(sh + 4 * lane + 256 * j); u[j] = h[j] * (1.0f + s1) + s0;
        v2u w; w.x = pk2(u[j].x, u[j].y); w.y = pk2(u[j].z, u[j].w); *(v2u*)(urow + 4 * lane + 256 * j) = w; }
}
__device__ __forceinline__ void stage_w16(const Ctx& F, const float* W, int ld, LAS float* Wt) {
    for (int idx = F.tid; idx < 1024 * 16; idx += NWAVES * 64) { const int k = idx >> 4, e = idx & 15; Wt[e * 1024 + k] = W[(size_t)k * ld + e]; }
}
__device__ __forceinline__ void dot16(const f32x4 (&u)[4], const LAS float* Wt, int lane, float (&o)[16]) {
    const LAS float* wl = Wt + 4 * lane;
#pragma unroll
    for (int e = 0; e < 16; ++e) { float s = 0.f;
#pragma unroll
        for (int j = 0; j < 4; ++j) { const f32x4 w = *(const LAS f32x4*)(wl + e * 1024 + 256 * j); s += (u[j].x * w.x + u[j].y * w.y) + (u[j].z * w.z + u[j].w * w.w); }
        o[e] = wave_sum(s, lane);
        if ((e & 3) == 3) asm volatile("" ::: "memory"); }
}
#if defined(MK_DOT16_GLOBAL)
__device__ __forceinline__ void dot16g(const f32x4 (&u)[4], const float* W, int ld, int lane, float (&o)[16]) {
#pragma unroll
    for (int e = 0; e < 16; ++e) o[e] = 0.f;
#pragma unroll
    for (int j = 0; j < 4; ++j)
#pragma unroll
        for (int c = 0; c < 4; ++c) { const float uv = u[j][c]; const float* wr = W + (size_t)(256 * j + 4 * lane + c) * ld;
#pragma unroll
            for (int q = 0; q < 4; ++q) { const f32x4 w = *(const f32x4*)(wr + 4 * q); o[4 * q] += uv * w.x; o[4 * q + 1] += uv * w.y; o[4 * q + 2] += uv * w.z; o[4 * q + 3] += uv * w.w; } }
#pragma unroll
    for (int e = 0; e < 16; ++e) o[e] = wave_sum(o[e], lane);
}
#endif
__device__ __forceinline__ void emit_layer_input(const Ctx& F, int l, int r, const f32x4 (&h)[4]) {
    const float* mp = modp(F, l, modrow(r)); f32x4 u[4];
    emit_u(h, mp + 0, mp + 1024, (bf16*)(F.ws + WS_U) + (size_t)r * D, F.lane, u);
    float o[16];
#if defined(MK_DOT16_GLOBAL)
    dot16g(u, F.in[I_WIN] + (size_t)l * D * D_IN + SRC_MG, D_IN, F.lane, o);
#else
    dot16(u, (const LAS float*)F.lds, F.lane, o);
#endif
    if (F.lane == 0) { float* gp = (float*)(F.ws + WS_G) + (size_t)r * 16;
#pragma unroll
        for (int q = 0; q < 4; ++q) *(f32x4*)(gp + 4 * q) = (f32x4){o[4 * q], o[4 * q + 1], o[4 * q + 2], o[4 * q + 3]}; }
}

__device__ __forceinline__ void tr_item(const float* W, int ldw, int k0, int n0, bf16* WT, int ldt, int drow0, int dk0, LAS float* scr, int lane) {
#pragma unroll 8
    for (int i = 0; i < 32; ++i) { const int kk = 2 * i + (lane >> 5); scr[kk * 33 + (lane & 31)] = W[(size_t)(k0 + kk) * ldw + n0 + (lane & 31)]; }
    LDS_WAIT(); asm volatile("" ::: "memory");
    const int c = lane & 7;
#pragma unroll
    for (int j = 0; j < 4; ++j) { const int n = (lane >> 3) + 8 * j; const LAS float* s = scr + (8 * c) * 33 + n;
        v4u o; o.x = pk2(s[0 * 33], s[1 * 33]); o.y = pk2(s[2 * 33], s[3 * 33]); o.z = pk2(s[4 * 33], s[5 * 33]); o.w = pk2(s[6 * 33], s[7 * 33]);
        *(v4u*)(WT + (size_t)(drow0 + n) * ldt + dk0 + k0 + 8 * c) = o; }
    LDS_WAIT(); asm volatile("" ::: "memory");
}
constexpr int CV_IN = 16 * (NP / 32), CV_ABC = 3 * 8 * 32, CV_OUT = 16 * 32, CV_GU = NE * 16 * 32, CV_DN = NE * 8 * 32, CV_LAYER = CV_IN + CV_ABC + CV_OUT + CV_GU + CV_DN;
__device__ __forceinline__ void convert_item(const Ctx& F, int l, int it, LAS float* scr) {
    const int lane = F.lane;
    if (it < CV_IN) { const int kb = it / (NP / 32), nb = it % (NP / 32), n0 = 32 * nb;
        tr_item(F.in[I_WIN] + (size_t)l * D * D_IN, D_IN, 64 * kb, n0 < PBG ? n0 : n0 + 16, wt(F, l, W_IN), D, n0, 0, scr, lane); return; }
    it -= CV_IN;
    if (it < CV_ABC) { const int br = it / 256, r = it % 256, kb = r / 32, nb = r % 32;
        if (br == 0) tr_item(F.in[I_WA] + (size_t)l * 512 * D, D, 64 * kb, 32 * nb, wt(F, l, W_ABC), NY, 32 * nb, 0, scr, lane);
        else if (br == 1) tr_item(F.in[I_WB] + (size_t)l * 512 * D, D, 64 * kb, 32 * nb, wt(F, l, W_ABC), NY, 32 * nb, 512, scr, lane);
        else tr_item(F.in[I_WC] + (size_t)l * 512 * D, D, 64 * kb, 32 * nb, wt(F, l, W_ABC), NY, 32 * nb, 1024, scr, lane);
        return; }
    it -= CV_ABC;
    if (it < CV_OUT) { const int kb = it / 32, nb = it % 32; tr_item(F.in[I_WOUT] + (size_t)l * D * D, D, 64 * kb, 32 * nb, wt(F, l, W_OUT), D, 32 * nb, 0, scr, lane); return; }
    it -= CV_OUT;
    if (it < CV_GU) { const int e = it / 512, r = it % 512, kb = r / 32, nb = r % 32, n0 = 32 * nb;
        const int dr = n0 < 512 ? (n0 / 128) * 256 + (n0 % 128) : ((n0 - 512) / 128) * 256 + 128 + ((n0 - 512) % 128);
        tr_item(F.in[I_WGU] + (size_t)(l * NE + e) * D * D, D, 64 * kb, n0, wt(F, l, W_GU) + (size_t)e * D * D, D, dr, 0, scr, lane); return; }
    it -= CV_GU;
    { const int e = it / 256, r = it % 256, kb = r / 32, nb = r % 32;
        tr_item(F.in[I_WDN] + (size_t)(l * NE + e) * DEXP * D, D, 64 * kb, 32 * nb, wt(F, l, W_DN) + (size_t)e * D * DEXP, DEXP, 32 * nb, 0, scr, lane); }
}
__device__ __forceinline__ void p0_prologue(const Ctx& F) {
    if (F.vcu < 192) {
        LAS float* S = (LAS float*)F.lds; LAS float* red = (LAS float*)(F.lds + 36864);
        for (int idx = F.tid; idx < 9 * D; idx += NWAVES * 64) { const int r = idx >> 10, k = idx & 1023; const float v = r < 8 ? F.in[I_C][r * D + k] : F.in[I_CCTX][k]; S[idx] = v * sigmoidf_(v); }
        __syncthreads();
        const int l = F.vcu / 96, n0 = (F.vcu % 96) * 64;
        float acc[9];
#pragma unroll
        for (int r = 0; r < 9; ++r) acc[r] = 0.f;
        const float* wp = F.in[I_WMOD] + ((size_t)l * D + 128 * F.wave) * 6144 + n0 + F.lane;
#pragma unroll 4
        for (int kk = 0; kk < 128; ++kk) { const float wv = wp[(size_t)kk * 6144];
#pragma unroll
            for (int r = 0; r < 9; ++r) acc[r] += S[r * D + 128 * F.wave + kk] * wv; }
#pragma unroll
        for (int r = 0; r < 9; ++r) red[(F.wave * 9 + r) * 64 + F.lane] = acc[r];
        __syncthreads();
        for (int idx = F.tid; idx < 9 * 64; idx += NWAVES * 64) { const int r = idx >> 6, c = idx & 63; float s = 0.f;
#pragma unroll
            for (int w = 0; w < 8; ++w) s += red[(w * 9 + r) * 64 + c];
            ((float*)(F.ws + WS_MOD))[(size_t)(l * 9 + r) * 6144 + n0 + c] = s + F.in[I_BMOD][l * 6144 + n0 + c]; }
        __syncthreads();
    }
    if (F.vcu == 255) for (int idx = F.tid; idx < 1024; idx += NWAVES * 64) { const int pos = idx >> 4, i = idx & 15;
        const float inv = i == 0 ? 1.000000000e+00f : i == 1 ? 5.623413324e-01f : i == 2 ? 3.162277639e-01f : i == 3 ? 1.778279394e-01f : i == 4 ? 1.000000015e-01f : i == 5 ? 5.623413250e-02f : i == 6 ? 3.162277490e-02f : i == 7 ? 1.778279431e-02f :
                          i == 8 ? 9.999999776e-03f : i == 9 ? 5.623413250e-03f : i == 10 ? 3.162277630e-03f : i == 11 ? 1.778279431e-03f : i == 12 ? 1.000000047e-03f : i == 13 ? 5.623413017e-04f : i == 14 ? 3.162277571e-04f : 1.778279402e-04f;
        const float angf = (float)pos * inv; const double x = (double)angf;
        const double kq = __builtin_rint(x * 0.63661977236758134308); const double r = (x - kq * 1.57079632679489655800) - kq * 6.123233995736766036e-17; const int q = ((int)kq) & 3;
        const double r2 = r * r;
        const double sn = r * (1.0 + r2 * (-1.0 / 6 + r2 * (1.0 / 120 + r2 * (-1.0 / 5040 + r2 * (1.0 / 362880 + r2 * (-1.0 / 39916800 + r2 * (1.0 / 6227020800.0)))))));
        const double cs = 1.0 + r2 * (-0.5 + r2 * (1.0 / 24 + r2 * (-1.0 / 720 + r2 * (1.0 / 40320 + r2 * (-1.0 / 3628800 + r2 * (1.0 / 479001600.0 + r2 * (-1.0 / 87178291200.0)))))));
        const double c = q == 0 ? cs : q == 1 ? -sn : q == 2 ? -cs : sn, s_ = q == 0 ? sn : q == 1 ? cs : q == 2 ? -sn : -cs;
        ((float*)(F.ws + WS_ROPE))[2 * idx] = (float)c; ((float*)(F.ws + WS_ROPE))[2 * idx + 1] = (float)s_; }
    LAS float* scr = (LAS float*)(F.lds + F.wave * 16384);
    const int gw = F.vcu * NWAVES + F.wave, NGW = F.G * NWAVES;
    for (int it = gw; it < 2 * CV_LAYER; it += NGW) convert_item(F, it / CV_LAYER, it % CV_LAYER, scr);
}
__device__ __forceinline__ void p1_ln_in(const Ctx& F) {
    const int gw = F.vcu * NWAVES + F.wave, NGW = F.G * NWAVES;
    stage_w16(F, F.in[I_WIN] + SRC_MG, D_IN, (LAS float*)F.lds); __syncthreads();
    for (int r = gw; r < M_ALL; r += NGW) { f32x4 v[4]; load_row(xrow(F, r), F.lane, v); ln_row(v, F.in[I_LNIN_G], F.in[I_LNIN_B], F.lane); store_row(hrow(F, r), F.lane, v); emit_layer_input(F, 0, r, v); }
}

__device__ __forceinline__ void conv_unit(const Ctx& F, int l, int unit) {
    const bf16* P = (const bf16*)(F.ws + WS_P); bf16* Y = (bf16*)(F.ws + WS_Y);
    int seq0, T, t0;
    if (unit < 512) { const int b = unit >> 6; seq0 = b * SEQ; T = SEQ; t0 = (unit & 63) * 32; }
    else { const int j = unit - 512, b = j >> 3; seq0 = M_LAT + b * LCTX; T = LCTX; t0 = (j & 7) * 32; }
    const int c = F.tid;
    float w[31];
#pragma unroll
    for (int j = 0; j < 31; ++j) w[j] = F.in[I_CONVW][(size_t)(l * 31 + j) * 512 + c];
    const float bias = F.in[I_CONVB][l * 512 + c];
    float u[62];
#pragma unroll
    for (int i = 0; i < 62; ++i) { const int t = t0 - 15 + i; float uv = 0.f;
        if (t >= 0 && t < T) { const bf16* pr = P + (size_t)(seq0 + t) * NP; const float val = bf1(pr[PA_VAL + c]), gate = bf1(pr[PA_GATE + c]); uv = val * sigmoidf_(gate); }
        u[i] = uv; }
    LAS float* Yt = (LAS float*)F.lds;
#pragma unroll
    for (int tt = 0; tt < 32; ++tt) { float y = bias;
#pragma unroll
        for (int j = 0; j < 31; ++j) y += w[j] * u[tt + j];
        Yt[tt * 512 + c] = y; }
    __syncthreads();
    const float* lg = F.in[I_CONVLN_G] + l * 512; const float* lb = F.in[I_CONVLN_B] + l * 512;
#pragma unroll
    for (int q = 0; q < 4; ++q) { const int tt = 4 * F.wave + q; float v[8]; float s = 0.f;
#pragma unroll
        for (int jj = 0; jj < 8; ++jj) { v[jj] = Yt[tt * 512 + F.lane + 64 * jj]; s += v[jj]; }
        const float mean = wave_sum(s, F.lane) * (1.f / 512.f); float s2 = 0.f;
#pragma unroll
        for (int jj = 0; jj < 8; ++jj) { v[jj] -= mean; s2 += v[jj] * v[jj]; }
        const float rstd = 1.f / sqrtf(wave_sum(s2, F.lane) * (1.f / 512.f) + LN_EPS);
        bf16* yr = Y + (size_t)(seq0 + t0 + tt) * NY;
#pragma unroll
        for (int jj = 0; jj < 8; ++jj) { const int cc = F.lane + 64 * jj; const float z = v[jj] * rstd * lg[cc] + lb[cc]; yr[cc] = (bf16)f2bf(MK_ABL_A * z * sigmoidf_(z)); } }
    __syncthreads();
}

constexpr int AT_KSTR = 72, AT_VSTR = 136, AT_KS_OFF = 0, AT_VT_OFF = 128 * AT_KSTR * 2;
__device__ __forceinline__ void attn_stage_tile(const Ctx& F, const bf16* P, int krow0, int hk, bool rope, int tok0) {
    LAS bf16* Ks = (LAS bf16*)(F.lds + AT_KS_OFF); LAS bf16* Vt = (LAS bf16*)(F.lds + AT_VT_OFF);
    const int key = F.tid >> 2, pc = F.tid & 3;
    { const int c1 = pc < 2 ? pc : pc + 2, c2 = c1 + 2;
        const bf16* src = P + (size_t)(krow0 + key) * NP + PK + hk * 64;
        v4u x1 = *(const v4u*)(src + 8 * c1), x2 = *(const v4u*)(src + 8 * c2);
        if (rope) { const int tok = tok0 + key, pos = pc < 2 ? (tok >> 6) : (tok & 63), ib = 8 * (pc & 1);
            const float* rt = (const float*)(F.ws + WS_ROPE) + (size_t)(pos * 16 + ib) * 2;
            float a[8], b[8], oa[8], ob[8]; unpack8(x1, a); unpack8(x2, b);
#pragma unroll
            for (int j = 0; j < 8; ++j) { const float cs = rt[2 * j], sn = rt[2 * j + 1]; oa[j] = a[j] * cs - b[j] * sn; ob[j] = a[j] * sn + b[j] * cs; }
            x1 = pack8(oa); x2 = pack8(ob); }
        *(LAS v4u*)(Ks + key * AT_KSTR + 8 * c1) = x1; *(LAS v4u*)(Ks + key * AT_KSTR + 8 * c2) = x2; }
    { const bf16* src = P + (size_t)(krow0 + key) * NP + PV + hk * 64 + 16 * pc;
        const v4u y1 = *(const v4u*)(src), y2 = *(const v4u*)(src + 8);
        const unsigned ww[8] = {y1.x, y1.y, y1.z, y1.w, y2.x, y2.y, y2.z, y2.w};
#pragma unroll
        for (int j = 0; j < 8; ++j) { Vt[(16 * pc + 2 * j) * AT_VSTR + key] = (bf16)(ww[j] & 0xffffu); Vt[(16 * pc + 2 * j + 1) * AT_VSTR + key] = (bf16)(ww[j] >> 16); } }
}
__device__ __forceinline__ void attn_unit(const Ctx& F, int l, int kind, int b, int nb, int hk) {
    const bf16* P = (const bf16*)(F.ws + WS_P); bf16* Y = (bf16*)(F.ws + WS_Y);
    const LAS bf16* Ks = (const LAS bf16*)(F.lds + AT_KS_OFF); const LAS bf16* Vt = (const LAS bf16*)(F.lds + AT_VT_OFF);
    const int lane = F.lane, w = F.wave, gi = w >> 1, th = w & 1, g = 4 * hk + gi, l31 = lane & 31, h = lane >> 5;
    bf16x8 qf[2][4]; int qrow[2];
#pragma unroll
    for (int qb = 0; qb < 2; ++qb) {
        const int iq = 64 * th + 32 * qb + l31, tok = nb * 128 + iq;
        const int row = kind == 0 ? b * SEQ + tok : M_LAT + b * LCTX + tok; qrow[qb] = row;
        const bf16* src = P + (size_t)row * NP + PQ + g * 64 + 8 * h;
        float x[4][8];
#pragma unroll
        for (int s = 0; s < 4; ++s) { const v4u raw = *(const v4u*)(src + 16 * s); unpack8(raw, x[s]); }
        if (kind == 0) {
            const float* rtr = (const float*)(F.ws + WS_ROPE) + (size_t)((tok >> 6) * 16 + 8 * h) * 2; const float* rtc = (const float*)(F.ws + WS_ROPE) + (size_t)((tok & 63) * 16 + 8 * h) * 2;
#pragma unroll
            for (int j = 0; j < 8; ++j) { float cs = rtr[2 * j], sn = rtr[2 * j + 1]; float a = x[0][j], bb = x[1][j]; x[0][j] = a * cs - bb * sn; x[1][j] = a * sn + bb * cs;
                cs = rtc[2 * j]; sn = rtc[2 * j + 1]; a = x[2][j]; bb = x[3][j]; x[2][j] = a * cs - bb * sn; x[3][j] = a * sn + bb * cs; } }
#pragma unroll
        for (int s = 0; s < 4; ++s) {
#pragma unroll
            for (int j = 0; j < 8; ++j) x[s][j] *= 0.125f;
            const v4u pk = pack8(x[s]); qf[qb][s] = __builtin_bit_cast(bf16x8, pk); }
    }
    f32x16 O[2][2];
    float mrun[2], lsum[2];
    const float sink = F.in[I_SINK][l * 8 + g];
#pragma unroll
    for (int qb = 0; qb < 2; ++qb) { mrun[qb] = sink; lsum[qb] = h == 0 ? 1.0f : 0.0f;
#pragma unroll
        for (int db = 0; db < 2; ++db)
#pragma unroll
            for (int r = 0; r < 16; ++r) O[db][qb][r] = 0.f; }
    const int ntile = kind == 0 ? 5 : 2;
    for (int ti = 0; ti < ntile; ++ti) {
        int krow0, mode = 0, tok0 = 0; bool rope = false;
        if (ti < 2) krow0 = M_LAT + b * LCTX + 128 * ti;
        else { const int kb = nb + ti - 3; if (kb < 0 || kb >= SEQ / 128) continue; krow0 = b * SEQ + kb * 128; tok0 = kb * 128; rope = true; mode = ti == 2 ? 1 : ti == 4 ? 2 : 0; }
        __syncthreads();
        attn_stage_tile(F, P, krow0, hk, rope, tok0);
        __syncthreads();
#pragma unroll 1
        for (int kh = 0; kh < 2; ++kh) {
#pragma unroll
            for (int qb = 0; qb < 2; ++qb) {
                f32x16 st[2];
#pragma unroll
                for (int kb = 0; kb < 2; ++kb) {
#pragma unroll
                    for (int r = 0; r < 16; ++r) st[kb][r] = 0.f;
#pragma unroll
                    for (int s = 0; s < 4; ++s) { const bf16x8 a = *(const LAS bf16x8*)(Ks + (64 * kh + 32 * kb + l31) * AT_KSTR + 16 * s + 8 * h);
                        st[kb] = __builtin_amdgcn_mfma_f32_32x32x16_bf16(a, qf[qb][s], st[kb], 0, 0, 0); } }
                const int iq = 64 * th + 32 * qb + l31;
                float mx = -INFINITY;
#pragma unroll
                for (int kb = 0; kb < 2; ++kb)
#pragma unroll
                    for (int r = 0; r < 16; ++r) { const int key = 64 * kh + 32 * kb + (r & 3) + 8 * (r >> 2) + 4 * h;
                        const bool valid = mode == 0 || (mode == 1 ? key >= iq : key <= iq);
                        const float sv = valid ? st[kb][r] : -INFINITY; st[kb][r] = sv; mx = fmaxf(mx, sv); }
                mx = fmaxf(mx, shx(mx, 32, lane));
                const float mnew = fmaxf(mrun[qb], mx), alpha = __expf(mrun[qb] - mnew); mrun[qb] = mnew;
                float ps = 0.f;
#pragma unroll
                for (int kb = 0; kb < 2; ++kb)
#pragma unroll
                    for (int r = 0; r < 16; ++r) { const float p = __expf(st[kb][r] - mnew); st[kb][r] = p; ps += p; }
                lsum[qb] = lsum[qb] * alpha + ps;
#pragma unroll
                for (int db = 0; db < 2; ++db)
#pragma unroll
                    for (int r = 0; r < 16; ++r) O[db][qb][r] *= alpha;
#pragma unroll
                for (int kb = 0; kb < 2; ++kb)
#pragma unroll
                    for (int s2 = 0; s2 < 2; ++s2) {
                        v4u pw; pw.x = pk2(st[kb][8 * s2 + 0], st[kb][8 * s2 + 1]); pw.y = pk2(st[kb][8 * s2 + 2], st[kb][8 * s2 + 3]);
                        pw.z = pk2(st[kb][8 * s2 + 4], st[kb][8 * s2 + 5]); pw.w = pk2(st[kb][8 * s2 + 6], st[kb][8 * s2 + 7]);
                        const bf16x8 pf = __builtin_bit_cast(bf16x8, pw);
#pragma unroll
                        for (int db = 0; db < 2; ++db) { const LAS bf16* vp = Vt + (32 * db + l31) * AT_VSTR + 64 * kh + 32 * kb + 16 * s2 + 4 * h;
                            const v2u v0 = *(const LAS v2u*)(vp), v1 = *(const LAS v2u*)(vp + 8);
                            v4u av; av.x = v0.x; av.y = v0.y; av.z = v1.x; av.w = v1.y;
                            O[db][qb] = __builtin_amdgcn_mfma_f32_32x32x16_bf16(__builtin_bit_cast(bf16x8, av), pf, O[db][qb], 0, 0, 0); }
                    }
                asm volatile("" ::: "memory");
            }
        }
    }
#pragma unroll
    for (int qb = 0; qb < 2; ++qb) {
        const float lt = lsum[qb] + shx(lsum[qb], 32, lane), inv = MK_ABL_B / lt;
        bf16* yr = Y + (size_t)qrow[qb] * NY + 512 + g * 64;
#pragma unroll
        for (int db = 0; db < 2; ++db)
#pragma unroll
            for (int gq = 0; gq < 4; ++gq) { v2u o; o.x = pk2(O[db][qb][4 * gq] * inv, O[db][qb][4 * gq + 1] * inv); o.y = pk2(O[db][qb][4 * gq + 2] * inv, O[db][qb][4 * gq + 3] * inv);
                *(v2u*)(yr + 32 * db + 8 * gq + 4 * h) = o; }
    }
}

constexpr int ML_QS = 0, ML_KS = 17408, ML_KTS = 34816, ML_VTS = 53248, ML_WS = 73984, ML_CTS = 83200, ML_SM = 122368;
constexpr int ML_QSTR = 136, ML_TSTR = 72;
static_assert(ML_SM + 5 * 256 <= RING_BYTES, "mLSTM LDS");
__device__ __forceinline__ float log_sigmoid(float x) { return fminf(x, 0.f) - log1pf(__expf(-fabsf(x))); }
__device__ __forceinline__ int ml_chunk_base(int ci, int b, int dir) { const int cc = ci < 4 ? ci : ci - 4, nc = ci < 4 ? 4 : 32, cs = dir == 0 ? cc : nc - 1 - cc; return (ci < 4 ? M_LAT + b * LCTX : b * SEQ) + 64 * cs; }
__device__ __forceinline__ void mlstm_chain(const Ctx& F, int l, int chain) {
    const bf16* P = (const bf16*)(F.ws + WS_P); const float* G = (const float*)(F.ws + WS_G);
    const int b = chain >> 3, hd = (chain >> 1) & 3, dir = chain & 1, lane = F.lane, w = F.wave, tid = F.tid, l15 = lane & 15, lq = lane >> 4;
    bf16* Hout = (bf16*)(F.ws + (dir == 0 ? WS_HF : WS_HB));
    LAS bf16* Qs = (LAS bf16*)(F.lds + ML_QS); LAS bf16* Ks = (LAS bf16*)(F.lds + ML_KS); LAS bf16* KTs = (LAS bf16*)(F.lds + ML_KTS); LAS bf16* VTs = (LAS bf16*)(F.lds + ML_VTS);
    LAS bf16* Ws = (LAS bf16*)(F.lds + ML_WS); LAS bf16* CTs = (LAS bf16*)(F.lds + ML_CTS);
    LAS float* GA = (LAS float*)(F.lds + ML_SM); LAS float* GG = GA + 64; LAS float* WIN = GA + 128; LAS float* EM = GA + 192; LAS float* DEN = GA + 256;
    const float gbi = F.in[I_GATEB][l * 16 + dir * 8 + hd], gbf = F.in[I_GATEB][l * 16 + dir * 8 + 4 + hd];
    __syncthreads();
#if defined(MK_PROBE_LDSCLR)
    for (int i = tid; i < RING_BYTES / 4; i += NWAVES * 64) ((LAS unsigned*)F.lds)[i] = 0u;
    __syncthreads();
#endif
    for (int i = tid; i < 144 * ML_QSTR / 2; i += NWAVES * 64) ((LAS unsigned*)CTs)[i] = 0u;
    for (int i = tid; i < 16 * ML_TSTR / 2; i += NWAVES * 64) ((LAS unsigned*)(VTs + 128 * ML_TSTR))[i] = (i < ML_TSTR / 2) ? 0x3f803f80u : 0u;
    f32x4 Cacc[9];
#pragma unroll
    for (int e = 0; e < 9; ++e) Cacc[e] = (f32x4){0.f, 0.f, 0.f, 0.f};
    float mst = 0.f;
    const int pr0 = tid >> 4, c16 = tid & 15;
    v4u nq[2], nk[2], nv[2]; float nig, nfg;
#define ML_ISSUE_LOADS(ci_) do { const int base_ = ml_chunk_base((ci_), b, dir); \
        _Pragma("unroll") for (int q = 0; q < 2; ++q) { const int jj = pr0 + 32 * q, tok = base_ + (dir == 0 ? jj : 63 - jj); const bf16* rp = P + (size_t)tok * NP + hd * 128 + 8 * c16; \
            nq[q] = *(const v4u*)(rp + PMQ); nk[q] = *(const v4u*)(rp + PMK); nv[q] = *(const v4u*)(rp + PMV); } \
        { const int tok = base_ + (dir == 0 ? lane : 63 - lane); nig = G[(size_t)tok * 16 + dir * 8 + hd]; nfg = G[(size_t)tok * 16 + dir * 8 + 4 + hd]; } } while (0)
    ML_ISSUE_LOADS(0);
    for (int ci = 0; ci < 36; ++ci) {
        const int base = ml_chunk_base(ci, b, dir);
#if defined(MK_PROBE_NOGATES)
        const float ig = gbi, lf = log_sigmoid(gbf);
#else
        const float ig = nig + gbi, lf = log_sigmoid(nfg + gbf);
#endif
        float bc = lf;
#pragma unroll
        for (int o = 1; o < 64; o <<= 1) { const float t = shup(bc, o, lane); if (lane >= o) bc += t; }
        const float a = ig - bc; float pm = a;
#pragma unroll
        for (int o = 1; o < 64; o <<= 1) { const float t = shup(pm, o, lane); if (lane >= o) pm = fmaxf(pm, t); }
        const float gj = fmaxf(mst, pm), g63 = shidx(gj, 63), b63 = shidx(bc, 63);
        const float wsc = __expf(a - g63) * KSCALE, decay = __expf(mst - g63);
        if (w == 0) { GA[lane] = a; GG[lane] = gj; WIN[lane] = __expf(mst - gj); EM[lane] = __expf(-(bc + gj)); }
#if defined(MK_PROBE_MORESYNC)
        __syncthreads();
#endif
#pragma unroll
        for (int q = 0; q < 2; ++q) { const int jj = pr0 + 32 * q;
            *(LAS v4u*)(Qs + jj * ML_QSTR + 8 * c16) = nq[q]; *(LAS v4u*)(Ks + jj * ML_QSTR + 8 * c16) = nk[q];
            const float ws = shidx(wsc, jj); float kf[8]; unpack8(nk[q], kf);
            const unsigned vv[4] = {nv[q].x, nv[q].y, nv[q].z, nv[q].w};
#pragma unroll
            for (int j = 0; j < 8; ++j) KTs[(8 * c16 + j) * ML_TSTR + jj] = (bf16)f2bf(kf[j] * ws);
#pragma unroll
            for (int j = 0; j < 4; ++j) { VTs[(8 * c16 + 2 * j) * ML_TSTR + jj] = (bf16)(vv[j] & 0xffffu); VTs[(8 * c16 + 2 * j + 1) * ML_TSTR + jj] = (bf16)(vv[j] >> 16); } }
        if (ci + 1 < 36) ML_ISSUE_LOADS(ci + 1);
        __syncthreads();
        { const int rb = w >> 1; f32x4 sa[2] = {(f32x4){0.f, 0.f, 0.f, 0.f}, (f32x4){0.f, 0.f, 0.f, 0.f}};
#pragma unroll
            for (int kk = 0; kk < 4; ++kk) { const bf16x8 af = *(const LAS bf16x8*)(Qs + (16 * rb + l15) * ML_QSTR + 32 * kk + 8 * lq);
#pragma unroll
                for (int cb = 0; cb < 2; ++cb) { const bf16x8 bfr = *(const LAS bf16x8*)(Ks + (16 * (2 * (w & 1) + cb) + l15) * ML_QSTR + 32 * kk + 8 * lq);
                    sa[cb] = __builtin_amdgcn_mfma_f32_16x16x32_bf16(af, bfr, sa[cb], 0, 0, 0); } }
#pragma unroll
            for (int cb = 0; cb < 2; ++cb) { const int s = 16 * (2 * (w & 1) + cb) + l15; const float as = GA[s];
#pragma unroll
                for (int r = 0; r < 4; ++r) { const int j = 16 * rb + 4 * lq + r; const float wv = s <= j ? sa[cb][r] * KSCALE * __expf(as - GG[j]) : 0.f; Ws[j * ML_TSTR + s] = (bf16)f2bf(wv); } } }
        __syncthreads();
        const int rb = w >> 1, eb0 = (w & 1) ? 5 : 0, neb = (w & 1) ? 4 : 5;
        f32x4 num[5];
        { bf16x8 wf[2], qf[4];
#pragma unroll
            for (int kk = 0; kk < 2; ++kk) wf[kk] = *(const LAS bf16x8*)(Ws + (16 * rb + l15) * ML_TSTR + 32 * kk + 8 * lq);
#pragma unroll
            for (int kk = 0; kk < 4; ++kk) qf[kk] = *(const LAS bf16x8*)(Qs + (16 * rb + l15) * ML_QSTR + 32 * kk + 8 * lq);
            float win[4];
#pragma unroll
            for (int r = 0; r < 4; ++r) win[r] = WIN[16 * rb + 4 * lq + r];
#pragma unroll
            for (int i = 0; i < 5; ++i) { if (i < neb) { const int eb = eb0 + i; f32x4 aw = (f32x4){0.f, 0.f, 0.f, 0.f}, ac = (f32x4){0.f, 0.f, 0.f, 0.f};
#pragma unroll
                for (int kk = 0; kk < 2; ++kk) aw = __builtin_amdgcn_mfma_f32_16x16x32_bf16(wf[kk], *(const LAS bf16x8*)(VTs + (16 * eb + l15) * ML_TSTR + 32 * kk + 8 * lq), aw, 0, 0, 0);
#pragma unroll
                for (int kk = 0; kk < 4; ++kk) ac = __builtin_amdgcn_mfma_f32_16x16x32_bf16(qf[kk], *(const LAS bf16x8*)(CTs + (16 * eb + l15) * ML_QSTR + 32 * kk + 8 * lq), ac, 0, 0, 0);
#pragma unroll
                for (int r = 0; r < 4; ++r) num[i][r] = aw[r] + win[r] * ac[r];
                if (eb == 8 && l15 == 0) {
#pragma unroll
                    for (int r = 0; r < 4; ++r) DEN[16 * rb + 4 * lq + r] = num[i][r]; } } } }
        __syncthreads();
        { float dn[4];
#pragma unroll
            for (int r = 0; r < 4; ++r) { const int j = 16 * rb + 4 * lq + r; dn[r] = 1.0f / fmaxf(fabsf(DEN[j]), EM[j]); }
#pragma unroll
            for (int i = 0; i < 5; ++i) { if (i < neb && eb0 + i < 8) { const int e = 16 * (eb0 + i) + l15;
#pragma unroll
                for (int r = 0; r < 4; ++r) { const int j = 16 * rb + 4 * lq + r, tok = base + (dir == 0 ? j : 63 - j); Hout[(size_t)tok * 512 + hd * 128 + e] = (bf16)f2bf(num[i][r] * dn[r]); } } } }
#if defined(MK_PROBE_MORESYNC)
        __syncthreads();
#endif
        { bf16x8 kf[2];
#pragma unroll
            for (int kk = 0; kk < 2; ++kk) kf[kk] = *(const LAS bf16x8*)(KTs + (16 * w + l15) * ML_TSTR + 32 * kk + 8 * lq);
#pragma unroll
            for (int eb = 0; eb < 9; ++eb) { Cacc[eb] = Cacc[eb] * decay;
#pragma unroll
                for (int kk = 0; kk < 2; ++kk) Cacc[eb] = __builtin_amdgcn_mfma_f32_16x16x32_bf16(kf[kk], *(const LAS bf16x8*)(VTs + (16 * eb + l15) * ML_TSTR + 32 * kk + 8 * lq), Cacc[eb], 0, 0, 0);
                v2u o; o.x = pk2(Cacc[eb][0], Cacc[eb][1]); o.y = pk2(Cacc[eb][2], Cacc[eb][3]);
                *(LAS v2u*)(CTs + (16 * eb + l15) * ML_QSTR + 16 * w + 4 * lq) = o; } }
        mst = b63 + g63;
        __syncthreads();
    }
#undef ML_ISSUE_LOADS
}

__device__ __forceinline__ void c0_combine(const Ctx& F, int l, int nrows) {
    const bf16* P = (const bf16*)(F.ws + WS_P); const bf16* HF = (const bf16*)(F.ws + WS_HF); const bf16* HB = (const bf16*)(F.ws + WS_HB); bf16* Y = (bf16*)(F.ws + WS_Y);
    const int gw = F.vcu * NWAVES + F.wave, NGW = F.G * NWAVES, lane = F.lane;
    for (int it = gw; it < nrows * 4; it += NGW) { const int r = it >> 2, hd = it & 3, col = hd * 128 + 2 * lane;
        const unsigned a = *(const unsigned*)(HF + (size_t)r * 512 + col), bq = *(const unsigned*)(HB + (size_t)r * 512 + col), mo = *(const unsigned*)(P + (size_t)r * NP + PMO + col);
#if defined(MK_PROBE_C0)
        float x0 = bflo(mo) + 0.f * (bflo(a) + bflo(bq)) * 0.f, x1 = bfhi(mo);
#else
        float x0 = bflo(a) + bflo(bq), x1 = bfhi(a) + bfhi(bq);
#endif
        const float mean = wave_sum(x0 + x1, lane) * (1.f / 128.f); x0 -= mean; x1 -= mean;
        const float rstd = 1.f / sqrtf(wave_sum(x0 * x0 + x1 * x1, lane) * (1.f / 128.f) + LN_EPS);
        const float g0 = F.in[I_NORMG][l * 512 + col], g1 = F.in[I_NORMG][l * 512 + col + 1];
        *(unsigned*)(Y + (size_t)r * NY + 1024 + col) = pk2(MK_ABL_C * sigmoidf_(bflo(mo)) * x0 * rstd * g0, MK_ABL_C * sigmoidf_(bfhi(mo)) * x1 * rstd * g1); }
}

struct EpiProj {
    static constexpr bool PERM = true, AFTER_DRAIN = false, RESCALE = false;
    bf16* O; int ldc;
    __device__ __forceinline__ void operator()(const pg8::f32x4 (&acc)[2][2][4][2], const pg8::Unit& u, int wr, int wc, int fr, int fq) const {
        const int row0 = u.pm * 256 + wr * 64 + fr, col0 = u.pn * 256 + wc * 32 + 8 * fq;
#pragma unroll
        for (int ai = 0; ai < 2; ++ai)
#pragma unroll
            for (int m = 0; m < 4; ++m) { bf16* rowp = O + (size_t)(row0 + ai * 128 + m * 16) * ldc + col0;
#pragma unroll
                for (int bj = 0; bj < 2; ++bj) { const pg8::f32x4 v0 = acc[ai][bj][m][0], v1 = acc[ai][bj][m][1];
                    v4u w; w.x = pk2(v0[0], v0[1]); w.y = pk2(v0[2], v0[3]); w.z = pk2(v1[0], v1[1]); w.w = pk2(v1[2], v1[3]);
                    *(v4u*)(rowp + bj * 128) = w; } }
    }
};
__device__ __forceinline__ float gate_e(float x) { return __expf(-fminf(fmaxf(x, -30.f), 30.f)); }
struct EpiMerge {
    static constexpr bool PERM = true, AFTER_DRAIN = false, RESCALE = true;
    const bf16* P; bf16* Z;
    __device__ __forceinline__ void rescale(pg8::f32x4 (&acc)[2][2][4][2], const pg8::Unit& u, int step, int wr, int wc, int fr, int fq) const {
        const int row0 = u.pm * 256 + wr * 64 + fr, col0 = u.pn * 256 + wc * 32 + 8 * fq;
        const int cn = PBG + (step - 1) * 1024, cd = PBG + step * 1024;
#pragma unroll
        for (int ai = 0; ai < 2; ++ai)
#pragma unroll
            for (int m = 0; m < 4; ++m) { const bf16* rowp = P + (size_t)(row0 + ai * 128 + m * 16) * NP + col0;
#pragma unroll
                for (int bj = 0; bj < 2; ++bj) { const v4u xn = *(const v4u*)(rowp + cn + bj * 128), xd = *(const v4u*)(rowp + cd + bj * 128);
                    float a[8], b[8]; unpack8(xn, a); unpack8(xd, b);
#pragma unroll
                    for (int i = 0; i < 8; ++i) { const float ratio = (1.0f + gate_e(b[i])) / (1.0f + gate_e(a[i])); acc[ai][bj][m][i >> 2][i & 3] *= ratio; } }
                asm volatile("" ::: "memory"); }
    }
    __device__ __forceinline__ void operator()(const pg8::f32x4 (&acc)[2][2][4][2], const pg8::Unit& u, int wr, int wc, int fr, int fq) const {
        const int row0 = u.pm * 256 + wr * 64 + fr, col0 = u.pn * 256 + wc * 32 + 8 * fq;
#pragma unroll
        for (int ai = 0; ai < 2; ++ai)
#pragma unroll
            for (int m = 0; m < 4; ++m) { const size_t r = (size_t)(row0 + ai * 128 + m * 16);
#pragma unroll
                for (int bj = 0; bj < 2; ++bj) { const v4u xc = *(const v4u*)(P + r * NP + PBG + 2048 + col0 + bj * 128); float c[8], o[8]; unpack8(xc, c);
#pragma unroll
                    for (int i = 0; i < 8; ++i) o[i] = acc[ai][bj][m][i >> 2][i & 3] / (1.0f + gate_e(c[i]));
                    *(v4u*)(Z + r * D + col0 + bj * 128) = pack8(o); }
                asm volatile("" ::: "memory"); }
    }
};
struct EpiResid {
    static constexpr bool PERM = false, AFTER_DRAIN = false, RESCALE = false;
    float* out; float* hc; const float* mod_l;
    __device__ __forceinline__ void operator()(const pg8::f32x4 (&acc)[2][2][4][2], const pg8::Unit& u, int wr, int wc, int fr, int fq) const {
        const int rt = u.pm * 256; float* hb = rt < M_LAT ? out + (size_t)rt * D : hc + (size_t)(rt - M_LAT) * D;
        const float* g1 = mod_l + (size_t)(rt < M_LAT ? (rt >> 11) : 8) * 6144 + 2048;
        const int rl0 = wr * 64 + fr, col0 = u.pn * 256 + wc * 32 + 4 * fq;
#pragma unroll
        for (int ai = 0; ai < 2; ++ai)
#pragma unroll
            for (int m = 0; m < 4; ++m) { float* rowp = hb + (size_t)(rl0 + ai * 128 + m * 16) * D + col0;
#pragma unroll
                for (int bj = 0; bj < 2; ++bj)
#pragma unroll
                    for (int n = 0; n < 2; ++n) { const pg8::f32x4 g = *(const pg8::f32x4*)(g1 + col0 + bj * 128 + n * 16), h = *(const pg8::f32x4*)(rowp + bj * 128 + n * 16);
                        *(pg8::f32x4*)(rowp + bj * 128 + n * 16) = h * ALPHA + g * acc[ai][bj][m][n]; } }
    }
};
struct EpiSwiGLU {
    static constexpr bool PERM = true, AFTER_DRAIN = false, RESCALE = false;
    bf16* act;
    __device__ __forceinline__ void operator()(const pg8::f32x4 (&acc)[2][2][4][2], const pg8::Unit& u, int wr, int wc, int fr, int fq) const {
        const int row0 = u.pm * 256 + wr * 64 + fr, col0 = (u.pn & 3) * 128 + wc * 32 + 8 * fq;
#pragma unroll
        for (int ai = 0; ai < 2; ++ai)
#pragma unroll
            for (int m = 0; m < 4; ++m) { float o[8];
#pragma unroll
                for (int i = 0; i < 8; ++i) { const float g = acc[ai][0][m][i >> 2][i & 3], uu = acc[ai][1][m][i >> 2][i & 3]; o[i] = g * sigmoidf_(g) * uu; }
                *(v4u*)(act + (size_t)(row0 + ai * 128 + m * 16) * DEXP + col0) = pack8(o); }
    }
};
struct EpiScatter {
    static constexpr bool PERM = true, AFTER_DRAIN = false, RESCALE = false;
    const int* rowmap; const float* roww; bf16* Fo;
    __device__ __forceinline__ void operator()(const pg8::f32x4 (&acc)[2][2][4][2], const pg8::Unit& u, int wr, int wc, int fr, int fq) const {
        const int row0 = u.pm * 256 + wr * 64 + fr, col0 = (u.pn & 3) * 256 + wc * 32 + 8 * fq;
#pragma unroll
        for (int ai = 0; ai < 2; ++ai)
#pragma unroll
            for (int m = 0; m < 4; ++m) { const int sr = row0 + ai * 128 + m * 16, dst = rowmap[sr]; const float wgt = roww[sr];
                if (dst >= 0) {
#pragma unroll
                    for (int bj = 0; bj < 2; ++bj) { pg8::f32x4 v0 = acc[ai][bj][m][0] * wgt, v1 = acc[ai][bj][m][1] * wgt;
#if defined(MK_PROBE_SCATTER) && MK_PROBE_SCATTER == 1
                        v0 = (pg8::f32x4){wgt, wgt, wgt, wgt}; v1 = v0;
#elif defined(MK_PROBE_SCATTER) && MK_PROBE_SCATTER == 2
                        v0 = acc[ai][bj][m][0]; v1 = acc[ai][bj][m][1];
#endif
                        v4u w; w.x = pk2(v0[0], v0[1]); w.y = pk2(v0[2], v0[3]); w.z = pk2(v1[0], v1[1]); w.w = pk2(v1[2], v1[3]);
                        *(v4u*)(Fo + (size_t)dst * D + col0 + bj * 128) = w; } } }
    }
};
struct MoeOrder {
    int G, c; const LAS int* toff;
    __device__ __forceinline__ bool next(int i, pg8::Unit& u) const {
        const long L = (long)i * G + c; const int nt = toff[16]; if (L >= (long)nt * 4) return false;
        const int pm = (int)(L >> 2), ct = (int)(L & 3); int e = 0;
#pragma unroll
        for (int k = 1; k < 16; ++k) e += (pm >= toff[k]) ? 1 : 0;
        u.pm = pm; u.pn = e * 4 + ct; return true;
    }
    __device__ __forceinline__ void a_ready(const pg8::Unit&) const {}
    __device__ __forceinline__ void done(const pg8::Unit&) const {}
};
__device__ __forceinline__ void moe_toff(const Ctx& F, int l, LAS int* toff) {
    if (F.tid == 0) { int acc = 0; const int* tot = (const int*)(F.ws + WS_BCNT) + 2 * 4096 + l * 16;
        for (int e = 0; e < 16; ++e) { toff[e] = acc; acc += (tot[e] + 255) >> 8; }
        toff[16] = acc; }
    __syncthreads();
}

__device__ __forceinline__ void e_ln1_route(const Ctx& F, int l, int nrows) {
    const int rpb = nrows / 256, row0 = F.vcu * rpb;
    LAS int* lcnt = (LAS int*)F.lds; LAS int* rinfo = lcnt + 16; LAS float* rwt = (LAS float*)(lcnt + 16 + 160); LAS int* lrk = lcnt + 16 + 320;
    stage_w16(F, F.in[I_WROUTER], 16, (LAS float*)(F.lds + 4096));
    __syncthreads();
    for (int i = F.wave; i < rpb; i += NWAVES) { const int r = row0 + i;
        f32x4 v[4]; float* hp = hrow(F, r); load_row(hp, F.lane, v); ln_row(v, F.in[I_LN1G] + l * D, F.in[I_LN1B] + l * D, F.lane); store_row(hp, F.lane, v);
        const float* mp = modp(F, l, modrow(r)); f32x4 u[4];
        emit_u(v, mp + 3072, mp + 4096, (bf16*)(F.ws + WS_U) + (size_t)r * D, F.lane, u);
        float lg[16]; dot16(u, (const LAS float*)(F.lds + 4096), F.lane, lg);
        float sc[16], sel[16];
#pragma unroll
        for (int e = 0; e < 16; ++e) { sc[e] = sigmoidf_(lg[e]); sel[e] = sc[e] + F.in[I_BROUTER][e]; }
        int bg = 0; float bgs = -INFINITY;
#pragma unroll
        for (int g = 0; g < 4; ++g) { float m1 = -INFINITY, m2 = -INFINITY;
#pragma unroll
            for (int k = 0; k < 4; ++k) { const float x = sel[4 * g + k]; if (x > m1) { m2 = m1; m1 = x; } else if (x > m2) m2 = x; }
            const float gs = m1 + m2; if (gs > bgs) { bgs = gs; bg = g; } }
        float s4[4], c4[4];
#pragma unroll
        for (int k = 0; k < 4; ++k) { s4[k] = bg == 0 ? sel[k] : bg == 1 ? sel[4 + k] : bg == 2 ? sel[8 + k] : sel[12 + k]; c4[k] = bg == 0 ? sc[k] : bg == 1 ? sc[4 + k] : bg == 2 ? sc[8 + k] : sc[12 + k]; }
        int i1 = 0;
#pragma unroll
        for (int k = 1; k < 4; ++k) if (s4[k] > s4[i1]) i1 = k;
        int i2 = i1 == 0 ? 1 : 0;
#pragma unroll
        for (int k = 0; k < 4; ++k) if (k != i1 && k != i2 && s4[k] > s4[i2]) i2 = k;
        const float w1 = c4[i1], w2 = c4[i2], ws = 1.0f / (w1 + w2);
        if (F.lane == 0) { rinfo[2 * i] = 4 * bg + i1; rinfo[2 * i + 1] = 4 * bg + i2; rwt[2 * i] = w1 * ws; rwt[2 * i + 1] = w2 * ws; }
    }
    __syncthreads();
    if (F.tid < 16) { int c = 0; for (int idx = 0; idx < 2 * rpb; ++idx) if (rinfo[idx] == F.tid) lrk[idx] = c++;
        ((int*)(F.ws + WS_BCNT))[(l * 256 + F.vcu) * 16 + F.tid] = c; }
    __syncthreads();
    for (int idx = F.tid; idx < 2 * rpb; idx += NWAVES * 64) { unsigned* rp = (unsigned*)(F.ws + WS_ROUTE + (size_t)(2 * row0 + idx) * 16);
        rp[0] = (unsigned)rinfo[idx]; rp[1] = (unsigned)lrk[idx]; ((float*)rp)[2] = rwt[idx]; rp[3] = (unsigned)F.vcu; }
    __syncthreads();
}
__device__ __forceinline__ void f_gather(const Ctx& F, int l, int nrows) {
    LAS int* toff = (LAS int*)F.lds; LAS int* cnts = toff + 32; LAS int* csum = toff + 64; LAS int* bbase = toff + 1024;
    const int* bc = (const int*)(F.ws + WS_BCNT) + l * 4096;
    { const int e = F.tid & 15, ch = F.tid >> 4; int s = 0;
#pragma unroll
        for (int k = 0; k < 8; ++k) { const int v = bc[(8 * ch + k) * 16 + e]; bbase[(8 * ch + k) * 16 + e] = s; s += v; }
        csum[ch * 16 + e] = s; }
    __syncthreads();
    { const int e = F.tid & 15, ch = F.tid >> 4; int pre = 0;
        for (int k = 0; k < ch; ++k) pre += csum[k * 16 + e];
#pragma unroll
        for (int k = 0; k < 8; ++k) bbase[(8 * ch + k) * 16 + e] += pre;
        if (ch == 31) { const int tot = pre + csum[31 * 16 + e]; cnts[e] = tot; if (F.vcu == 0) ((int*)(F.ws + WS_BCNT))[2 * 4096 + l * 16 + e] = tot; } }
    __syncthreads();
    if (F.tid == 0) { int acc = 0; for (int e = 0; e < 16; ++e) { toff[e] = acc; acc += (cnts[e] + 255) >> 8; } toff[16] = acc; }
    __syncthreads();
    const int gw = F.vcu * NWAVES + F.wave, NGW = F.G * NWAVES, lane = F.lane;
    const bf16* U = (const bf16*)(F.ws + WS_U); bf16* As = (bf16*)(F.ws + WS_AS); int* rowmap = (int*)(F.ws + WS_ROWMAP); float* roww = (float*)(F.ws + WS_ROWW);
    for (int ts = gw; ts < 2 * nrows; ts += NGW) { const unsigned* rp = (const unsigned*)(F.ws + WS_ROUTE + (size_t)ts * 16); const unsigned re = rp[0], rk = rp[1], rb = rp[3]; const float rwv = ((const float*)rp)[2];
        const int pos = toff[re] * 256 + bbase[rb * 16 + re] + (int)rk;
        const v4u* src = (const v4u*)(U + (size_t)(ts >> 1) * D); v4u* dst = (v4u*)(As + (size_t)pos * D);
        dst[lane] = src[lane]; dst[lane + 64] = src[lane + 64];
        if (lane == 0) { rowmap[pos] = ts; roww[pos] = rwv; } }
    for (int e = 0; e < 16; ++e) { const int cnt = cnts[e], first = toff[e] * 256 + cnt, npad = toff[e + 1] * 256 - first;
        for (int i = gw; i < npad; i += NGW) { v4u* dst = (v4u*)(As + (size_t)(first + i) * D); unsigned z0 = 0u; asm volatile("" : "+v"(z0)); const v4u z = {z0, z0, z0, z0}; dst[lane] = z; dst[lane + 64] = z; if (lane == 0) { rowmap[first + i] = -1; roww[first + i] = 0.f; } } }
    __syncthreads();
}
__device__ __forceinline__ void h_ln2(const Ctx& F, int l, int nrows) {
    const int gw = F.vcu * NWAVES + F.wave, NGW = F.G * NWAVES, lane = F.lane; const bf16* Fs = (const bf16*)(F.ws + WS_F);
    if (l + 1 < DEPTH) { stage_w16(F, F.in[I_WIN] + (size_t)(l + 1) * D * D_IN + SRC_MG, D_IN, (LAS float*)F.lds); __syncthreads(); }
    for (int r = gw; r < nrows; r += NGW) { f32x4 v[4]; float* hp = hrow(F, r); load_row(hp, lane, v); const float* g2 = modp(F, l, modrow(r)) + 5120;
#pragma unroll
        for (int j = 0; j < 4; ++j) { const v2u a = *(const v2u*)(Fs + (size_t)(2 * r) * D + 4 * lane + 256 * j), b = *(const v2u*)(Fs + (size_t)(2 * r + 1) * D + 4 * lane + 256 * j);
            const f32x4 f = (f32x4){bflo(a.x) + bflo(b.x), bfhi(a.x) + bfhi(b.x), bflo(a.y) + bflo(b.y), bfhi(a.y) + bfhi(b.y)}, g = *(const f32x4*)(g2 + 4 * lane + 256 * j);
            v[j] = v[j] * ALPHA + g * f * MK_ABL_F; }
        ln_row(v, F.in[I_LN2G] + l * D, F.in[I_LN2B] + l * D, lane); store_row(hp, lane, v);
        if (l + 1 < DEPTH) emit_layer_input(F, l + 1, r, v); }
}

constexpr int NPHASE = 2 + 10 * DEPTH;
struct Args { const float* in[N_IN]; float* out; unsigned char* ws; int ph_lo, ph_hi, li, pad; };
static_assert(sizeof(Args) == 8 * N_IN + 16 + 16, "no padding bytes in Args");
#ifndef MK_PHASE_MASK
#define MK_PHASE_MASK 0xFFFu
#endif
#define PON(j) (((MK_PHASE_MASK) >> (j)) & 1u)
#define IN(k) (lo <= (k) && (k) < hi)
#define PCTX(Fp) Ctx Fp = F; Fp.lane = lane_id(); Fp.tid = F.wave * 64 + Fp.lane
#define SEAM(k) do { if (IN(k) && IN((k) + 1)) xcd_barrier(bar); } while (0)
template <int l> __device__ __forceinline__ void run_layer(const Ctx& F, const int lo, const int hi, const XcdBarrier& bar) {
        const int pb = 2 + 10 * l; const bool lastl = (l == DEPTH - 1); const int nrows = lastl ? M_LAT : M_ALL;
        bf16* const Pb = (bf16*)(F.ws + WS_P); bf16* const Ub = (bf16*)(F.ws + WS_U); bf16* const Yb = (bf16*)(F.ws + WS_Y);
        if (PON(2) && IN(pb + 0)) {
            pg8::Gemm g{Ub, wt(F, l, W_IN), M_ALL, NP, D}; pg8::StaticOrder S; S.init(M_ALL, NP, F.G, (int)blockIdx.x);
            EpiProj E{Pb, NP};
            pg8::gemm_phase<EpiProj, pg8::StaticOrder, true, true>(F.lds, g, S, E, F.wave);
            SEAM(pb + 0);
        }
        if (PON(3) && IN(pb + 1)) {
#ifndef MK_NO_MLSTM
            PCTX(Fp);
            if (F.vcu < 64) mlstm_chain(Fp, l, F.vcu);
            else
#endif
            {
                const int idx = F.vcu - 64, nw = F.G - 64, n_attn = lastl ? 256 : 288, n_conv = lastl ? 512 : 576;
#ifndef MK_NO_ATTN
                for (int u = idx; u < n_attn; u += nw) { if (u < 256) attn_unit(Fp, l, 0, u >> 5, (u >> 1) & 15, u & 1); else { const int j = u - 256; attn_unit(Fp, l, 1, j >> 2, (j >> 1) & 1, j & 1); } }
#endif
                __syncthreads();
#ifndef MK_NO_CONV
                for (int u = idx; u < n_conv; u += nw) conv_unit(Fp, l, u);
#endif
            }
            SEAM(pb + 1);
        }
        if (PON(4) && IN(pb + 2)) { PCTX(Fp); c0_combine(Fp, l, nrows); SEAM(pb + 2); }
        if (PON(5) && IN(pb + 3)) {
            pg8::Gemm g{Yb, wt(F, l, W_ABC), nrows, D, NY}; pg8::StaticOrder S; S.init(nrows, D, F.G, (int)blockIdx.x);
            EpiMerge E{Pb, Ub};
            pg8::gemm_phase<EpiMerge, pg8::StaticOrder, true, true>(F.lds, g, S, E, F.wave);
            SEAM(pb + 3);
        }
        if (PON(6) && IN(pb + 4)) {
            pg8::Gemm g{Ub, wt(F, l, W_OUT), nrows, D, D}; pg8::StaticOrder S; S.init(nrows, D, F.G, (int)blockIdx.x);
            EpiResid E{F.out, (float*)(F.ws + WS_HC), (const float*)(F.ws + WS_MOD) + (size_t)l * 9 * 6144};
            pg8::gemm_phase<EpiResid, pg8::StaticOrder, true, true>(F.lds, g, S, E, F.wave);
            SEAM(pb + 4);
        }
        if (PON(7) && IN(pb + 5)) { PCTX(Fp); e_ln1_route(Fp, l, nrows); SEAM(pb + 5); }
        if (PON(8) && IN(pb + 6)) { PCTX(Fp); f_gather(Fp, l, nrows); SEAM(pb + 6); }
        if (PON(9) && IN(pb + 7)) {
            LAS int* toff = (LAS int*)(F.lds + LDSCTL_OFF); { PCTX(Fp); moe_toff(Fp, l, toff); }
            pg8::Gemm g{(const bf16*)(F.ws + WS_AS), wt(F, l, W_GU), AS_ROWS, NE * D, D}; MoeOrder S{F.G, (int)blockIdx.x, toff};
            EpiSwiGLU E{(bf16*)(F.ws + WS_ACT)};
            pg8::gemm_phase<EpiSwiGLU, MoeOrder, true, true>(F.lds, g, S, E, F.wave);
            SEAM(pb + 7);
        }
        if (PON(10) && IN(pb + 8)) {
            LAS int* toff = (LAS int*)(F.lds + LDSCTL_OFF); { PCTX(Fp); moe_toff(Fp, l, toff); }
            pg8::Gemm g{(const bf16*)(F.ws + WS_ACT), wt(F, l, W_DN), AS_ROWS, NE * D, DEXP}; MoeOrder S{F.G, (int)blockIdx.x, toff};
            EpiScatter E{(const int*)(F.ws + WS_ROWMAP), (const float*)(F.ws + WS_ROWW), (bf16*)(F.ws + WS_F)};
            pg8::gemm_phase<EpiScatter, MoeOrder, true, true>(F.lds, g, S, E, F.wave);
            SEAM(pb + 8);
        }
        if (PON(11) && IN(pb + 9)) { PCTX(Fp); h_ln2(Fp, l, nrows); SEAM(pb + 9); }
    }
__global__ void __launch_bounds__(NWAVES * 64, 2) mk_fwd(Args args) {
    extern __shared__ __attribute__((aligned(16))) unsigned char lds[];
    Ctx F;
    F.lds = (LAS unsigned char*)lds; F.MISC = (volatile LAS unsigned*)(F.lds + MISC_OFF);
    F.tid = 0; F.lane = 0; F.wave = __builtin_amdgcn_readfirstlane((int)threadIdx.x >> 6);
    F.G = gridDim.x; { const int bx = blockIdx.x; F.vcu = (F.G % 8 == 0) ? (bx % 8) * (F.G / 8) + bx / 8 : bx; }
    F.ws = args.ws; F.out = args.out; F.ctl = (unsigned*)(args.ws + WS_CTL);
    F.in = args.in;
    for (int u = (int)threadIdx.x; u < (LDS_BYTES - LDSCTL_OFF) / 4; u += NWAVES * 64) ((LAS unsigned*)(F.lds + LDSCTL_OFF))[u] = 0u;
    __syncthreads();
    const int lo = args.ph_lo, hi = args.ph_hi;
    XcdBarrier bar; bar.bar = (unsigned*)(F.ctl + CW_BAR) + args.li * XCD_BAR_WORDS; bar.x = 0; bar.st = nullptr; bar.w0 = false;
    if (hi - lo > 1) bar = xcd_barrier_post((unsigned*)(F.ctl + CW_BAR) + args.li * XCD_BAR_WORDS, F.MISC + 8);
    bar.w0 = (F.wave == 0);
    if (PON(0) && IN(0)) { PCTX(Fp); p0_prologue(Fp); SEAM(0); }
    if (PON(1) && IN(1)) { PCTX(Fp); p1_ln_in(Fp); SEAM(1); }
    run_layer<0>(F, lo, hi, bar);
    run_layer<1>(F, lo, hi, bar);
#undef IN
#undef SEAM
}


#if defined(MK_DIAG)
constexpr int CW_DIAG = 3072;
__global__ void __launch_bounds__(512, 2) mk_diag(Args args) {
    unsigned char* ws = args.ws; float* acc = (float*)((unsigned*)(ws + WS_CTL) + CW_DIAG);
    const int gt = blockIdx.x * 512 + threadIdx.x, NT = gridDim.x * 512;
    const int* rowmap = (const int*)(ws + WS_ROWMAP); const bf16* As = (const bf16*)(ws + WS_AS); const bf16* act = (const bf16*)(ws + WS_ACT); const bf16* Fs = (const bf16*)(ws + WS_F);
    const unsigned* cnt = (const unsigned*)(ws + WS_CTL) + CW_CNT;
    int ntile = 0; for (int e = 0; e < 16; ++e) ntile += (int)((cnt[64 * e] + 255u) >> 8);
    float s0 = 0.f, s1 = 0.f, s2 = 0.f, s3 = 0.f;
    for (int pos = gt; pos < ntile * 256; pos += NT) { if (rowmap[pos] >= 0) { s0 += 1.f; float a = 0.f, b = 0.f;
        for (int k = 0; k < 1024; k += 37) a += fabsf(bf1(As[(size_t)pos * D + k]));
        for (int k = 0; k < 512; k += 19) b += fabsf(bf1(act[(size_t)pos * DEXP + k]));
        s1 += a * (1.f / 28.f); s2 += b * (1.f / 27.f); } }
    for (int ts = gt; ts < 2 * M_ALL; ts += NT) { float f = 0.f; for (int k = 0; k < 1024; k += 37) f += fabsf(bf1(Fs[(size_t)ts * D + k])); s3 += f * (1.f / 28.f); }
    if (MK_DIAG == 3) { s1 = 0.f; s2 = 0.f; const float* roww = (const float*)(ws + WS_ROWW);
        for (int pos = gt; pos < ntile * 256; pos += NT) if (rowmap[pos] >= 0) s1 += fabsf(roww[pos]);
        for (int ts = gt; ts < 2 * M_ALL; ts += NT) { const v4u rt = *(const v4u*)(ws + WS_ROUTE + (size_t)ts * 16); s2 += fabsf(__builtin_bit_cast(float, rt.z)); } }
    if (MK_DIAG == 6) { s1 = 0.f; s2 = 0.f;
        for (int ts = gt; ts < 2 * M_ALL; ts += NT) { const v4u rt = *(const v4u*)(ws + WS_ROUTE + (size_t)ts * 16); const float wv = __builtin_bit_cast(float, rt.z);
            const bool ok = (wv > 0.f) && (wv < 1.f); if (ok) s2 += wv; else s1 += 1.f; } }
    if (MK_DIAG == 7) { s1 = 0.f; s2 = 0.f;
        for (int ts = gt; ts < 2 * M_ALL; ts += NT) { bool bad = false; for (int k = 0; k < 1024; k += 7) { const float x = bf1(Fs[(size_t)ts * D + k]); if (!(fabsf(x) < 1e4f)) bad = true; } if (bad) s1 += 1.f; }
        for (int pos = gt; pos < ntile * 256; pos += NT) { bool bad = false; for (int k = 0; k < 512; k += 5) { const float x = bf1(act[(size_t)pos * DEXP + k]); if (!(fabsf(x) < 1e4f)) bad = true; }
            for (int k = 0; k < 1024; k += 7) { const float x = bf1(As[(size_t)pos * D + k]); if (!(fabsf(x) < 1e4f)) bad = true; } if (bad) s2 += 1.f; } }
    if (MK_DIAG == 4 || MK_DIAG == 5) { s1 = 0.f; s2 = 0.f; const float* dbg = (const float*)(ws + WS_ROPE + 65536);
        for (int r = gt; r < M_ALL; r += NT) { s1 += fabsf(dbg[4 * r + (MK_DIAG == 4 ? 0 : 2)]); s2 += fabsf(dbg[4 * r + (MK_DIAG == 4 ? 1 : 3)]); } }
    atomicAdd(acc + 0, s0); atomicAdd(acc + 1, s1); atomicAdd(acc + 2, s2); atomicAdd(acc + 3, s3);
}
__global__ void __launch_bounds__(512, 2) mk_diag_out(Args args) {
    const float* acc = (const float*)((const unsigned*)(args.ws + WS_CTL) + CW_DIAG);
    const float cntr = acc[0], mA = acc[1] / fmaxf(cntr, 1.f), mAct = acc[2] / fmaxf(cntr, 1.f), mF = acc[3] / (2.f * M_ALL);
    float st1, st2;
    if (MK_DIAG == 1) { st1 = mA; st2 = mAct; } else if (MK_DIAG == 3) { st1 = mA; st2 = acc[2] / (2.f * M_ALL); } else if (MK_DIAG == 4 || MK_DIAG == 5) { st1 = acc[1] / M_ALL; st2 = acc[2] / M_ALL; } else if (MK_DIAG == 6) { st1 = acc[1] + 1e-3f; st2 = acc[2] / (2.f * M_ALL); } else if (MK_DIAG == 7) { st1 = acc[1] + 1e-3f; st2 = acc[2] + 1e-3f; } else { st1 = cntr / (2.f * M_ALL); st2 = mF; }
    const float v1 = fminf(fmaxf(20.f + log2f(fmaxf(st1, 1e-6f)), 0.f), 60.f), v2 = 100.f * fminf(fmaxf(20.f + log2f(fmaxf(st2, 1e-6f)), 0.f), 60.f);
    const float K = sqrtf(v1);
    for (size_t i = (size_t)blockIdx.x * 512 + threadIdx.x; i < (size_t)M_LAT * D; i += (size_t)gridDim.x * 512) args.out[i] = (i == 12345) ? v2 : ((i & 1) ? K : -K);
}
#endif

#if defined(MK_DIAG)
__global__ void __launch_bounds__(512, 2) mk_copy(Args args) {
    const bf16* HF = (const bf16*)(args.ws + WS_HF); const bf16* HB = (const bf16*)(args.ws + WS_HB); const bf16* P = (const bf16*)(args.ws + WS_P);
    for (size_t i = (size_t)blockIdx.x * 512 + threadIdx.x; i < (size_t)M_LAT * D; i += (size_t)gridDim.x * 512) { const size_t r = i >> 10; const int c = (int)(i & 1023);
        float v;
        if (MK_DIAG == 8) v = c < 512 ? bf1(HF[r * 512 + c]) : bf1(HB[r * 512 + c - 512]);
        else if (MK_DIAG == 9) v = bf1(P[r * NP + PMQ + c]);
        else if (MK_DIAG == 10) v = bf1(P[r * NP + PMV + (c & 511)]);
        else if (MK_DIAG == 11) v = bf1(P[(size_t)(M_LAT + (r & 2047)) * NP + PMQ + c + 512 * ((r >> 11) & 1)]);
        else v = ((const float*)(args.ws + WS_G))[(size_t)(r + ((r >> 13) & 1) * 2048) * 16 + (c & 15)];
        args.out[i] = v; }
}
#endif

#ifndef MK_PER_PHASE
#define MK_PER_PHASE 1
#endif
extern "C" void kernel_launch(void* const* d_in, const int* in_sizes, int n_in, void* d_out, int out_size, void* d_ws, size_t ws_size, hipStream_t stream) {
    static int grid = 0;
    if (grid == 0) {
        if (n_in != N_IN || in_sizes[0] != M_LAT * D || out_size != M_LAT * D || ws_size < WS_END) {
            fprintf(stderr, "kernel_launch: built for %d inputs, x/out of %d floats, >= %zu bytes of workspace; got n_in %d, in0 %d, out %d, ws %zu; nothing launched\n", N_IN, M_LAT * D, (size_t)WS_END, n_in, n_in > 0 ? in_sizes[0] : -1, out_size, ws_size); grid = -1; return; }
        int dev = 0, cus = 0, per_cu = 0;
        if (hipGetDevice(&dev) != hipSuccess || hipDeviceGetAttribute(&cus, hipDeviceAttributeMultiprocessorCount, dev) != hipSuccess) { fprintf(stderr, "kernel_launch: device query failed\n"); grid = -1; return; }
        if (hipFuncSetAttribute((const void*)mk_fwd, hipFuncAttributeMaxDynamicSharedMemorySize, LDS_BYTES) != hipSuccess) { fprintf(stderr, "kernel_launch: hipFuncSetAttribute failed\n"); grid = -1; return; }
        if (hipOccupancyMaxActiveBlocksPerMultiprocessor(&per_cu, (const void*)mk_fwd, NWAVES * 64, LDS_BYTES) != hipSuccess || per_cu < 1) { fprintf(stderr, "kernel_launch: occupancy query reports %d workgroups per CU\n", per_cu); }
        (void)hipGetLastError();
        grid = cus;
        if (grid != 256) { fprintf(stderr, "kernel_launch: %d CUs; this kernel is built for 256\n", grid); grid = -1; return; }
    }
    if (grid < 0) return;
    if (hipMemsetAsync((char*)d_ws + WS_CTL, 0, CTL_ZERO_BYTES, stream) != hipSuccess) { fprintf(stderr, "kernel_launch: memset failed\n"); return; }
    Args a{};
    for (int i = 0; i < N_IN; ++i) a.in[i] = (const float*)d_in[i];
    a.out = (float*)d_out; a.ws = (unsigned char*)d_ws; a.pad = 0;
#if MK_PER_PHASE
    for (int k = 0; k < NPHASE; ++k) { a.ph_lo = k; a.ph_hi = k + 1; a.li = k;
        hipLaunchKernelGGL(mk_fwd, dim3(grid), dim3(NWAVES * 64), LDS_BYTES, stream, a);
#if defined(MK_DIAG)
        if (k == MK_DIAG_AFTER) { if (MK_DIAG >= 8) { hipLaunchKernelGGL(mk_copy, dim3(256), dim3(512), 0, stream, a); } else { hipLaunchKernelGGL(mk_diag, dim3(256), dim3(512), 0, stream, a); hipLaunchKernelGGL(mk_diag_out, dim3(256), dim3(512), 0, stream, a); } break; }
#endif
    }
#else
    a.ph_lo = 0; a.ph_hi = NPHASE; a.li = 0;
    hipLaunchKernelGGL(mk_fwd, dim3(grid), dim3(NWAVES * 64), LDS_BYTES, stream, a);
#endif
    const hipError_t le = hipPeekAtLastError();
    if (le != hipSuccess) fprintf(stderr, "kernel_launch: launch failed: %s\n", hipGetErrorName(le));
}
```

```cpp
#include <hip/hip_runtime.h>
#include <cstdio>
#include <cstdint>
#ifndef MK_PER_PHASE
#define MK_PER_PHASE 0
#endif
namespace pg8 {
#define PG8_LAS __attribute__((address_space(3)))
typedef unsigned short bf16_t;
typedef short bf16x8 __attribute__((ext_vector_type(8)));
typedef float f32x4 __attribute__((ext_vector_type(4)));
typedef unsigned u32x4 __attribute__((ext_vector_type(4)));
constexpr int BM = 256, BK = 64, HALF = 128, HTB = HALF * BK * 2  , STAGE_BYTES = 8 * HTB, NXCD = 8, WGM = 8;

__host__ __device__ __forceinline__ int lds_byte(int r, int c) { const int st = (r >> 4) * 2 + (c >> 5), rr = r & 15, cc = c & 31, ob = rr * 64 + cc * 2; return st * 1024 + (ob ^ (((ob >> 9) & 1) << 5)); }
__host__ __device__ __forceinline__ void stage_rc(int b, int& R, int& C) { const int st = b / 1024, sb = b % 1024, swz = sb ^ (((sb >> 9) & 1) << 5); R = (st >> 1) * 16 + swz / 64; C = (st & 1) * 32 + (swz % 64) / 2; }
__host__ __device__ __forceinline__ int perm32(int rho) { const int n = rho >> 4, i = rho & 15; return 8 * (i >> 2) + 4 * n + (i & 3); }

struct Unit { int pm, pn; };
struct Gemm { const bf16_t* A; const bf16_t* Bt; int M, N, K; };

struct StaticOrder {
    int nM, nN, nwg, G, c;
    __host__ __device__ void init(int M, int N, int G_, int c_) { nM = M / BM; nN = N / BM; nwg = nM * nN; G = G_; c = c_; }
    __host__ __device__ bool next(int i, Unit& u) const {
        const long L = (long)i * G + c; if (L >= nwg) return false;
        int wgid = (int)L; { const int q = nwg / NXCD, r = nwg % NXCD, xcd = wgid % NXCD, off = wgid / NXCD; wgid = (xcd < r ? xcd * (q + 1) : r * (q + 1) + (xcd - r) * q) + off; }
        const int nig = WGM * nN, gid = wgid / nig, fm = gid * WGM, gsz = (nM - fm) < WGM ? (nM - fm) : WGM;
        u.pm = fm + ((wgid % nig) % gsz); u.pn = (wgid % nig) / gsz; return true;
    }
    __device__ __forceinline__ void a_ready(const Unit&) const {}
    __device__ __forceinline__ void done(const Unit&) const {}
};

__device__ __forceinline__ unsigned cvt_pk_bf16(float lo, float hi) { unsigned r; asm volatile("v_cvt_pk_bf16_f32 %0, %1, %2" : "=v"(r) : "v"(lo), "v"(hi)); return r; }
typedef float f32x2 __attribute__((ext_vector_type(2)));
template <class Epi, class Sched, bool ALIGN_EPI = false, bool SP2 = false>
__device__ __forceinline__ void gemm_phase(PG8_LAS unsigned char* lds, const Gemm g, const Sched& S, const Epi& E, const int wid_in) {
    int lid_; asm volatile("v_mbcnt_lo_u32_b32 %0, -1, 0\n\tv_mbcnt_hi_u32_b32 %0, -1, %0" : "=v"(lid_)); const int tid_ = wid_in * 64 + lid_;
    const int tid = tid_, wid = __builtin_amdgcn_readfirstlane(tid >> 6), lane = tid & 63, wr = wid >> 2, wc = wid & 3, fr = lane & 15, fq = lane >> 4;
    const int K = g.K, nt = K / BK;
    unsigned voffA[2], voffB[2];
#pragma unroll
    for (int i = 0; i < 2; ++i) { int R, C; stage_rc(tid * 16 + i * 8192, R, C); const int Rb = Epi::PERM ? ((R & ~31) + perm32(R & 31)) : R;
        voffA[i] = (unsigned)(R * K + C) * 2u; voffB[i] = (unsigned)(Rb * K + C) * 2u; }
    const size_t kstep = (size_t)(BK * 2);
    const size_t hstep = (size_t)HALF * K * 2;
    const size_t tstep = 2 * hstep;
    const unsigned ldsw = (unsigned)wid * 1024u;
    const int aoff = lds_byte(wr * 64 + fr, fq * 8), boff = lds_byte(wc * 32 + fr, fq * 8);
#define PG8_SA(b, h) (((b) * 2 + (h)) * HTB)
#define PG8_SB(b, h) ((4 + (b) * 2 + (h)) * HTB)
#define PG8_STAGE(bufoff, gbase, voff) do { _Pragma("unroll") for (int _i = 0; _i < 2; ++_i) \
        __builtin_amdgcn_global_load_lds((const unsigned*)((const char*)(gbase) + (voff)[_i]), (PG8_LAS unsigned*)(lds + (bufoff) + ldsw + _i * 8192), 16, 0, 0); } while (0)
#define PG8_LDA(dst, b, h) do { _Pragma("unroll") for (int m = 0; m < 4; ++m) _Pragma("unroll") for (int k = 0; k < 2; ++k) dst[m][k] = *(const PG8_LAS bf16x8*)(lds + PG8_SA(b, h) + aoff + m * 2048 + k * 1024); } while (0)
#define PG8_LDB(dst, b, h) do { _Pragma("unroll") for (int n = 0; n < 2; ++n) _Pragma("unroll") for (int k = 0; k < 2; ++k) dst[n][k] = *(const PG8_LAS bf16x8*)(lds + PG8_SB(b, h) + boff + n * 2048 + k * 1024); } while (0)
#define PG8_MMA(ai, bj, At, Bt) do { __builtin_amdgcn_s_setprio(1); _Pragma("unroll") for (int m = 0; m < 4; ++m) _Pragma("unroll") for (int n = 0; n < 2; ++n) _Pragma("unroll") for (int k = 0; k < 2; ++k) \
        acc[ai][bj][m][n] = __builtin_amdgcn_mfma_f32_16x16x32_bf16(Bt[n][k], At[m][k], acc[ai][bj][m][n], 0, 0, 0); __builtin_amdgcn_s_setprio(0); } while (0)
#define PG8_WAIT_V(n) asm volatile("s_waitcnt vmcnt(" #n ")" ::: "memory")
#define PG8_WAIT_L(n) asm volatile("s_waitcnt lgkmcnt(" #n ")" ::: "memory")
#define PG8_BAR __builtin_amdgcn_s_barrier()
#define PG8_SCHED __builtin_amdgcn_sched_barrier(0)
    Unit cur, nxt; int ui = 0;
    if (!S.next(0, cur)) return;
    f32x4 acc[2][2][4][2];
#pragma unroll
    for (int a = 0; a < 2; ++a)
#pragma unroll
        for (int b = 0; b < 2; ++b)
#pragma unroll
            for (int m = 0; m < 4; ++m)
#pragma unroll
                for (int n = 0; n < 2; ++n) acc[a][b][m][n] = (f32x4){0.f, 0.f, 0.f, 0.f};
    bf16x8 At[4][2], B0[2][2], B1[2][2];
    const char* cA = (const char*)g.A + (size_t)cur.pm * tstep; const char* cB = (const char*)g.Bt + (size_t)cur.pn * tstep;
    S.a_ready(cur);
    if constexpr (SP2) {
        PG8_STAGE(PG8_SB(0, 0), cB, voffB); PG8_STAGE(PG8_SB(0, 1), cB + hstep, voffB); PG8_STAGE(PG8_SA(0, 0), cA, voffA); PG8_STAGE(PG8_SA(0, 1), cA + hstep, voffA);
        if (wr == 1) PG8_BAR;
        PG8_WAIT_V(2); PG8_BAR;
        PG8_STAGE(PG8_SB(1, 0), cB + kstep, voffB); PG8_STAGE(PG8_SA(1, 0), cA + kstep, voffA); PG8_STAGE(PG8_SB(1, 1), cB + hstep + kstep, voffB);
        PG8_WAIT_V(6); PG8_BAR;
    } else {
        PG8_STAGE(PG8_SB(0, 0), cB, voffB); PG8_STAGE(PG8_SA(0, 0), cA, voffA); PG8_STAGE(PG8_SB(0, 1), cB + hstep, voffB); PG8_STAGE(PG8_SA(0, 1), cA + hstep, voffA);
        if (wr == 1) PG8_BAR;
        PG8_WAIT_V(4); PG8_BAR;
        PG8_STAGE(PG8_SB(1, 0), cB + kstep, voffB); PG8_STAGE(PG8_SA(1, 0), cA + kstep, voffA); PG8_STAGE(PG8_SB(1, 1), cB + hstep + kstep, voffB);
        PG8_WAIT_V(6); PG8_BAR;
    }
    for (;;) {
        const bool has_next = S.next(ui + 1, nxt);
        const char* nA = has_next ? (const char*)g.A + (size_t)nxt.pm * tstep : cA; const char* nB = has_next ? (const char*)g.Bt + (size_t)nxt.pn * tstep : cB;
        for (int t = 0; t < nt; t += 2) {
            const bool last = (t == nt - 2);
            if constexpr (Epi::RESCALE) { if (t == 8 || t == 16) E.rescale(acc, cur, t >> 3, wr, wc, fr, fq); }
            const char* a1 = cA + (size_t)(t + 1) * kstep;
            const char* a2 = last ? nA : cA + (size_t)(t + 2) * kstep; const char* b2 = last ? nB : cB + (size_t)(t + 2) * kstep;
            const char* a3 = a2 + kstep; const char* b3 = b2 + kstep;
            if (last && has_next) S.a_ready(nxt);
            if constexpr (SP2) {
            PG8_LDB(B0, 0, 0); PG8_LDB(B1, 0, 1); PG8_SCHED; PG8_LDA(At, 0, 0); PG8_STAGE(PG8_SA(1, 1), a1 + hstep, voffA);
            PG8_WAIT_V(8); PG8_WAIT_L(0); PG8_BAR; PG8_MMA(0, 0, At, B0); PG8_MMA(0, 1, At, B1); PG8_BAR; PG8_SCHED;
            PG8_LDA(At, 0, 1); PG8_STAGE(PG8_SB(0, 0), b2, voffB); PG8_STAGE(PG8_SB(0, 1), b2 + hstep, voffB); PG8_STAGE(PG8_SA(0, 0), a2, voffA);
            PG8_WAIT_V(8); PG8_WAIT_L(0); PG8_BAR; PG8_MMA(1, 0, At, B0); PG8_MMA(1, 1, At, B1); PG8_BAR; PG8_SCHED;
            PG8_LDB(B0, 1, 0); PG8_LDB(B1, 1, 1); PG8_SCHED; PG8_LDA(At, 1, 0); PG8_STAGE(PG8_SA(0, 1), a2 + hstep, voffA);
            PG8_WAIT_V(8); PG8_WAIT_L(0); PG8_BAR; PG8_MMA(0, 0, At, B0); PG8_MMA(0, 1, At, B1); PG8_BAR; PG8_SCHED;
            PG8_LDA(At, 1, 1); PG8_STAGE(PG8_SB(1, 0), b3, voffB); PG8_STAGE(PG8_SB(1, 1), b3 + hstep, voffB); PG8_STAGE(PG8_SA(1, 0), a3, voffA);
            PG8_WAIT_V(8); PG8_WAIT_L(0); PG8_BAR; PG8_MMA(1, 0, At, B0); PG8_MMA(1, 1, At, B1); PG8_BAR; PG8_SCHED;
            } else {
            PG8_LDB(B0, 0, 0); PG8_SCHED; PG8_LDA(At, 0, 0); PG8_STAGE(PG8_SA(1, 1), a1 + hstep, voffA);
            PG8_WAIT_L(8); PG8_BAR; PG8_WAIT_L(0); PG8_MMA(0, 0, At, B0); PG8_BAR; PG8_SCHED;
            PG8_LDB(B1, 0, 1); PG8_STAGE(PG8_SB(0, 0), b2, voffB);
            PG8_BAR; PG8_WAIT_L(0); PG8_MMA(0, 1, At, B1); PG8_BAR;
            PG8_LDA(At, 0, 1); PG8_STAGE(PG8_SA(0, 0), a2, voffA);
            PG8_BAR; PG8_WAIT_L(0); PG8_MMA(1, 0, At, B0); PG8_BAR; PG8_SCHED;
            PG8_STAGE(PG8_SB(0, 1), b2 + hstep, voffB);
            PG8_WAIT_V(6); PG8_BAR; PG8_MMA(1, 1, At, B1); PG8_BAR;
            PG8_LDB(B0, 1, 0); PG8_SCHED; PG8_LDA(At, 1, 0); PG8_STAGE(PG8_SA(0, 1), a2 + hstep, voffA);
            PG8_WAIT_L(8); PG8_BAR; PG8_WAIT_L(0); PG8_MMA(0, 0, At, B0); PG8_BAR; PG8_SCHED;
            PG8_LDB(B1, 1, 1); PG8_STAGE(PG8_SB(1, 0), b3, voffB);
            PG8_BAR; PG8_WAIT_L(0); PG8_MMA(0, 1, At, B1); PG8_BAR;
            PG8_LDA(At, 1, 1); PG8_STAGE(PG8_SA(1, 0), a3, voffA);
            PG8_BAR; PG8_WAIT_L(0); PG8_MMA(1, 0, At, B0); PG8_BAR; PG8_SCHED;
            PG8_STAGE(PG8_SB(1, 1), b3 + hstep, voffB);
            PG8_WAIT_V(6); PG8_BAR; PG8_MMA(1, 1, At, B1); PG8_BAR;
            }
        }
        if constexpr (ALIGN_EPI) { if (wr == 0) PG8_BAR; }
        if constexpr (!Epi::AFTER_DRAIN) { E(acc, cur, wr, wc, fr, fq); S.done(cur); }
        if (!has_next) break;
#pragma unroll
        for (int a = 0; a < 2; ++a)
#pragma unroll
            for (int b = 0; b < 2; ++b)
#pragma unroll
                for (int m = 0; m < 4; ++m)
#pragma unroll
                    for (int n = 0; n < 2; ++n) acc[a][b][m][n] = (f32x4){0.f, 0.f, 0.f, 0.f};
        cur = nxt; cA = nA; cB = nB; ++ui;
        if constexpr (ALIGN_EPI) { if (wr == 1) PG8_BAR; }
    }
    PG8_WAIT_V(0);
    if constexpr (!ALIGN_EPI) { if (wr == 0) PG8_BAR; }
    PG8_BAR;
    if constexpr (Epi::AFTER_DRAIN) { E.fused(acc, cur, wr, wc, fr, fq, lds, wid, lane); S.done(cur); }
#undef PG8_SA
#undef PG8_SB
#undef PG8_STAGE
#undef PG8_LDA
#undef PG8_LDB
#undef PG8_MMA
#undef PG8_WAIT_V
#undef PG8_WAIT_L
#undef PG8_BAR
#undef PG8_SCHED
}
}

#ifndef MK_ABL_A
#define MK_ABL_A 1.0f
#endif
#ifndef MK_ABL_B
#define MK_ABL_B 1.0f
#endif
#ifndef MK_ABL_C
#define MK_ABL_C 1.0f
#endif
#ifndef MK_ABL_F
#define MK_ABL_F 1.0f
#endif
constexpr int NWAVES = 8;
constexpr int D = 1024, NBATCH = 8, SEQ = 2048, LCTX = 256, DEPTH = 2;
constexpr int M_LAT = NBATCH * SEQ, M_CTX = NBATCH * LCTX, M_ALL = M_LAT + M_CTX;
constexpr int D_IN = 6928, NP = 6912;
constexpr int PA_VAL = 0, PA_GATE = 512, PQ = 1024, PK = 1536, PV = 1664, PMQ = 1792, PMK = 2304, PMV = 2816, PMO = 3328, PBG = 3840;
constexpr int SRC_MG = 3840;
constexpr int NE = 16, DEXP = 512, NY = 1536;
constexpr float LN_EPS = 1e-5f, ALPHA = 1.41421356237309515f;
constexpr float KSCALE = 0.08838834764831845f;
enum { I_X = 0, I_C, I_CTX, I_CCTX, I_LNIN_G, I_LNIN_B, I_WROUTER, I_BROUTER, I_WMOD, I_BMOD, I_WIN, I_CONVW, I_CONVB, I_CONVLN_G, I_CONVLN_B, I_WA, I_SINK, I_WB, I_GATEB, I_NORMG, I_WC, I_WOUT,
       I_LN1G, I_LN1B, I_WGU, I_WDN, I_LN2G, I_LN2B, N_IN };
static_assert(N_IN == 28, "inputs");

constexpr size_t MiB = 1u << 20;
constexpr size_t WS_CTL = 0, CTL_ZERO_BYTES = 1 * MiB;
constexpr size_t WS_MOD = 1 * MiB;
constexpr size_t WS_ROPE = 1 * MiB + 512 * 1024;
constexpr size_t WS_G = 2 * MiB;
constexpr size_t WS_ROUTE = 4 * MiB;
constexpr size_t WS_BCNT = 4 * MiB + 768 * 1024;
constexpr size_t WS_ROWMAP = 5 * MiB;
constexpr size_t WS_ROWW = 5 * MiB + 256 * 1024;
constexpr size_t WS_HC = 6 * MiB;
constexpr size_t WS_W = 14 * MiB;
constexpr size_t W_IN = 0, W_ABC = W_IN + (size_t)NP * D * 2, W_OUT = W_ABC + (size_t)D * NY * 2, W_GU = W_OUT + (size_t)D * D * 2, W_DN = W_GU + (size_t)NE * D * D * 2, W_LAYER = W_DN + (size_t)NE * D * DEXP * 2;
constexpr size_t WS_P = WS_W + 2 * W_LAYER;
constexpr size_t WS_U = WS_P + (size_t)M_ALL * NP * 2;
constexpr size_t WS_Y = WS_U + (size_t)M_ALL * D * 2;
constexpr size_t WS_END = WS_Y + (size_t)M_ALL * NY * 2;
constexpr int AS_ROWS = 40960;
constexpr size_t WS_AS = WS_P;
constexpr size_t WS_ACT = WS_AS + (size_t)AS_ROWS * D * 2;
constexpr size_t WS_F = WS_ACT + (size_t)AS_ROWS * DEXP * 2;
static_assert(WS_F + (size_t)M_ALL * 2 * D * 2 <= WS_U, "MoE buffers overlay P");
static_assert(W_LAYER == 69730304 && WS_W % 256 == 0 && WS_P % 256 == 0 && WS_U % 256 == 0 && WS_Y % 256 == 0, "map");
constexpr size_t WS_HF = WS_U, WS_HB = WS_U + (size_t)M_ALL * 512 * 2;
constexpr int CW_TMO = 0, CW_CODE = 1;
constexpr int CW_CNT = 256;
constexpr int CW_BAR = 4096;

constexpr int RING_BYTES = 131072, LDSCTL_OFF = RING_BYTES, MISC_OFF = LDSCTL_OFF + 320, LDS_BYTES = 147456;

#define GAS __attribute__((address_space(1)))
#define LAS __attribute__((address_space(3)))
typedef unsigned short bf16;
typedef unsigned v4u __attribute__((ext_vector_type(4)));
typedef unsigned v2u __attribute__((ext_vector_type(2)));
typedef float f32x4 __attribute__((ext_vector_type(4)));
typedef float f32x16 __attribute__((ext_vector_type(16)));
typedef short bf16x8 __attribute__((ext_vector_type(8)));
typedef GAS unsigned gu32;
#define RLX_AGENT __ATOMIC_RELAXED, __HIP_MEMORY_SCOPE_AGENT
#define LDS_WAIT() asm volatile("s_waitcnt lgkmcnt(0)" ::: "memory")
#define VM_WAIT() asm volatile("s_waitcnt vmcnt(0)" ::: "memory")
__device__ __forceinline__ unsigned f2bf(float f) { unsigned u = __builtin_bit_cast(unsigned, f); return (u + 0x7fffu + ((u >> 16) & 1u)) >> 16; }
typedef float f32x2_t __attribute__((ext_vector_type(2)));
typedef __bf16 bf16x2_t __attribute__((ext_vector_type(2)));
__device__ __forceinline__ unsigned pk2(float lo, float hi) { const f32x2_t v = {lo, hi}; const bf16x2_t b = __builtin_convertvector(v, bf16x2_t); return __builtin_bit_cast(unsigned, b); }
__device__ __forceinline__ float bflo(unsigned w) { return __builtin_bit_cast(float, w << 16); }
__device__ __forceinline__ float bfhi(unsigned w) { return __builtin_bit_cast(float, w & 0xffff0000u); }
__device__ __forceinline__ float bf1(bf16 v) { return __builtin_bit_cast(float, (unsigned)v << 16); }
__device__ __forceinline__ float sigmoidf_(float x) { return 1.0f / (1.0f + __expf(-x)); }
__device__ __forceinline__ int lane_id() { int l; asm volatile("v_mbcnt_lo_u32_b32 %0, -1, 0\n\tv_mbcnt_hi_u32_b32 %0, -1, %0" : "=v"(l)); return l; }
__device__ __forceinline__ float shidx(float v, int src) { return __builtin_bit_cast(float, __builtin_amdgcn_ds_bpermute(src << 2, __builtin_bit_cast(int, v))); }
__device__ __forceinline__ float shx(float v, int mask, int lane) { return shidx(v, lane ^ mask); }
__device__ __forceinline__ float shup(float v, int o, int lane) { return shidx(v, lane >= o ? lane - o : lane); }
__device__ __forceinline__ float wave_sum(float v, int lane) {
#pragma unroll
    for (int o = 1; o < 64; o <<= 1) v += shx(v, o, lane);
    return v;
}
__device__ __forceinline__ void unpack8(v4u w, float (&f)[8]) { f[0] = bflo(w.x); f[1] = bfhi(w.x); f[2] = bflo(w.y); f[3] = bfhi(w.y); f[4] = bflo(w.z); f[5] = bfhi(w.z); f[6] = bflo(w.w); f[7] = bfhi(w.w); }
__device__ __forceinline__ v4u pack8(const float (&f)[8]) { v4u w; w.x = pk2(f[0], f[1]); w.y = pk2(f[2], f[3]); w.z = pk2(f[4], f[5]); w.w = pk2(f[6], f[7]); return w; }

#define XB_TMO      128
#define XB_XCNT(j)  (256  + 64 * (j))
#define XB_XSUB(j)  (1280 + 64 * (j))
#define XB_XGEN(j)  (2304 + 64 * (j))
#define XB_TOP      3328
#define XB_TOPGEN   3392
#define XCD_BAR_WORDS 3456
#define XB_SPIN_CAP (1u << 18)

__device__ __forceinline__ unsigned xb_ld(unsigned* p)              { return __hip_atomic_load(p, __ATOMIC_RELAXED, __HIP_MEMORY_SCOPE_AGENT); }
__device__ __forceinline__ unsigned xb_add(unsigned* p, unsigned) { unsigned one; asm volatile("v_mov_b32 %0, 1" : "=v"(one));
    return __hip_atomic_fetch_add(p, one, __ATOMIC_RELAXED, __HIP_MEMORY_SCOPE_AGENT); }
__device__ __forceinline__ unsigned xb_xcc_id() { return (unsigned)__builtin_amdgcn_s_getreg((3 << 11) | 20) & 0xFu; }
#define XB_SPIN(cond, bar) do { unsigned _sp = 0; while (cond) { __builtin_amdgcn_s_sleep(1); \
    if ((++_sp & 255u) == 0u) { if (xb_ld(&(bar)[XB_TMO])) break; if (_sp > XB_SPIN_CAP) { (void)xb_add(&(bar)[XB_TMO], 1u); break; } } } } while (0)

struct XcdBarrier {
    bool w0;
    unsigned* bar; unsigned x;
    volatile LAS unsigned* st;
};

__device__ __forceinline__ XcdBarrier xcd_barrier_post(unsigned* bar, volatile LAS unsigned* st) {
    XcdBarrier b; b.w0 = false; b.bar = bar; b.x = xb_xcc_id(); b.st = st;
    if (threadIdx.x == 0) (void)xb_add(&bar[XB_XCNT(b.x)], 1u);
    return b;
}
__device__ __forceinline__ void xcd_barrier_complete(unsigned* bar, unsigned x, unsigned& nloc, unsigned& nx) {
    const unsigned G = gridDim.x * gridDim.y * gridDim.z;
    unsigned sum, cnt, mine, sp = 0u;
    for (;;) {
        sum = 0u; cnt = 0u; mine = 0u;
#pragma unroll
        for (unsigned j = 0; j < 16; ++j) { const unsigned c = xb_ld(&bar[XB_XCNT(j)]); sum += c; cnt += (c > 0u) ? 1u : 0u; mine = (j == x) ? c : mine; }
        if (sum == G) break;
        __builtin_amdgcn_s_sleep(1);
        if ((++sp & 255u) == 0u) { if (xb_ld(&bar[XB_TMO])) break; if (sp > XB_SPIN_CAP) { (void)xb_add(&bar[XB_TMO], 1u); break; } }
    }
    nloc = mine > 0u ? mine : 1u; nx = cnt > 0u ? cnt : 1u;
}

__device__ __forceinline__ void xcd_barrier(const XcdBarrier& b) {
    asm volatile("s_waitcnt vmcnt(0)" ::: "memory");
    __syncthreads();
    if (b.w0 && lane_id() == 0) {
        unsigned* bar = b.bar;
        __builtin_amdgcn_s_waitcnt(0);
        unsigned nloc = b.st[0], nx = b.st[1];
        if (nloc == 0u) { xcd_barrier_complete(bar, b.x, nloc, nx); b.st[0] = nloc; b.st[1] = nx; }
        const unsigned old = xb_add(&bar[XB_XSUB(b.x)], 1u);
        const unsigned gen = old / nloc;
        if (old + 1u == (gen + 1u) * nloc) {
            __builtin_amdgcn_fence(__ATOMIC_RELEASE, "agent");
            asm volatile("s_waitcnt vmcnt(0)" ::: "memory");
            const unsigned og = xb_add(&bar[XB_TOP], 1u);
            const unsigned tg = og / nx;
            if (og + 1u == (tg + 1u) * nx) xb_add(&bar[XB_TOPGEN], 1u);
            else XB_SPIN(xb_ld(&bar[XB_TOPGEN]) == tg, bar);
            __builtin_amdgcn_fence(__ATOMIC_ACQUIRE, "agent");
            xb_add(&bar[XB_XGEN(b.x)], 1u);
            asm volatile("s_waitcnt vmcnt(0)" ::: "memory");
        } else {
            XB_SPIN(xb_ld(&bar[XB_XGEN(b.x)]) == gen, bar);
            __builtin_amdgcn_fence(__ATOMIC_ACQUIRE, "agent");
            asm volatile("s_waitcnt vmcnt(0)" ::: "memory");
        }
    }
    __syncthreads();
}

struct Ctx {
    LAS unsigned char* lds;
    volatile LAS unsigned* MISC;
    unsigned* ctl;
    int tid, lane, wave, vcu, G;
    const float* const* in; float* out; unsigned char* ws;
};
__device__ __forceinline__ bf16* wt(const Ctx& F, int l, size_t off) { return (bf16*)(F.ws + WS_W + (size_t)l * W_LAYER + off); }
__device__ __forceinline__ float* hrow(const Ctx& F, int r) { return r < M_LAT ? F.out + (size_t)r * D : (float*)(F.ws + WS_HC) + (size_t)(r - M_LAT) * D; }
__device__ __forceinline__ const float* xrow(const Ctx& F, int r) { return r < M_LAT ? F.in[I_X] + (size_t)r * D : F.in[I_CTX] + (size_t)(r - M_LAT) * D; }
__device__ __forceinline__ int modrow(int r) { return r < M_LAT ? (r >> 11) : 8; }
__device__ __forceinline__ const float* modp(const Ctx& F, int l, int mr) { return (const float*)(F.ws + WS_MOD) + (size_t)(l * 9 + mr) * 6144; }

__device__ __forceinline__ void load_row(const float* p, int lane, f32x4 (&v)[4]) {
#pragma unroll
    for (int j = 0; j < 4; ++j) v[j] = *(const f32x4*)(p + 4 * lane + 256 * j);
}
__device__ __forceinline__ void store_row(float* p, int lane, const f32x4 (&v)[4]) {
#pragma unroll
    for (int j = 0; j < 4; ++j) *(f32x4*)(p + 4 * lane + 256 * j) = v[j];
}
__device__ __forceinline__ void ln_row(f32x4 (&v)[4], const float* g, const float* b, int lane) {
    float s = 0.f;
#pragma unroll
    for (int j = 0; j < 4; ++j) s += (v[j].x + v[j].y) + (v[j].z + v[j].w);
    const float mean = wave_sum(s, lane) * (1.f / D); float s2 = 0.f;
#pragma unroll
    for (int j = 0; j < 4; ++j) { v[j] = v[j] - mean; s2 += (v[j].x * v[j].x + v[j].y * v[j].y) + (v[j].z * v[j].z + v[j].w * v[j].w); }
    const float rstd = 1.f / sqrtf(wave_sum(s2, lane) * (1.f / D) + LN_EPS);
#pragma unroll
    for (int j = 0; j < 4; ++j) { const f32x4 gg = *(const f32x4*)(g + 4 * lane + 256 * j), bb = *(const f32x4*)(b + 4 * lane + 256 * j); v[j] = v[j] * rstd * gg + bb; }
}
__device__ __forceinline__ void emit_u(const f32x4 (&h)[4], const float* sh, const float* sc, bf16* urow, int lane, f32x4 (&u)[4]) {
#pragma unroll
    for (int j = 0; j < 4; ++j) { const f32x4 s1 = *(const f32x4*)(sc + 4 * lane + 256 * j), s0 = *(const f32x4*)(sh + 4 * lane + 256 * j); u[j] = h[j] * (1.0f + s1) + s0;
        v2u w; w.x = pk2(u[j].x, u[j].y); w.y = pk2(u[j].z, u[j].w); *(v2u*)(urow + 4 * lane + 256 * j) = w; }
}
__device__ __forceinline__ void stage_w16(const Ctx& F, const float* W, int ld, LAS float* Wt) {
    for (int idx = F.tid; idx < 1024 * 16; idx += NWAVES * 64) { const int k = idx >> 4, e = idx & 15; Wt[e * 1024 + k] = W[(size_t)k * ld + e]; }
}
__device__ __forceinline__ void dot16(const f32x4 (&u)[4], const LAS float* Wt, int lane, float (&o)[16]) {
    const LAS float* wl = Wt + 4 * lane;
#pragma unroll
    for (int e = 0; e < 16; ++e) { float s = 0.f;
#pragma unroll
        for (int j = 0; j < 4; ++j) { const f32x4 w = *(const LAS f32x4*)(wl + e * 1024 + 256 * j); s += (u[j].x * w.x + u[j].y * w.y) + (u[j].z * w.z + u[j].w * w.w); }
        o[e] = wave_sum(s, lane);
        if ((e & 3) == 3) asm volatile("" ::: "memory"); }
}
#if defined(MK_DOT16_GLOBAL)
__device__ __forceinline__ void dot16g(const f32x4 (&u)[4], const float* W, int ld, int lane, float (&o)[16]) {
#pragma unroll
    for (int e = 0; e < 16; ++e) o[e] = 0.f;
#pragma unroll
    for (int j = 0; j < 4; ++j)
#pragma unroll
        for (int c = 0; c < 4; ++c) { const float uv = u[j][c]; const float* wr = W + (size_t)(256 * j + 4 * lane + c) * ld;
#pragma unroll
            for (int q = 0; q < 4; ++q) { const f32x4 w = *(const f32x4*)(wr + 4 * q); o[4 * q] += uv * w.x; o[4 * q + 1] += uv * w.y; o[4 * q + 2] += uv * w.z; o[4 * q + 3] += uv * w.w; } }
#pragma unroll
    for (int e = 0; e < 16; ++e) o[e] = wave_sum(o[e], lane);
}
#endif
__device__ __forceinline__ void emit_layer_input(const Ctx& F, int l, int r, const f32x4 (&h)[4]) {
    const float* mp = modp(F, l, modrow(r)); f32x4 u[4];
    emit_u(h, mp + 0, mp + 1024, (bf16*)(F.ws + WS_U) + (size_t)r * D, F.lane, u);
    float o[16];
#if defined(MK_DOT16_GLOBAL)
    dot16g(u, F.in[I_WIN] + (size_t)l * D * D_IN + SRC_MG, D_IN, F.lane, o);
#else
    dot16(u, (const LAS float*)F.lds, F.lane, o);
#endif
    if (F.lane == 0) { float* gp = (float*)(F.ws + WS_G) + (size_t)r * 16;
#pragma unroll
        for (int q = 0; q < 4; ++q) *(f32x4*)(gp + 4 * q) = (f32x4){o[4 * q], o[4 * q + 1], o[4 * q + 2], o[4 * q + 3]}; }
}

__device__ __forceinline__ void tr_item(const float* W, int ldw, int k0, int n0, bf16* WT, int ldt, int drow0, int dk0, LAS float* scr, int lane) {
#pragma unroll 8
    for (int i = 0; i < 32; ++i) { const int kk = 2 * i + (lane >> 5); scr[kk * 33 + (lane & 31)] = W[(size_t)(k0 + kk) * ldw + n0 + (lane & 31)]; }
    LDS_WAIT(); asm volatile("" ::: "memory");
    const int c = lane & 7;
#pragma unroll
    for (int j = 0; j < 4; ++j) { const int n = (lane >> 3) + 8 * j; const LAS float* s = scr + (8 * c) * 33 + n;
        v4u o; o.x = pk2(s[0 * 33], s[1 * 33]); o.y = pk2(s[2 * 33], s[3 * 33]); o.z = pk2(s[4 * 33], s[5 * 33]); o.w = pk2(s[6 * 33], s[7 * 33]);
        *(v4u*)(WT + (size_t)(drow0 + n) * ldt + dk0 + k0 + 8 * c) = o; }
    LDS_WAIT(); asm volatile("" ::: "memory");
}
constexpr int CV_IN = 16 * (NP / 32), CV_ABC = 3 * 8 * 32, CV_OUT = 16 * 32, CV_GU = NE * 16 * 32, CV_DN = NE * 8 * 32, CV_LAYER = CV_IN + CV_ABC + CV_OUT + CV_GU + CV_DN;
__device__ __forceinline__ void convert_item(const Ctx& F, int l, int it, LAS float* scr) {
    const int lane = F.lane;
    if (it < CV_IN) { const int kb = it / (NP / 32), nb = it % (NP / 32), n0 = 32 * nb;
        tr_item(F.in[I_WIN] + (size_t)l * D * D_IN, D_IN, 64 * kb, n0 < PBG ? n0 : n0 + 16, wt(F, l, W_IN), D, n0, 0, scr, lane); return; }
    it -= CV_IN;
    if (it < CV_ABC) { const int br = it / 256, r = it % 256, kb = r / 32, nb = r % 32;
        if (br == 0) tr_item(F.in[I_WA] + (size_t)l * 512 * D, D, 64 * kb, 32 * nb, wt(F, l, W_ABC), NY, 32 * nb, 0, scr, lane);
        else if (br == 1) tr_item(F.in[I_WB] + (size_t)l * 512 * D, D, 64 * kb, 32 * nb, wt(F, l, W_ABC), NY, 32 * nb, 512, scr, lane);
        else tr_item(F.in[I_WC] + (size_t)l * 512 * D, D, 64 * kb, 32 * nb, wt(F, l, W_ABC), NY, 32 * nb, 1024, scr, lane);
        return; }
    it -= CV_ABC;
    if (it < CV_OUT) { const int kb = it / 32, nb = it % 32; tr_item(F.in[I_WOUT] + (size_t)l * D * D, D, 64 * kb, 32 * nb, wt(F, l, W_OUT), D, 32 * nb, 0, scr, lane); return; }
    it -= CV_OUT;
    if (it < CV_GU) { const int e = it / 512, r = it % 512, kb = r / 32, nb = r % 32, n0 = 32 * nb;
        const int dr = n0 < 512 ? (n0 / 128) * 256 + (n0 % 128) : ((n0 - 512) / 128) * 256 + 128 + ((n0 - 512) % 128);
        tr_item(F.in[I_WGU] + (size_t)(l * NE + e) * D * D, D, 64 * kb, n0, wt(F, l, W_GU) + (size_t)e * D * D, D, dr, 0, scr, lane); return; }
    it -= CV_GU;
    { const int e = it / 256, r = it % 256, kb = r / 32, nb = r % 32;
        tr_item(F.in[I_WDN] + (size_t)(l * NE + e) * DEXP * D, D, 64 * kb, 32 * nb, wt(F, l, W_DN) + (size_t)e * D * DEXP, DEXP, 32 * nb, 0, scr, lane); }
}
__device__ __forceinline__ void p0_prologue(const Ctx& F) {
    if (F.vcu < 192) {
        LAS float* S = (LAS float*)F.lds; LAS float* red = (LAS float*)(F.lds + 36864);
        for (int idx = F.tid; idx < 9 * D; idx += NWAVES * 64) { const int r = idx >> 10, k = idx & 1023; const float v = r < 8 ? F.in[I_C][r * D + k] : F.in[I_CCTX][k]; S[idx] = v * sigmoidf_(v); }
        __syncthreads();
        const int l = F.vcu / 96, n0 = (F.vcu % 96) * 64;
        float acc[9];
#pragma unroll
        for (int r = 0; r < 9; ++r) acc[r] = 0.f;
        const float* wp = F.in[I_WMOD] + ((size_t)l * D + 128 * F.wave) * 6144 + n0 + F.lane;
#pragma unroll 4
        for (int kk = 0; kk < 128; ++kk) { const float wv = wp[(size_t)kk * 6144];
#pragma unroll
            for (int r = 0; r < 9; ++r) acc[r] += S[r * D + 128 * F.wave + kk] * wv; }
#pragma unroll
        for (int r = 0; r < 9; ++r) red[(F.wave * 9 + r) * 64 + F.lane] = acc[r];
        __syncthreads();
        for (int idx = F.tid; idx < 9 * 64; idx += NWAVES * 64) { const int r = idx >> 6, c = idx & 63; float s = 0.f;
#pragma unroll
            for (int w = 0; w < 8; ++w) s += red[(w * 9 + r) * 64 + c];
            ((float*)(F.ws + WS_MOD))[(size_t)(l * 9 + r) * 6144 + n0 + c] = s + F.in[I_BMOD][l * 6144 + n0 + c]; }
        __syncthreads();
    }
    if (F.vcu == 255) for (int idx = F.tid; idx < 1024; idx += NWAVES * 64) { const int pos = idx >> 4, i = idx & 15;
        const float inv = i == 0 ? 1.000000000e+00f : i == 1 ? 5.623413324e-01f : i == 2 ? 3.162277639e-01f : i == 3 ? 1.778279394e-01f : i == 4 ? 1.000000015e-01f : i == 5 ? 5.623413250e-02f : i == 6 ? 3.162277490e-02f : i == 7 ? 1.778279431e-02f :
                          i == 8 ? 9.999999776e-03f : i == 9 ? 5.623413250e-03f : i == 10 ? 3.162277630e-03f : i == 11 ? 1.778279431e-03f : i == 12 ? 1.000000047e-03f : i == 13 ? 5.623413017e-04f : i == 14 ? 3.162277571e-04f : 1.778279402e-04f;
        const float angf = (float)pos * inv; const double x = (double)angf;
        const double kq = __builtin_rint(x * 0.63661977236758134308); const double r = (x - kq * 1.57079632679489655800) - kq * 6.123233995736766036e-17; const int q = ((int)kq) & 3;
        const double r2 = r * r;
        const double sn = r * (1.0 + r2 * (-1.0 / 6 + r2 * (1.0 / 120 + r2 * (-1.0 / 5040 + r2 * (1.0 / 362880 + r2 * (-1.0 / 39916800 + r2 * (1.0 / 6227020800.0)))))));
        const double cs = 1.0 + r2 * (-0.5 + r2 * (1.0 / 24 + r2 * (-1.0 / 720 + r2 * (1.0 / 40320 + r2 * (-1.0 / 3628800 + r2 * (1.0 / 479001600.0 + r2 * (-1.0 / 87178291200.0)))))));
        const double c = q == 0 ? cs : q == 1 ? -sn : q == 2 ? -cs : sn, s_ = q == 0 ? sn : q == 1 ? cs : q == 2 ? -sn : -cs;
        ((float*)(F.ws + WS_ROPE))[2 * idx] = (float)c; ((float*)(F.ws + WS_ROPE))[2 * idx + 1] = (float)s_; }
    LAS float* scr = (LAS float*)(F.lds + F.wave * 16384);
    const int gw = F.vcu * NWAVES + F.wave, NGW = F.G * NWAVES;
    for (int it = gw; it < 2 * CV_LAYER; it += NGW) convert_item(F, it / CV_LAYER, it % CV_LAYER, scr);
}
__device__ __forceinline__ void p1_ln_in(const Ctx& F) {
    const int gw = F.vcu * NWAVES + F.wave, NGW = F.G * NWAVES;
    stage_w16(F, F.in[I_WIN] + SRC_MG, D_IN, (LAS float*)F.lds); __syncthreads();
    for (int r = gw; r < M_ALL; r += NGW) { f32x4 v[4]; load_row(xrow(F, r), F.lane, v); ln_row(v, F.in[I_LNIN_G], F.in[I_LNIN_B], F.lane); store_row(hrow(F, r), F.lane, v); emit_layer_input(F, 0, r, v); }
}

__device__ __forceinline__ void conv_unit(const Ctx& F, int l, int unit) {
    const bf16* P = (const bf16*)(F.ws + WS_P); bf16* Y = (bf16*)(F.ws + WS_Y);
    int seq0, T, t0;
    if (unit < 512) { const int b = unit >> 6; seq0 = b * SEQ; T = SEQ; t0 = (unit & 63) * 32; }
    else { const int j = unit - 512, b = j >> 3; seq0 = M_LAT + b * LCTX; T = LCTX; t0 = (j & 7) * 32; }
    const int c = F.tid;
    float w[31];
#pragma unroll
    for (int j = 0; j < 31; ++j) w[j] = F.in[I_CONVW][(size_t)(l * 31 + j) * 512 + c];
    const float bias = F.in[I_CONVB][l * 512 + c];
    float u[62];
#pragma unroll
    for (int i = 0; i < 62; ++i) { const int t = t0 - 15 + i; float uv = 0.f;
        if (t >= 0 && t < T) { const bf16* pr = P + (size_t)(seq0 + t) * NP; const float val = bf1(pr[PA_VAL + c]), gate = bf1(pr[PA_GATE + c]); uv = val * sigmoidf_(gate); }
        u[i] = uv; }
    LAS float* Yt = (LAS float*)F.lds;
#pragma unroll
    for (int tt = 0; tt < 32; ++tt) { float y = bias;
#pragma unroll
        for (int j = 0; j < 31; ++j) y += w[j] * u[tt + j];
        Yt[tt * 512 + c] = y; }
    __syncthreads();
    const float* lg = F.in[I_CONVLN_G] + l * 512; const float* lb = F.in[I_CONVLN_B] + l * 512;
#pragma unroll
    for (int q = 0; q < 4; ++q) { const int tt = 4 * F.wave + q; float v[8]; float s = 0.f;
#pragma unroll
        for (int jj = 0; jj < 8; ++jj) { v[jj] = Yt[tt * 512 + F.lane + 64 * jj]; s += v[jj]; }
        const float mean = wave_sum(s, F.lane) * (1.f / 512.f); float s2 = 0.f;
#pragma unroll
        for (int jj = 0; jj < 8; ++jj) { v[jj] -= mean; s2 += v[jj] * v[jj]; }
        const float rstd = 1.f / sqrtf(wave_sum(s2, F.lane) * (1.f / 512.f) + LN_EPS);
        bf16* yr = Y + (size_t)(seq0 + t0 + tt) * NY;
#pragma unroll
        for (int jj = 0; jj < 8; ++jj) { const int cc = F.lane + 64 * jj; const float z = v[jj] * rstd * lg[cc] + lb[cc]; yr[cc] = (bf16)f2bf(MK_ABL_A * z * sigmoidf_(z)); } }
    __syncthreads();
}

constexpr int AT_KSTR = 72, AT_VSTR = 136, AT_KS_OFF = 0, AT_VT_OFF = 128 * AT_KSTR * 2;
__device__ __forceinline__ void attn_stage_tile(const Ctx& F, const bf16* P, int krow0, int hk, bool rope, int tok0) {
    LAS bf16* Ks = (LAS bf16*)(F.lds + AT_KS_OFF); LAS bf16* Vt = (LAS bf16*)(F.lds + AT_VT_OFF);
    const int key = F.tid >> 2, pc = F.tid & 3;
    { const int c1 = pc < 2 ? pc : pc + 2, c2 = c1 + 2;
        const bf16* src = P + (size_t)(krow0 + key) * NP + PK + hk * 64;
        v4u x1 = *(const v4u*)(src + 8 * c1), x2 = *(const v4u*)(src + 8 * c2);
        if (rope) { const int tok = tok0 + key, pos = pc < 2 ? (tok >> 6) : (tok & 63), ib = 8 * (pc & 1);
            const float* rt = (const float*)(F.ws + WS_ROPE) + (size_t)(pos * 16 + ib) * 2;
            float a[8], b[8], oa[8], ob[8]; unpack8(x1, a); unpack8(x2, b);
#pragma unroll
            for (int j = 0; j < 8; ++j) { const float cs = rt[2 * j], sn = rt[2 * j + 1]; oa[j] = a[j] * cs - b[j] * sn; ob[j] = a[j] * sn + b[j] * cs; }
            x1 = pack8(oa); x2 = pack8(ob); }
        *(LAS v4u*)(Ks + key * AT_KSTR + 8 * c1) = x1; *(LAS v4u*)(Ks + key * AT_KSTR + 8 * c2) = x2; }
    { const bf16* src = P + (size_t)(krow0 + key) * NP + PV + hk * 64 + 16 * pc;
        const v4u y1 = *(const v4u*)(src), y2 = *(const v4u*)(src + 8);
        const unsigned ww[8] = {y1.x, y1.y, y1.z, y1.w, y2.x, y2.y, y2.z, y2.w};
#pragma unroll
        for (int j = 0; j < 8; ++j) { Vt[(16 * pc + 2 * j) * AT_VSTR + key] = (bf16)(ww[j] & 0xffffu); Vt[(16 * pc + 2 * j + 1) * AT_VSTR + key] = (bf16)(ww[j] >> 16); } }
}
__device__ __forceinline__ void attn_unit(const Ctx& F, int l, int kind, int b, int nb, int hk) {
    const bf16* P = (const bf16*)(F.ws + WS_P); bf16* Y = (bf16*)(F.ws + WS_Y);
    const LAS bf16* Ks = (const LAS bf16*)(F.lds + AT_KS_OFF); const LAS bf16* Vt = (const LAS bf16*)(F.lds + AT_VT_OFF);
    const int lane = F.lane, w = F.wave, gi = w >> 1, th = w & 1, g = 4 * hk + gi, l31 = lane & 31, h = lane >> 5;
    bf16x8 qf[2][4]; int qrow[2];
#pragma unroll
    for (int qb = 0; qb < 2; ++qb) {
        const int iq = 64 * th + 32 * qb + l31, tok = nb * 128 + iq;
        const int row = kind == 0 ? b * SEQ + tok : M_LAT + b * LCTX + tok; qrow[qb] = row;
        const bf16* src = P + (size_t)row * NP + PQ + g * 64 + 8 * h;
        float x[4][8];
#pragma unroll
        for (int s = 0; s < 4; ++s) { const v4u raw = *(const v4u*)(src + 16 * s); unpack8(raw, x[s]); }
        if (kind == 0) {
            const float* rtr = (const float*)(F.ws + WS_ROPE) + (size_t)((tok >> 6) * 16 + 8 * h) * 2; const float* rtc = (const float*)(F.ws + WS_ROPE) + (size_t)((tok & 63) * 16 + 8 * h) * 2;
#pragma unroll
            for (int j = 0; j < 8; ++j) { float cs = rtr[2 * j], sn = rtr[2 * j + 1]; float a = x[0][j], bb = x[1][j]; x[0][j] = a * cs - bb * sn; x[1][j] = a * sn + bb * cs;
                cs = rtc[2 * j]; sn = rtc[2 * j + 1]; a = x[2][j]; bb = x[3][j]; x[2][j] = a * cs - bb * sn; x[3][j] = a * sn + bb * cs; } }
#pragma unroll
        for (int s = 0; s < 4; ++s) {
#pragma unroll
            for (int j = 0; j < 8; ++j) x[s][j] *= 0.125f;
            const v4u pk = pack8(x[s]); qf[qb][s] = __builtin_bit_cast(bf16x8, pk); }
    }
    f32x16 O[2][2];
    float mrun[2], lsum[2];
    const float sink = F.in[I_SINK][l * 8 + g];
#pragma unroll
    for (int qb = 0; qb < 2; ++qb) { mrun[qb] = sink; lsum[qb] = h == 0 ? 1.0f : 0.0f;
#pragma unroll
        for (int db = 0; db < 2; ++db)
#pragma unroll
            for (int r = 0; r < 16; ++r) O[db][qb][r] = 0.f; }
    const int ntile = kind == 0 ? 5 : 2;
    for (int ti = 0; ti < ntile; ++ti) {
        int krow0, mode = 0, tok0 = 0; bool rope = false;
        if (ti < 2) krow0 = M_LAT + b * LCTX + 128 * ti;
        else { const int kb = nb + ti - 3; if (kb < 0 || kb >= SEQ / 128) continue; krow0 = b * SEQ + kb * 128; tok0 = kb * 128; rope = true; mode = ti == 2 ? 1 : ti == 4 ? 2 : 0; }
        __syncthreads();
        attn_stage_tile(F, P, krow0, hk, rope, tok0);
        __syncthreads();
#pragma unroll 1
        for (int kh = 0; kh < 2; ++kh) {
#pragma unroll
            for (int qb = 0; qb < 2; ++qb) {
                f32x16 st[2];
#pragma unroll
                for (int kb = 0; kb < 2; ++kb) {
#pragma unroll
                    for (int r = 0; r < 16; ++r) st[kb][r] = 0.f;
#pragma unroll
                    for (int s = 0; s < 4; ++s) { const bf16x8 a = *(const LAS bf16x8*)(Ks + (64 * kh + 32 * kb + l31) * AT_KSTR + 16 * s + 8 * h);
                        st[kb] = __builtin_amdgcn_mfma_f32_32x32x16_bf16(a, qf[qb][s], st[kb], 0, 0, 0); } }
                const int iq = 64 * th + 32 * qb + l31;
                float mx = -INFINITY;
#pragma unroll
                for (int kb = 0; kb < 2; ++kb)
#pragma unroll
                    for (int r = 0; r < 16; ++r) { const int key = 64 * kh + 32 * kb + (r & 3) + 8 * (r >> 2) + 4 * h;
                        const bool valid = mode == 0 || (mode == 1 ? key >= iq : key <= iq);
                        const float sv = valid ? st[kb][r] : -INFINITY; st[kb][r] = sv; mx = fmaxf(mx, sv); }
                mx = fmaxf(mx, shx(mx, 32, lane));
                const float mnew = fmaxf(mrun[qb], mx), alpha = __expf(mrun[qb] - mnew); mrun[qb] = mnew;
                float ps = 0.f;
#pragma unroll
                for (int kb = 0; kb < 2; ++kb)
#pragma unroll
                    for (int r = 0; r < 16; ++r) { const float p = __expf(st[kb][r] - mnew); st[kb][r] = p; ps += p; }
                lsum[qb] = lsum[qb] * alpha + ps;
#pragma unroll
                for (int db = 0; db < 2; ++db)
#pragma unroll
                    for (int r = 0; r < 16; ++r) O[db][qb][r] *= alpha;
#pragma unroll
                for (int kb = 0; kb < 2; ++kb)
#pragma unroll
                    for (int s2 = 0; s2 < 2; ++s2) {
                        v4u pw; pw.x = pk2(st[kb][8 * s2 + 0], st[kb][8 * s2 + 1]); pw.y = pk2(st[kb][8 * s2 + 2], st[kb][8 * s2 + 3]);
                        pw.z = pk2(st[kb][8 * s2 + 4], st[kb][8 * s2 + 5]); pw.w = pk2(st[kb][8 * s2 + 6], st[kb][8 * s2 + 7]);
                        const bf16x8 pf = __builtin_bit_cast(bf16x8, pw);
#pragma unroll
                        for (int db = 0; db < 2; ++db) { const LAS bf16* vp = Vt + (32 * db + l31) * AT_VSTR + 64 * kh + 32 * kb + 16 * s2 + 4 * h;
                            const v2u v0 = *(const LAS v2u*)(vp), v1 = *(const LAS v2u*)(vp + 8);
                            v4u av; av.x = v0.x; av.y = v0.y; av.z = v1.x; av.w = v1.y;
                            O[db][qb] = __builtin_amdgcn_mfma_f32_32x32x16_bf16(__builtin_bit_cast(bf16x8, av), pf, O[db][qb], 0, 0, 0); }
                    }
                asm volatile("" ::: "memory");
            }
        }
    }
#pragma unroll
    for (int qb = 0; qb < 2; ++qb) {
        const float lt = lsum[qb] + shx(lsum[qb], 32, lane), inv = MK_ABL_B / lt;
        bf16* yr = Y + (size_t)qrow[qb] * NY + 512 + g * 64;
#pragma unroll
        for (int db = 0; db < 2; ++db)
#pragma unroll
            for (int gq = 0; gq < 4; ++gq) { v2u o; o.x = pk2(O[db][qb][4 * gq] * inv, O[db][qb][4 * gq + 1] * inv); o.y = pk2(O[db][qb][4 * gq + 2] * inv, O[db][qb][4 * gq + 3] * inv);
                *(v2u*)(yr + 32 * db + 8 * gq + 4 * h) = o; }
    }
}

constexpr int ML_QS = 0, ML_KS = 17408, ML_KTS = 34816, ML_VTS = 53248, ML_WS = 73984, ML_CTS = 83200, ML_SM = 122368;
constexpr int ML_QSTR = 136, ML_TSTR = 72;
static_assert(ML_SM + 5 * 256 <= RING_BYTES, "mLSTM LDS");
__device__ __forceinline__ float log_sigmoid(float x) { return fminf(x, 0.f) - log1pf(__expf(-fabsf(x))); }
__device__ __forceinline__ int ml_chunk_base(int ci, int b, int dir) { const int cc = ci < 4 ? ci : ci - 4, nc = ci < 4 ? 4 : 32, cs = dir == 0 ? cc : nc - 1 - cc; return (ci < 4 ? M_LAT + b * LCTX : b * SEQ) + 64 * cs; }
__device__ __forceinline__ void mlstm_chain(const Ctx& F, int l, int chain) {
    const bf16* P = (const bf16*)(F.ws + WS_P); const float* G = (const float*)(F.ws + WS_G);
    const int b = chain >> 3, hd = (chain >> 1) & 3, dir = chain & 1, lane = F.lane, w = F.wave, tid = F.tid, l15 = lane & 15, lq = lane >> 4;
    bf16* Hout = (bf16*)(F.ws + (dir == 0 ? WS_HF : WS_HB));
    LAS bf16* Qs = (LAS bf16*)(F.lds + ML_QS); LAS bf16* Ks = (LAS bf16*)(F.lds + ML_KS); LAS bf16* KTs = (LAS bf16*)(F.lds + ML_KTS); LAS bf16* VTs = (LAS bf16*)(F.lds + ML_VTS);
    LAS bf16* Ws = (LAS bf16*)(F.lds + ML_WS); LAS bf16* CTs = (LAS bf16*)(F.lds + ML_CTS);
    LAS float* GA = (LAS float*)(F.lds + ML_SM); LAS float* GG = GA + 64; LAS float* WIN = GA + 128; LAS float* EM = GA + 192; LAS float* DEN = GA + 256;
    const float gbi = F.in[I_GATEB][l * 16 + dir * 8 + hd], gbf = F.in[I_GATEB][l * 16 + dir * 8 + 4 + hd];
    __syncthreads();
#if defined(MK_PROBE_LDSCLR)
    for (int i = tid; i < RING_BYTES / 4; i += NWAVES * 64) ((LAS unsigned*)F.lds)[i] = 0u;
    __syncthreads();
#endif
    for (int i = tid; i < 144 * ML_QSTR / 2; i += NWAVES * 64) ((LAS unsigned*)CTs)[i] = 0u;
    for (int i = tid; i < 16 * ML_TSTR / 2; i += NWAVES * 64) ((LAS unsigned*)(VTs + 128 * ML_TSTR))[i] = (i < ML_TSTR / 2) ? 0x3f803f80u : 0u;
    f32x4 Cacc[9];
#pragma unroll
    for (int e = 0; e < 9; ++e) Cacc[e] = (f32x4){0.f, 0.f, 0.f, 0.f};
    float mst = 0.f;
    const int pr0 = tid >> 4, c16 = tid & 15;
    v4u nq[2], nk[2], nv[2]; float nig, nfg;
#define ML_ISSUE_LOADS(ci_) do { const int base_ = ml_chunk_base((ci_), b, dir); \
        _Pragma("unroll") for (int q = 0; q < 2; ++q) { const int jj = pr0 + 32 * q, tok = base_ + (dir == 0 ? jj : 63 - jj); const bf16* rp = P + (size_t)tok * NP + hd * 128 + 8 * c16; \
            nq[q] = *(const v4u*)(rp + PMQ); nk[q] = *(const v4u*)(rp + PMK); nv[q] = *(const v4u*)(rp + PMV); } \
        { const int tok = base_ + (dir == 0 ? lane : 63 - lane); nig = G[(size_t)tok * 16 + dir * 8 + hd]; nfg = G[(size_t)tok * 16 + dir * 8 + 4 + hd]; } } while (0)
    ML_ISSUE_LOADS(0);
    for (int ci = 0; ci < 36; ++ci) {
        const int base = ml_chunk_base(ci, b, dir);
#if defined(MK_PROBE_NOGATES)
        const float ig = gbi, lf = log_sigmoid(gbf);
#else
        const float ig = nig + gbi, lf = log_sigmoid(nfg + gbf);
#endif
        float bc = lf;
#pragma unroll
        for (int o = 1; o < 64; o <<= 1) { const float t = shup(bc, o, lane); if (lane >= o) bc += t; }
        const float a = ig - bc; float pm = a;
#pragma unroll
        for (int o = 1; o < 64; o <<= 1) { const float t = shup(pm, o, lane); if (lane >= o) pm = fmaxf(pm, t); }
        const float gj = fmaxf(mst, pm), g63 = shidx(gj, 63), b63 = shidx(bc, 63);
        const float wsc = __expf(a - g63) * KSCALE, decay = __expf(mst - g63);
        if (w == 0) { GA[lane] = a; GG[lane] = gj; WIN[lane] = __expf(mst - gj); EM[lane] = __expf(-(bc + gj)); }
#if defined(MK_PROBE_MORESYNC)
        __syncthreads();
#endif
#pragma unroll
        for (int q = 0; q < 2; ++q) { const int jj = pr0 + 32 * q;
            *(LAS v4u*)(Qs + jj * ML_QSTR + 8 * c16) = nq[q]; *(LAS v4u*)(Ks + jj * ML_QSTR + 8 * c16) = nk[q];
            const float ws = shidx(wsc, jj); float kf[8]; unpack8(nk[q], kf);
            const unsigned vv[4] = {nv[q].x, nv[q].y, nv[q].z, nv[q].w};
#pragma unroll
            for (int j = 0; j < 8; ++j) KTs[(8 * c16 + j) * ML_TSTR + jj] = (bf16)f2bf(kf[j] * ws);
#pragma unroll
            for (int j = 0; j < 4; ++j) { VTs[(8 * c16 + 2 * j) * ML_TSTR + jj] = (bf16)(vv[j] & 0xffffu); VTs[(8 * c16 + 2 * j + 1) * ML_TSTR + jj] = (bf16)(vv[j] >> 16); } }
        if (ci + 1 < 36) ML_ISSUE_LOADS(ci + 1);
        __syncthreads();
        { const int rb = w >> 1; f32x4 sa[2] = {(f32x4){0.f, 0.f, 0.f, 0.f}, (f32x4){0.f, 0.f, 0.f, 0.f}};
#pragma unroll
            for (int kk = 0; kk < 4; ++kk) { const bf16x8 af = *(const LAS bf16x8*)(Qs + (16 * rb + l15) * ML_QSTR + 32 * kk + 8 * lq);
#pragma unroll
                for (int cb = 0; cb < 2; ++cb) { const bf16x8 bfr = *(const LAS bf16x8*)(Ks + (16 * (2 * (w & 1) + cb) + l15) * ML_QSTR + 32 * kk + 8 * lq);
                    sa[cb] = __builtin_amdgcn_mfma_f32_16x16x32_bf16(af, bfr, sa[cb], 0, 0, 0); } }
#pragma unroll
            for (int cb = 0; cb < 2; ++cb) { const int s = 16 * (2 * (w & 1) + cb) + l15; const float as = GA[s];
#pragma unroll
                for (int r = 0; r < 4; ++r) { const int j = 16 * rb + 4 * lq + r; const float wv = s <= j ? sa[cb][r] * KSCALE * __expf(as - GG[j]) : 0.f; Ws[j * ML_TSTR + s] = (bf16)f2bf(wv); } } }
        __syncthreads();
        const int rb = w >> 1, eb0 = (w & 1) ? 5 : 0, neb = (w & 1) ? 4 : 5;
        f32x4 num[5];
        { bf16x8 wf[2], qf[4];
#pragma unroll
            for (int kk = 0; kk < 2; ++kk) wf[kk] = *(const LAS bf16x8*)(Ws + (16 * rb + l15) * ML_TSTR + 32 * kk + 8 * lq);
#pragma unroll
            for (int kk = 0; kk < 4; ++kk) qf[kk] = *(const LAS bf16x8*)(Qs + (16 * rb + l15) * ML_QSTR + 32 * kk + 8 * lq);
            float win[4];
#pragma unroll
            for (int r = 0; r < 4; ++r) win[r] = WIN[16 * rb + 4 * lq + r];
#pragma unroll
            for (int i = 0; i < 5; ++i) { if (i < neb) { const int eb = eb0 + i; f32x4 aw = (f32x4){0.f, 0.f, 0.f, 0.f}, ac = (f32x4){0.f, 0.f, 0.f, 0.f};
#pragma unroll
                for (int kk = 0; kk < 2; ++kk) aw = __builtin_amdgcn_mfma_f32_16x16x32_bf16(wf[kk], *(const LAS bf16x8*)(VTs + (16 * eb + l15) * ML_TSTR + 32 * kk + 8 * lq), aw, 0, 0, 0);
#pragma unroll
                for (int kk = 0; kk < 4; ++kk) ac = __builtin_amdgcn_mfma_f32_16x16x32_bf16(qf[kk], *(const LAS bf16x8*)(CTs + (16 * eb + l15) * ML_QSTR + 32 * kk + 8 * lq), ac, 0, 0, 0);
#pragma unroll
                for (int r = 0; r < 4; ++r) num[i][r] = aw[r] + win[r] * ac[r];
                if (eb == 8 && l15 == 0) {
#pragma unroll
                    for (int r = 0; r < 4; ++r) DEN[16 * rb + 4 * lq + r] = num[i][r]; } } } }
        __syncthreads();
        { float dn[4];
#pragma unroll
            for (int r = 0; r < 4; ++r) { const int j = 16 * rb + 4 * lq + r; dn[r] = 1.0f / fmaxf(fabsf(DEN[j]), EM[j]); }
#pragma unroll
            for (int i = 0; i < 5; ++i) { if (i < neb && eb0 + i < 8) { const int e = 16 * (eb0 + i) + l15;
#pragma unroll
                for (int r = 0; r < 4; ++r) { const int j = 16 * rb + 4 * lq + r, tok = base + (dir == 0 ? j : 63 - j); Hout[(size_t)tok * 512 + hd * 128 + e] = (bf16)f2bf(num[i][r] * dn[r]); } } } }
#if defined(MK_PROBE_MORESYNC)
        __syncthreads();
#endif
        { bf16x8 kf[2];
#pragma unroll
            for (int kk = 0; kk < 2; ++kk) kf[kk] = *(const LAS bf16x8*)(KTs + (16 * w + l15) * ML_TSTR + 32 * kk + 8 * lq);
#pragma unroll
            for (int eb = 0; eb < 9; ++eb) { Cacc[eb] = Cacc[eb] * decay;
#pragma unroll
                for (int kk = 0; kk < 2; ++kk) Cacc[eb] = __builtin_amdgcn_mfma_f32_16x16x32_bf16(kf[kk], *(const LAS bf16x8*)(VTs + (16 * eb + l15) * ML_TSTR + 32 * kk + 8 * lq), Cacc[eb], 0, 0, 0);
                v2u o; o.x = pk2(Cacc[eb][0], Cacc[eb][1]); o.y = pk2(Cacc[eb][2], Cacc[eb][3]);
                *(LAS v2u*)(CTs + (16 * eb + l15) * ML_QSTR + 16 * w + 4 * lq) = o; } }
        mst = b63 + g63;
        __syncthreads();
    }
#undef ML_ISSUE_LOADS
}

__device__ __forceinline__ void c0_combine(const Ctx& F, int l, int nrows) {
    const bf16* P = (const bf16*)(F.ws + WS_P); const bf16* HF = (const bf16*)(F.ws + WS_HF); const bf16* HB = (const bf16*)(F.ws + WS_HB); bf16* Y = (bf16*)(F.ws + WS_Y);
    const int gw = F.vcu * NWAVES + F.wave, NGW = F.G * NWAVES, lane = F.lane;
    for (int it = gw; it < nrows * 4; it += NGW) { const int r = it >> 2, hd = it & 3, col = hd * 128 + 2 * lane;
        const unsigned a = *(const unsigned*)(HF + (size_t)r * 512 + col), bq = *(const unsigned*)(HB + (size_t)r * 512 + col), mo = *(const unsigned*)(P + (size_t)r * NP + PMO + col);
#if defined(MK_PROBE_C0)
        float x0 = bflo(mo) + 0.f * (bflo(a) + bflo(bq)) * 0.f, x1 = bfhi(mo);
#else
        float x0 = bflo(a) + bflo(bq), x1 = bfhi(a) + bfhi(bq);
#endif
        const float mean = wave_sum(x0 + x1, lane) * (1.f / 128.f); x0 -= mean; x1 -= mean;
        const float rstd = 1.f / sqrtf(wave_sum(x0 * x0 + x1 * x1, lane) * (1.f / 128.f) + LN_EPS);
        const float g0 = F.in[I_NORMG][l * 512 + col], g1 = F.in[I_NORMG][l * 512 + col + 1];
        *(unsigned*)(Y + (size_t)r * NY + 1024 + col) = pk2(MK_ABL_C * sigmoidf_(bflo(mo)) * x0 * rstd * g0, MK_ABL_C * sigmoidf_(bfhi(mo)) * x1 * rstd * g1); }
}

struct EpiProj {
    static constexpr bool PERM = true, AFTER_DRAIN = false, RESCALE = false;
    bf16* O; int ldc;
    __device__ __forceinline__ void operator()(const pg8::f32x4 (&acc)[2][2][4][2], const pg8::Unit& u, int wr, int wc, int fr, int fq) const {
        const int row0 = u.pm * 256 + wr * 64 + fr, col0 = u.pn * 256 + wc * 32 + 8 * fq;
#pragma unroll
        for (int ai = 0; ai < 2; ++ai)
#pragma unroll
            for (int m = 0; m < 4; ++m) { bf16* rowp = O + (size_t)(row0 + ai * 128 + m * 16) * ldc + col0;
#pragma unroll
                for (int bj = 0; bj < 2; ++bj) { const pg8::f32x4 v0 = acc[ai][bj][m][0], v1 = acc[ai][bj][m][1];
                    v4u w; w.x = pk2(v0[0], v0[1]); w.y = pk2(v0[2], v0[3]); w.z = pk2(v1[0], v1[1]); w.w = pk2(v1[2], v1[3]);
                    *(v4u*)(rowp + bj * 128) = w; } }
    }
};
__device__ __forceinline__ float gate_e(float x) { return __expf(-fminf(fmaxf(x, -30.f), 30.f)); }
struct EpiMerge {
    static constexpr bool PERM = true, AFTER_DRAIN = false, RESCALE = true;
    const bf16* P; bf16* Z;
    __device__ __forceinline__ void rescale(pg8::f32x4 (&acc)[2][2][4][2], const pg8::Unit& u, int step, int wr, int wc, int fr, int fq) const {
        const int row0 = u.pm * 256 + wr * 64 + fr, col0 = u.pn * 256 + wc * 32 + 8 * fq;
        const int cn = PBG + (step - 1) * 1024, cd = PBG + step * 1024;
#pragma unroll
        for (int ai = 0; ai < 2; ++ai)
#pragma unroll
            for (int m = 0; m < 4; ++m) { const bf16* rowp = P + (size_t)(row0 + ai * 128 + m * 16) * NP + col0;
#pragma unroll
                for (int bj = 0; bj < 2; ++bj) { const v4u xn = *(const v4u*)(rowp + cn + bj * 128), xd = *(const v4u*)(rowp + cd + bj * 128);
                    float a[8], b[8]; unpack8(xn, a); unpack8(xd, b);
#pragma unroll
                    for (int i = 0; i < 8; ++i) { const float ratio = (1.0f + gate_e(b[i])) / (1.0f + gate_e(a[i])); acc[ai][bj][m][i >> 2][i & 3] *= ratio; } }
                asm volatile("" ::: "memory"); }
    }
    __device__ __forceinline__ void operator()(const pg8::f32x4 (&acc)[2][2][4][2], const pg8::Unit& u, int wr, int wc, int fr, int fq) const {
        const int row0 = u.pm * 256 + wr * 64 + fr, col0 = u.pn * 256 + wc * 32 + 8 * fq;
#pragma unroll
        for (int ai = 0; ai < 2; ++ai)
#pragma unroll
            for (int m = 0; m < 4; ++m) { const size_t r = (size_t)(row0 + ai * 128 + m * 16);
#pragma unroll
                for (int bj = 0; bj < 2; ++bj) { const v4u xc = *(const v4u*)(P + r * NP + PBG + 2048 + col0 + bj * 128); float c[8], o[8]; unpack8(xc, c);
#pragma unroll
                    for (int i = 0; i < 8; ++i) o[i] = acc[ai][bj][m][i >> 2][i & 3] / (1.0f + gate_e(c[i]));
                    *(v4u*)(Z + r * D + col0 + bj * 128) = pack8(o); }
                asm volatile("" ::: "memory"); }
    }
};
struct EpiResid {
    static constexpr bool PERM = false, AFTER_DRAIN = false, RESCALE = false;
    float* out; float* hc; const float* mod_l;
    __device__ __forceinline__ void operator()(const pg8::f32x4 (&acc)[2][2][4][2], const pg8::Unit& u, int wr, int wc, int fr, int fq) const {
        const int rt = u.pm * 256; float* hb = rt < M_LAT ? out + (size_t)rt * D : hc + (size_t)(rt - M_LAT) * D;
        const float* g1 = mod_l + (size_t)(rt < M_LAT ? (rt >> 11) : 8) * 6144 + 2048;
        const int rl0 = wr * 64 + fr, col0 = u.pn * 256 + wc * 32 + 4 * fq;
#pragma unroll
        for (int ai = 0; ai < 2; ++ai)
#pragma unroll
            for (int m = 0; m < 4; ++m) { float* rowp = hb + (size_t)(rl0 + ai * 128 + m * 16) * D + col0;
#pragma unroll
                for (int bj = 0; bj < 2; ++bj)
#pragma unroll
                    for (int n = 0; n < 2; ++n) { const pg8::f32x4 g = *(const pg8::f32x4*)(g1 + col0 + bj * 128 + n * 16), h = *(const pg8::f32x4*)(rowp + bj * 128 + n * 16);
                        *(pg8::f32x4*)(rowp + bj * 128 + n * 16) = h * ALPHA + g * acc[ai][bj][m][n]; } }
    }
};
struct EpiSwiGLU {
    static constexpr bool PERM = true, AFTER_DRAIN = false, RESCALE = false;
    bf16* act;
    __device__ __forceinline__ void operator()(const pg8::f32x4 (&acc)[2][2][4][2], const pg8::Unit& u, int wr, int wc, int fr, int fq) const {
        const int row0 = u.pm * 256 + wr * 64 + fr, col0 = (u.pn & 3) * 128 + wc * 32 + 8 * fq;
#pragma unroll
        for (int ai = 0; ai < 2; ++ai)
#pragma unroll
            for (int m = 0; m < 4; ++m) { float o[8];
#pragma unroll
                for (int i = 0; i < 8; ++i) { const float g = acc[ai][0][m][i >> 2][i & 3], uu = acc[ai][1][m][i >> 2][i & 3]; o[i] = g * sigmoidf_(g) * uu; }
                *(v4u*)(act + (size_t)(row0 + ai * 128 + m * 16) * DEXP + col0) = pack8(o); }
    }
};
struct EpiScatter {
    static constexpr bool PERM = true, AFTER_DRAIN = false, RESCALE = false;
    const int* rowmap; const float* roww; bf16* Fo;
    __device__ __forceinline__ void operator()(const pg8::f32x4 (&acc)[2][2][4][2], const pg8::Unit& u, int wr, int wc, int fr, int fq) const {
        const int row0 = u.pm * 256 + wr * 64 + fr, col0 = (u.pn & 3) * 256 + wc * 32 + 8 * fq;
#pragma unroll
        for (int ai = 0; ai < 2; ++ai)
#pragma unroll
            for (int m = 0; m < 4; ++m) { const int sr = row0 + ai * 128 + m * 16, dst = rowmap[sr]; const float wgt = roww[sr];
                if (dst >= 0) {
#pragma unroll
                    for (int bj = 0; bj < 2; ++bj) { pg8::f32x4 v0 = acc[ai][bj][m][0] * wgt, v1 = acc[ai][bj][m][1] * wgt;
#if defined(MK_PROBE_SCATTER) && MK_PROBE_SCATTER == 1
                        v0 = (pg8::f32x4){wgt, wgt, wgt, wgt}; v1 = v0;
#elif defined(MK_PROBE_SCATTER) && MK_PROBE_SCATTER == 2
                        v0 = acc[ai][bj][m][0]; v1 = acc[ai][bj][m][1];
#endif
                        v4u w; w.x = pk2(v0[0], v0[1]); w.y = pk2(v0[2], v0[3]); w.z = pk2(v1[0], v1[1]); w.w = pk2(v1[2], v1[3]);
                        *(v4u*)(Fo + (size_t)dst * D + col0 + bj * 128) = w; } } }
    }
};
struct MoeOrder {
    int G, c; const LAS int* toff;
    __device__ __forceinline__ bool next(int i, pg8::Unit& u) const {
        const long L = (long)i * G + c; const int nt = toff[16]; if (L >= (long)nt * 4) return false;
        const int pm = (int)(L >> 2), ct = (int)(L & 3); int e = 0;
#pragma unroll
        for (int k = 1; k < 16; ++k) e += (pm >= toff[k]) ? 1 : 0;
        u.pm = pm; u.pn = e * 4 + ct; return true;
    }
    __device__ __forceinline__ void a_ready(const pg8::Unit&) const {}
    __device__ __forceinline__ void done(const pg8::Unit&) const {}
};
__device__ __forceinline__ void moe_toff(const Ctx& F, int l, LAS int* toff) {
    if (F.tid == 0) { int acc = 0; const int* tot = (const int*)(F.ws + WS_BCNT) + 2 * 4096 + l * 16;
        for (int e = 0; e < 16; ++e) { toff[e] = acc; acc += (tot[e] + 255) >> 8; }
        toff[16] = acc; }
    __syncthreads();
}

__device__ __forceinline__ void e_ln1_route(const Ctx& F, int l, int nrows) {
    const int rpb = nrows / 256, row0 = F.vcu * rpb;
    LAS int* lcnt = (LAS int*)F.lds; LAS int* rinfo = lcnt + 16; LAS float* rwt = (LAS float*)(lcnt + 16 + 160); LAS int* lrk = lcnt + 16 + 320;
    stage_w16(F, F.in[I_WROUTER], 16, (LAS float*)(F.lds + 4096));
    __syncthreads();
    for (int i = F.wave; i < rpb; i += NWAVES) { const int r = row0 + i;
        f32x4 v[4]; float* hp = hrow(F, r); load_row(hp, F.lane, v); ln_row(v, F.in[I_LN1G] + l * D, F.in[I_LN1B] + l * D, F.lane); store_row(hp, F.lane, v);
        const float* mp = modp(F, l, modrow(r)); f32x4 u[4];
        emit_u(v, mp + 3072, mp + 4096, (bf16*)(F.ws + WS_U) + (size_t)r * D, F.lane, u);
        float lg[16]; dot16(u, (const LAS float*)(F.lds + 4096), F.lane, lg);
        float sc[16], sel[16];
#pragma unroll
        for (int e = 0; e < 16; ++e) { sc[e] = sigmoidf_(lg[e]); sel[e] = sc[e] + F.in[I_BROUTER][e]; }
        int bg = 0; float bgs = -INFINITY;
#pragma unroll
        for (int g = 0; g < 4; ++g) { float m1 = -INFINITY, m2 = -INFINITY;
#pragma unroll
            for (int k = 0; k < 4; ++k) { const float x = sel[4 * g + k]; if (x > m1) { m2 = m1; m1 = x; } else if (x > m2) m2 = x; }
            const float gs = m1 + m2; if (gs > bgs) { bgs = gs; bg = g; } }
        float s4[4], c4[4];
#pragma unroll
        for (int k = 0; k < 4; ++k) { s4[k] = bg == 0 ? sel[k] : bg == 1 ? sel[4 + k] : bg == 2 ? sel[8 + k] : sel[12 + k]; c4[k] = bg == 0 ? sc[k] : bg == 1 ? sc[4 + k] : bg == 2 ? sc[8 + k] : sc[12 + k]; }
        int i1 = 0;
#pragma unroll
        for (int k = 1; k < 4; ++k) if (s4[k] > s4[i1]) i1 = k;
        int i2 = i1 == 0 ? 1 : 0;
#pragma unroll
        for (int k = 0; k < 4; ++k) if (k != i1 && k != i2 && s4[k] > s4[i2]) i2 = k;
        const float w1 = c4[i1], w2 = c4[i2], ws = 1.0f / (w1 + w2);
        if (F.lane == 0) { rinfo[2 * i] = 4 * bg + i1; rinfo[2 * i + 1] = 4 * bg + i2; rwt[2 * i] = w1 * ws; rwt[2 * i + 1] = w2 * ws; }
    }
    __syncthreads();
    if (F.tid < 16) { int c = 0; for (int idx = 0; idx < 2 * rpb; ++idx) if (rinfo[idx] == F.tid) lrk[idx] = c++;
        ((int*)(F.ws + WS_BCNT))[(l * 256 + F.vcu) * 16 + F.tid] = c; }
    __syncthreads();
    for (int idx = F.tid; idx < 2 * rpb; idx += NWAVES * 64) { unsigned* rp = (unsigned*)(F.ws + WS_ROUTE + (size_t)(2 * row0 + idx) * 16);
        rp[0] = (unsigned)rinfo[idx]; rp[1] = (unsigned)lrk[idx]; ((float*)rp)[2] = rwt[idx]; rp[3] = (unsigned)F.vcu; }
    __syncthreads();
}
__device__ __forceinline__ void f_gather(const Ctx& F, int l, int nrows) {
    LAS int* toff = (LAS int*)F.lds; LAS int* cnts = toff + 32; LAS int* csum = toff + 64; LAS int* bbase = toff + 1024;
    const int* bc = (const int*)(F.ws + WS_BCNT) + l * 4096;
    { const int e = F.tid & 15, ch = F.tid >> 4; int s = 0;
#pragma unroll
        for (int k = 0; k < 8; ++k) { const int v = bc[(8 * ch + k) * 16 + e]; bbase[(8 * ch + k) * 16 + e] = s; s += v; }
        csum[ch * 16 + e] = s; }
    __syncthreads();
    { const int e = F.tid & 15, ch = F.tid >> 4; int pre = 0;
        for (int k = 0; k < ch; ++k) pre += csum[k * 16 + e];
#pragma unroll
        for (int k = 0; k < 8; ++k) bbase[(8 * ch + k) * 16 + e] += pre;
        if (ch == 31) { const int tot = pre + csum[31 * 16 + e]; cnts[e] = tot; if (F.vcu == 0) ((int*)(F.ws + WS_BCNT))[2 * 4096 + l * 16 + e] = tot; } }
    __syncthreads();
    if (F.tid == 0) { int acc = 0; for (int e = 0; e < 16; ++e) { toff[e] = acc; acc += (cnts[e] + 255) >> 8; } toff[16] = acc; }
    __syncthreads();
    const int gw = F.vcu * NWAVES + F.wave, NGW = F.G * NWAVES, lane = F.lane;
    const bf16* U = (const bf16*)(F.ws + WS_U); bf16* As = (bf16*)(F.ws + WS_AS); int* rowmap = (int*)(F.ws + WS_ROWMAP); float* roww = (float*)(F.ws + WS_ROWW);
    for (int ts = gw; ts < 2 * nrows; ts += NGW) { const unsigned* rp = (const unsigned*)(F.ws + WS_ROUTE + (size_t)ts * 16); const unsigned re = rp[0], rk = rp[1], rb = rp[3]; const float rwv = ((const float*)rp)[2];
        const int pos = toff[re] * 256 + bbase[rb * 16 + re] + (int)rk;
        const v4u* src = (const v4u*)(U + (size_t)(ts >> 1) * D); v4u* dst = (v4u*)(As + (size_t)pos * D);
        dst[lane] = src[lane]; dst[lane + 64] = src[lane + 64];
        if (lane == 0) { rowmap[pos] = ts; roww[pos] = rwv; } }
    for (int e = 0; e < 16; ++e) { const int cnt = cnts[e], first = toff[e] * 256 + cnt, npad = toff[e + 1] * 256 - first;
        for (int i = gw; i < npad; i += NGW) { v4u* dst = (v4u*)(As + (size_t)(first + i) * D); unsigned z0 = 0u; asm volatile("" : "+v"(z0)); const v4u z = {z0, z0, z0, z0}; dst[lane] = z; dst[lane + 64] = z; if (lane == 0) { rowmap[first + i] = -1; roww[first + i] = 0.f; } } }
    __syncthreads();
}
__device__ __forceinline__ void h_ln2(const Ctx& F, int l, int nrows) {
    const int gw = F.vcu * NWAVES + F.wave, NGW = F.G * NWAVES, lane = F.lane; const bf16* Fs = (const bf16*)(F.ws + WS_F);
    if (l + 1 < DEPTH) { stage_w16(F, F.in[I_WIN] + (size_t)(l + 1) * D * D_IN + SRC_MG, D_IN, (LAS float*)F.lds); __syncthreads(); }
    for (int r = gw; r < nrows; r += NGW) { f32x4 v[4]; float* hp = hrow(F, r); load_row(hp, lane, v); const float* g2 = modp(F, l, modrow(r)) + 5120;
#pragma unroll
        for (int j = 0; j < 4; ++j) { const v2u a = *(const v2u*)(Fs + (size_t)(2 * r) * D + 4 * lane + 256 * j), b = *(const v2u*)(Fs + (size_t)(2 * r + 1) * D + 4 * lane + 256 * j);
            const f32x4 f = (f32x4){bflo(a.x) + bflo(b.x), bfhi(a.x) + bfhi(b.x), bflo(a.y) + bflo(b.y), bfhi(a.y) + bfhi(b.y)}, g = *(const f32x4*)(g2 + 4 * lane + 256 * j);
            v[j] = v[j] * ALPHA + g * f * MK_ABL_F; }
        ln_row(v, F.in[I_LN2G] + l * D, F.in[I_LN2B] + l * D, lane); store_row(hp, lane, v);
        if (l + 1 < DEPTH) emit_layer_input(F, l + 1, r, v); }
}

constexpr int NPHASE = 2 + 10 * DEPTH;
struct Args { const float* in[N_IN]; float* out; unsigned char* ws; int ph_lo, ph_hi, li, pad; };
static_assert(sizeof(Args) == 8 * N_IN + 16 + 16, "no padding bytes in Args");
#ifndef MK_PHASE_MASK
#define MK_PHASE_MASK 0xFFFu
#endif
#define PON(j) (((MK_PHASE_MASK) >> (j)) & 1u)
#define IN(k) (lo <= (k) && (k) < hi)
#define PCTX(Fp) Ctx Fp = F; Fp.lane = lane_id(); Fp.tid = F.wave * 64 + Fp.lane
#define SEAM(k) do { if (IN(k) && IN((k) + 1)) xcd_barrier(bar); } while (0)
template <int l> __device__ __forceinline__ void run_layer(const Ctx& F, const int lo, const int hi, const XcdBarrier& bar) {
        const int pb = 2 + 10 * l; const bool lastl = (l == DEPTH - 1); const int nrows = lastl ? M_LAT : M_ALL;
        bf16* const Pb = (bf16*)(F.ws + WS_P); bf16* const Ub = (bf16*)(F.ws + WS_U); bf16* const Yb = (bf16*)(F.ws + WS_Y);
        if (PON(2) && IN(pb + 0)) {
            pg8::Gemm g{Ub, wt(F, l, W_IN), M_ALL, NP, D}; pg8::StaticOrder S; S.init(M_ALL, NP, F.G, (int)blockIdx.x);
            EpiProj E{Pb, NP};
            pg8::gemm_phase<EpiProj, pg8::StaticOrder, true, true>(F.lds, g, S, E, F.wave);
            SEAM(pb + 0);
        }
        if (PON(3) && IN(pb + 1)) {
#ifndef MK_NO_MLSTM
            PCTX(Fp);
            if (F.vcu < 64) mlstm_chain(Fp, l, F.vcu);
            else
#endif
            {
                const int idx = F.vcu - 64, nw = F.G - 64, n_attn = lastl ? 256 : 288, n_conv = lastl ? 512 : 576;
#ifndef MK_NO_ATTN
                for (int u = idx; u < n_attn; u += nw) { if (u < 256) attn_unit(Fp, l, 0, u >> 5, (u >> 1) & 15, u & 1); else { const int j = u - 256; attn_unit(Fp, l, 1, j >> 2, (j >> 1) & 1, j & 1); } }
#endif
                __syncthreads();
#ifndef MK_NO_CONV
                for (int u = idx; u < n_conv; u += nw) conv_unit(Fp, l, u);
#endif
            }
            SEAM(pb + 1);
        }
        if (PON(4) && IN(pb + 2)) { PCTX(Fp); c0_combine(Fp, l, nrows); SEAM(pb + 2); }
        if (PON(5) && IN(pb + 3)) {
            pg8::Gemm g{Yb, wt(F, l, W_ABC), nrows, D, NY}; pg8::StaticOrder S; S.init(nrows, D, F.G, (int)blockIdx.x);
            EpiMerge E{Pb, Ub};
            pg8::gemm_phase<EpiMerge, pg8::StaticOrder, true, true>(F.lds, g, S, E, F.wave);
            SEAM(pb + 3);
        }
        if (PON(6) && IN(pb + 4)) {
            pg8::Gemm g{Ub, wt(F, l, W_OUT), nrows, D, D}; pg8::StaticOrder S; S.init(nrows, D, F.G, (int)blockIdx.x);
            EpiResid E{F.out, (float*)(F.ws + WS_HC), (const float*)(F.ws + WS_MOD) + (size_t)l * 9 * 6144};
            pg8::gemm_phase<EpiResid, pg8::StaticOrder, true, true>(F.lds, g, S, E, F.wave);
            SEAM(pb + 4);
        }
        if (PON(7) && IN(pb + 5)) { PCTX(Fp); e_ln1_route(Fp, l, nrows); SEAM(pb + 5); }
        if (PON(8) && IN(pb + 6)) { PCTX(Fp); f_gather(Fp, l, nrows); SEAM(pb + 6); }
        if (PON(9) && IN(pb + 7)) {
            LAS int* toff = (LAS int*)(F.lds + LDSCTL_OFF); { PCTX(Fp); moe_toff(Fp, l, toff); }
            pg8::Gemm g{(const bf16*)(F.ws + WS_AS), wt(F, l, W_GU), AS_ROWS, NE * D, D}; MoeOrder S{F.G, (int)blockIdx.x, toff};
            EpiSwiGLU E{(bf16*)(F.ws + WS_ACT)};
            pg8::gemm_phase<EpiSwiGLU, MoeOrder, true, true>(F.lds, g, S, E, F.wave);
            SEAM(pb + 7);
        }
        if (PON(10) && IN(pb + 8)) {
            LAS int* toff = (LAS int*)(F.lds + LDSCTL_OFF); { PCTX(Fp); moe_toff(Fp, l, toff); }
            pg8::Gemm g{(const bf16*)(F.ws + WS_ACT), wt(F, l, W_DN), AS_ROWS, NE * D, DEXP}; MoeOrder S{F.G, (int)blockIdx.x, toff};
            EpiScatter E{(const int*)(F.ws + WS_ROWMAP), (const float*)(F.ws + WS_ROWW), (bf16*)(F.ws + WS_F)};
            pg8::gemm_phase<EpiScatter, MoeOrder, true, true>(F.lds, g, S, E, F.wave);
            SEAM(pb + 8);
        }
        if (PON(11) && IN(pb + 9)) { PCTX(Fp); h_ln2(Fp, l, nrows); SEAM(pb + 9); }
    }
__global__ void __launch_bounds__(NWAVES * 64, 2) mk_fwd(Args args) {
    extern __shared__ __attribute__((aligned(16))) unsigned char lds[];
    Ctx F;
    F.lds = (LAS unsigned char*)lds; F.MISC = (volatile LAS unsigned*)(F.lds + MISC_OFF);
    F.tid = 0; F.lane = 0; F.wave = __builtin_amdgcn_readfirstlane((int)threadIdx.x >> 6);
    F.G = gridDim.x; { const int bx = blockIdx.x; F.vcu = (F.G % 8 == 0) ? (bx % 8) * (F.G / 8) + bx / 8 : bx; }
    F.ws = args.ws; F.out = args.out; F.ctl = (unsigned*)(args.ws + WS_CTL);
    F.in = args.in;
    for (int u = (int)threadIdx.x; u < (LDS_BYTES - LDSCTL_OFF) / 4; u += NWAVES * 64) ((LAS unsigned*)(F.lds + LDSCTL_OFF))[u] = 0u;
    __syncthreads();
    const int lo = args.ph_lo, hi = args.ph_hi;
    XcdBarrier bar; bar.bar = (unsigned*)(F.ctl + CW_BAR) + args.li * XCD_BAR_WORDS; bar.x = 0; bar.st = nullptr; bar.w0 = false;
    if (hi - lo > 1) bar = xcd_barrier_post((unsigned*)(F.ctl + CW_BAR) + args.li * XCD_BAR_WORDS, F.MISC + 8);
    bar.w0 = (F.wave == 0);
    if (PON(0) && IN(0)) { PCTX(Fp); p0_prologue(Fp); SEAM(0); }
    if (PON(1) && IN(1)) { PCTX(Fp); p1_ln_in(Fp); SEAM(1); }
    run_layer<0>(F, lo, hi, bar);
    run_layer<1>(F, lo, hi, bar);
#undef IN
#undef SEAM
}


#if defined(MK_DIAG)
constexpr int CW_DIAG = 3072;
__global__ void __launch_bounds__(512, 2) mk_diag(Args args) {
    unsigned char* ws = args.ws; float* acc = (float*)((unsigned*)(ws + WS_CTL) + CW_DIAG);
    const int gt = blockIdx.x * 512 + threadIdx.x, NT = gridDim.x * 512;
    const int* rowmap = (const int*)(ws + WS_ROWMAP); const bf16* As = (const bf16*)(ws + WS_AS); const bf16* act = (const bf16*)(ws + WS_ACT); const bf16* Fs = (const bf16*)(ws + WS_F);
    const unsigned* cnt = (const unsigned*)(ws + WS_CTL) + CW_CNT;
    int ntile = 0; for (int e = 0; e < 16; ++e) ntile += (int)((cnt[64 * e] + 255u) >> 8);
    float s0 = 0.f, s1 = 0.f, s2 = 0.f, s3 = 0.f;
    for (int pos = gt; pos < ntile * 256; pos += NT) { if (rowmap[pos] >= 0) { s0 += 1.f; float a = 0.f, b = 0.f;
        for (int k = 0; k < 1024; k += 37) a += fabsf(bf1(As[(size_t)pos * D + k]));
        for (int k = 0; k < 512; k += 19) b += fabsf(bf1(act[(size_t)pos * DEXP + k]));
        s1 += a * (1.f / 28.f); s2 += b * (1.f / 27.f); } }
    for (int ts = gt; ts < 2 * M_ALL; ts += NT) { float f = 0.f; for (int k = 0; k < 1024; k += 37) f += fabsf(bf1(Fs[(size_t)ts * D + k])); s3 += f * (1.f / 28.f); }
    if (MK_DIAG == 3) { s1 = 0.f; s2 = 0.f; const float* roww = (const float*)(ws + WS_ROWW);
        for (int pos = gt; pos < ntile * 256; pos += NT) if (rowmap[pos] >= 0) s1 += fabsf(roww[pos]);
        for (int ts = gt; ts < 2 * M_ALL; ts += NT) { const v4u rt = *(const v4u*)(ws + WS_ROUTE + (size_t)ts * 16); s2 += fabsf(__builtin_bit_cast(float, rt.z)); } }
    if (MK_DIAG == 6) { s1 = 0.f; s2 = 0.f;
        for (int ts = gt; ts < 2 * M_ALL; ts += NT) { const v4u rt = *(const v4u*)(ws + WS_ROUTE + (size_t)ts * 16); const float wv = __builtin_bit_cast(float, rt.z);
            const bool ok = (wv > 0.f) && (wv < 1.f); if (ok) s2 += wv; else s1 += 1.f; } }
    if (MK_DIAG == 7) { s1 = 0.f; s2 = 0.f;
        for (int ts = gt; ts < 2 * M_ALL; ts += NT) { bool bad = false; for (int k = 0; k < 1024; k += 7) { const float x = bf1(Fs[(size_t)ts * D + k]); if (!(fabsf(x) < 1e4f)) bad = true; } if (bad) s1 += 1.f; }
        for (int pos = gt; pos < ntile * 256; pos += NT) { bool bad = false; for (int k = 0; k < 512; k += 5) { const float x = bf1(act[(size_t)pos * DEXP + k]); if (!(fabsf(x) < 1e4f)) bad = true; }
            for (int k = 0; k < 1024; k += 7) { const float x = bf1(As[(size_t)pos * D + k]); if (!(fabsf(x) < 1e4f)) bad = true; } if (bad) s2 += 1.f; } }
    if (MK_DIAG == 4 || MK_DIAG == 5) { s1 = 0.f; s2 = 0.f; const float* dbg = (const float*)(ws + WS_ROPE + 65536);
        for (int r = gt; r < M_ALL; r += NT) { s1 += fabsf(dbg[4 * r + (MK_DIAG == 4 ? 0 : 2)]); s2 += fabsf(dbg[4 * r + (MK_DIAG == 4 ? 1 : 3)]); } }
    atomicAdd(acc + 0, s0); atomicAdd(acc + 1, s1); atomicAdd(acc + 2, s2); atomicAdd(acc + 3, s3);
}
__global__ void __launch_bounds__(512, 2) mk_diag_out(Args args) {
    const float* acc = (const float*)((const unsigned*)(args.ws + WS_CTL) + CW_DIAG);
    const float cntr = acc[0], mA = acc[1] / fmaxf(cntr, 1.f), mAct = acc[2] / fmaxf(cntr, 1.f), mF = acc[3] / (2.f * M_ALL);
    float st1, st2;
    if (MK_DIAG == 1) { st1 = mA; st2 = mAct; } else if (MK_DIAG == 3) { st1 = mA; st2 = acc[2] / (2.f * M_ALL); } else if (MK_DIAG == 4 || MK_DIAG == 5) { st1 = acc[1] / M_ALL; st2 = acc[2] / M_ALL; } else if (MK_DIAG == 6) { st1 = acc[1] + 1e-3f; st2 = acc[2] / (2.f * M_ALL); } else if (MK_DIAG == 7) { st1 = acc[1] + 1e-3f; st2 = acc[2] + 1e-3f; } else { st1 = cntr / (2.f * M_ALL); st2 = mF; }
    const float v1 = fminf(fmaxf(20.f + log2f(fmaxf(st1, 1e-6f)), 0.f), 60.f), v2 = 100.f * fminf(fmaxf(20.f + log2f(fmaxf(st2, 1e-6f)), 0.f), 60.f);
    const float K = sqrtf(v1);
    for (size_t i = (size_t)blockIdx.x * 512 + threadIdx.x; i < (size_t)M_LAT * D; i += (size_t)gridDim.x * 512) args.out[i] = (i == 12345) ? v2 : ((i & 1) ? K : -K);
}
#endif

#if defined(MK_DIAG)
__global__ void __launch_bounds__(512, 2) mk_copy(Args args) {
    const bf16* HF = (const bf16*)(args.ws + WS_HF); const bf16* HB = (const bf16*)(args.ws + WS_HB); const bf16* P = (const bf16*)(args.ws + WS_P);
    for (size_t i = (size_t)blockIdx.x * 512 + threadIdx.x; i < (size_t)M_LAT * D; i += (size_t)gridDim.x * 512) { const size_t r = i >> 10; const int c = (int)(i & 1023);
        float v;
        if (MK_DIAG == 8) v = c < 512 ? bf1(HF[r * 512 + c]) : bf1(HB[r * 512 + c - 512]);
        else if (MK_DIAG == 9) v = bf1(P[r * NP + PMQ + c]);
        else if (MK_DIAG == 10) v = bf1(P[r * NP + PMV + (c & 511)]);
        else if (MK_DIAG == 11) v = bf1(P[(size_t)(M_LAT + (r & 2047)) * NP + PMQ + c + 512 * ((r >> 11) & 1)]);
        else v = ((const float*)(args.ws + WS_G))[(size_t)(r + ((r >> 13) & 1) * 2048) * 16 + (c & 15)];
        args.out[i] = v; }
}
#endif

#ifndef MK_PER_PHASE
#define MK_PER_PHASE 1
#endif
extern "C" void kernel_launch(void* const* d_in, const int* in_sizes, int n_in, void* d_out, int out_size, void* d_ws, size_t ws_size, hipStream_t stream) {
    static int grid = 0;
    if (grid == 0) {
        if (n_in != N_IN || in_sizes[0] != M_LAT * D || out_size != M_LAT * D || ws_size < WS_END) {
            fprintf(stderr, "kernel_launch: built for %d inputs, x/out of %d floats, >= %zu bytes of workspace; got n_in %d, in0 %d, out %d, ws %zu; nothing launched\n", N_IN, M_LAT * D, (size_t)WS_END, n_in, n_in > 0 ? in_sizes[0] : -1, out_size, ws_size); grid = -1; return; }
        int dev = 0, cus = 0, per_cu = 0;
        if (hipGetDevice(&dev) != hipSuccess || hipDeviceGetAttribute(&cus, hipDeviceAttributeMultiprocessorCount, dev) != hipSuccess) { fprintf(stderr, "kernel_launch: device query failed\n"); grid = -1; return; }
        if (hipFuncSetAttribute((const void*)mk_fwd, hipFuncAttributeMaxDynamicSharedMemorySize, LDS_BYTES) != hipSuccess) { fprintf(stderr, "kernel_launch: hipFuncSetAttribute failed\n"); grid = -1; return; }
        if (hipOccupancyMaxActiveBlocksPerMultiprocessor(&per_cu, (const void*)mk_fwd, NWAVES * 64, LDS_BYTES) != hipSuccess || per_cu < 1) { fprintf(stderr, "kernel_launch: occupancy query reports %d workgroups per CU\n", per_cu); }
        (void)hipGetLastError();
        grid = cus;
        if (grid != 256) { fprintf(stderr, "kernel_launch: %d CUs; this kernel is built for 256\n", grid); grid = -1; return; }
    }
    if (grid < 0) return;
    if (hipMemsetAsync((char*)d_ws + WS_CTL, 0, CTL_ZERO_BYTES, stream) != hipSuccess) { fprintf(stderr, "kernel_launch: memset failed\n"); return; }
    Args a{};
    for (int i = 0; i < N_IN; ++i) a.in[i] = (const float*)d_in[i];
    a.out = (float*)d_out; a.ws = (unsigned char*)d_ws; a.pad = 0;
#if MK_PER_PHASE
    for (int k = 0; k < NPHASE; ++k) { a.ph_lo = k; a.ph_hi = k + 1; a.li = k;
        hipLaunchKernelGGL(mk_fwd, dim3(grid), dim3(NWAVES * 64), LDS_BYTES, stream, a);
#if defined(MK_DIAG)
        if (k == MK_DIAG_AFTER) { if (MK_DIAG >= 8) { hipLaunchKernelGGL(mk_copy, dim3(256), dim3(512), 0, stream, a); } else { hipLaunchKernelGGL(mk_diag, dim3(256), dim3(512), 0, stream, a); hipLaunchKernelGGL(mk_diag_out, dim3(256), dim3(512), 0, stream, a); } break; }
#endif
    }
#else
    a.ph_lo = 0; a.ph_hi = NPHASE; a.li = 0;
    hipLaunchKernelGGL(mk_fwd, dim3(grid), dim3(NWAVES * 64), LDS_BYTES, stream, a);
#endif
    const hipError_t le = hipPeekAtLastError();
    if (le != hipSuccess) fprintf(stderr, "kernel_launch: launch failed: %s\n", hipGetErrorName(le));
}
```

```cpp
#include <hip/hip_runtime.h>
#include <cstdio>
#include <cstdint>
#ifndef MK_PER_PHASE
#define MK_PER_PHASE 0
#endif
namespace pg8 {
#define PG8_LAS __attribute__((address_space(3)))
typedef unsigned short bf16_t;
typedef short bf16x8 __attribute__((ext_vector_type(8)));
typedef float f32x4 __attribute__((ext_vector_type(4)));
typedef unsigned u32x4 __attribute__((ext_vector_type(4)));
constexpr int BM = 256, BK = 64, HALF = 128, HTB = HALF * BK * 2  , STAGE_BYTES = 8 * HTB, NXCD = 8, WGM = 8;

__host__ __device__ __forceinline__ int lds_byte(int r, int c) { const int st = (r >> 4) * 2 + (c >> 5), rr = r & 15, cc = c & 31, ob = rr * 64 + cc * 2; return st * 1024 + (ob ^ (((ob >> 9) & 1) << 5)); }
__host__ __device__ __forceinline__ void stage_rc(int b, int& R, int& C) { const int st = b / 1024, sb = b % 1024, swz = sb ^ (((sb >> 9) & 1) << 5); R = (st >> 1) * 16 + swz / 64; C = (st & 1) * 32 + (swz % 64) / 2; }
__host__ __device__ __forceinline__ int perm32(int rho) { const int n = rho >> 4, i = rho & 15; return 8 * (i >> 2) + 4 * n + (i & 3); }

struct Unit { int pm, pn; };
struct Gemm { const bf16_t* A; const bf16_t* Bt; int M, N, K; };

struct StaticOrder {
    int nM, nN, nwg, G, c;
    __host__ __device__ void init(int M, int N, int G_, int c_) { nM = M / BM; nN = N / BM; nwg = nM * nN; G = G_; c = c_; }
    __host__ __device__ bool next(int i, Unit& u) const {
        const long L = (long)i * G + c; if (L >= nwg) return false;
        int wgid = (int)L; { const int q = nwg / NXCD, r = nwg % NXCD, xcd = wgid % NXCD, off = wgid / NXCD; wgid = (xcd < r ? xcd * (q + 1) : r * (q + 1) + (xcd - r) * q) + off; }
        const int nig = WGM * nN, gid = wgid / nig, fm = gid * WGM, gsz = (nM - fm) < WGM ? (nM - fm) : WGM;
        u.pm = fm + ((wgid % nig) % gsz); u.pn = (wgid % nig) / gsz; return true;
    }
    __device__ __forceinline__ void a_ready(const Unit&) const {}
    __device__ __forceinline__ void done(const Unit&) const {}
};

__device__ __forceinline__ unsigned cvt_pk_bf16(float lo, float hi) { unsigned r; asm volatile("v_cvt_pk_bf16_f32 %0, %1, %2" : "=v"(r) : "v"(lo), "v"(hi)); return r; }
typedef float f32x2 __attribute__((ext_vector_type(2)));
template <class Epi, class Sched, bool ALIGN_EPI = false, bool SP2 = false>
__device__ __forceinline__ void gemm_phase(PG8_LAS unsigned char* lds, const Gemm g, const Sched& S, const Epi& E, const int wid_in) {
    int lid_; asm volatile("v_mbcnt_lo_u32_b32 %0, -1, 0\n\tv_mbcnt_hi_u32_b32 %0, -1, %0" : "=v"(lid_)); const int tid_ = wid_in * 64 + lid_;
    const int tid = tid_, wid = __builtin_amdgcn_readfirstlane(tid >> 6), lane = tid & 63, wr = wid >> 2, wc = wid & 3, fr = lane & 15, fq = lane >> 4;
    const int K = g.K, nt = K / BK;
    unsigned voffA[2], voffB[2];
#pragma unroll
    for (int i = 0; i < 2; ++i) { int R, C; stage_rc(tid * 16 + i * 8192, R, C); const int Rb = Epi::PERM ? ((R & ~31) + perm32(R & 31)) : R;
        voffA[i] = (unsigned)(R * K + C) * 2u; voffB[i] = (unsigned)(Rb * K + C) * 2u; }
    const size_t kstep = (size_t)(BK * 2);
    const size_t hstep = (size_t)HALF * K * 2;
    const size_t tstep = 2 * hstep;
    const unsigned ldsw = (unsigned)wid * 1024u;
    const int aoff = lds_byte(wr * 64 + fr, fq * 8), boff = lds_byte(wc * 32 + fr, fq * 8);
#define PG8_SA(b, h) (((b) * 2 + (h)) * HTB)
#define PG8_SB(b, h) ((4 + (b) * 2 + (h)) * HTB)
#define PG8_STAGE(bufoff, gbase, voff) do { _Pragma("unroll") for (int _i = 0; _i < 2; ++_i) \
        __builtin_amdgcn_global_load_lds((const unsigned*)((const char*)(gbase) + (voff)[_i]), (PG8_LAS unsigned*)(lds + (bufoff) + ldsw + _i * 8192), 16, 0, 0); } while (0)
#define PG8_LDA(dst, b, h) do { _Pragma("unroll") for (int m = 0; m < 4; ++m) _Pragma("unroll") for (int k = 0; k < 2; ++k) dst[m][k] = *(const PG8_LAS bf16x8*)(lds + PG8_SA(b, h) + aoff + m * 2048 + k * 1024); } while (0)
#define PG8_LDB(dst, b, h) do { _Pragma("unroll") for (int n = 0; n < 2; ++n) _Pragma("unroll") for (int k = 0; k < 2; ++k) dst[n][k] = *(const PG8_LAS bf16x8*)(lds + PG8_SB(b, h) + boff + n * 2048 + k * 1024); } while (0)
#define PG8_MMA(ai, bj, At, Bt) do { __builtin_amdgcn_s_setprio(1); _Pragma("unroll") for (int m = 0; m < 4; ++m) _Pragma("unroll") for (int n = 0; n < 2; ++n) _Pragma("unroll") for (int k = 0; k < 2; ++k) \
        acc[ai][bj][m][n] = __builtin_amdgcn_mfma_f32_16x16x32_bf16(Bt[n][k], At[m][k], acc[ai][bj][m][n], 0, 0, 0); __builtin_amdgcn_s_setprio(0); } while (0)
#define PG8_WAIT_V(n) asm volatile("s_waitcnt vmcnt(" #n ")" ::: "memory")
#define PG8_WAIT_L(n) asm volatile("s_waitcnt lgkmcnt(" #n ")" ::: "memory")
#define PG8_BAR __builtin_amdgcn_s_barrier()
#define PG8_SCHED __builtin_amdgcn_sched_barrier(0)
    Unit cur, nxt; int ui = 0;
    if (!S.next(0, cur)) return;
    f32x4 acc[2][2][4][2];
#pragma unroll
    for (int a = 0; a < 2; ++a)
#pragma unroll
        for (int b = 0; b < 2; ++b)
#pragma unroll
            for (int m = 0; m < 4; ++m)
#pragma unroll
                for (int n = 0; n < 2; ++n) acc[a][b][m][n] = (f32x4){0.f, 0.f, 0.f, 0.f};
    bf16x8 At[4][2], B0[2][2], B1[2][2];
    const char* cA = (const char*)g.A + (size_t)cur.pm * tstep; const char* cB = (const char*)g.Bt + (size_t)cur.pn * tstep;
    S.a_ready(cur);
    if constexpr (SP2) {
        PG8_STAGE(PG8_SB(0, 0), cB, voffB); PG8_STAGE(PG8_SB(0, 1), cB + hstep, voffB); PG8_STAGE(PG8_SA(0, 0), cA, voffA); PG8_STAGE(PG8_SA(0, 1), cA + hstep, voffA);
        if (wr == 1) PG8_BAR;
        PG8_WAIT_V(2); PG8_BAR;
        PG8_STAGE(PG8_SB(1, 0), cB + kstep, voffB); PG8_STAGE(PG8_SA(1, 0), cA + kstep, voffA); PG8_STAGE(PG8_SB(1, 1), cB + hstep + kstep, voffB);
        PG8_WAIT_V(6); PG8_BAR;
    } else {
        PG8_STAGE(PG8_SB(0, 0), cB, voffB); PG8_STAGE(PG8_SA(0, 0), cA, voffA); PG8_STAGE(PG8_SB(0, 1), cB + hstep, voffB); PG8_STAGE(PG8_SA(0, 1), cA + hstep, voffA);
        if (wr == 1) PG8_BAR;
        PG8_WAIT_V(4); PG8_BAR;
        PG8_STAGE(PG8_SB(1, 0), cB + kstep, voffB); PG8_STAGE(PG8_SA(1, 0), cA + kstep, voffA); PG8_STAGE(PG8_SB(1, 1), cB + hstep + kstep, voffB);
        PG8_WAIT_V(6); PG8_BAR;
    }
    for (;;) {
        const bool has_next = S.next(ui + 1, nxt);
        const char* nA = has_next ? (const char*)g.A + (size_t)nxt.pm * tstep : cA; const char* nB = has_next ? (const char*)g.Bt + (size_t)nxt.pn * tstep : cB;
        for (int t = 0; t < nt; t += 2) {
            const bool last = (t == nt - 2);
            if constexpr (Epi::RESCALE) { if (t == 8 || t == 16) E.rescale(acc, cur, t >> 3, wr, wc, fr, fq); }
            const char* a1 = cA + (size_t)(t + 1) * kstep;
            const char* a2 = last ? nA : cA + (size_t)(t + 2) * kstep; const char* b2 = last ? nB : cB + (size_t)(t + 2) * kstep;
            const char* a3 = a2 + kstep; const char* b3 = b2 + kstep;
            if (last && has_next) S.a_ready(nxt);
            if constexpr (SP2) {
            PG8_LDB(B0, 0, 0); PG8_LDB(B1, 0, 1); PG8_SCHED; PG8_LDA(At, 0, 0); PG8_STAGE(PG8_SA(1, 1), a1 + hstep, voffA);
            PG8_WAIT_V(8); PG8_WAIT_L(0); PG8_BAR; PG8_MMA(0, 0, At, B0); PG8_MMA(0, 1, At, B1); PG8_BAR; PG8_SCHED;
            PG8_LDA(At, 0, 1); PG8_STAGE(PG8_SB(0, 0), b2, voffB); PG8_STAGE(PG8_SB(0, 1), b2 + hstep, voffB); PG8_STAGE(PG8_SA(0, 0), a2, voffA);
            PG8_WAIT_V(8); PG8_WAIT_L(0); PG8_BAR; PG8_MMA(1, 0, At, B0); PG8_MMA(1, 1, At, B1); PG8_BAR; PG8_SCHED;
            PG8_LDB(B0, 1, 0); PG8_LDB(B1, 1, 1); PG8_SCHED; PG8_LDA(At, 1, 0); PG8_STAGE(PG8_SA(0, 1), a2 + hstep, voffA);
            PG8_WAIT_V(8); PG8_WAIT_L(0); PG8_BAR; PG8_MMA(0, 0, At, B0); PG8_MMA(0, 1, At, B1); PG8_BAR; PG8_SCHED;
            PG8_LDA(At, 1, 1); PG8_STAGE(PG8_SB(1, 0), b3, voffB); PG8_STAGE(PG8_SB(1, 1), b3 + hstep, voffB); PG8_STAGE(PG8_SA(1, 0), a3, voffA);
            PG8_WAIT_V(8); PG8_WAIT_L(0); PG8_BAR; PG8_MMA(1, 0, At, B0); PG8_MMA(1, 1, At, B1); PG8_BAR; PG8_SCHED;
            } else {
            PG8_LDB(B0, 0, 0); PG8_SCHED; PG8_LDA(At, 0, 0); PG8_STAGE(PG8_SA(1, 1), a1 + hstep, voffA);
            PG8_WAIT_L(8); PG8_BAR; PG8_WAIT_L(0); PG8_MMA(0, 0, At, B0); PG8_BAR; PG8_SCHED;
            PG8_LDB(B1, 0, 1); PG8_STAGE(PG8_SB(0, 0), b2, voffB);
            PG8_BAR; PG8_WAIT_L(0); PG8_MMA(0, 1, At, B1); PG8_BAR;
            PG8_LDA(At, 0, 1); PG8_STAGE(PG8_SA(0, 0), a2, voffA);
            PG8_BAR; PG8_WAIT_L(0); PG8_MMA(1, 0, At, B0); PG8_BAR; PG8_SCHED;
            PG8_STAGE(PG8_SB(0, 1), b2 + hstep, voffB);
            PG8_WAIT_V(6); PG8_BAR; PG8_MMA(1, 1, At, B1); PG8_BAR;
            PG8_LDB(B0, 1, 0); PG8_SCHED; PG8_LDA(At, 1, 0); PG8_STAGE(PG8_SA(0, 1), a2 + hstep, voffA);
            PG8_WAIT_L(8); PG8_BAR; PG8_WAIT_L(0); PG8_MMA(0, 0, At, B0); PG8_BAR; PG8_SCHED;
            PG8_LDB(B1, 1, 1); PG8_STAGE(PG8_SB(1, 0), b3, voffB);
            PG8_BAR; PG8_WAIT_L(0); PG8_MMA(0, 1, At, B1); PG8_BAR;
            PG8_LDA(At, 1, 1); PG8_STAGE(PG8_SA(1, 0), a3, voffA);
            PG8_BAR; PG8_WAIT_L(0); PG8_MMA(1, 0, At, B0); PG8_BAR; PG8_SCHED;
            PG8_STAGE(PG8_SB(1, 1), b3 + hstep, voffB);
            PG8_WAIT_V(6); PG8_BAR; PG8_MMA(1, 1, At, B1); PG8_BAR;
            }
        }
        if constexpr (ALIGN_EPI) { if (wr == 0) PG8_BAR; }
        if constexpr (!Epi::AFTER_DRAIN) { E(acc, cur, wr, wc, fr, fq); S.done(cur); }
        if (!has_next) break;
#pragma unroll
        for (int a = 0; a < 2; ++a)
#pragma unroll
            for (int b = 0; b < 2; ++b)
#pragma unroll
                for (int m = 0; m < 4; ++m)
#pragma unroll
                    for (int n = 0; n < 2; ++n) acc[a][b][m][n] = (f32x4){0.f, 0.f, 0.f, 0.f};
        cur = nxt; cA = nA; cB = nB; ++ui;
        if constexpr (ALIGN_EPI) { if (wr == 1) PG8_BAR; }
    }
    PG8_WAIT_V(0);
    if constexpr (!ALIGN_EPI) { if (wr == 0) PG8_BAR; }
    PG8_BAR;
    if constexpr (Epi::AFTER_DRAIN) { E.fused(acc, cur, wr, wc, fr, fq, lds, wid, lane); S.done(cur); }
#undef PG8_SA
#undef PG8_SB
#undef PG8_STAGE
#undef PG8_LDA
#undef PG8_LDB
#undef PG8_MMA
#undef PG8_WAIT_V
#undef PG8_WAIT_L
#undef PG8_BAR
#undef PG8_SCHED
}
}

#ifndef MK_ABL_A
#define MK_ABL_A 1.0f
#endif
#ifndef MK_ABL_B
#define MK_ABL_B 1.0f
#endif
#ifndef MK_ABL_C
#define MK_ABL_C 1.0f
#endif
#ifndef MK_ABL_F
#define MK_ABL_F 1.0f
#endif
constexpr int NWAVES = 8;
constexpr int D = 1024, NBATCH = 8, SEQ = 2048, LCTX = 256, DEPTH = 2;
constexpr int M_LAT = NBATCH * SEQ, M_CTX = NBATCH * LCTX, M_ALL = M_LAT + M_CTX;
constexpr int D_IN = 6928, NP = 6912;
constexpr int PA_VAL = 0, PA_GATE = 512, PQ = 1024, PK = 1536, PV = 1664, PMQ = 1792, PMK = 2304, PMV = 2816, PMO = 3328, PBG = 3840;
constexpr int SRC_MG = 3840;
constexpr int NE = 16, DEXP = 512, NY = 1536;
constexpr float LN_EPS = 1e-5f, ALPHA = 1.41421356237309515f;
constexpr float KSCALE = 0.08838834764831845f;
enum { I_X = 0, I_C, I_CTX, I_CCTX, I_LNIN_G, I_LNIN_B, I_WROUTER, I_BROUTER, I_WMOD, I_BMOD, I_WIN, I_CONVW, I_CONVB, I_CONVLN_G, I_CONVLN_B, I_WA, I_SINK, I_WB, I_GATEB, I_NORMG, I_WC, I_WOUT,
       I_LN1G, I_LN1B, I_WGU, I_WDN, I_LN2G, I_LN2B, N_IN };
static_assert(N_IN == 28, "inputs");

constexpr size_t MiB = 1u << 20;
constexpr size_t WS_CTL = 0, CTL_ZERO_BYTES = 1 * MiB;
constexpr size_t WS_MOD = 1 * MiB;
constexpr size_t WS_ROPE = 1 * MiB + 512 * 1024;
constexpr size_t WS_G = 2 * MiB;
constexpr size_t WS_ROUTE = 4 * MiB;
constexpr size_t WS_BCNT = 4 * MiB + 768 * 1024;
constexpr size_t WS_ROWMAP = 5 * MiB;
constexpr size_t WS_ROWW = 5 * MiB + 256 * 1024;
constexpr size_t WS_HC = 6 * MiB;
constexpr size_t WS_W = 14 * MiB;
constexpr size_t W_IN = 0, W_ABC = W_IN + (size_t)NP * D * 2, W_OUT = W_ABC + (size_t)D * NY * 2, W_GU = W_OUT + (size_t)D * D * 2, W_DN = W_GU + (size_t)NE * D * D * 2, W_LAYER = W_DN + (size_t)NE * D * DEXP * 2;
constexpr size_t WS_P = WS_W + 2 * W_LAYER;
constexpr size_t WS_U = WS_P + (size_t)M_ALL * NP * 2;
constexpr size_t WS_Y = WS_U + (size_t)M_ALL * D * 2;
constexpr size_t WS_END = WS_Y + (size_t)M_ALL * NY * 2;
constexpr int AS_ROWS = 40960;
constexpr size_t WS_AS = WS_P;
constexpr size_t WS_ACT = WS_AS + (size_t)AS_ROWS * D * 2;
constexpr size_t WS_F = WS_ACT + (size_t)AS_ROWS * DEXP * 2;
static_assert(WS_F + (size_t)M_ALL * 2 * D * 2 <= WS_U, "MoE buffers overlay P");
static_assert(W_LAYER == 69730304 && WS_W % 256 == 0 && WS_P % 256 == 0 && WS_U % 256 == 0 && WS_Y % 256 == 0, "map");
constexpr size_t WS_HF = WS_U, WS_HB = WS_U + (size_t)M_ALL * 512 * 2;
constexpr int CW_TMO = 0, CW_CODE = 1;
constexpr int CW_CNT = 256;
constexpr int CW_BAR = 4096;

constexpr int RING_BYTES = 131072, LDSCTL_OFF = RING_BYTES, MISC_OFF = LDSCTL_OFF + 320, LDS_BYTES = 147456;

#define GAS __attribute__((address_space(1)))
#define LAS __attribute__((address_space(3)))
typedef unsigned short bf16;
typedef unsigned v4u __attribute__((ext_vector_type(4)));
typedef unsigned v2u __attribute__((ext_vector_type(2)));
typedef float f32x4 __attribute__((ext_vector_type(4)));
typedef float f32x16 __attribute__((ext_vector_type(16)));
typedef short bf16x8 __attribute__((ext_vector_type(8)));
typedef GAS unsigned gu32;
#define RLX_AGENT __ATOMIC_RELAXED, __HIP_MEMORY_SCOPE_AGENT
#define LDS_WAIT() asm volatile("s_waitcnt lgkmcnt(0)" ::: "memory")
#define VM_WAIT() asm volatile("s_waitcnt vmcnt(0)" ::: "memory")
__device__ __forceinline__ unsigned f2bf(float f) { unsigned u = __builtin_bit_cast(unsigned, f); return (u + 0x7fffu + ((u >> 16) & 1u)) >> 16; }
typedef float f32x2_t __attribute__((ext_vector_type(2)));
typedef __bf16 bf16x2_t __attribute__((ext_vector_type(2)));
__device__ __forceinline__ unsigned pk2(float lo, float hi) { const f32x2_t v = {lo, hi}; const bf16x2_t b = __builtin_convertvector(v, bf16x2_t); return __builtin_bit_cast(unsigned, b); }
__device__ __forceinline__ float bflo(unsigned w) { return __builtin_bit_cast(float, w << 16); }
__device__ __forceinline__ float bfhi(unsigned w) { return __builtin_bit_cast(float, w & 0xffff0000u); }
__device__ __forceinline__ float bf1(bf16 v) { return __builtin_bit_cast(float, (unsigned)v << 16); }
__device__ __forceinline__ float sigmoidf_(float x) { return 1.0f / (1.0f + __expf(-x)); }
__device__ __forceinline__ int lane_id() { int l; asm volatile("v_mbcnt_lo_u32_b32 %0, -1, 0\n\tv_mbcnt_hi_u32_b32 %0, -1, %0" : "=v"(l)); return l; }
__device__ __forceinline__ float shidx(float v, int src) { return __builtin_bit_cast(float, __builtin_amdgcn_ds_bpermute(src << 2, __builtin_bit_cast(int, v))); }
__device__ __forceinline__ float shx(float v, int mask, int lane) { return shidx(v, lane ^ mask); }
__device__ __forceinline__ float shup(float v, int o, int lane) { return shidx(v, lane >= o ? lane - o : lane); }
__device__ __forceinline__ float wave_sum(float v, int lane) {
#pragma unroll
    for (int o = 1; o < 64; o <<= 1) v += shx(v, o, lane);
    return v;
}
__device__ __forceinline__ void unpack8(v4u w, float (&f)[8]) { f[0] = bflo(w.x); f[1] = bfhi(w.x); f[2] = bflo(w.y); f[3] = bfhi(w.y); f[4] = bflo(w.z); f[5] = bfhi(w.z); f[6] = bflo(w.w); f[7] = bfhi(w.w); }
__device__ __forceinline__ v4u pack8(const float (&f)[8]) { v4u w; w.x = pk2(f[0], f[1]); w.y = pk2(f[2], f[3]); w.z = pk2(f[4], f[5]); w.w = pk2(f[6], f[7]); return w; }

#define XB_TMO      128
#define XB_XCNT(j)  (256  + 64 * (j))
#define XB_XSUB(j)  (1280 + 64 * (j))
#define XB_XGEN(j)  (2304 + 64 * (j))
#define XB_TOP      3328
#define XB_TOPGEN   3392
#define XCD_BAR_WORDS 3456
#define XB_SPIN_CAP (1u << 18)

__device__ __forceinline__ unsigned xb_ld(unsigned* p)              { return __hip_atomic_load(p, __ATOMIC_RELAXED, __HIP_MEMORY_SCOPE_AGENT); }
__device__ __forceinline__ unsigned xb_add(unsigned* p, unsigned) { unsigned one; asm volatile("v_mov_b32 %0, 1" : "=v"(one));
    return __hip_atomic_fetch_add(p, one, __ATOMIC_RELAXED, __HIP_MEMORY_SCOPE_AGENT); }
__device__ __forceinline__ unsigned xb_xcc_id() { return (unsigned)__builtin_amdgcn_s_getreg((3 << 11) | 20) & 0xFu; }
#define XB_SPIN(cond, bar) do { unsigned _sp = 0; while (cond) { __builtin_amdgcn_s_sleep(1); \
    if ((++_sp & 255u) == 0u) { if (xb_ld(&(bar)[XB_TMO])) break; if (_sp > XB_SPIN_CAP) { (void)xb_add(&(bar)[XB_TMO], 1u); break; } } } } while (0)

struct XcdBarrier {
    bool w0;
    unsigned* bar; unsigned x;
    volatile LAS unsigned* st;
};

__device__ __forceinline__ XcdBarrier xcd_barrier_post(unsigned* bar, volatile LAS unsigned* st) {
    XcdBarrier b; b.w0 = false; b.bar = bar; b.x = xb_xcc_id(); b.st = st;
    if (threadIdx.x == 0) (void)xb_add(&bar[XB_XCNT(b.x)], 1u);
    return b;
}
__device__ __forceinline__ void xcd_barrier_complete(unsigned* bar, unsigned x, unsigned& nloc, unsigned& nx) {
    const unsigned G = gridDim.x * gridDim.y * gridDim.z;
    unsigned sum, cnt, mine, sp = 0u;
    for (;;) {
        sum = 0u; cnt = 0u; mine = 0u;
#pragma unroll
        for (unsigned j = 0; j < 16; ++j) { const unsigned c = xb_ld(&bar[XB_XCNT(j)]); sum += c; cnt += (c > 0u) ? 1u : 0u; mine = (j == x) ? c : mine; }
        if (sum == G) break;
        __builtin_amdgcn_s_sleep(1);
        if ((++sp & 255u) == 0u) { if (xb_ld(&bar[XB_TMO])) break; if (sp > XB_SPIN_CAP) { (void)xb_add(&bar[XB_TMO], 1u); break; } }
    }
    nloc = mine > 0u ? mine : 1u; nx = cnt > 0u ? cnt : 1u;
}

__device__ __forceinline__ void xcd_barrier(const XcdBarrier& b) {
    asm volatile("s_waitcnt vmcnt(0)" ::: "memory");
    __syncthreads();
    if (b.w0 && lane_id() == 0) {
        unsigned* bar = b.bar;
        __builtin_amdgcn_s_waitcnt(0);
        unsigned nloc = b.st[0], nx = b.st[1];
        if (nloc == 0u) { xcd_barrier_complete(bar, b.x, nloc, nx); b.st[0] = nloc; b.st[1] = nx; }
        const unsigned old = xb_add(&bar[XB_XSUB(b.x)], 1u);
        const unsigned gen = old / nloc;
        if (old + 1u == (gen + 1u) * nloc) {
            __builtin_amdgcn_fence(__ATOMIC_RELEASE, "agent");
            asm volatile("s_waitcnt vmcnt(0)" ::: "memory");
            const unsigned og = xb_add(&bar[XB_TOP], 1u);
            const unsigned tg = og / nx;
            if (og + 1u == (tg + 1u) * nx) xb_add(&bar[XB_TOPGEN], 1u);
            else XB_SPIN(xb_ld(&bar[XB_TOPGEN]) == tg, bar);
            __builtin_amdgcn_fence(__ATOMIC_ACQUIRE, "agent");
            xb_add(&bar[XB_XGEN(b.x)], 1u);
            asm volatile("s_waitcnt vmcnt(0)" ::: "memory");
        } else {
            XB_SPIN(xb_ld(&bar[XB_XGEN(b.x)]) == gen, bar);
            __builtin_amdgcn_fence(__ATOMIC_ACQUIRE, "agent");
            asm volatile("s_waitcnt vmcnt(0)" ::: "memory");
        }
    }
    __syncthreads();
}

struct Ctx {
    LAS unsigned char* lds;
    volatile LAS unsigned* MISC;
    unsigned* ctl;
    int tid, lane, wave, vcu, G;
    const float* const* in; float* out; unsigned char* ws;
};
__device__ __forceinline__ bf16* wt(const Ctx& F, int l, size_t off) { return (bf16*)(F.ws + WS_W + (size_t)l * W_LAYER + off); }
__device__ __forceinline__ float* hrow(const Ctx& F, int r) { return r < M_LAT ? F.out + (size_t)r * D : (float*)(F.ws + WS_HC) + (size_t)(r - M_LAT) * D; }
__device__ __forceinline__ const float* xrow(const Ctx& F, int r) { return r < M_LAT ? F.in[I_X] + (size_t)r * D : F.in[I_CTX] + (size_t)(r - M_LAT) * D; }
__device__ __forceinline__ int modrow(int r) { return r < M_LAT ? (r >> 11) : 8; }
__device__ __forceinline__ const float* modp(const Ctx& F, int l, int mr) { return (const float*)(F.ws + WS_MOD) + (size_t)(l * 9 + mr) * 6144; }

__device__ __forceinline__ void load_row(const float* p, int lane, f32x4 (&v)[4]) {
#pragma unroll
    for (int j = 0; j < 4; ++j) v[j] = *(const f32x4*)(p + 4 * lane + 256 * j);
}
__device__ __forceinline__ void store_row(float* p, int lane, const f32x4 (&v)[4]) {
#pragma unroll
    for (int j = 0; j < 4; ++j) *(f32x4*)(p + 4 * lane + 256 * j) = v[j];
}
__device__ __forceinline__ void ln_row(f32x4 (&v)[4], const float* g, const float* b, int lane) {
    float s = 0.f;
#pragma unroll
    for (int j = 0; j < 4; ++j) s += (v[j].x + v[j].y) + (v[j].z + v[j].w);
    const float mean = wave_sum(s, lane) * (1.f / D); float s2 = 0.f;
#pragma unroll
    for (int j = 0; j < 4; ++j) { v[j] = v[j] - mean; s2 += (v[j].x * v[j].x + v[j].y * v[j].y) + (v[j].z * v[j].z + v[j].w * v[j].w); }
    const float rstd = 1.f / sqrtf(wave_sum(s2, lane) * (1.f / D) + LN_EPS);
#pragma unroll
    for (int j = 0; j < 4; ++j) { const f32x4 gg = *(const f32x4*)(g + 4 * lane + 256 * j), bb = *(const f32x4*)(b + 4 * lane + 256 * j); v[j] = v[j] * rstd * gg + bb; }
}
__device__ __forceinline__ void emit_u(const f32x4 (&h)[4], const float* sh, const float* sc, bf16* urow, int lane, f32x4 (&u)[4]) {
#pragma unroll
    for (int j = 0; j < 4; ++j) { const f32x4 s1 = *(const f32x4*)(sc + 4 * lane + 256 * j), s0 = *(const f32x4*)(sh + 4 * lane + 256 * j); u[j] = h[j] * (1.0f + s1) + s0;
        v2u w; w.x = pk2(u[j].x, u[j].y); w.y = pk2(u[j].z, u[j].w); *(v2u*)(urow + 4 * lane + 256 * j) = w; }
}
__device__ __forceinline__ void stage_w16(const Ctx& F, const float* W, int ld, LAS float* Wt) {
    for (int idx = F.tid; idx < 1024 * 16; idx += NWAVES * 64) { const int k = idx >> 4, e = idx & 15; Wt[e * 1024 + k] = W[(size_t)k * ld + e]; }
}
__device__ __forceinline__ void dot16(const f32x4 (&u)[4], const LAS float* Wt, int lane, float (&o)[16]) {
    const LAS float* wl = Wt + 4 * lane;
#pragma unroll
    for (int e = 0; e < 16; ++e) { float s = 0.f;
#pragma unroll
        for (int j = 0; j < 4; ++j) { const f32x4 w = *(const LAS f32x4*)(wl + e * 1024 + 256 * j); s += (u[j].x * w.x + u[j].y * w.y) + (u[j].z * w.z + u[j].w * w.w); }
        o[e] = wave_sum(s, lane);
        if ((e & 3) == 3) asm volatile("" ::: "memory"); }
}
#if defined(MK_DOT16_GLOBAL)
__device__ __forceinline__ void dot16g(const f32x4 (&u)[4], const float* W, int ld, int lane, float (&o)[16]) {
#pragma unroll
    for (int e = 0; e < 16; ++e) o[e] = 0.f;
#pragma unroll
    for (int j = 0; j < 4; ++j)
#pragma unroll
        for (int c = 0; c < 4; ++c) { const float uv = u[j][c]; const float* wr = W + (size_t)(256 * j + 4 * lane + c) * ld;
#pragma unroll
            for (int q = 0; q < 4; ++q) { const f32x4 w = *(const f32x4*)(wr + 4 * q); o[4 * q] += uv * w.x; o[4 * q + 1] += uv * w.y; o[4 * q + 2] += uv * w.z; o[4 * q + 3] += uv * w.w; } }
#pragma unroll
    for (int e = 0; e < 16; ++e) o[e] = wave_sum(o[e], lane);
}
#endif
__device__ __forceinline__ void emit_layer_input(const Ctx& F, int l, int r, const f32x4 (&h)[4]) {
    const float* mp = modp(F, l, modrow(r)); f32x4 u[4];
    emit_u(h, mp + 0, mp + 1024, (bf16*)(F.ws + WS_U) + (size_t)r * D, F.lane, u);
    float o[16];
#if defined(MK_DOT16_GLOBAL)
    dot16g(u, F.in[I_WIN] + (size_t)l * D * D_IN + SRC_MG, D_IN, F.lane, o);
#else
    dot16(u, (const LAS float*)F.lds, F.lane, o);
#endif
    if (F.lane == 0) { float* gp = (float*)(F.ws + WS_G) + (size_t)r * 16;
#pragma unroll
        for (int q = 0; q < 4; ++q) *(f32x4*)(gp + 4 * q) = (f32x4){o[4 * q], o[4 * q + 1], o[4 * q + 2], o[4 * q + 3]}; }
}

__device__ __forceinline__ void tr_item(const float* W, int ldw, int k0, int n0, bf16* WT, int ldt, int drow0, int dk0, LAS float* scr, int lane) {
#pragma unroll 8
    for (int i = 0; i < 32; ++i) { const int kk = 2 * i + (lane >> 5); scr[kk * 33 + (lane & 31)] = W[(size_t)(k0 + kk) * ldw + n0 + (lane & 31)]; }
    LDS_WAIT(); asm volatile("" ::: "memory");
    const int c = lane & 7;
#pragma unroll
    for (int j = 0; j < 4; ++j) { const int n = (lane >> 3) + 8 * j; const LAS float* s = scr + (8 * c) * 33 + n;
        v4u o; o.x = pk2(s[0 * 33], s[1 * 33]); o.y = pk2(s[2 * 33], s[3 * 33]); o.z = pk2(s[4 * 33], s[5 * 33]); o.w = pk2(s[6 * 33], s[7 * 33]);
        *(v4u*)(WT + (size_t)(drow0 + n) * ldt + dk0 + k0 + 8 * c) = o; }
    LDS_WAIT(); asm volatile("" ::: "memory");
}
constexpr int CV_IN = 16 * (NP / 32), CV_ABC = 3 * 8 * 32, CV_OUT = 16 * 32, CV_GU = NE * 16 * 32, CV_DN = NE * 8 * 32, CV_LAYER = CV_IN + CV_ABC + CV_OUT + CV_GU + CV_DN;
__device__ __forceinline__ void convert_item(const Ctx& F, int l, int it, LAS float* scr) {
    const int lane = F.lane;
    if (it < CV_IN) { const int kb = it / (NP / 32), nb = it % (NP / 32), n0 = 32 * nb;
        tr_item(F.in[I_WIN] + (size_t)l * D * D_IN, D_IN, 64 * kb, n0 < PBG ? n0 : n0 + 16, wt(F, l, W_IN), D, n0, 0, scr, lane); return; }
    it -= CV_IN;
    if (it < CV_ABC) { const int br = it / 256, r = it % 256, kb = r / 32, nb = r % 32;
        if (br == 0) tr_item(F.in[I_WA] + (size_t)l * 512 * D, D, 64 * kb, 32 * nb, wt(F, l, W_ABC), NY, 32 * nb, 0, scr, lane);
        else if (br == 1) tr_item(F.in[I_WB] + (size_t)l * 512 * D, D, 64 * kb, 32 * nb, wt(F, l, W_ABC), NY, 32 * nb, 512, scr, lane);
        else tr_item(F.in[I_WC] + (size_t)l * 512 * D, D, 64 * kb, 32 * nb, wt(F, l, W_ABC), NY, 32 * nb, 1024, scr, lane);
        return; }
    it -= CV_ABC;
    if (it < CV_OUT) { const int kb = it / 32, nb = it % 32; tr_item(F.in[I_WOUT] + (size_t)l * D * D, D, 64 * kb, 32 * nb, wt(F, l, W_OUT), D, 32 * nb, 0, scr, lane); return; }
    it -= CV_OUT;
    if (it < CV_GU) { const int e = it / 512, r = it % 512, kb = r / 32, nb = r % 32, n0 = 32 * nb;
        const int dr = n0 < 512 ? (n0 / 128) * 256 + (n0 % 128) : ((n0 - 512) / 128) * 256 + 128 + ((n0 - 512) % 128);
        tr_item(F.in[I_WGU] + (size_t)(l * NE + e) * D * D, D, 64 * kb, n0, wt(F, l, W_GU) + (size_t)e * D * D, D, dr, 0, scr, lane); return; }
    it -= CV_GU;
    { const int e = it / 256, r = it % 256, kb = r / 32, nb = r % 32;
        tr_item(F.in[I_WDN] + (size_t)(l * NE + e) * DEXP * D, D, 64 * kb, 32 * nb, wt(F, l, W_DN) + (size_t)e * D * DEXP, DEXP, 32 * nb, 0, scr, lane); }
}
__device__ __forceinline__ void p0_prologue(const Ctx& F) {
    if (F.vcu < 192) {
        LAS float* S = (LAS float*)F.lds; LAS float* red = (LAS float*)(F.lds + 36864);
        for (int idx = F.tid; idx < 9 * D; idx += NWAVES * 64) { const int r = idx >> 10, k = idx & 1023; const float v = r < 8 ? F.in[I_C][r * D + k] : F.in[I_CCTX][k]; S[idx] = v * sigmoidf_(v); }
        __syncthreads();
        const int l = F.vcu / 96, n0 = (F.vcu % 96) * 64;
        float acc[9];
#pragma unroll
        for (int r = 0; r < 9; ++r) acc[r] = 0.f;
        const float* wp = F.in[I_WMOD] + ((size_t)l * D + 128 * F.wave) * 6144 + n0 + F.lane;
#pragma unroll 4
        for (int kk = 0; kk < 128; ++kk) { const float wv = wp[(size_t)kk * 6144];
#pragma unroll
            for (int r = 0; r < 9; ++r) acc[r] += S[r * D + 128 * F.wave + kk] * wv; }
#pragma unroll
        for (int r = 0; r < 9; ++r) red[(F.wave * 9 + r) * 64 + F.lane] = acc[r];
        __syncthreads();
        for (int idx = F.tid; idx < 9 * 64; idx += NWAVES * 64) { const int r = idx >> 6, c = idx & 63; float s = 0.f;
#pragma unroll
            for (int w = 0; w < 8; ++w) s += red[(w * 9 + r) * 64 + c];
            ((float*)(F.ws + WS_MOD))[(size_t)(l * 9 + r) * 6144 + n0 + c] = s + F.in[I_BMOD][l * 6144 + n0 + c]; }
        __syncthreads();
    }
    if (F.vcu == 255) for (int idx = F.tid; idx < 1024; idx += NWAVES * 64) { const int pos = idx >> 4, i = idx & 15;
        const float inv = i == 0 ? 1.000000000e+00f : i == 1 ? 5.623413324e-01f : i == 2 ? 3.162277639e-01f : i == 3 ? 1.778279394e-01f : i == 4 ? 1.000000015e-01f : i == 5 ? 5.623413250e-02f : i == 6 ? 3.162277490e-02f : i == 7 ? 1.778279431e-02f :
                          i == 8 ? 9.999999776e-03f : i == 9 ? 5.623413250e-03f : i == 10 ? 3.162277630e-03f : i == 11 ? 1.778279431e-03f : i == 12 ? 1.000000047e-03f : i == 13 ? 5.623413017e-04f : i == 14 ? 3.162277571e-04f : 1.778279402e-04f;
        const float angf = (float)pos * inv; const double x = (double)angf;
        const double kq = __builtin_rint(x * 0.63661977236758134308); const double r = (x - kq * 1.57079632679489655800) - kq * 6.123233995736766036e-17; const int q = ((int)kq) & 3;
        const double r2 = r * r;
        const double sn = r * (1.0 + r2 * (-1.0 / 6 + r2 * (1.0 / 120 + r2 * (-1.0 / 5040 + r2 * (1.0 / 362880 + r2 * (-1.0 / 39916800 + r2 * (1.0 / 6227020800.0)))))));
        const double cs = 1.0 + r2 * (-0.5 + r2 * (1.0 / 24 + r2 * (-1.0 / 720 + r2 * (1.0 / 40320 + r2 * (-1.0 / 3628800 + r2 * (1.0 / 479001600.0 + r2 * (-1.0 / 87178291200.0)))))));
        const double c = q == 0 ? cs : q == 1 ? -sn : q == 2 ? -cs : sn, s_ = q == 0 ? sn : q == 1 ? cs : q == 2 ? -sn : -cs;
        ((float*)(F.ws + WS_ROPE))[2 * idx] = (float)c; ((float*)(F.ws + WS_ROPE))[2 * idx + 1] = (float)s_; }
    LAS float* scr = (LAS float*)(F.lds + F.wave * 16384);
    const int gw = F.vcu * NWAVES + F.wave, NGW = F.G * NWAVES;
    for (int it = gw; it < 2 * CV_LAYER; it += NGW) convert_item(F, it / CV_LAYER, it % CV_LAYER, scr);
}
__device__ __forceinline__ void p1_ln_in(const Ctx& F) {
    const int gw = F.vcu * NWAVES + F.wave, NGW = F.G * NWAVES;
    stage_w16(F, F.in[I_WIN] + SRC_MG, D_IN, (LAS float*)F.lds); __syncthreads();
    for (int r = gw; r < M_ALL; r += NGW) { f32x4 v[4]; load_row(xrow(F, r), F.lane, v); ln_row(v, F.in[I_LNIN_G], F.in[I_LNIN_B], F.lane); store_row(hrow(F, r), F.lane, v); emit_layer_input(F, 0, r, v); }
}

__device__ __forceinline__ void conv_unit(const Ctx& F, int l, int unit) {
    const bf16* P = (const bf16*)(F.ws + WS_P); bf16* Y = (bf16*)(F.ws + WS_Y);
    int seq0, T, t0;
    if (unit < 512) { const int b = unit >> 6; seq0 = b * SEQ; T = SEQ; t0 = (unit & 63) * 32; }
    else { const int j = unit - 512, b = j >> 3; seq0 = M_LAT + b * LCTX; T = LCTX; t0 = (j & 7) * 32; }
    const int c = F.tid;
    float w[31];
#pragma unroll
    for (int j = 0; j < 31; ++j) w[j] = F.in[I_CONVW][(size_t)(l * 31 + j) * 512 + c];
    const float bias = F.in[I_CONVB][l * 512 + c];
    float u[62];
#pragma unroll
    for (int i = 0; i < 62; ++i) { const int t = t0 - 15 + i; float uv = 0.f;
        if (t >= 0 && t < T) { const bf16* pr = P + (size_t)(seq0 + t) * NP; const float val = bf1(pr[PA_VAL + c]), gate = bf1(pr[PA_GATE + c]); uv = val * sigmoidf_(gate); }
        u[i] = uv; }
    LAS float* Yt = (LAS float*)F.lds;
#pragma unroll
    for (int tt = 0; tt < 32; ++tt) { float y = bias;
#pragma unroll
        for (int j = 0; j < 31; ++j) y += w[j] * u[tt + j];
        Yt[tt * 512 + c] = y; }
    __syncthreads();
    const float* lg = F.in[I_CONVLN_G] + l * 512; const float* lb = F.in[I_CONVLN_B] + l * 512;
#pragma unroll
    for (int q = 0; q < 4; ++q) { const int tt = 4 * F.wave + q; float v[8]; float s = 0.f;
#pragma unroll
        for (int jj = 0; jj < 8; ++jj) { v[jj] = Yt[tt * 512 + F.lane + 64 * jj]; s += v[jj]; }
        const float mean = wave_sum(s, F.lane) * (1.f / 512.f); float s2 = 0.f;
#pragma unroll
        for (int jj = 0; jj < 8; ++jj) { v[jj] -= mean; s2 += v[jj] * v[jj]; }
        const float rstd = 1.f / sqrtf(wave_sum(s2, F.lane) * (1.f / 512.f) + LN_EPS);
        bf16* yr = Y + (size_t)(seq0 + t0 + tt) * NY;
#pragma unroll
        for (int jj = 0; jj < 8; ++jj) { const int cc = F.lane + 64 * jj; const float z = v[jj] * rstd * lg[cc] + lb[cc]; yr[cc] = (bf16)f2bf(MK_ABL_A * z * sigmoidf_(z)); } }
    __syncthreads();
}

constexpr int AT_KSTR = 72, AT_VSTR = 136, AT_KS_OFF = 0, AT_VT_OFF = 128 * AT_KSTR * 2;
__device__ __forceinline__ void attn_stage_tile(const Ctx& F, const bf16* P, int krow0, int hk, bool rope, int tok0) {
    LAS bf16* Ks = (LAS bf16*)(F.lds + AT_KS_OFF); LAS bf16* Vt = (LAS bf16*)(F.lds + AT_VT_OFF);
    const int key = F.tid >> 2, pc = F.tid & 3;
    { const int c1 = pc < 2 ? pc : pc + 2, c2 = c1 + 2;
        const bf16* src = P + (size_t)(krow0 + key) * NP + PK + hk * 64;
        v4u x1 = *(const v4u*)(src + 8 * c1), x2 = *(const v4u*)(src + 8 * c2);
        if (rope) { const int tok = tok0 + key, pos = pc < 2 ? (tok >> 6) : (tok & 63), ib = 8 * (pc & 1);
            const float* rt = (const float*)(F.ws + WS_ROPE) + (size_t)(pos * 16 + ib) * 2;
            float a[8], b[8], oa[8], ob[8]; unpack8(x1, a); unpack8(x2, b);
#pragma unroll
            for (int j = 0; j < 8; ++j) { const float cs = rt[2 * j], sn = rt[2 * j + 1]; oa[j] = a[j] * cs - b[j] * sn; ob[j] = a[j] * sn + b[j] * cs; }
            x1 = pack8(oa); x2 = pack8(ob); }
        *(LAS v4u*)(Ks + key * AT_KSTR + 8 * c1) = x1; *(LAS v4u*)(Ks + key * AT_KSTR + 8 * c2) = x2; }
    { const int key = F.tid & 127, pc = F.tid >> 7;
        const bf16* src = P + (size_t)(krow0 + key) * NP + PV + hk * 64 + 16 * pc;
        const v4u y1 = *(const v4u*)(src), y2 = *(const v4u*)(src + 8);
        const unsigned ww[8] = {y1.x, y1.y, y1.z, y1.w, y2.x, y2.y, y2.z, y2.w};
#pragma unroll
        for (int j = 0; j < 8; ++j) { Vt[(16 * pc + 2 * j) * AT_VSTR + key] = (bf16)(ww[j] & 0xffffu); Vt[(16 * pc + 2 * j + 1) * AT_VSTR + key] = (bf16)(ww[j] >> 16); } }
}
__device__ __forceinline__ void attn_unit(const Ctx& F, int l, int kind, int b, int nb, int hk) {
    const bf16* P = (const bf16*)(F.ws + WS_P); bf16* Y = (bf16*)(F.ws + WS_Y);
    const LAS bf16* Ks = (const LAS bf16*)(F.lds + AT_KS_OFF); const LAS bf16* Vt = (const LAS bf16*)(F.lds + AT_VT_OFF);
    const int lane = F.lane, w = F.wave, gi = w >> 1, th = w & 1, g = 4 * hk + gi, l31 = lane & 31, h = lane >> 5;
    bf16x8 qf[2][4]; int qrow[2];
#pragma unroll
    for (int qb = 0; qb < 2; ++qb) {
        const int iq = 64 * th + 32 * qb + l31, tok = nb * 128 + iq;
        const int row = kind == 0 ? b * SEQ + tok : M_LAT + b * LCTX + tok; qrow[qb] = row;
        const bf16* src = P + (size_t)row * NP + PQ + g * 64 + 8 * h;
        float x[4][8];
#pragma unroll
        for (int s = 0; s < 4; ++s) { const v4u raw = *(const v4u*)(src + 16 * s); unpack8(raw, x[s]); }
        if (kind == 0) {
            const float* rtr = (const float*)(F.ws + WS_ROPE) + (size_t)((tok >> 6) * 16 + 8 * h) * 2; const float* rtc = (const float*)(F.ws + WS_ROPE) + (size_t)((tok & 63) * 16 + 8 * h) * 2;
#pragma unroll
            for (int j = 0; j < 8; ++j) { float cs = rtr[2 * j], sn = rtr[2 * j + 1]; float a = x[0][j], bb = x[1][j]; x[0][j] = a * cs - bb * sn; x[1][j] = a * sn + bb * cs;
                cs = rtc[2 * j]; sn = rtc[2 * j + 1]; a = x[2][j]; bb = x[3][j]; x[2][j] = a * cs - bb * sn; x[3][j] = a * sn + bb * cs; } }
#pragma unroll
        for (int s = 0; s < 4; ++s) {
#pragma unroll
            for (int j = 0; j < 8; ++j) x[s][j] *= 0.125f;
            const v4u pk = pack8(x[s]); qf[qb][s] = __builtin_bit_cast(bf16x8, pk); }
    }
    f32x16 O[2][2];
    float mrun[2], lsum[2];
    const float sink = F.in[I_SINK][l * 8 + g];
#pragma unroll
    for (int qb = 0; qb < 2; ++qb) { mrun[qb] = sink; lsum[qb] = h == 0 ? 1.0f : 0.0f;
#pragma unroll
        for (int db = 0; db < 2; ++db)
#pragma unroll
            for (int r = 0; r < 16; ++r) O[db][qb][r] = 0.f; }
    const int ntile = kind == 0 ? 5 : 2;
    for (int ti = 0; ti < ntile; ++ti) {
        int krow0, mode = 0, tok0 = 0; bool rope = false;
        if (ti < 2) krow0 = M_LAT + b * LCTX + 128 * ti;
        else { const int kb = nb + ti - 3; if (kb < 0 || kb >= SEQ / 128) continue; krow0 = b * SEQ + kb * 128; tok0 = kb * 128; rope = true; mode = ti == 2 ? 1 : ti == 4 ? 2 : 0; }
        __syncthreads();
        attn_stage_tile(F, P, krow0, hk, rope, tok0);
        __syncthreads();
#pragma unroll 1
        for (int kh = 0; kh < 2; ++kh) {
#pragma unroll
            for (int qb = 0; qb < 2; ++qb) {
                f32x16 st[2];
#pragma unroll
                for (int kb = 0; kb < 2; ++kb) {
#pragma unroll
                    for (int r = 0; r < 16; ++r) st[kb][r] = 0.f;
#pragma unroll
                    for (int s = 0; s < 4; ++s) { const bf16x8 a = *(const LAS bf16x8*)(Ks + (64 * kh + 32 * kb + l31) * AT_KSTR + 16 * s + 8 * h);
                        st[kb] = __builtin_amdgcn_mfma_f32_32x32x16_bf16(a, qf[qb][s], st[kb], 0, 0, 0); } }
                const int iq = 64 * th + 32 * qb + l31;
                float mx = -INFINITY;
#pragma unroll
                for (int kb = 0; kb < 2; ++kb)
#pragma unroll
                    for (int r = 0; r < 16; ++r) { const int key = 64 * kh + 32 * kb + (r & 3) + 8 * (r >> 2) + 4 * h;
                        const bool valid = mode == 0 || (mode == 1 ? key >= iq : key <= iq);
                        const float sv = valid ? st[kb][r] : -INFINITY; st[kb][r] = sv; mx = fmaxf(mx, sv); }
                mx = fmaxf(mx, shx(mx, 32, lane));
                const float mnew = fmaxf(mrun[qb], mx), alpha = __expf(mrun[qb] - mnew); mrun[qb] = mnew;
                float ps = 0.f;
#pragma unroll
                for (int kb = 0; kb < 2; ++kb)
#pragma unroll
                    for (int r = 0; r < 16; ++r) { const float p = __expf(st[kb][r] - mnew); st[kb][r] = p; ps += p; }
                lsum[qb] = lsum[qb] * alpha + ps;
#pragma unroll
                for (int db = 0; db < 2; ++db)
#pragma unroll
                    for (int r = 0; r < 16; ++r) O[db][qb][r] *= alpha;
#pragma unroll
                for (int kb = 0; kb < 2; ++kb)
#pragma unroll
                    for (int s2 = 0; s2 < 2; ++s2) {
                        v4u pw; pw.x = pk2(st[kb][8 * s2 + 0], st[kb][8 * s2 + 1]); pw.y = pk2(st[kb][8 * s2 + 2], st[kb][8 * s2 + 3]);
                        pw.z = pk2(st[kb][8 * s2 + 4], st[kb][8 * s2 + 5]); pw.w = pk2(st[kb][8 * s2 + 6], st[kb][8 * s2 + 7]);
                        const bf16x8 pf = __builtin_bit_cast(bf16x8, pw);
#pragma unroll
                        for (int db = 0; db < 2; ++db) { const LAS bf16* vp = Vt + (32 * db + l31) * AT_VSTR + 64 * kh + 32 * kb + 16 * s2 + 4 * h;
                            const v2u v0 = *(const LAS v2u*)(vp), v1 = *(const LAS v2u*)(vp + 8);
                            v4u av; av.x = v0.x; av.y = v0.y; av.z = v1.x; av.w = v1.y;
                            O[db][qb] = __builtin_amdgcn_mfma_f32_32x32x16_bf16(__builtin_bit_cast(bf16x8, av), pf, O[db][qb], 0, 0, 0); }
                    }
                asm volatile("" ::: "memory");
            }
        }
    }
#pragma unroll
    for (int qb = 0; qb < 2; ++qb) {
        const float lt = lsum[qb] + shx(lsum[qb], 32, lane), inv = MK_ABL_B / lt;
        bf16* yr = Y + (size_t)qrow[qb] * NY + 512 + g * 64;
#pragma unroll
        for (int db = 0; db < 2; ++db)
#pragma unroll
            for (int gq = 0; gq < 4; ++gq) { v2u o; o.x = pk2(O[db][qb][4 * gq] * inv, O[db][qb][4 * gq + 1] * inv); o.y = pk2(O[db][qb][4 * gq + 2] * inv, O[db][qb][4 * gq + 3] * inv);
                *(v2u*)(yr + 32 * db + 8 * gq + 4 * h) = o; }
    }
}

constexpr int ML_QS = 0, ML_KS = 17408, ML_KTS = 34816, ML_VTS = 53248, ML_WS = 73984, ML_CTS = 83200, ML_SM = 122368;
constexpr int ML_QSTR = 136, ML_TSTR = 72;
static_assert(ML_SM + 5 * 256 <= RING_BYTES, "mLSTM LDS");
__device__ __forceinline__ float log_sigmoid(float x) { return fminf(x, 0.f) - log1pf(__expf(-fabsf(x))); }
__device__ __forceinline__ int ml_chunk_base(int ci, int b, int dir) { const int cc = ci < 4 ? ci : ci - 4, nc = ci < 4 ? 4 : 32, cs = dir == 0 ? cc : nc - 1 - cc; return (ci < 4 ? M_LAT + b * LCTX : b * SEQ) + 64 * cs; }
__device__ __forceinline__ void mlstm_chain(const Ctx& F, int l, int chain) {
    const bf16* P = (const bf16*)(F.ws + WS_P); const float* G = (const float*)(F.ws + WS_G);
    const int b = chain >> 3, hd = (chain >> 1) & 3, dir = chain & 1, lane = F.lane, w = F.wave, tid = F.tid, l15 = lane & 15, lq = lane >> 4;
    bf16* Hout = (bf16*)(F.ws + (dir == 0 ? WS_HF : WS_HB));
    LAS bf16* Qs = (LAS bf16*)(F.lds + ML_QS); LAS bf16* Ks = (LAS bf16*)(F.lds + ML_KS); LAS bf16* KTs = (LAS bf16*)(F.lds + ML_KTS); LAS bf16* VTs = (LAS bf16*)(F.lds + ML_VTS);
    LAS bf16* Ws = (LAS bf16*)(F.lds + ML_WS); LAS bf16* CTs = (LAS bf16*)(F.lds + ML_CTS);
    LAS float* GA = (LAS float*)(F.lds + ML_SM); LAS float* GG = GA + 64; LAS float* WIN = GA + 128; LAS float* EM = GA + 192; LAS float* DEN = GA + 256;
    const float gbi = F.in[I_GATEB][l * 16 + dir * 8 + hd], gbf = F.in[I_GATEB][l * 16 + dir * 8 + 4 + hd];
    __syncthreads();
#if defined(MK_PROBE_LDSCLR)
    for (int i = tid; i < RING_BYTES / 4; i += NWAVES * 64) ((LAS unsigned*)F.lds)[i] = 0u;
    __syncthreads();
#endif
    for (int i = tid; i < 144 * ML_QSTR / 2; i += NWAVES * 64) ((LAS unsigned*)CTs)[i] = 0u;
    for (int i = tid; i < 16 * ML_TSTR / 2; i += NWAVES * 64) ((LAS unsigned*)(VTs + 128 * ML_TSTR))[i] = (i < ML_TSTR / 2) ? 0x3f803f80u : 0u;
    f32x4 Cacc[9];
#pragma unroll
    for (int e = 0; e < 9; ++e) Cacc[e] = (f32x4){0.f, 0.f, 0.f, 0.f};
    float mst = 0.f;
    const int pr0 = tid & 31, c16 = tid >> 5;
    v4u nq[2], nk[2], nv[2]; float nig, nfg;
#define ML_ISSUE_LOADS(ci_) do { const int base_ = ml_chunk_base((ci_), b, dir); \
        _Pragma("unroll") for (int q = 0; q < 2; ++q) { const int jj = pr0 + 32 * q, tok = base_ + (dir == 0 ? jj : 63 - jj); const bf16* rp = P + (size_t)tok * NP + hd * 128 + 8 * c16; \
            nq[q] = *(const v4u*)(rp + PMQ); nk[q] = *(const v4u*)(rp + PMK); nv[q] = *(const v4u*)(rp + PMV); } \
        { const int tok = base_ + (dir == 0 ? lane : 63 - lane); nig = G[(size_t)tok * 16 + dir * 8 + hd]; nfg = G[(size_t)tok * 16 + dir * 8 + 4 + hd]; } } while (0)
    ML_ISSUE_LOADS(0);
    for (int ci = 0; ci < 36; ++ci) {
        const int base = ml_chunk_base(ci, b, dir);
#if defined(MK_PROBE_NOGATES)
        const float ig = gbi, lf = log_sigmoid(gbf);
#else
        const float ig = nig + gbi, lf = log_sigmoid(nfg + gbf);
#endif
        float bc = lf;
#pragma unroll
        for (int o = 1; o < 64; o <<= 1) { const float t = shup(bc, o, lane); if (lane >= o) bc += t; }
        const float a = ig - bc; float pm = a;
#pragma unroll
        for (int o = 1; o < 64; o <<= 1) { const float t = shup(pm, o, lane); if (lane >= o) pm = fmaxf(pm, t); }
        const float gj = fmaxf(mst, pm), g63 = shidx(gj, 63), b63 = shidx(bc, 63);
        const float wsc = __expf(a - g63) * KSCALE, decay = __expf(mst - g63);
        if (w == 0) { GA[lane] = a; GG[lane] = gj; WIN[lane] = __expf(mst - gj); EM[lane] = __expf(-(bc + gj)); }
#if defined(MK_PROBE_MORESYNC)
        __syncthreads();
#endif
#pragma unroll
        for (int q = 0; q < 2; ++q) { const int jj = pr0 + 32 * q;
            *(LAS v4u*)(Qs + jj * ML_QSTR + 8 * c16) = nq[q]; *(LAS v4u*)(Ks + jj * ML_QSTR + 8 * c16) = nk[q];
            const float ws = shidx(wsc, jj); float kf[8]; unpack8(nk[q], kf);
            const unsigned vv[4] = {nv[q].x, nv[q].y, nv[q].z, nv[q].w};
#pragma unroll
            for (int j = 0; j < 8; ++j) KTs[(8 * c16 + j) * ML_TSTR + jj] = (bf16)f2bf(kf[j] * ws);
#pragma unroll
            for (int j = 0; j < 4; ++j) { VTs[(8 * c16 + 2 * j) * ML_TSTR + jj] = (bf16)(vv[j] & 0xffffu); VTs[(8 * c16 + 2 * j + 1) * ML_TSTR + jj] = (bf16)(vv[j] >> 16); } }
        if (ci + 1 < 36) ML_ISSUE_LOADS(ci + 1);
        __syncthreads();
        { const int rb = w >> 1; f32x4 sa[2] = {(f32x4){0.f, 0.f, 0.f, 0.f}, (f32x4){0.f, 0.f, 0.f, 0.f}};
#pragma unroll
            for (int kk = 0; kk < 4; ++kk) { const bf16x8 af = *(const LAS bf16x8*)(Qs + (16 * rb + l15) * ML_QSTR + 32 * kk + 8 * lq);
#pragma unroll
                for (int cb = 0; cb < 2; ++cb) { const bf16x8 bfr = *(const LAS bf16x8*)(Ks + (16 * (2 * (w & 1) + cb) + l15) * ML_QSTR + 32 * kk + 8 * lq);
                    sa[cb] = __builtin_amdgcn_mfma_f32_16x16x32_bf16(af, bfr, sa[cb], 0, 0, 0); } }
#pragma unroll
            for (int cb = 0; cb < 2; ++cb) { const int s = 16 * (2 * (w & 1) + cb) + l15; const float as = GA[s];
#pragma unroll
                for (int r = 0; r < 4; ++r) { const int j = 16 * rb + 4 * lq + r; const float wv = s <= j ? sa[cb][r] * KSCALE * __expf(as - GG[j]) : 0.f; Ws[j * ML_TSTR + s] = (bf16)f2bf(wv); } } }
        __syncthreads();
        const int rb = w >> 1, eb0 = (w & 1) ? 5 : 0, neb = (w & 1) ? 4 : 5;
        f32x4 num[5];
        { bf16x8 wf[2], qf[4];
#pragma unroll
            for (int kk = 0; kk < 2; ++kk) wf[kk] = *(const LAS bf16x8*)(Ws + (16 * rb + l15) * ML_TSTR + 32 * kk + 8 * lq);
#pragma unroll
            for (int kk = 0; kk < 4; ++kk) qf[kk] = *(const LAS bf16x8*)(Qs + (16 * rb + l15) * ML_QSTR + 32 * kk + 8 * lq);
            float win[4];
#pragma unroll
            for (int r = 0; r < 4; ++r) win[r] = WIN[16 * rb + 4 * lq + r];
#pragma unroll
            for (int i = 0; i < 5; ++i) { if (i < neb) { const int eb = eb0 + i; f32x4 aw = (f32x4){0.f, 0.f, 0.f, 0.f}, ac = (f32x4){0.f, 0.f, 0.f, 0.f};
#pragma unroll
                for (int kk = 0; kk < 2; ++kk) aw = __builtin_amdgcn_mfma_f32_16x16x32_bf16(wf[kk], *(const LAS bf16x8*)(VTs + (16 * eb + l15) * ML_TSTR + 32 * kk + 8 * lq), aw, 0, 0, 0);
#pragma unroll
                for (int kk = 0; kk < 4; ++kk) ac = __builtin_amdgcn_mfma_f32_16x16x32_bf16(qf[kk], *(const LAS bf16x8*)(CTs + (16 * eb + l15) * ML_QSTR + 32 * kk + 8 * lq), ac, 0, 0, 0);
#pragma unroll
                for (int r = 0; r < 4; ++r) num[i][r] = aw[r] + win[r] * ac[r];
                if (eb == 8 && l15 == 0) {
#pragma unroll
                    for (int r = 0; r < 4; ++r) DEN[16 * rb + 4 * lq + r] = num[i][r]; } } } }
        __syncthreads();
        { float dn[4];
#pragma unroll
            for (int r = 0; r < 4; ++r) { const int j = 16 * rb + 4 * lq + r; dn[r] = 1.0f / fmaxf(fabsf(DEN[j]), EM[j]); }
#pragma unroll
            for (int i = 0; i < 5; ++i) { if (i < neb && eb0 + i < 8) { const int e = 16 * (eb0 + i) + l15;
#pragma unroll
                for (int r = 0; r < 4; ++r) { const int j = 16 * rb + 4 * lq + r, tok = base + (dir == 0 ? j : 63 - j); Hout[(size_t)tok * 512 + hd * 128 + e] = (bf16)f2bf(num[i][r] * dn[r]); } } } }
#if defined(MK_PROBE_MORESYNC)
        __syncthreads();
#endif
        { bf16x8 kf[2];
#pragma unroll
            for (int kk = 0; kk < 2; ++kk) kf[kk] = *(const LAS bf16x8*)(KTs + (16 * w + l15) * ML_TSTR + 32 * kk + 8 * lq);
#pragma unroll
            for (int eb = 0; eb < 9; ++eb) { Cacc[eb] = Cacc[eb] * decay;
#pragma unroll
                for (int kk = 0; kk < 2; ++kk) Cacc[eb] = __builtin_amdgcn_mfma_f32_16x16x32_bf16(kf[kk], *(const LAS bf16x8*)(VTs + (16 * eb + l15) * ML_TSTR + 32 * kk + 8 * lq), Cacc[eb], 0, 0, 0);
                v2u o; o.x = pk2(Cacc[eb][0], Cacc[eb][1]); o.y = pk2(Cacc[eb][2], Cacc[eb][3]);
                *(LAS v2u*)(CTs + (16 * eb + l15) * ML_QSTR + 16 * w + 4 * lq) = o; } }
        mst = b63 + g63;
        __syncthreads();
    }
#undef ML_ISSUE_LOADS
}

__device__ __forceinline__ void c0_combine(const Ctx& F, int l, int nrows) {
    const bf16* P = (const bf16*)(F.ws + WS_P); const bf16* HF = (const bf16*)(F.ws + WS_HF); const bf16* HB = (const bf16*)(F.ws + WS_HB); bf16* Y = (bf16*)(F.ws + WS_Y);
    const int gw = F.vcu * NWAVES + F.wave, NGW = F.G * NWAVES, lane = F.lane;
    for (int it = gw; it < nrows * 4; it += NGW) { const int r = it >> 2, hd = it & 3, col = hd * 128 + 2 * lane;
        const unsigned a = *(const unsigned*)(HF + (size_t)r * 512 + col), bq = *(const unsigned*)(HB + (size_t)r * 512 + col), mo = *(const unsigned*)(P + (size_t)r * NP + PMO + col);
#if defined(MK_PROBE_C0)
        float x0 = bflo(mo) + 0.f * (bflo(a) + bflo(bq)) * 0.f, x1 = bfhi(mo);
#else
        float x0 = bflo(a) + bflo(bq), x1 = bfhi(a) + bfhi(bq);
#endif
        const float mean = wave_sum(x0 + x1, lane) * (1.f / 128.f); x0 -= mean; x1 -= mean;
        const float rstd = 1.f / sqrtf(wave_sum(x0 * x0 + x1 * x1, lane) * (1.f / 128.f) + LN_EPS);
        const float g0 = F.in[I_NORMG][l * 512 + col], g1 = F.in[I_NORMG][l * 512 + col + 1];
        *(unsigned*)(Y + (size_t)r * NY + 1024 + col) = pk2(MK_ABL_C * sigmoidf_(bflo(mo)) * x0 * rstd * g0, MK_ABL_C * sigmoidf_(bfhi(mo)) * x1 * rstd * g1); }
}

struct EpiProj {
    static constexpr bool PERM = true, AFTER_DRAIN = false, RESCALE = false;
    bf16* O; int ldc;
    __device__ __forceinline__ void operator()(const pg8::f32x4 (&acc)[2][2][4][2], const pg8::Unit& u, int wr, int wc, int fr, int fq) const {
        const int row0 = u.pm * 256 + wr * 64 + fr, col0 = u.pn * 256 + wc * 32 + 8 * fq;
#pragma unroll
        for (int ai = 0; ai < 2; ++ai)
#pragma unroll
            for (int m = 0; m < 4; ++m) { bf16* rowp = O + (size_t)(row0 + ai * 128 + m * 16) * ldc + col0;
#pragma unroll
                for (int bj = 0; bj < 2; ++bj) { const pg8::f32x4 v0 = acc[ai][bj][m][0], v1 = acc[ai][bj][m][1];
                    v4u w; w.x = pk2(v0[0], v0[1]); w.y = pk2(v0[2], v0[3]); w.z = pk2(v1[0], v1[1]); w.w = pk2(v1[2], v1[3]);
                    *(v4u*)(rowp + bj * 128) = w; } }
    }
};
__device__ __forceinline__ float gate_e(float x) { return __expf(-fminf(fmaxf(x, -30.f), 30.f)); }
struct EpiMerge {
    static constexpr bool PERM = true, AFTER_DRAIN = false, RESCALE = true;
    const bf16* P; bf16* Z;
    __device__ __forceinline__ void rescale(pg8::f32x4 (&acc)[2][2][4][2], const pg8::Unit& u, int step, int wr, int wc, int fr, int fq) const {
        const int row0 = u.pm * 256 + wr * 64 + fr, col0 = u.pn * 256 + wc * 32 + 8 * fq;
        const int cn = PBG + (step - 1) * 1024, cd = PBG + step * 1024;
#pragma unroll
        for (int ai = 0; ai < 2; ++ai)
#pragma unroll
            for (int m = 0; m < 4; ++m) { const bf16* rowp = P + (size_t)(row0 + ai * 128 + m * 16) * NP + col0;
#pragma unroll
                for (int bj = 0; bj < 2; ++bj) { const v4u xn = *(const v4u*)(rowp + cn + bj * 128), xd = *(const v4u*)(rowp + cd + bj * 128);
                    float a[8], b[8]; unpack8(xn, a); unpack8(xd, b);
#pragma unroll
                    for (int i = 0; i < 8; ++i) { const float ratio = (1.0f + gate_e(b[i])) / (1.0f + gate_e(a[i])); acc[ai][bj][m][i >> 2][i & 3] *= ratio; } }
                asm volatile("" ::: "memory"); }
    }
    __device__ __forceinline__ void operator()(const pg8::f32x4 (&acc)[2][2][4][2], const pg8::Unit& u, int wr, int wc, int fr, int fq) const {
        const int row0 = u.pm * 256 + wr * 64 + fr, col0 = u.pn * 256 + wc * 32 + 8 * fq;
#pragma unroll
        for (int ai = 0; ai < 2; ++ai)
#pragma unroll
            for (int m = 0; m < 4; ++m) { const size_t r = (size_t)(row0 + ai * 128 + m * 16);
#pragma unroll
                for (int bj = 0; bj < 2; ++bj) { const v4u xc = *(const v4u*)(P + r * NP + PBG + 2048 + col0 + bj * 128); float c[8], o[8]; unpack8(xc, c);
#pragma unroll
                    for (int i = 0; i < 8; ++i) o[i] = acc[ai][bj][m][i >> 2][i & 3] / (1.0f + gate_e(c[i]));
                    *(v4u*)(Z + r * D + col0 + bj * 128) = pack8(o); }
                asm volatile("" ::: "memory"); }
    }
};
struct EpiResid {
    static constexpr bool PERM = false, AFTER_DRAIN = false, RESCALE = false;
    float* out; float* hc; const float* mod_l;
    __device__ __forceinline__ void operator()(const pg8::f32x4 (&acc)[2][2][4][2], const pg8::Unit& u, int wr, int wc, int fr, int fq) const {
        const int rt = u.pm * 256; float* hb = rt < M_LAT ? out + (size_t)rt * D : hc + (size_t)(rt - M_LAT) * D;
        const float* g1 = mod_l + (size_t)(rt < M_LAT ? (rt >> 11) : 8) * 6144 + 2048;
        const int rl0 = wr * 64 + fr, col0 = u.pn * 256 + wc * 32 + 4 * fq;
#pragma unroll
        for (int ai = 0; ai < 2; ++ai)
#pragma unroll
            for (int m = 0; m < 4; ++m) { float* rowp = hb + (size_t)(rl0 + ai * 128 + m * 16) * D + col0;
#pragma unroll
                for (int bj = 0; bj < 2; ++bj)
#pragma unroll
                    for (int n = 0; n < 2; ++n) { const pg8::f32x4 g = *(const pg8::f32x4*)(g1 + col0 + bj * 128 + n * 16), h = *(const pg8::f32x4*)(rowp + bj * 128 + n * 16);
                        *(pg8::f32x4*)(rowp + bj * 128 + n * 16) = h * ALPHA + g * acc[ai][bj][m][n]; } }
    }
};
struct EpiSwiGLU {
    static constexpr bool PERM = true, AFTER_DRAIN = false, RESCALE = false;
    bf16* act;
    __device__ __forceinline__ void operator()(const pg8::f32x4 (&acc)[2][2][4][2], const pg8::Unit& u, int wr, int wc, int fr, int fq) const {
        const int row0 = u.pm * 256 + wr * 64 + fr, col0 = (u.pn & 3) * 128 + wc * 32 + 8 * fq;
#pragma unroll
        for (int ai = 0; ai < 2; ++ai)
#pragma unroll
            for (int m = 0; m < 4; ++m) { float o[8];
#pragma unroll
                for (int i = 0; i < 8; ++i) { const float g = acc[ai][0][m][i >> 2][i & 3], uu = acc[ai][1][m][i >> 2][i & 3]; o[i] = g * sigmoidf_(g) * uu; }
                *(v4u*)(act + (size_t)(row0 + ai * 128 + m * 16) * DEXP + col0) = pack8(o); }
    }
};
struct EpiScatter {
    static constexpr bool PERM = true, AFTER_DRAIN = false, RESCALE = false;
    const int* rowmap; const float* roww; bf16* Fo;
    __device__ __forceinline__ void operator()(const pg8::f32x4 (&acc)[2][2][4][2], const pg8::Unit& u, int wr, int wc, int fr, int fq) const {
        const int row0 = u.pm * 256 + wr * 64 + fr, col0 = (u.pn & 3) * 256 + wc * 32 + 8 * fq;
#pragma unroll
        for (int ai = 0; ai < 2; ++ai)
#pragma unroll
            for (int m = 0; m < 4; ++m) { const int sr = row0 + ai * 128 + m * 16, dst = rowmap[sr]; const float wgt = roww[sr];
                if (dst >= 0) {
#pragma unroll
                    for (int bj = 0; bj < 2; ++bj) { pg8::f32x4 v0 = acc[ai][bj][m][0] * wgt, v1 = acc[ai][bj][m][1] * wgt;
#if defined(MK_PROBE_SCATTER) && MK_PROBE_SCATTER == 1
                        v0 = (pg8::f32x4){wgt, wgt, wgt, wgt}; v1 = v0;
#elif defined(MK_PROBE_SCATTER) && MK_PROBE_SCATTER == 2
                        v0 = acc[ai][bj][m][0]; v1 = acc[ai][bj][m][1];
#endif
                        v4u w; w.x = pk2(v0[0], v0[1]); w.y = pk2(v0[2], v0[3]); w.z = pk2(v1[0], v1[1]); w.w = pk2(v1[2], v1[3]);
                        *(v4u*)(Fo + (size_t)dst * D + col0 + bj * 128) = w; } } }
    }
};
struct MoeOrder {
    int G, c; const LAS int* toff;
    __device__ __forceinline__ bool next(int i, pg8::Unit& u) const {
        const long L = (long)i * G + c; const int nt = toff[16]; if (L >= (long)nt * 4) return false;
        const int pm = (int)(L >> 2), ct = (int)(L & 3); int e = 0;
#pragma unroll
        for (int k = 1; k < 16; ++k) e += (pm >= toff[k]) ? 1 : 0;
        u.pm = pm; u.pn = e * 4 + ct; return true;
    }
    __device__ __forceinline__ void a_ready(const pg8::Unit&) const {}
    __device__ __forceinline__ void done(const pg8::Unit&) const {}
};
__device__ __forceinline__ void moe_toff(const Ctx& F, int l, LAS int* toff) {
    if (F.tid == 0) { int acc = 0; const int* tot = (const int*)(F.ws + WS_BCNT) + 2 * 4096 + l * 16;
        for (int e = 0; e < 16; ++e) { toff[e] = acc; acc += (tot[e] + 255) >> 8; }
        toff[16] = acc; }
    __syncthreads();
}

__device__ __forceinline__ void e_ln1_route(const Ctx& F, int l, int nrows) {
    const int rpb = nrows / 256, row0 = F.vcu * rpb;
    LAS int* lcnt = (LAS int*)F.lds; LAS int* rinfo = lcnt + 16; LAS float* rwt = (LAS float*)(lcnt + 16 + 160); LAS int* lrk = lcnt + 16 + 320;
    stage_w16(F, F.in[I_WROUTER], 16, (LAS float*)(F.lds + 4096));
    __syncthreads();
    for (int i = F.wave; i < rpb; i += NWAVES) { const int r = row0 + i;
        f32x4 v[4]; float* hp = hrow(F, r); load_row(hp, F.lane, v); ln_row(v, F.in[I_LN1G] + l * D, F.in[I_LN1B] + l * D, F.lane); store_row(hp, F.lane, v);
        const float* mp = modp(F, l, modrow(r)); f32x4 u[4];
        emit_u(v, mp + 3072, mp + 4096, (bf16*)(F.ws + WS_U) + (size_t)r * D, F.lane, u);
        float lg[16]; dot16(u, (const LAS float*)(F.lds + 4096), F.lane, lg);
        float sc[16], sel[16];
#pragma unroll
        for (int e = 0; e < 16; ++e) { sc[e] = sigmoidf_(lg[e]); sel[e] = sc[e] + F.in[I_BROUTER][e]; }
        int bg = 0; float bgs = -INFINITY;
#pragma unroll
        for (int g = 0; g < 4; ++g) { float m1 = -INFINITY, m2 = -INFINITY;
#pragma unroll
            for (int k = 0; k < 4; ++k) { const float x = sel[4 * g + k]; if (x > m1) { m2 = m1; m1 = x; } else if (x > m2) m2 = x; }
            const float gs = m1 + m2; if (gs > bgs) { bgs = gs; bg = g; } }
        float s4[4], c4[4];
#pragma unroll
        for (int k = 0; k < 4; ++k) { s4[k] = bg == 0 ? sel[k] : bg == 1 ? sel[4 + k] : bg == 2 ? sel[8 + k] : sel[12 + k]; c4[k] = bg == 0 ? sc[k] : bg == 1 ? sc[4 + k] : bg == 2 ? sc[8 + k] : sc[12 + k]; }
        int i1 = 0;
#pragma unroll
        for (int k = 1; k < 4; ++k) if (s4[k] > s4[i1]) i1 = k;
        int i2 = i1 == 0 ? 1 : 0;
#pragma unroll
        for (int k = 0; k < 4; ++k) if (k != i1 && k != i2 && s4[k] > s4[i2]) i2 = k;
        const float w1 = c4[i1], w2 = c4[i2], ws = 1.0f / (w1 + w2);
        if (F.lane == 0) { rinfo[2 * i] = 4 * bg + i1; rinfo[2 * i + 1] = 4 * bg + i2; rwt[2 * i] = w1 * ws; rwt[2 * i + 1] = w2 * ws; }
    }
    __syncthreads();
    if (F.tid < 16) { int c = 0; for (int idx = 0; idx < 2 * rpb; ++idx) if (rinfo[idx] == F.tid) lrk[idx] = c++;
        ((int*)(F.ws + WS_BCNT))[(l * 256 + F.vcu) * 16 + F.tid] = c; }
    __syncthreads();
    for (int idx = F.tid; idx < 2 * rpb; idx += NWAVES * 64) { unsigned* rp = (unsigned*)(F.ws + WS_ROUTE + (size_t)(2 * row0 + idx) * 16);
        rp[0] = (unsigned)rinfo[idx]; rp[1] = (unsigned)lrk[idx]; ((float*)rp)[2] = rwt[idx]; rp[3] = (unsigned)F.vcu; }
    __syncthreads();
}
__device__ __forceinline__ void f_gather(const Ctx& F, int l, int nrows) {
    LAS int* toff = (LAS int*)F.lds; LAS int* cnts = toff + 32; LAS int* csum = toff + 64; LAS int* bbase = toff + 1024;
    const int* bc = (const int*)(F.ws + WS_BCNT) + l * 4096;
    { const int e = F.tid & 15, ch = F.tid >> 4; int s = 0;
#pragma unroll
        for (int k = 0; k < 8; ++k) { const int v = bc[(8 * ch + k) * 16 + e]; bbase[(8 * ch + k) * 16 + e] = s; s += v; }
        csum[ch * 16 + e] = s; }
    __syncthreads();
    { const int e = F.tid & 15, ch = F.tid >> 4; int pre = 0;
        for (int k = 0; k < ch; ++k) pre += csum[k * 16 + e];
#pragma unroll
        for (int k = 0; k < 8; ++k) bbase[(8 * ch + k) * 16 + e] += pre;
        if (ch == 31) { const int tot = pre + csum[31 * 16 + e]; cnts[e] = tot; if (F.vcu == 0) ((int*)(F.ws + WS_BCNT))[2 * 4096 + l * 16 + e] = tot; } }
    __syncthreads();
    if (F.tid == 0) { int acc = 0; for (int e = 0; e < 16; ++e) { toff[e] = acc; acc += (cnts[e] + 255) >> 8; } toff[16] = acc; }
    __syncthreads();
    const int gw = F.vcu * NWAVES + F.wave, NGW = F.G * NWAVES, lane = F.lane;
    const bf16* U = (const bf16*)(F.ws + WS_U); bf16* As = (bf16*)(F.ws + WS_AS); int* rowmap = (int*)(F.ws + WS_ROWMAP); float* roww = (float*)(F.ws + WS_ROWW);
    for (int ts = gw; ts < 2 * nrows; ts += NGW) { const unsigned* rp = (const unsigned*)(F.ws + WS_ROUTE + (size_t)ts * 16); const unsigned re = rp[0], rk = rp[1], rb = rp[3]; const float rwv = ((const float*)rp)[2];
        const int pos = toff[re] * 256 + bbase[rb * 16 + re] + (int)rk;
        const v4u* src = (const v4u*)(U + (size_t)(ts >> 1) * D); v4u* dst = (v4u*)(As + (size_t)pos * D);
        dst[lane] = src[lane]; dst[lane + 64] = src[lane + 64];
        if (lane == 0) { rowmap[pos] = ts; roww[pos] = rwv; } }
    for (int e = 0; e < 16; ++e) { const int cnt = cnts[e], first = toff[e] * 256 + cnt, npad = toff[e + 1] * 256 - first;
        for (int i = gw; i < npad; i += NGW) { v4u* dst = (v4u*)(As + (size_t)(first + i) * D); unsigned z0 = 0u; asm volatile("" : "+v"(z0)); const v4u z = {z0, z0, z0, z0}; dst[lane] = z; dst[lane + 64] = z; if (lane == 0) { rowmap[first + i] = -1; roww[first + i] = 0.f; } } }
    __syncthreads();
}
__device__ __forceinline__ void h_ln2(const Ctx& F, int l, int nrows) {
    const int gw = F.vcu * NWAVES + F.wave, NGW = F.G * NWAVES, lane = F.lane; const bf16* Fs = (const bf16*)(F.ws + WS_F);
    if (l + 1 < DEPTH) { stage_w16(F, F.in[I_WIN] + (size_t)(l + 1) * D * D_IN + SRC_MG, D_IN, (LAS float*)F.lds); __syncthreads(); }
    for (int r = gw; r < nrows; r += NGW) { f32x4 v[4]; float* hp = hrow(F, r); load_row(hp, lane, v); const float* g2 = modp(F, l, modrow(r)) + 5120;
#pragma unroll
        for (int j = 0; j < 4; ++j) { const v2u a = *(const v2u*)(Fs + (size_t)(2 * r) * D + 4 * lane + 256 * j), b = *(const v2u*)(Fs + (size_t)(2 * r + 1) * D + 4 * lane + 256 * j);
            const f32x4 f = (f32x4){bflo(a.x) + bflo(b.x), bfhi(a.x) + bfhi(b.x), bflo(a.y) + bflo(b.y), bfhi(a.y) + bfhi(b.y)}, g = *(const f32x4*)(g2 + 4 * lane + 256 * j);
            v[j] = v[j] * ALPHA + g * f * MK_ABL_F; }
        ln_row(v, F.in[I_LN2G] + l * D, F.in[I_LN2B] + l * D, lane); store_row(hp, lane, v);
        if (l + 1 < DEPTH) emit_layer_input(F, l + 1, r, v); }
}

constexpr int NPHASE = 2 + 10 * DEPTH;
struct Args { const float* in[N_IN]; float* out; unsigned char* ws; int ph_lo, ph_hi, li, pad; };
static_assert(sizeof(Args) == 8 * N_IN + 16 + 16, "no padding bytes in Args");
#ifndef MK_PHASE_MASK
#define MK_PHASE_MASK 0xFFFu
#endif
#define PON(j) (((MK_PHASE_MASK) >> (j)) & 1u)
#ifndef MK_DUP
#define MK_DUP (-1)
#endif
#define REP(k) for (int rep_ = 0; rep_ < (((MK_DUP) == (k)) ? 2 : 1); ++rep_)
#define IN(k) (lo <= (k) && (k) < hi)
#define PCTX(Fp) Ctx Fp = F; Fp.lane = lane_id(); Fp.tid = F.wave * 64 + Fp.lane
#if defined(MK_STAMPS)
#define SEAM(k) do { if (IN(k) && IN((k) + 1)) xcd_barrier(bar); if (blockIdx.x == 0 && F.wave == 0 && lane_id() == 0) ((unsigned long long*)(F.ws + WS_CTL + 16384))[(k) + 1] = __builtin_amdgcn_s_memrealtime(); } while (0)
#else
#define SEAM(k) do { if (IN(k) && IN((k) + 1)) xcd_barrier(bar); } while (0)
#endif
template <int l> __device__ __forceinline__ void run_layer(const Ctx& F, const int lo, const int hi, const XcdBarrier& bar) {
        const int pb = 2 + 10 * l; const bool lastl = (l == DEPTH - 1); const int nrows = lastl ? M_LAT : M_ALL;
        bf16* const Pb = (bf16*)(F.ws + WS_P); bf16* const Ub = (bf16*)(F.ws + WS_U); bf16* const Yb = (bf16*)(F.ws + WS_Y);
        if (PON(2) && IN(pb + 0)) REP(pb + 0) {
            pg8::Gemm g{Ub, wt(F, l, W_IN), M_ALL, NP, D}; pg8::StaticOrder S; S.init(M_ALL, NP, F.G, (int)blockIdx.x);
            EpiProj E{Pb, NP};
            pg8::gemm_phase<EpiProj, pg8::StaticOrder, true, true>(F.lds, g, S, E, F.wave);
            SEAM(pb + 0);
        }
        if (PON(3) && IN(pb + 1)) REP(pb + 1) {
#ifndef MK_NO_MLSTM
            PCTX(Fp);
            if (F.vcu < 64) mlstm_chain(Fp, l, F.vcu);
            else
#endif
            {
                const int idx = F.vcu - 64, nw = F.G - 64, n_attn = lastl ? 256 : 288, n_conv = lastl ? 512 : 576;
#ifndef MK_NO_ATTN
                for (int u = idx; u < n_attn; u += nw) { if (u < 256) attn_unit(Fp, l, 0, u >> 5, (u >> 1) & 15, u & 1); else { const int j = u - 256; attn_unit(Fp, l, 1, j >> 2, (j >> 1) & 1, j & 1); } }
#endif
                __syncthreads();
#ifndef MK_NO_CONV
                for (int u = idx; u < n_conv; u += nw) conv_unit(Fp, l, u);
#endif
            }
            SEAM(pb + 1);
        }
        if (PON(4) && IN(pb + 2)) REP(pb + 2) { PCTX(Fp); c0_combine(Fp, l, nrows); SEAM(pb + 2); }
        if (PON(5) && IN(pb + 3)) REP(pb + 3) {
            pg8::Gemm g{Yb, wt(F, l, W_ABC), nrows, D, NY}; pg8::StaticOrder S; S.init(nrows, D, F.G, (int)blockIdx.x);
            EpiMerge E{Pb, Ub};
            pg8::gemm_phase<EpiMerge, pg8::StaticOrder, true, true>(F.lds, g, S, E, F.wave);
            SEAM(pb + 3);
        }
        if (PON(6) && IN(pb + 4)) REP(pb + 4) {
            pg8::Gemm g{Ub, wt(F, l, W_OUT), nrows, D, D}; pg8::StaticOrder S; S.init(nrows, D, F.G, (int)blockIdx.x);
            EpiResid E{F.out, (float*)(F.ws + WS_HC), (const float*)(F.ws + WS_MOD) + (size_t)l * 9 * 6144};
            pg8::gemm_phase<EpiResid, pg8::StaticOrder, true, true>(F.lds, g, S, E, F.wave);
            SEAM(pb + 4);
        }
        if (PON(7) && IN(pb + 5)) REP(pb + 5) { PCTX(Fp); e_ln1_route(Fp, l, nrows); SEAM(pb + 5); }
        if (PON(8) && IN(pb + 6)) REP(pb + 6) { PCTX(Fp); f_gather(Fp, l, nrows); SEAM(pb + 6); }
        if (PON(9) && IN(pb + 7)) REP(pb + 7) {
            LAS int* toff = (LAS int*)(F.lds + LDSCTL_OFF); { PCTX(Fp); moe_toff(Fp, l, toff); }
            pg8::Gemm g{(const bf16*)(F.ws + WS_AS), wt(F, l, W_GU), AS_ROWS, NE * D, D}; MoeOrder S{F.G, (int)blockIdx.x, toff};
            EpiSwiGLU E{(bf16*)(F.ws + WS_ACT)};
            pg8::gemm_phase<EpiSwiGLU, MoeOrder, true, true>(F.lds, g, S, E, F.wave);
            SEAM(pb + 7);
        }
        if (PON(10) && IN(pb + 8)) REP(pb + 8) {
            LAS int* toff = (LAS int*)(F.lds + LDSCTL_OFF); { PCTX(Fp); moe_toff(Fp, l, toff); }
            pg8::Gemm g{(const bf16*)(F.ws + WS_ACT), wt(F, l, W_DN), AS_ROWS, NE * D, DEXP}; MoeOrder S{F.G, (int)blockIdx.x, toff};
            EpiScatter E{(const int*)(F.ws + WS_ROWMAP), (const float*)(F.ws + WS_ROWW), (bf16*)(F.ws + WS_F)};
            pg8::gemm_phase<EpiScatter, MoeOrder, true, true>(F.lds, g, S, E, F.wave);
            SEAM(pb + 8);
        }
        if (PON(11) && IN(pb + 9)) REP(pb + 9) { PCTX(Fp); h_ln2(Fp, l, nrows); SEAM(pb + 9); }
    }
__global__ void __launch_bounds__(NWAVES * 64, 2) mk_fwd(Args args) {
    extern __shared__ __attribute__((aligned(16))) unsigned char lds[];
    Ctx F;
    F.lds = (LAS unsigned char*)lds; F.MISC = (volatile LAS unsigned*)(F.lds + MISC_OFF);
    F.tid = 0; F.lane = 0; F.wave = __builtin_amdgcn_readfirstlane((int)threadIdx.x >> 6);
    F.G = gridDim.x; { const int bx = blockIdx.x; F.vcu = (F.G % 8 == 0) ? (bx % 8) * (F.G / 8) + bx / 8 : bx; }
    F.ws = args.ws; F.out = args.out; F.ctl = (unsigned*)(args.ws + WS_CTL);
    F.in = args.in;
    for (int u = (int)threadIdx.x; u < (LDS_BYTES - LDSCTL_OFF) / 4; u += NWAVES * 64) ((LAS unsigned*)(F.lds + LDSCTL_OFF))[u] = 0u;
    __syncthreads();
    const int lo = args.ph_lo, hi = args.ph_hi;
    XcdBarrier bar; bar.bar = (unsigned*)(F.ctl + CW_BAR) + args.li * XCD_BAR_WORDS; bar.x = 0; bar.st = nullptr; bar.w0 = false;
    if (hi - lo > 1) bar = xcd_barrier_post((unsigned*)(F.ctl + CW_BAR) + args.li * XCD_BAR_WORDS, F.MISC + 8);
    bar.w0 = (F.wave == 0);
#if defined(MK_STAMPS)
    if (blockIdx.x == 0 && F.wave == 0 && lane_id() == 0) ((unsigned long long*)(F.ws + WS_CTL + 16384))[0] = __builtin_amdgcn_s_memrealtime();
#endif
    if (PON(0) && IN(0)) REP(0) { PCTX(Fp); p0_prologue(Fp); SEAM(0); }
    if (PON(1) && IN(1)) REP(1) { PCTX(Fp); p1_ln_in(Fp); SEAM(1); }
    run_layer<0>(F, lo, hi, bar);
    run_layer<1>(F, lo, hi, bar);
#undef IN
#undef SEAM
}


#if defined(MK_DIAG)
constexpr int CW_DIAG = 3072;
__global__ void __launch_bounds__(512, 2) mk_diag(Args args) {
    unsigned char* ws = args.ws; float* acc = (float*)((unsigned*)(ws + WS_CTL) + CW_DIAG);
    const int gt = blockIdx.x * 512 + threadIdx.x, NT = gridDim.x * 512;
    const int* rowmap = (const int*)(ws + WS_ROWMAP); const bf16* As = (const bf16*)(ws + WS_AS); const bf16* act = (const bf16*)(ws + WS_ACT); const bf16* Fs = (const bf16*)(ws + WS_F);
    const unsigned* cnt = (const unsigned*)(ws + WS_CTL) + CW_CNT;
    int ntile = 0; for (int e = 0; e < 16; ++e) ntile += (int)((cnt[64 * e] + 255u) >> 8);
    float s0 = 0.f, s1 = 0.f, s2 = 0.f, s3 = 0.f;
    for (int pos = gt; pos < ntile * 256; pos += NT) { if (rowmap[pos] >= 0) { s0 += 1.f; float a = 0.f, b = 0.f;
        for (int k = 0; k < 1024; k += 37) a += fabsf(bf1(As[(size_t)pos * D + k]));
        for (int k = 0; k < 512; k += 19) b += fabsf(bf1(act[(size_t)pos * DEXP + k]));
        s1 += a * (1.f / 28.f); s2 += b * (1.f / 27.f); } }
    for (int ts = gt; ts < 2 * M_ALL; ts += NT) { float f = 0.f; for (int k = 0; k < 1024; k += 37) f += fabsf(bf1(Fs[(size_t)ts * D + k])); s3 += f * (1.f / 28.f); }
    if (MK_DIAG == 3) { s1 = 0.f; s2 = 0.f; const float* roww = (const float*)(ws + WS_ROWW);
        for (int pos = gt; pos < ntile * 256; pos += NT) if (rowmap[pos] >= 0) s1 += fabsf(roww[pos]);
        for (int ts = gt; ts < 2 * M_ALL; ts += NT) { const v4u rt = *(const v4u*)(ws + WS_ROUTE + (size_t)ts * 16); s2 += fabsf(__builtin_bit_cast(float, rt.z)); } }
    if (MK_DIAG == 6) { s1 = 0.f; s2 = 0.f;
        for (int ts = gt; ts < 2 * M_ALL; ts += NT) { const v4u rt = *(const v4u*)(ws + WS_ROUTE + (size_t)ts * 16); const float wv = __builtin_bit_cast(float, rt.z);
            const bool ok = (wv > 0.f) && (wv < 1.f); if (ok) s2 += wv; else s1 += 1.f; } }
    if (MK_DIAG == 7) { s1 = 0.f; s2 = 0.f;
        for (int ts = gt; ts < 2 * M_ALL; ts += NT) { bool bad = false; for (int k = 0; k < 1024; k += 7) { const float x = bf1(Fs[(size_t)ts * D + k]); if (!(fabsf(x) < 1e4f)) bad = true; } if (bad) s1 += 1.f; }
        for (int pos = gt; pos < ntile * 256; pos += NT) { bool bad = false; for (int k = 0; k < 512; k += 5) { const float x = bf1(act[(size_t)pos * DEXP + k]); if (!(fabsf(x) < 1e4f)) bad = true; }
            for (int k = 0; k < 1024; k += 7) { const float x = bf1(As[(size_t)pos * D + k]); if (!(fabsf(x) < 1e4f)) bad = true; } if (bad) s2 += 1.f; } }
    if (MK_DIAG == 4 || MK_DIAG == 5) { s1 = 0.f; s2 = 0.f; const float* dbg = (const float*)(ws + WS_ROPE + 65536);
        for (int r = gt; r < M_ALL; r += NT) { s1 += fabsf(dbg[4 * r + (MK_DIAG == 4 ? 0 : 2)]); s2 += fabsf(dbg[4 * r + (MK_DIAG == 4 ? 1 : 3)]); } }
    atomicAdd(acc + 0, s0); atomicAdd(acc + 1, s1); atomicAdd(acc + 2, s2); atomicAdd(acc + 3, s3);
}
__global__ void __launch_bounds__(512, 2) mk_diag_out(Args args) {
    const float* acc = (const float*)((const unsigned*)(args.ws + WS_CTL) + CW_DIAG);
    const float cntr = acc[0], mA = acc[1] / fmaxf(cntr, 1.f), mAct = acc[2] / fmaxf(cntr, 1.f), mF = acc[3] / (2.f * M_ALL);
    float st1, st2;
    if (MK_DIAG == 1) { st1 = mA; st2 = mAct; } else if (MK_DIAG == 3) { st1 = mA; st2 = acc[2] / (2.f * M_ALL); } else if (MK_DIAG == 4 || MK_DIAG == 5) { st1 = acc[1] / M_ALL; st2 = acc[2] / M_ALL; } else if (MK_DIAG == 6) { st1 = acc[1] + 1e-3f; st2 = acc[2] / (2.f * M_ALL); } else if (MK_DIAG == 7) { st1 = acc[1] + 1e-3f; st2 = acc[2] + 1e-3f; } else { st1 = cntr / (2.f * M_ALL); st2 = mF; }
    const float v1 = fminf(fmaxf(20.f + log2f(fmaxf(st1, 1e-6f)), 0.f), 60.f), v2 = 100.f * fminf(fmaxf(20.f + log2f(fmaxf(st2, 1e-6f)), 0.f), 60.f);
    const float K = sqrtf(v1);
    for (size_t i = (size_t)blockIdx.x * 512 + threadIdx.x; i < (size_t)M_LAT * D; i += (size_t)gridDim.x * 512) args.out[i] = (i == 12345) ? v2 : ((i & 1) ? K : -K);
}
#endif

#if defined(MK_DIAG)
__global__ void __launch_bounds__(512, 2) mk_copy(Args args) {
    const bf16* HF = (const bf16*)(args.ws + WS_HF); const bf16* HB = (const bf16*)(args.ws + WS_HB); const bf16* P = (const bf16*)(args.ws + WS_P);
    for (size_t i = (size_t)blockIdx.x * 512 + threadIdx.x; i < (size_t)M_LAT * D; i += (size_t)gridDim.x * 512) { const size_t r = i >> 10; const int c = (int)(i & 1023);
        float v;
        if (MK_DIAG == 8) v = c < 512 ? bf1(HF[r * 512 + c]) : bf1(HB[r * 512 + c - 512]);
        else if (MK_DIAG == 9) v = bf1(P[r * NP + PMQ + c]);
        else if (MK_DIAG == 10) v = bf1(P[r * NP + PMV + (c & 511)]);
        else if (MK_DIAG == 11) v = bf1(P[(size_t)(M_LAT + (r & 2047)) * NP + PMQ + c + 512 * ((r >> 11) & 1)]);
        else v = ((const float*)(args.ws + WS_G))[(size_t)(r + ((r >> 13) & 1) * 2048) * 16 + (c & 15)];
        args.out[i] = v; }
}
#endif

#if defined(MK_STAMPS)
__global__ void __launch_bounds__(512, 2) mk_stamp_out(Args args) {
    const unsigned long long* ts = (const unsigned long long*)(args.ws + WS_CTL + 16384);
    const float d1 = (float)(ts[MK_ST_E1] - ts[MK_ST_S1]) * 0.01f, d2 = (float)(ts[MK_ST_E2] - ts[MK_ST_S2]) * 0.01f;
    const float K = sqrtf(d1 * 0.1f);
    for (size_t i = (size_t)blockIdx.x * 512 + threadIdx.x; i < (size_t)M_LAT * D; i += (size_t)gridDim.x * 512) args.out[i] = (i == 12345) ? d2 : ((i & 1) ? K : -K);
}
#endif

#ifndef MK_PER_PHASE
#define MK_PER_PHASE 1
#endif
extern "C" void kernel_launch(void* const* d_in, const int* in_sizes, int n_in, void* d_out, int out_size, void* d_ws, size_t ws_size, hipStream_t stream) {
    static int grid = 0;
    if (grid == 0) {
        if (n_in != N_IN || in_sizes[0] != M_LAT * D || out_size != M_LAT * D || ws_size < WS_END) {
            fprintf(stderr, "kernel_launch: built for %d inputs, x/out of %d floats, >= %zu bytes of workspace; got n_in %d, in0 %d, out %d, ws %zu; nothing launched\n", N_IN, M_LAT * D, (size_t)WS_END, n_in, n_in > 0 ? in_sizes[0] : -1, out_size, ws_size); grid = -1; return; }
        int dev = 0, cus = 0, per_cu = 0;
        if (hipGetDevice(&dev) != hipSuccess || hipDeviceGetAttribute(&cus, hipDeviceAttributeMultiprocessorCount, dev) != hipSuccess) { fprintf(stderr, "kernel_launch: device query failed\n"); grid = -1; return; }
        if (hipFuncSetAttribute((const void*)mk_fwd, hipFuncAttributeMaxDynamicSharedMemorySize, LDS_BYTES) != hipSuccess) { fprintf(stderr, "kernel_launch: hipFuncSetAttribute failed\n"); grid = -1; return; }
        if (hipOccupancyMaxActiveBlocksPerMultiprocessor(&per_cu, (const void*)mk_fwd, NWAVES * 64, LDS_BYTES) != hipSuccess || per_cu < 1) { fprintf(stderr, "kernel_launch: occupancy query reports %d workgroups per CU\n", per_cu); }
        (void)hipGetLastError();
        grid = cus;
        if (grid != 256) { fprintf(stderr, "kernel_launch: %d CUs; this kernel is built for 256\n", grid); grid = -1; return; }
    }
    if (grid < 0) return;
    if (hipMemsetAsync((char*)d_ws + WS_CTL, 0, CTL_ZERO_BYTES, stream) != hipSuccess) { fprintf(stderr, "kernel_launch: memset failed\n"); return; }
    Args a{};
    for (int i = 0; i < N_IN; ++i) a.in[i] = (const float*)d_in[i];
    a.out = (float*)d_out; a.ws = (unsigned char*)d_ws; a.pad = 0;
#if MK_PER_PHASE
    for (int k = 0; k < NPHASE; ++k) { a.ph_lo = k; a.ph_hi = k + 1; a.li = k;
        hipLaunchKernelGGL(mk_fwd, dim3(grid), dim3(NWAVES * 64), LDS_BYTES, stream, a);
#if defined(MK_DIAG)
        if (k == MK_DIAG_AFTER) { if (MK_DIAG >= 8) { hipLaunchKernelGGL(mk_copy, dim3(256), dim3(512), 0, stream, a); } else { hipLaunchKernelGGL(mk_diag, dim3(256), dim3(512), 0, stream, a); hipLaunchKernelGGL(mk_diag_out, dim3(256), dim3(512), 0, stream, a); } break; }
#endif
    }
#else
    a.ph_lo = 0; a.ph_hi = NPHASE; a.li = 0;
    hipLaunchKernelGGL(mk_fwd, dim3(grid), dim3(NWAVES * 64), LDS_BYTES, stream, a);
#if defined(MK_STAMPS)
    hipLaunchKernelGGL(mk_stamp_out, dim3(256), dim3(512), 0, stream, a);
#endif
#endif
    const hipError_t le = hipPeekAtLastError();
    if (le != hipSuccess) fprintf(stderr, "kernel_launch: launch failed: %s\n", hipGetErrorName(le));
}
```

```cpp
#include <hip/hip_runtime.h>
#include <cstdio>
#include <cstdint>
#ifndef MK_PER_PHASE
#define MK_PER_PHASE 0
#endif
namespace pg8 {
#define PG8_LAS __attribute__((address_space(3)))
typedef unsigned short bf16_t;
typedef short bf16x8 __attribute__((ext_vector_type(8)));
typedef float f32x4 __attribute__((ext_vector_type(4)));
typedef unsigned u32x4 __attribute__((ext_vector_type(4)));
constexpr int BM = 256, BK = 64, HALF = 128, HTB = HALF * BK * 2  , STAGE_BYTES = 8 * HTB, NXCD = 8, WGM = 8;

__host__ __device__ __forceinline__ int lds_byte(int r, int c) { const int st = (r >> 4) * 2 + (c >> 5), rr = r & 15, cc = c & 31, ob = rr * 64 + cc * 2; return st * 1024 + (ob ^ (((ob >> 9) & 1) << 5)); }
__host__ __device__ __forceinline__ void stage_rc(int b, int& R, int& C) { const int st = b / 1024, sb = b % 1024, swz = sb ^ (((sb >> 9) & 1) << 5); R = (st >> 1) * 16 + swz / 64; C = (st & 1) * 32 + (swz % 64) / 2; }
__host__ __device__ __forceinline__ int perm32(int rho) { const int n = rho >> 4, i = rho & 15; return 8 * (i >> 2) + 4 * n + (i & 3); }

struct Unit { int pm, pn; };
struct Gemm { const bf16_t* A; const bf16_t* Bt; int M, N, K; };

struct StaticOrder {
    int nM, nN, nwg, G, c;
    __host__ __device__ void init(int M, int N, int G_, int c_) { nM = M / BM; nN = N / BM; nwg = nM * nN; G = G_; c = c_; }
    __host__ __device__ bool next(int i, Unit& u) const {
        const long L = (long)i * G + c; if (L >= nwg) return false;
        int wgid = (int)L; { const int q = nwg / NXCD, r = nwg % NXCD, xcd = wgid % NXCD, off = wgid / NXCD; wgid = (xcd < r ? xcd * (q + 1) : r * (q + 1) + (xcd - r) * q) + off; }
        const int nig = WGM * nN, gid = wgid / nig, fm = gid * WGM, gsz = (nM - fm) < WGM ? (nM - fm) : WGM;
        u.pm = fm + ((wgid % nig) % gsz); u.pn = (wgid % nig) / gsz; return true;
    }
    __device__ __forceinline__ void a_ready(const Unit&) const {}
    __device__ __forceinline__ void done(const Unit&) const {}
};

__device__ __forceinline__ unsigned cvt_pk_bf16(float lo, float hi) { unsigned r; asm volatile("v_cvt_pk_bf16_f32 %0, %1, %2" : "=v"(r) : "v"(lo), "v"(hi)); return r; }
typedef float f32x2 __attribute__((ext_vector_type(2)));
template <class Epi, class Sched, bool ALIGN_EPI = false, bool SP2 = false>
__device__ __forceinline__ void gemm_phase(PG8_LAS unsigned char* lds, const Gemm g, const Sched& S, const Epi& E, const int wid_in) {
    int lid_; asm volatile("v_mbcnt_lo_u32_b32 %0, -1, 0\n\tv_mbcnt_hi_u32_b32 %0, -1, %0" : "=v"(lid_)); const int tid_ = wid_in * 64 + lid_;
    const int tid = tid_, wid = __builtin_amdgcn_readfirstlane(tid >> 6), lane = tid & 63, wr = wid >> 2, wc = wid & 3, fr = lane & 15, fq = lane >> 4;
    const int K = g.K, nt = K / BK;
    unsigned voffA[2], voffB[2];
#pragma unroll
    for (int i = 0; i < 2; ++i) { int R, C; stage_rc(tid * 16 + i * 8192, R, C); const int Rb = Epi::PERM ? ((R & ~31) + perm32(R & 31)) : R;
        voffA[i] = (unsigned)(R * K + C) * 2u; voffB[i] = (unsigned)(Rb * K + C) * 2u; }
    const size_t kstep = (size_t)(BK * 2);
    const size_t hstep = (size_t)HALF * K * 2;
    const size_t tstep = 2 * hstep;
    const unsigned ldsw = (unsigned)wid * 1024u;
    const int aoff = lds_byte(wr * 64 + fr, fq * 8), boff = lds_byte(wc * 32 + fr, fq * 8);
#define PG8_SA(b, h) (((b) * 2 + (h)) * HTB)
#define PG8_SB(b, h) ((4 + (b) * 2 + (h)) * HTB)
#define PG8_STAGE(bufoff, gbase, voff) do { _Pragma("unroll") for (int _i = 0; _i < 2; ++_i) \
        __builtin_amdgcn_global_load_lds((const unsigned*)((const char*)(gbase) + (voff)[_i]), (PG8_LAS unsigned*)(lds + (bufoff) + ldsw + _i * 8192), 16, 0, 0); } while (0)
#define PG8_LDA(dst, b, h) do { _Pragma("unroll") for (int m = 0; m < 4; ++m) _Pragma("unroll") for (int k = 0; k < 2; ++k) dst[m][k] = *(const PG8_LAS bf16x8*)(lds + PG8_SA(b, h) + aoff + m * 2048 + k * 1024); } while (0)
#define PG8_LDB(dst, b, h) do { _Pragma("unroll") for (int n = 0; n < 2; ++n) _Pragma("unroll") for (int k = 0; k < 2; ++k) dst[n][k] = *(const PG8_LAS bf16x8*)(lds + PG8_SB(b, h) + boff + n * 2048 + k * 1024); } while (0)
#define PG8_MMA(ai, bj, At, Bt) do { __builtin_amdgcn_s_setprio(1); _Pragma("unroll") for (int m = 0; m < 4; ++m) _Pragma("unroll") for (int n = 0; n < 2; ++n) _Pragma("unroll") for (int k = 0; k < 2; ++k) \
        acc[ai][bj][m][n] = __builtin_amdgcn_mfma_f32_16x16x32_bf16(Bt[n][k], At[m][k], acc[ai][bj][m][n], 0, 0, 0); __builtin_amdgcn_s_setprio(0); } while (0)
#define PG8_WAIT_V(n) asm volatile("s_waitcnt vmcnt(" #n ")" ::: "memory")
#define PG8_WAIT_L(n) asm volatile("s_waitcnt lgkmcnt(" #n ")" ::: "memory")
#define PG8_BAR __builtin_amdgcn_s_barrier()
#define PG8_SCHED __builtin_amdgcn_sched_barrier(0)
    Unit cur, nxt; int ui = 0;
    if (!S.next(0, cur)) return;
    f32x4 acc[2][2][4][2];
#pragma unroll
    for (int a = 0; a < 2; ++a)
#pragma unroll
        for (int b = 0; b < 2; ++b)
#pragma unroll
            for (int m = 0; m < 4; ++m)
#pragma unroll
                for (int n = 0; n < 2; ++n) acc[a][b][m][n] = (f32x4){0.f, 0.f, 0.f, 0.f};
    bf16x8 At[4][2], B0[2][2], B1[2][2];
    const char* cA = (const char*)g.A + (size_t)cur.pm * tstep; const char* cB = (const char*)g.Bt + (size_t)cur.pn * tstep;
    S.a_ready(cur);
    if constexpr (SP2) {
        PG8_STAGE(PG8_SB(0, 0), cB, voffB); PG8_STAGE(PG8_SB(0, 1), cB + hstep, voffB); PG8_STAGE(PG8_SA(0, 0), cA, voffA); PG8_STAGE(PG8_SA(0, 1), cA + hstep, voffA);
        if (wr == 1) PG8_BAR;
        PG8_WAIT_V(2); PG8_BAR;
        PG8_STAGE(PG8_SB(1, 0), cB + kstep, voffB); PG8_STAGE(PG8_SA(1, 0), cA + kstep, voffA); PG8_STAGE(PG8_SB(1, 1), cB + hstep + kstep, voffB);
        PG8_WAIT_V(6); PG8_BAR;
    } else {
        PG8_STAGE(PG8_SB(0, 0), cB, voffB); PG8_STAGE(PG8_SA(0, 0), cA, voffA); PG8_STAGE(PG8_SB(0, 1), cB + hstep, voffB); PG8_STAGE(PG8_SA(0, 1), cA + hstep, voffA);
        if (wr == 1) PG8_BAR;
        PG8_WAIT_V(4); PG8_BAR;
        PG8_STAGE(PG8_SB(1, 0), cB + kstep, voffB); PG8_STAGE(PG8_SA(1, 0), cA + kstep, voffA); PG8_STAGE(PG8_SB(1, 1), cB + hstep + kstep, voffB);
        PG8_WAIT_V(6); PG8_BAR;
    }
    for (;;) {
        const bool has_next = S.next(ui + 1, nxt);
        const char* nA = has_next ? (const char*)g.A + (size_t)nxt.pm * tstep : cA; const char* nB = has_next ? (const char*)g.Bt + (size_t)nxt.pn * tstep : cB;
        for (int t = 0; t < nt; t += 2) {
            const bool last = (t == nt - 2);
            if constexpr (Epi::RESCALE) { if (t == 8 || t == 16) E.rescale(acc, cur, t >> 3, wr, wc, fr, fq); }
            const char* a1 = cA + (size_t)(t + 1) * kstep;
            const char* a2 = last ? nA : cA + (size_t)(t + 2) * kstep; const char* b2 = last ? nB : cB + (size_t)(t + 2) * kstep;
            const char* a3 = a2 + kstep; const char* b3 = b2 + kstep;
            if (last && has_next) S.a_ready(nxt);
            if constexpr (SP2) {
            PG8_LDB(B0, 0, 0); PG8_LDB(B1, 0, 1); PG8_SCHED; PG8_LDA(At, 0, 0); PG8_STAGE(PG8_SA(1, 1), a1 + hstep, voffA);
            PG8_WAIT_V(8); PG8_WAIT_L(0); PG8_BAR; PG8_MMA(0, 0, At, B0); PG8_MMA(0, 1, At, B1); PG8_BAR; PG8_SCHED;
            PG8_LDA(At, 0, 1); PG8_STAGE(PG8_SB(0, 0), b2, voffB); PG8_STAGE(PG8_SB(0, 1), b2 + hstep, voffB); PG8_STAGE(PG8_SA(0, 0), a2, voffA);
            PG8_WAIT_V(8); PG8_WAIT_L(0); PG8_BAR; PG8_MMA(1, 0, At, B0); PG8_MMA(1, 1, At, B1); PG8_BAR; PG8_SCHED;
            PG8_LDB(B0, 1, 0); PG8_LDB(B1, 1, 1); PG8_SCHED; PG8_LDA(At, 1, 0); PG8_STAGE(PG8_SA(0, 1), a2 + hstep, voffA);
            PG8_WAIT_V(8); PG8_WAIT_L(0); PG8_BAR; PG8_MMA(0, 0, At, B0); PG8_MMA(0, 1, At, B1); PG8_BAR; PG8_SCHED;
            PG8_LDA(At, 1, 1); PG8_STAGE(PG8_SB(1, 0), b3, voffB); PG8_STAGE(PG8_SB(1, 1), b3 + hstep, voffB); PG8_STAGE(PG8_SA(1, 0), a3, voffA);
            PG8_WAIT_V(8); PG8_WAIT_L(0); PG8_BAR; PG8_MMA(1, 0, At, B0); PG8_MMA(1, 1, At, B1); PG8_BAR; PG8_SCHED;
            } else {
            PG8_LDB(B0, 0, 0); PG8_SCHED; PG8_LDA(At, 0, 0); PG8_STAGE(PG8_SA(1, 1), a1 + hstep, voffA);
            PG8_WAIT_L(8); PG8_BAR; PG8_WAIT_L(0); PG8_MMA(0, 0, At, B0); PG8_BAR; PG8_SCHED;
            PG8_LDB(B1, 0, 1); PG8_STAGE(PG8_SB(0, 0), b2, voffB);
            PG8_BAR; PG8_WAIT_L(0); PG8_MMA(0, 1, At, B1); PG8_BAR;
            PG8_LDA(At, 0, 1); PG8_STAGE(PG8_SA(0, 0), a2, voffA);
            PG8_BAR; PG8_WAIT_L(0); PG8_MMA(1, 0, At, B0); PG8_BAR; PG8_SCHED;
            PG8_STAGE(PG8_SB(0, 1), b2 + hstep, voffB);
            PG8_WAIT_V(6); PG8_BAR; PG8_MMA(1, 1, At, B1); PG8_BAR;
            PG8_LDB(B0, 1, 0); PG8_SCHED; PG8_LDA(At, 1, 0); PG8_STAGE(PG8_SA(0, 1), a2 + hstep, voffA);
            PG8_WAIT_L(8); PG8_BAR; PG8_WAIT_L(0); PG8_MMA(0, 0, At, B0); PG8_BAR; PG8_SCHED;
            PG8_LDB(B1, 1, 1); PG8_STAGE(PG8_SB(1, 0), b3, voffB);
            PG8_BAR; PG8_WAIT_L(0); PG8_MMA(0, 1, At, B1); PG8_BAR;
            PG8_LDA(At, 1, 1); PG8_STAGE(PG8_SA(1, 0), a3, voffA);
            PG8_BAR; PG8_WAIT_L(0); PG8_MMA(1, 0, At, B0); PG8_BAR; PG8_SCHED;
            PG8_STAGE(PG8_SB(1, 1), b3 + hstep, voffB);
            PG8_WAIT_V(6); PG8_BAR; PG8_MMA(1, 1, At, B1); PG8_BAR;
            }
        }
        if constexpr (ALIGN_EPI) { if (wr == 0) PG8_BAR; }
        if constexpr (!Epi::AFTER_DRAIN) { E(acc, cur, wr, wc, fr, fq); S.done(cur); }
        if (!has_next) break;
#pragma unroll
        for (int a = 0; a < 2; ++a)
#pragma unroll
            for (int b = 0; b < 2; ++b)
#pragma unroll
                for (int m = 0; m < 4; ++m)
#pragma unroll
                    for (int n = 0; n < 2; ++n) acc[a][b][m][n] = (f32x4){0.f, 0.f, 0.f, 0.f};
        cur = nxt; cA = nA; cB = nB; ++ui;
        if constexpr (ALIGN_EPI) { if (wr == 1) PG8_BAR; }
    }
    PG8_WAIT_V(0);
    if constexpr (!ALIGN_EPI) { if (wr == 0) PG8_BAR; }
    PG8_BAR;
    if constexpr (Epi::AFTER_DRAIN) { E.fused(acc, cur, wr, wc, fr, fq, lds, wid, lane); S.done(cur); }
#undef PG8_SA
#undef PG8_SB
#undef PG8_STAGE
#undef PG8_LDA
#undef PG8_LDB
#undef PG8_MMA
#undef PG8_WAIT_V
#undef PG8_WAIT_L
#undef PG8_BAR
#undef PG8_SCHED
}
}

#ifndef MK_ABL_A
#define MK_ABL_A 1.0f
#endif
#ifndef MK_ABL_B
#define MK_ABL_B 1.0f
#endif
#ifndef MK_ABL_C
#define MK_ABL_C 1.0f
#endif
#ifndef MK_ABL_F
#define MK_ABL_F 1.0f
#endif
constexpr int NWAVES = 8;
constexpr int D = 1024, NBATCH = 8, SEQ = 2048, LCTX = 256, DEPTH = 2;
constexpr int M_LAT = NBATCH * SEQ, M_CTX = NBATCH * LCTX, M_ALL = M_LAT + M_CTX;
constexpr int D_IN = 6928, NP = 6912;
constexpr int PA_VAL = 0, PA_GATE = 512, PQ = 1024, PK = 1536, PV = 1664, PMQ = 1792, PMK = 2304, PMV = 2816, PMO = 3328, PBG = 3840;
constexpr int SRC_MG = 3840;
constexpr int NE = 16, DEXP = 512, NY = 1536;
constexpr float LN_EPS = 1e-5f, ALPHA = 1.41421356237309515f;
constexpr float KSCALE = 0.08838834764831845f;
enum { I_X = 0, I_C, I_CTX, I_CCTX, I_LNIN_G, I_LNIN_B, I_WROUTER, I_BROUTER, I_WMOD, I_BMOD, I_WIN, I_CONVW, I_CONVB, I_CONVLN_G, I_CONVLN_B, I_WA, I_SINK, I_WB, I_GATEB, I_NORMG, I_WC, I_WOUT,
       I_LN1G, I_LN1B, I_WGU, I_WDN, I_LN2G, I_LN2B, N_IN };
static_assert(N_IN == 28, "inputs");

constexpr size_t MiB = 1u << 20;
constexpr size_t WS_CTL = 0, CTL_ZERO_BYTES = 1 * MiB;
constexpr size_t WS_MOD = 1 * MiB;
constexpr size_t WS_ROPE = 1 * MiB + 512 * 1024;
constexpr size_t WS_G = 2 * MiB;
constexpr size_t WS_ROUTE = 4 * MiB;
constexpr size_t WS_BCNT = 4 * MiB + 768 * 1024;
constexpr size_t WS_ROWMAP = 5 * MiB;
constexpr size_t WS_ROWW = 5 * MiB + 256 * 1024;
constexpr size_t WS_HC = 6 * MiB;
constexpr size_t WS_W = 14 * MiB;
constexpr size_t W_IN = 0, W_ABC = W_IN + (size_t)NP * D * 2, W_OUT = W_ABC + (size_t)D * NY * 2, W_GU = W_OUT + (size_t)D * D * 2, W_DN = W_GU + (size_t)NE * D * D * 2, W_LAYER = W_DN + (size_t)NE * D * DEXP * 2;
constexpr size_t WS_P = WS_W + 2 * W_LAYER;
constexpr size_t WS_U = WS_P + (size_t)M_ALL * NP * 2;
constexpr size_t WS_Y = WS_U + (size_t)M_ALL * D * 2;
constexpr size_t WS_END = WS_Y + (size_t)M_ALL * NY * 2;
constexpr int AS_ROWS = 40960;
constexpr size_t WS_AS = WS_P;
constexpr size_t WS_ACT = WS_AS + (size_t)AS_ROWS * D * 2;
constexpr size_t WS_F = WS_ACT + (size_t)AS_ROWS * DEXP * 2;
static_assert(WS_F + (size_t)M_ALL * 2 * D * 2 <= WS_U, "MoE buffers overlay P");
static_assert(W_LAYER == 69730304 && WS_W % 256 == 0 && WS_P % 256 == 0 && WS_U % 256 == 0 && WS_Y % 256 == 0, "map");
constexpr size_t WS_HF = WS_U, WS_HB = WS_U + (size_t)M_ALL * 512 * 2;
constexpr int CW_TMO = 0, CW_CODE = 1;
constexpr int CW_CNT = 256;
constexpr int CW_WQ = 2560;
constexpr int CW_BAR = 4096;

constexpr int RING_BYTES = 131072, LDSCTL_OFF = RING_BYTES, MISC_OFF = LDSCTL_OFF + 320, LDS_BYTES = 147456;

#define GAS __attribute__((address_space(1)))
#define LAS __attribute__((address_space(3)))
typedef unsigned short bf16;
typedef unsigned v4u __attribute__((ext_vector_type(4)));
typedef unsigned v2u __attribute__((ext_vector_type(2)));
typedef float f32x4 __attribute__((ext_vector_type(4)));
typedef float f32x16 __attribute__((ext_vector_type(16)));
typedef short bf16x8 __attribute__((ext_vector_type(8)));
typedef GAS unsigned gu32;
#define RLX_AGENT __ATOMIC_RELAXED, __HIP_MEMORY_SCOPE_AGENT
#define LDS_WAIT() asm volatile("s_waitcnt lgkmcnt(0)" ::: "memory")
#define VM_WAIT() asm volatile("s_waitcnt vmcnt(0)" ::: "memory")
__device__ __forceinline__ unsigned f2bf(float f) { unsigned u = __builtin_bit_cast(unsigned, f); return (u + 0x7fffu + ((u >> 16) & 1u)) >> 16; }
typedef float f32x2_t __attribute__((ext_vector_type(2)));
typedef __bf16 bf16x2_t __attribute__((ext_vector_type(2)));
__device__ __forceinline__ unsigned pk2(float lo, float hi) { const f32x2_t v = {lo, hi}; const bf16x2_t b = __builtin_convertvector(v, bf16x2_t); return __builtin_bit_cast(unsigned, b); }
__device__ __forceinline__ float bflo(unsigned w) { return __builtin_bit_cast(float, w << 16); }
__device__ __forceinline__ float bfhi(unsigned w) { return __builtin_bit_cast(float, w & 0xffff0000u); }
__device__ __forceinline__ float bf1(bf16 v) { return __builtin_bit_cast(float, (unsigned)v << 16); }
__device__ __forceinline__ float sigmoidf_(float x) { return 1.0f / (1.0f + __expf(-x)); }
__device__ __forceinline__ int lane_id() { int l; asm volatile("v_mbcnt_lo_u32_b32 %0, -1, 0\n\tv_mbcnt_hi_u32_b32 %0, -1, %0" : "=v"(l)); return l; }
__device__ __forceinline__ float shidx(float v, int src) { return __builtin_bit_cast(float, __builtin_amdgcn_ds_bpermute(src << 2, __builtin_bit_cast(int, v))); }
__device__ __forceinline__ float shx(float v, int mask, int lane) { return shidx(v, lane ^ mask); }
__device__ __forceinline__ float shup(float v, int o, int lane) { return shidx(v, lane >= o ? lane - o : lane); }
__device__ __forceinline__ float wave_sum(float v, int lane) {
#pragma unroll
    for (int o = 1; o < 64; o <<= 1) v += shx(v, o, lane);
    return v;
}
__device__ __forceinline__ void unpack8(v4u w, float (&f)[8]) { f[0] = bflo(w.x); f[1] = bfhi(w.x); f[2] = bflo(w.y); f[3] = bfhi(w.y); f[4] = bflo(w.z); f[5] = bfhi(w.z); f[6] = bflo(w.w); f[7] = bfhi(w.w); }
__device__ __forceinline__ v4u pack8(const float (&f)[8]) { v4u w; w.x = pk2(f[0], f[1]); w.y = pk2(f[2], f[3]); w.z = pk2(f[4], f[5]); w.w = pk2(f[6], f[7]); return w; }

#define XB_TMO      128
#define XB_XCNT(j)  (256  + 64 * (j))
#define XB_XSUB(j)  (1280 + 64 * (j))
#define XB_XGEN(j)  (2304 + 64 * (j))
#define XB_TOP      3328
#define XB_TOPGEN   3392
#define XCD_BAR_WORDS 3456
#define XB_SPIN_CAP (1u << 18)

__device__ __forceinline__ unsigned xb_ld(unsigned* p)              { return __hip_atomic_load(p, __ATOMIC_RELAXED, __HIP_MEMORY_SCOPE_AGENT); }
__device__ __forceinline__ unsigned xb_add(unsigned* p, unsigned) { unsigned one; asm volatile("v_mov_b32 %0, 1" : "=v"(one));
    return __hip_atomic_fetch_add(p, one, __ATOMIC_RELAXED, __HIP_MEMORY_SCOPE_AGENT); }
__device__ __forceinline__ unsigned xb_xcc_id() { return (unsigned)__builtin_amdgcn_s_getreg((3 << 11) | 20) & 0xFu; }
#define XB_SPIN(cond, bar) do { unsigned _sp = 0; while (cond) { __builtin_amdgcn_s_sleep(1); \
    if ((++_sp & 255u) == 0u) { if (xb_ld(&(bar)[XB_TMO])) break; if (_sp > XB_SPIN_CAP) { (void)xb_add(&(bar)[XB_TMO], 1u); break; } } } } while (0)

struct XcdBarrier {
    bool w0;
    unsigned* bar; unsigned x;
    volatile LAS unsigned* st;
};

__device__ __forceinline__ XcdBarrier xcd_barrier_post(unsigned* bar, volatile LAS unsigned* st) {
    XcdBarrier b; b.w0 = false; b.bar = bar; b.x = xb_xcc_id(); b.st = st;
    if (threadIdx.x == 0) (void)xb_add(&bar[XB_XCNT(b.x)], 1u);
    return b;
}
__device__ __forceinline__ void xcd_barrier_complete(unsigned* bar, unsigned x, unsigned& nloc, unsigned& nx) {
    const unsigned G = gridDim.x * gridDim.y * gridDim.z;
    unsigned sum, cnt, mine, sp = 0u;
    for (;;) {
        sum = 0u; cnt = 0u; mine = 0u;
#pragma unroll
        for (unsigned j = 0; j < 16; ++j) { const unsigned c = xb_ld(&bar[XB_XCNT(j)]); sum += c; cnt += (c > 0u) ? 1u : 0u; mine = (j == x) ? c : mine; }
        if (sum == G) break;
        __builtin_amdgcn_s_sleep(1);
        if ((++sp & 255u) == 0u) { if (xb_ld(&bar[XB_TMO])) break; if (sp > XB_SPIN_CAP) { (void)xb_add(&bar[XB_TMO], 1u); break; } }
    }
    nloc = mine > 0u ? mine : 1u; nx = cnt > 0u ? cnt : 1u;
}

__device__ __forceinline__ void xcd_barrier(const XcdBarrier& b) {
    asm volatile("s_waitcnt vmcnt(0)" ::: "memory");
    __syncthreads();
    if (b.w0 && lane_id() == 0) {
        unsigned* bar = b.bar;
        __builtin_amdgcn_s_waitcnt(0);
        unsigned nloc = b.st[0], nx = b.st[1];
        if (nloc == 0u) { xcd_barrier_complete(bar, b.x, nloc, nx); b.st[0] = nloc; b.st[1] = nx; }
        const unsigned old = xb_add(&bar[XB_XSUB(b.x)], 1u);
        const unsigned gen = old / nloc;
        if (old + 1u == (gen + 1u) * nloc) {
            __builtin_amdgcn_fence(__ATOMIC_RELEASE, "agent");
            asm volatile("s_waitcnt vmcnt(0)" ::: "memory");
            const unsigned og = xb_add(&bar[XB_TOP], 1u);
            const unsigned tg = og / nx;
            if (og + 1u == (tg + 1u) * nx) xb_add(&bar[XB_TOPGEN], 1u);
            else XB_SPIN(xb_ld(&bar[XB_TOPGEN]) == tg, bar);
            __builtin_amdgcn_fence(__ATOMIC_ACQUIRE, "agent");
            xb_add(&bar[XB_XGEN(b.x)], 1u);
            asm volatile("s_waitcnt vmcnt(0)" ::: "memory");
        } else {
            XB_SPIN(xb_ld(&bar[XB_XGEN(b.x)]) == gen, bar);
            __builtin_amdgcn_fence(__ATOMIC_ACQUIRE, "agent");
            asm volatile("s_waitcnt vmcnt(0)" ::: "memory");
        }
    }
    __syncthreads();
}

struct Ctx {
    LAS unsigned char* lds;
    volatile LAS unsigned* MISC;
    unsigned* ctl;
    int tid, lane, wave, vcu, G;
    const float* const* in; float* out; unsigned char* ws;
};
__device__ __forceinline__ bf16* wt(const Ctx& F, int l, size_t off) { return (bf16*)(F.ws + WS_W + (size_t)l * W_LAYER + off); }
__device__ __forceinline__ float* hrow(const Ctx& F, int r) { return r < M_LAT ? F.out + (size_t)r * D : (float*)(F.ws + WS_HC) + (size_t)(r - M_LAT) * D; }
__device__ __forceinline__ const float* xrow(const Ctx& F, int r) { return r < M_LAT ? F.in[I_X] + (size_t)r * D : F.in[I_CTX] + (size_t)(r - M_LAT) * D; }
__device__ __forceinline__ int modrow(int r) { return r < M_LAT ? (r >> 11) : 8; }
__device__ __forceinline__ const float* modp(const Ctx& F, int l, int mr) { return (const float*)(F.ws + WS_MOD) + (size_t)(l * 9 + mr) * 6144; }

__device__ __forceinline__ void load_row(const float* p, int lane, f32x4 (&v)[4]) {
#pragma unroll
    for (int j = 0; j < 4; ++j) v[j] = *(const f32x4*)(p + 4 * lane + 256 * j);
}
__device__ __forceinline__ void store_row(float* p, int lane, const f32x4 (&v)[4]) {
#pragma unroll
    for (int j = 0; j < 4; ++j) *(f32x4*)(p + 4 * lane + 256 * j) = v[j];
}
__device__ __forceinline__ void ln_row(f32x4 (&v)[4], const float* g, const float* b, int lane) {
    float s = 0.f;
#pragma unroll
    for (int j = 0; j < 4; ++j) s += (v[j].x + v[j].y) + (v[j].z + v[j].w);
    const float mean = wave_sum(s, lane) * (1.f / D); float s2 = 0.f;
#pragma unroll
    for (int j = 0; j < 4; ++j) { v[j] = v[j] - mean; s2 += (v[j].x * v[j].x + v[j].y * v[j].y) + (v[j].z * v[j].z + v[j].w * v[j].w); }
    const float rstd = 1.f / sqrtf(wave_sum(s2, lane) * (1.f / D) + LN_EPS);
#pragma unroll
    for (int j = 0; j < 4; ++j) { const f32x4 gg = *(const f32x4*)(g + 4 * lane + 256 * j), bb = *(const f32x4*)(b + 4 * lane + 256 * j); v[j] = v[j] * rstd * gg + bb; }
}
__device__ __forceinline__ void emit_u(const f32x4 (&h)[4], const float* sh, const float* sc, bf16* urow, int lane, f32x4 (&u)[4]) {
#pragma unroll
    for (int j = 0; j < 4; ++j) { const f32x4 s1 = *(const f32x4*)(sc + 4 * lane + 256 * j), s0 = *(const f32x4*)(sh + 4 * lane + 256 * j); u[j] = h[j] * (1.0f + s1) + s0;
        v2u w; w.x = pk2(u[j].x, u[j].y); w.y = pk2(u[j].z, u[j].w); *(v2u*)(urow + 4 * lane + 256 * j) = w; }
}
__device__ __forceinline__ void stage_w16(const Ctx& F, const float* W, int ld, LAS float* Wt) {
    for (int idx = F.tid; idx < 1024 * 16; idx += NWAVES * 64) { const int k = idx >> 4, e = idx & 15; Wt[e * 1024 + k] = W[(size_t)k * ld + e]; }
}
__device__ __forceinline__ void dot16(const f32x4 (&u)[4], const LAS float* Wt, int lane, float (&o)[16]) {
    const LAS float* wl = Wt + 4 * lane;
#pragma unroll
    for (int e = 0; e < 16; ++e) { float s = 0.f;
#pragma unroll
        for (int j = 0; j < 4; ++j) { const f32x4 w = *(const LAS f32x4*)(wl + e * 1024 + 256 * j); s += (u[j].x * w.x + u[j].y * w.y) + (u[j].z * w.z + u[j].w * w.w); }
        o[e] = wave_sum(s, lane);
        if ((e & 3) == 3) asm volatile("" ::: "memory"); }
}
#if defined(MK_DOT16_GLOBAL)
__device__ __forceinline__ void dot16g(const f32x4 (&u)[4], const float* W, int ld, int lane, float (&o)[16]) {
#pragma unroll
    for (int e = 0; e < 16; ++e) o[e] = 0.f;
#pragma unroll
    for (int j = 0; j < 4; ++j)
#pragma unroll
        for (int c = 0; c < 4; ++c) { const float uv = u[j][c]; const float* wr = W + (size_t)(256 * j + 4 * lane + c) * ld;
#pragma unroll
            for (int q = 0; q < 4; ++q) { const f32x4 w = *(const f32x4*)(wr + 4 * q); o[4 * q] += uv * w.x; o[4 * q + 1] += uv * w.y; o[4 * q + 2] += uv * w.z; o[4 * q + 3] += uv * w.w; } }
#pragma unroll
    for (int e = 0; e < 16; ++e) o[e] = wave_sum(o[e], lane);
}
#endif
__device__ __forceinline__ void emit_layer_input(const Ctx& F, int l, int r, const f32x4 (&h)[4]) {
    const float* mp = modp(F, l, modrow(r)); f32x4 u[4];
    emit_u(h, mp + 0, mp + 1024, (bf16*)(F.ws + WS_U) + (size_t)r * D, F.lane, u);
    float o[16];
#if defined(MK_DOT16_GLOBAL)
    dot16g(u, F.in[I_WIN] + (size_t)l * D * D_IN + SRC_MG, D_IN, F.lane, o);
#else
    dot16(u, (const LAS float*)F.lds, F.lane, o);
#endif
    if (F.lane == 0) { float* gp = (float*)(F.ws + WS_G) + (size_t)r * 16;
#pragma unroll
        for (int q = 0; q < 4; ++q) *(f32x4*)(gp + 4 * q) = (f32x4){o[4 * q], o[4 * q + 1], o[4 * q + 2], o[4 * q + 3]}; }
}

__device__ __forceinline__ void tr_item(const float* W, int ldw, int k0, int n0, bf16* WT, int ldt, int drow0, int dk0, LAS float* scr, int lane) {
#pragma unroll 8
    for (int i = 0; i < 32; ++i) { const int kk = 2 * i + (lane >> 5); scr[kk * 33 + (lane & 31)] = W[(size_t)(k0 + kk) * ldw + n0 + (lane & 31)]; }
    LDS_WAIT(); asm volatile("" ::: "memory");
    const int c = lane & 7;
#pragma unroll
    for (int j = 0; j < 4; ++j) { const int n = (lane >> 3) + 8 * j; const LAS float* s = scr + (8 * c) * 33 + n;
        v4u o; o.x = pk2(s[0 * 33], s[1 * 33]); o.y = pk2(s[2 * 33], s[3 * 33]); o.z = pk2(s[4 * 33], s[5 * 33]); o.w = pk2(s[6 * 33], s[7 * 33]);
        *(v4u*)(WT + (size_t)(drow0 + n) * ldt + dk0 + k0 + 8 * c) = o; }
    LDS_WAIT(); asm volatile("" ::: "memory");
}
constexpr int CV_IN = 16 * (NP / 32), CV_ABC = 3 * 8 * 32, CV_OUT = 16 * 32, CV_GU = NE * 16 * 32, CV_DN = NE * 8 * 32, CV_LAYER = CV_IN + CV_ABC + CV_OUT + CV_GU + CV_DN;
__device__ __forceinline__ void convert_item(const Ctx& F, int l, int it, LAS float* scr) {
    const int lane = F.lane;
    if (it < CV_IN) { const int kb = it / (NP / 32), nb = it % (NP / 32), n0 = 32 * nb;
        tr_item(F.in[I_WIN] + (size_t)l * D * D_IN, D_IN, 64 * kb, n0 < PBG ? n0 : n0 + 16, wt(F, l, W_IN), D, n0, 0, scr, lane); return; }
    it -= CV_IN;
    if (it < CV_ABC) { const int br = it / 256, r = it % 256, kb = r / 32, nb = r % 32;
        if (br == 0) tr_item(F.in[I_WA] + (size_t)l * 512 * D, D, 64 * kb, 32 * nb, wt(F, l, W_ABC), NY, 32 * nb, 0, scr, lane);
        else if (br == 1) tr_item(F.in[I_WB] + (size_t)l * 512 * D, D, 64 * kb, 32 * nb, wt(F, l, W_ABC), NY, 32 * nb, 512, scr, lane);
        else tr_item(F.in[I_WC] + (size_t)l * 512 * D, D, 64 * kb, 32 * nb, wt(F, l, W_ABC), NY, 32 * nb, 1024, scr, lane);
        return; }
    it -= CV_ABC;
    if (it < CV_OUT) { const int kb = it / 32, nb = it % 32; tr_item(F.in[I_WOUT] + (size_t)l * D * D, D, 64 * kb, 32 * nb, wt(F, l, W_OUT), D, 32 * nb, 0, scr, lane); return; }
    it -= CV_OUT;
    if (it < CV_GU) { const int e = it / 512, r = it % 512, kb = r / 32, nb = r % 32, n0 = 32 * nb;
        const int dr = n0 < 512 ? (n0 / 128) * 256 + (n0 % 128) : ((n0 - 512) / 128) * 256 + 128 + ((n0 - 512) % 128);
        tr_item(F.in[I_WGU] + (size_t)(l * NE + e) * D * D, D, 64 * kb, n0, wt(F, l, W_GU) + (size_t)e * D * D, D, dr, 0, scr, lane); return; }
    it -= CV_GU;
    { const int e = it / 256, r = it % 256, kb = r / 32, nb = r % 32;
        tr_item(F.in[I_WDN] + (size_t)(l * NE + e) * DEXP * D, D, 64 * kb, 32 * nb, wt(F, l, W_DN) + (size_t)e * D * DEXP, DEXP, 32 * nb, 0, scr, lane); }
}
__device__ __forceinline__ void p0_prologue(const Ctx& F) {
    if (F.vcu < 192) {
        LAS float* S = (LAS float*)F.lds; LAS float* red = (LAS float*)(F.lds + 36864);
        for (int idx = F.tid; idx < 9 * D; idx += NWAVES * 64) { const int r = idx >> 10, k = idx & 1023; const float v = r < 8 ? F.in[I_C][r * D + k] : F.in[I_CCTX][k]; S[idx] = v * sigmoidf_(v); }
        __syncthreads();
        const int l = F.vcu / 96, n0 = (F.vcu % 96) * 64;
        float acc[9];
#pragma unroll
        for (int r = 0; r < 9; ++r) acc[r] = 0.f;
        const float* wp = F.in[I_WMOD] + ((size_t)l * D + 128 * F.wave) * 6144 + n0 + F.lane;
#pragma unroll 4
        for (int kk = 0; kk < 128; ++kk) { const float wv = wp[(size_t)kk * 6144];
#pragma unroll
            for (int r = 0; r < 9; ++r) acc[r] += S[r * D + 128 * F.wave + kk] * wv; }
#pragma unroll
        for (int r = 0; r < 9; ++r) red[(F.wave * 9 + r) * 64 + F.lane] = acc[r];
        __syncthreads();
        for (int idx = F.tid; idx < 9 * 64; idx += NWAVES * 64) { const int r = idx >> 6, c = idx & 63; float s = 0.f;
#pragma unroll
            for (int w = 0; w < 8; ++w) s += red[(w * 9 + r) * 64 + c];
            ((float*)(F.ws + WS_MOD))[(size_t)(l * 9 + r) * 6144 + n0 + c] = s + F.in[I_BMOD][l * 6144 + n0 + c]; }
        __syncthreads();
    }
    if (F.vcu == 255) for (int idx = F.tid; idx < 1024; idx += NWAVES * 64) { const int pos = idx >> 4, i = idx & 15;
        const float inv = i == 0 ? 1.000000000e+00f : i == 1 ? 5.623413324e-01f : i == 2 ? 3.162277639e-01f : i == 3 ? 1.778279394e-01f : i == 4 ? 1.000000015e-01f : i == 5 ? 5.623413250e-02f : i == 6 ? 3.162277490e-02f : i == 7 ? 1.778279431e-02f :
                          i == 8 ? 9.999999776e-03f : i == 9 ? 5.623413250e-03f : i == 10 ? 3.162277630e-03f : i == 11 ? 1.778279431e-03f : i == 12 ? 1.000000047e-03f : i == 13 ? 5.623413017e-04f : i == 14 ? 3.162277571e-04f : 1.778279402e-04f;
        const float angf = (float)pos * inv; const double x = (double)angf;
        const double kq = __builtin_rint(x * 0.63661977236758134308); const double r = (x - kq * 1.57079632679489655800) - kq * 6.123233995736766036e-17; const int q = ((int)kq) & 3;
        const double r2 = r * r;
        const double sn = r * (1.0 + r2 * (-1.0 / 6 + r2 * (1.0 / 120 + r2 * (-1.0 / 5040 + r2 * (1.0 / 362880 + r2 * (-1.0 / 39916800 + r2 * (1.0 / 6227020800.0)))))));
        const double cs = 1.0 + r2 * (-0.5 + r2 * (1.0 / 24 + r2 * (-1.0 / 720 + r2 * (1.0 / 40320 + r2 * (-1.0 / 3628800 + r2 * (1.0 / 479001600.0 + r2 * (-1.0 / 87178291200.0)))))));
        const double c = q == 0 ? cs : q == 1 ? -sn : q == 2 ? -cs : sn, s_ = q == 0 ? sn : q == 1 ? cs : q == 2 ? -sn : -cs;
        ((float*)(F.ws + WS_ROPE))[2 * idx] = (float)c; ((float*)(F.ws + WS_ROPE))[2 * idx + 1] = (float)s_; }
    LAS float* scr = (LAS float*)(F.lds + F.wave * 16384);
    const int gw = F.vcu * NWAVES + F.wave, NGW = F.G * NWAVES;
    for (int it = gw; it < CV_LAYER; it += NGW) convert_item(F, 0, it, scr);
}
__device__ __forceinline__ void convert_layer1_on_idle(const Ctx& F, int first) {
    LAS float* scr = (LAS float*)(F.lds + F.wave * 16384);
    const int gw = ((int)blockIdx.x - first) * NWAVES + F.wave, NGW = (F.G - first) * NWAVES;
    if ((int)blockIdx.x >= first) for (int it = gw; it < CV_LAYER; it += NGW) convert_item(F, 1, it, scr);
}
__device__ __forceinline__ void p1_ln_in(const Ctx& F) {
    const int gw = F.vcu * NWAVES + F.wave, NGW = F.G * NWAVES;
    stage_w16(F, F.in[I_WIN] + SRC_MG, D_IN, (LAS float*)F.lds); __syncthreads();
    for (int r = gw; r < M_ALL; r += NGW) { f32x4 v[4]; load_row(xrow(F, r), F.lane, v); ln_row(v, F.in[I_LNIN_G], F.in[I_LNIN_B], F.lane); store_row(hrow(F, r), F.lane, v); emit_layer_input(F, 0, r, v); }
}

__device__ __forceinline__ void conv_unit(const Ctx& F, int l, int unit) {
    const bf16* P = (const bf16*)(F.ws + WS_P); bf16* Y = (bf16*)(F.ws + WS_Y);
    int seq0, T, t0;
    if (unit < 512) { const int b = unit >> 6; seq0 = b * SEQ; T = SEQ; t0 = (unit & 63) * 32; }
    else { const int j = unit - 512, b = j >> 3; seq0 = M_LAT + b * LCTX; T = LCTX; t0 = (j & 7) * 32; }
    const int c = F.tid;
    LAS bf16* Ut = (LAS bf16*)F.lds;
#pragma unroll 2
    for (int p = F.tid; p < 62 * 64; p += NWAVES * 64) { const int i = p >> 6, c8 = p & 63, t = t0 - 15 + i; v4u o = {0u, 0u, 0u, 0u};
        if (t >= 0 && t < T) { const bf16* pr = P + (size_t)(seq0 + t) * NP + 8 * c8; const v4u xv = *(const v4u*)(pr + PA_VAL), xg = *(const v4u*)(pr + PA_GATE);
            float a[8], g[8], uo[8]; unpack8(xv, a); unpack8(xg, g);
#pragma unroll
            for (int j = 0; j < 8; ++j) uo[j] = a[j] * sigmoidf_(g[j]);
            o = pack8(uo); }
        *(LAS v4u*)(Ut + i * 512 + 8 * c8) = o; }
    float w[31];
#pragma unroll
    for (int j = 0; j < 31; ++j) w[j] = F.in[I_CONVW][(size_t)(l * 31 + j) * 512 + c];
    const float bias = F.in[I_CONVB][l * 512 + c];
    __syncthreads();
    float u[62];
#pragma unroll
    for (int i = 0; i < 62; ++i) u[i] = bf1(Ut[i * 512 + c]);
    LAS float* Yt = (LAS float*)(F.lds + 62 * 512 * 2);
#pragma unroll
    for (int tt = 0; tt < 32; ++tt) { float y = bias;
#pragma unroll
        for (int j = 0; j < 31; ++j) y += w[j] * u[tt + j];
        Yt[tt * 512 + c] = y; }
    __syncthreads();
    const float* lg = F.in[I_CONVLN_G] + l * 512; const float* lb = F.in[I_CONVLN_B] + l * 512;
#pragma unroll
    for (int q = 0; q < 4; ++q) { const int tt = 4 * F.wave + q; float v[8]; float s = 0.f;
#pragma unroll
        for (int jj = 0; jj < 8; ++jj) { v[jj] = Yt[tt * 512 + F.lane + 64 * jj]; s += v[jj]; }
        const float mean = wave_sum(s, F.lane) * (1.f / 512.f); float s2 = 0.f;
#pragma unroll
        for (int jj = 0; jj < 8; ++jj) { v[jj] -= mean; s2 += v[jj] * v[jj]; }
        const float rstd = 1.f / sqrtf(wave_sum(s2, F.lane) * (1.f / 512.f) + LN_EPS);
        bf16* yr = Y + (size_t)(seq0 + t0 + tt) * NY;
#pragma unroll
        for (int jj = 0; jj < 8; ++jj) { const int cc = F.lane + 64 * jj; const float z = v[jj] * rstd * lg[cc] + lb[cc]; yr[cc] = (bf16)f2bf(MK_ABL_A * z * sigmoidf_(z)); } }
    __syncthreads();
}

constexpr int AT_KSTR = 72, AT_VSTR = 136, AT_KS_OFF = 0, AT_VT_OFF = 128 * AT_KSTR * 2;
constexpr int AT_QF_OFF = 36864;
constexpr int AT_ROPE_OFF = LDSCTL_OFF + 1024;
struct AttnTileRegs { v4u k1, k2, v1, v2; };
__device__ __forceinline__ void attn_tile_src(int b, int nb, int ti, int& krow0, int& tok0, bool& rope, int& mode) {
    mode = 0; tok0 = 0; rope = false;
    if (ti < 2) krow0 = M_LAT + b * LCTX + 128 * ti;
    else { const int kb = nb + ti - 3; krow0 = b * SEQ + kb * 128; tok0 = kb * 128; rope = true; mode = ti == 2 ? 1 : ti == 4 ? 2 : 0; }
}
__device__ __forceinline__ void attn_tile_load(const Ctx& F, const bf16* P, int krow0, int hk, AttnTileRegs& R) {
    { const int key = F.tid >> 2, pc = F.tid & 3, c1 = pc < 2 ? pc : pc + 2; const unsigned eo = (unsigned)((krow0 + key) * NP + PK + hk * 64 + 8 * c1);
        R.k1 = *(const v4u*)(P + eo); R.k2 = *(const v4u*)(P + eo + 16); }
    { const int key = F.tid & 127, pc = F.tid >> 7; const unsigned eo = (unsigned)((krow0 + key) * NP + PV + hk * 64 + 16 * pc);
        R.v1 = *(const v4u*)(P + eo); R.v2 = *(const v4u*)(P + eo + 8); }
}
__device__ __forceinline__ void attn_tile_store(const Ctx& F, bool rope, int tok0, const AttnTileRegs& R) {
    LAS bf16* Ks = (LAS bf16*)(F.lds + AT_KS_OFF); LAS bf16* Vt = (LAS bf16*)(F.lds + AT_VT_OFF);
    { const int key = F.tid >> 2, pc = F.tid & 3, c1 = pc < 2 ? pc : pc + 2, c2 = c1 + 2; v4u x1 = R.k1, x2 = R.k2;
        if (rope) { const int tok = tok0 + key, pos = pc < 2 ? (tok >> 6) : (tok & 63), ib = 8 * (pc & 1);
            const LAS float* rt = (const LAS float*)(F.lds + AT_ROPE_OFF) + (pos * 16 + ib) * 2;
            float a[8], b[8], oa[8], ob[8]; unpack8(x1, a); unpack8(x2, b);
#pragma unroll
            for (int j = 0; j < 8; ++j) { const float cs = rt[2 * j], sn = rt[2 * j + 1]; oa[j] = a[j] * cs - b[j] * sn; ob[j] = a[j] * sn + b[j] * cs; }
            x1 = pack8(oa); x2 = pack8(ob); }
        *(LAS v4u*)(Ks + key * AT_KSTR + 8 * c1) = x1; *(LAS v4u*)(Ks + key * AT_KSTR + 8 * c2) = x2; }
    { const int key = F.tid & 127, pc = F.tid >> 7;
        const unsigned ww[8] = {R.v1.x, R.v1.y, R.v1.z, R.v1.w, R.v2.x, R.v2.y, R.v2.z, R.v2.w};
#pragma unroll
        for (int j = 0; j < 8; ++j) { Vt[(16 * pc + 2 * j) * AT_VSTR + key] = (bf16)(ww[j] & 0xffffu); Vt[(16 * pc + 2 * j + 1) * AT_VSTR + key] = (bf16)(ww[j] >> 16); } }
}
__device__ __forceinline__ void attn_rope_to_lds(const Ctx& F) {
    for (int i = F.tid; i < 2048; i += NWAVES * 64) ((LAS float*)(F.lds + AT_ROPE_OFF))[i] = ((const float*)(F.ws + WS_ROPE))[i];
    __syncthreads();
}
__device__ __forceinline__ void attn_unit(const Ctx& F, int l, int kind, int b, int nb, int hk) {
    const bf16* P = (const bf16*)(F.ws + WS_P); bf16* Y = (bf16*)(F.ws + WS_Y);
    const LAS bf16* Ks = (const LAS bf16*)(F.lds + AT_KS_OFF); const LAS bf16* Vt = (const LAS bf16*)(F.lds + AT_VT_OFF);
    const int lane = F.lane, w = F.wave, gi = w >> 1, th = w & 1, g = 4 * hk + gi, l31 = lane & 31, h = lane >> 5;
    int qrow[2];
#pragma unroll
    for (int qb = 0; qb < 2; ++qb) {
        const int iq = 64 * th + 32 * qb + l31, tok = nb * 128 + iq;
        const int row = kind == 0 ? b * SEQ + tok : M_LAT + b * LCTX + tok; qrow[qb] = row;
        const bf16* src = P + (size_t)row * NP + PQ + g * 64 + 8 * h;
        float x[4][8];
#pragma unroll
        for (int s = 0; s < 4; ++s) { const v4u raw = *(const v4u*)(src + 16 * s); unpack8(raw, x[s]); }
        if (kind == 0) {
            const LAS float* rtr = (const LAS float*)(F.lds + AT_ROPE_OFF) + ((tok >> 6) * 16 + 8 * h) * 2; const LAS float* rtc = (const LAS float*)(F.lds + AT_ROPE_OFF) + ((tok & 63) * 16 + 8 * h) * 2;
#pragma unroll
            for (int j = 0; j < 8; ++j) { float cs = rtr[2 * j], sn = rtr[2 * j + 1]; float a = x[0][j], bb = x[1][j]; x[0][j] = a * cs - bb * sn; x[1][j] = a * sn + bb * cs;
                cs = rtc[2 * j]; sn = rtc[2 * j + 1]; a = x[2][j]; bb = x[3][j]; x[2][j] = a * cs - bb * sn; x[3][j] = a * sn + bb * cs; } }
#pragma unroll
        for (int s = 0; s < 4; ++s) {
#pragma unroll
            for (int j = 0; j < 8; ++j) x[s][j] *= 0.125f * 1.44269504f;
            const v4u pk = pack8(x[s]); *(LAS v4u*)(F.lds + AT_QF_OFF + (((w * 2 + qb) * 4 + s) * 64 + lane) * 16) = pk; }
    }
    f32x16 O[2][2];
    float mrun[2], lsum[2];
    const float sink = F.in[I_SINK][l * 8 + g] * 1.44269504f;
#pragma unroll
    for (int qb = 0; qb < 2; ++qb) { mrun[qb] = sink; lsum[qb] = h == 0 ? 1.0f : 0.0f;
#pragma unroll
        for (int db = 0; db < 2; ++db)
#pragma unroll
            for (int r = 0; r < 16; ++r) O[db][qb][r] = 0.f; }
    const int ntile = kind == 0 ? 5 : 2;
    AttnTileRegs TR; int ti = 0;
    { int krow0, tok0, mode; bool rope; attn_tile_src(b, nb, 0, krow0, tok0, rope, mode); attn_tile_load(F, P, krow0, hk, TR); }
    while (ti < ntile) {
        int krow0, tok0, mode; bool rope; attn_tile_src(b, nb, ti, krow0, tok0, rope, mode);
        int tn = ti + 1; if (kind == 0) { if (tn == 2 && nb == 0) tn = 3; if (tn == 4 && nb == SEQ / 128 - 1) tn = 5; }
        __syncthreads();
        attn_tile_store(F, rope, tok0, TR);
        __syncthreads();
        if (tn < ntile) { int kr2, tk2, md2; bool rp2; attn_tile_src(b, nb, tn, kr2, tk2, rp2, md2); attn_tile_load(F, P, kr2, hk, TR); }
        ti = tn;
#pragma unroll 1
        for (int kh = 0; kh < 2; ++kh) {
            if ((mode == 1 && th == 1 && kh == 0) || (mode == 2 && th == 0 && kh == 1)) continue;
#pragma unroll
            for (int qb = 0; qb < 2; ++qb) {
                bf16x8 qfr[4];
#pragma unroll
                for (int s = 0; s < 4; ++s) qfr[s] = *(const LAS bf16x8*)(F.lds + AT_QF_OFF + (((w * 2 + qb) * 4 + s) * 64 + lane) * 16);
                f32x16 st[2];
#pragma unroll
                for (int kb = 0; kb < 2; ++kb) {
#pragma unroll
                    for (int r = 0; r < 16; ++r) st[kb][r] = 0.f;
#pragma unroll
                    for (int s = 0; s < 4; ++s) { const bf16x8 a = *(const LAS bf16x8*)(Ks + (64 * kh + 32 * kb + l31) * AT_KSTR + 16 * s + 8 * h);
                        st[kb] = __builtin_amdgcn_mfma_f32_32x32x16_bf16(a, qfr[s], st[kb], 0, 0, 0); }
                    asm volatile("" ::: "memory"); }
                const int iq = 64 * th + 32 * qb + l31;
                float mx = -INFINITY;
                if (mode != 0) {
#pragma unroll
                    for (int kb = 0; kb < 2; ++kb)
#pragma unroll
                        for (int r = 0; r < 16; ++r) { const int key = 64 * kh + 32 * kb + (r & 3) + 8 * (r >> 2) + 4 * h;
                            const bool valid = mode == 1 ? key >= iq : key <= iq; st[kb][r] = valid ? st[kb][r] : -INFINITY; } }
#pragma unroll
                for (int kb = 0; kb < 2; ++kb)
#pragma unroll
                    for (int r = 0; r < 16; ++r) mx = fmaxf(mx, st[kb][r]);
                mx = fmaxf(mx, shx(mx, 32, lane));
                const float mnew = fmaxf(mrun[qb], mx), alpha = __builtin_amdgcn_exp2f(mrun[qb] - mnew); mrun[qb] = mnew;
                float ps = 0.f;
#pragma unroll
                for (int kb = 0; kb < 2; ++kb)
#pragma unroll
                    for (int r = 0; r < 16; ++r) { const float p = __builtin_amdgcn_exp2f(st[kb][r] - mnew); st[kb][r] = p; ps += p; }
                lsum[qb] = lsum[qb] * alpha + ps;
#pragma unroll
                for (int db = 0; db < 2; ++db)
#pragma unroll
                    for (int r = 0; r < 16; ++r) O[db][qb][r] *= alpha;
#pragma unroll
                for (int kb = 0; kb < 2; ++kb)
#pragma unroll
                    for (int s2 = 0; s2 < 2; ++s2) {
                        v4u pw; pw.x = pk2(st[kb][8 * s2 + 0], st[kb][8 * s2 + 1]); pw.y = pk2(st[kb][8 * s2 + 2], st[kb][8 * s2 + 3]);
                        pw.z = pk2(st[kb][8 * s2 + 4], st[kb][8 * s2 + 5]); pw.w = pk2(st[kb][8 * s2 + 6], st[kb][8 * s2 + 7]);
                        const bf16x8 pf = __builtin_bit_cast(bf16x8, pw);
#pragma unroll
                        for (int db = 0; db < 2; ++db) { const LAS bf16* vp = Vt + (32 * db + l31) * AT_VSTR + 64 * kh + 32 * kb + 16 * s2 + 4 * h;
                            const v2u v0 = *(const LAS v2u*)(vp), v1 = *(const LAS v2u*)(vp + 8);
                            v4u av; av.x = v0.x; av.y = v0.y; av.z = v1.x; av.w = v1.y;
                            O[db][qb] = __builtin_amdgcn_mfma_f32_32x32x16_bf16(__builtin_bit_cast(bf16x8, av), pf, O[db][qb], 0, 0, 0); }
                    }
                asm volatile("" ::: "memory");
            }
        }
    }
#pragma unroll
    for (int qb = 0; qb < 2; ++qb) {
        const float lt = lsum[qb] + shx(lsum[qb], 32, lane), inv = MK_ABL_B / lt;
        bf16* yr = Y + (size_t)qrow[qb] * NY + 512 + g * 64;
#pragma unroll
        for (int db = 0; db < 2; ++db)
#pragma unroll
            for (int gq = 0; gq < 4; ++gq) { v2u o; o.x = pk2(O[db][qb][4 * gq] * inv, O[db][qb][4 * gq + 1] * inv); o.y = pk2(O[db][qb][4 * gq + 2] * inv, O[db][qb][4 * gq + 3] * inv);
                *(v2u*)(yr + 32 * db + 8 * gq + 4 * h) = o; }
    }
}

constexpr int ML_QS = 0, ML_KS = 17408, ML_KTS = 34816, ML_VTS = 53248, ML_WS = 73984, ML_CTS = 83200, ML_SM = 122368;
constexpr int ML_QSTR = 136, ML_TSTR = 72;
static_assert(ML_SM + 5 * 256 <= RING_BYTES, "mLSTM LDS");
__device__ __forceinline__ float log_sigmoid(float x) { return fminf(x, 0.f) - log1pf(__expf(-fabsf(x))); }
__device__ __forceinline__ int ml_chunk_base(int ci, int b, int dir) { const int cc = ci < 4 ? ci : ci - 4, nc = ci < 4 ? 4 : 32, cs = dir == 0 ? cc : nc - 1 - cc; return (ci < 4 ? M_LAT + b * LCTX : b * SEQ) + 64 * cs; }
__device__ __forceinline__ void mlstm_chain(const Ctx& F, int l, int unit) {
    const int chain = unit >> 1, half = unit & 1;
    const bf16* P = (const bf16*)(F.ws + WS_P); const float* G = (const float*)(F.ws + WS_G);
    const int b = chain >> 3, hd = (chain >> 1) & 3, dir = chain & 1, lane = F.lane, w = F.wave, tid = F.tid, l15 = lane & 15, lq = lane >> 4;
    bf16* Hout = (bf16*)(F.ws + (dir == 0 ? WS_HF : WS_HB));
    LAS bf16* Qs = (LAS bf16*)(F.lds + ML_QS); LAS bf16* Ks = (LAS bf16*)(F.lds + ML_KS); LAS bf16* KTs = (LAS bf16*)(F.lds + ML_KTS); LAS bf16* VTs = (LAS bf16*)(F.lds + ML_VTS);
    LAS bf16* Ws = (LAS bf16*)(F.lds + ML_WS); LAS bf16* CTs = (LAS bf16*)(F.lds + ML_CTS);
    LAS float* GA = (LAS float*)(F.lds + ML_SM); LAS float* GG = GA + 64; LAS float* WIN = GA + 128; LAS float* EM = GA + 192; LAS float* DEN = GA + 256;
    const float gbi = F.in[I_GATEB][l * 16 + dir * 8 + hd], gbf = F.in[I_GATEB][l * 16 + dir * 8 + 4 + hd];
    __syncthreads();
#if defined(MK_PROBE_LDSCLR)
    for (int i = tid; i < RING_BYTES / 4; i += NWAVES * 64) ((LAS unsigned*)F.lds)[i] = 0u;
    __syncthreads();
#endif
    for (int i = tid; i < 80 * ML_QSTR / 2; i += NWAVES * 64) ((LAS unsigned*)CTs)[i] = 0u;
    for (int i = tid; i < 16 * ML_TSTR / 2; i += NWAVES * 64) ((LAS unsigned*)(VTs + 64 * ML_TSTR))[i] = (i < ML_TSTR / 2) ? 0x3f803f80u : 0u;
    f32x4 Cacc[5];
#pragma unroll
    for (int e = 0; e < 5; ++e) Cacc[e] = (f32x4){0.f, 0.f, 0.f, 0.f};
    float mst = 0.f;
    const int pr0 = tid & 31, c16 = tid >> 5;
    v4u nq[2], nk[2], nv[2]; float nig, nfg;
#define ML_ISSUE_LOADS(ci_) do { const int base_ = ml_chunk_base((ci_), b, dir); \
        _Pragma("unroll") for (int q = 0; q < 2; ++q) { const int jj = pr0 + 32 * q, tok = base_ + (dir == 0 ? jj : 63 - jj); const bf16* rp = P + (size_t)tok * NP + hd * 128 + 8 * c16; \
            nq[q] = *(const v4u*)(rp + PMQ); nk[q] = *(const v4u*)(rp + PMK); nv[q] = *(const v4u*)(rp + PMV); } \
        { const int tok = base_ + (dir == 0 ? lane : 63 - lane); nig = G[(size_t)tok * 16 + dir * 8 + hd]; nfg = G[(size_t)tok * 16 + dir * 8 + 4 + hd]; } } while (0)
    ML_ISSUE_LOADS(0);
    for (int ci = 0; ci < 36; ++ci) {
        const int base = ml_chunk_base(ci, b, dir);
#if defined(MK_PROBE_NOGATES)
        const float ig = gbi, lf = log_sigmoid(gbf);
#else
        const float ig = nig + gbi, lf = log_sigmoid(nfg + gbf);
#endif
        float bc = lf;
#pragma unroll
        for (int o = 1; o < 64; o <<= 1) { const float t = shup(bc, o, lane); if (lane >= o) bc += t; }
        const float a = ig - bc; float pm = a;
#pragma unroll
        for (int o = 1; o < 64; o <<= 1) { const float t = shup(pm, o, lane); if (lane >= o) pm = fmaxf(pm, t); }
        const float gj = fmaxf(mst, pm), g63 = shidx(gj, 63), b63 = shidx(bc, 63);
        const float wsc = __expf(a - g63) * KSCALE, decay = __expf(mst - g63);
        if (w == 0) { GA[lane] = a; GG[lane] = gj; WIN[lane] = __expf(mst - gj); EM[lane] = __expf(-(bc + gj)); }
#pragma unroll
        for (int q = 0; q < 2; ++q) { const int jj = pr0 + 32 * q;
            *(LAS v4u*)(Qs + jj * ML_QSTR + 8 * c16) = nq[q]; *(LAS v4u*)(Ks + jj * ML_QSTR + 8 * c16) = nk[q];
            const float ws = shidx(wsc, jj); float kf[8]; unpack8(nk[q], kf);
            const unsigned vv[4] = {nv[q].x, nv[q].y, nv[q].z, nv[q].w};
#pragma unroll
            for (int j = 0; j < 8; ++j) KTs[(8 * c16 + j) * ML_TSTR + jj] = (bf16)f2bf(kf[j] * ws);
            if ((c16 >> 3) == half) {
#pragma unroll
            for (int j = 0; j < 4; ++j) { VTs[(8 * (c16 & 7) + 2 * j) * ML_TSTR + jj] = (bf16)(vv[j] & 0xffffu); VTs[(8 * (c16 & 7) + 2 * j + 1) * ML_TSTR + jj] = (bf16)(vv[j] >> 16); } } }
        if (ci + 1 < 36) ML_ISSUE_LOADS(ci + 1);
        __syncthreads();
        const int rb = w >> 1, eb0 = (w & 1) ? 3 : 0, neb = (w & 1) ? 2 : 3;
        f32x4 inter[3];
        { f32x4 sa[2] = {(f32x4){0.f, 0.f, 0.f, 0.f}, (f32x4){0.f, 0.f, 0.f, 0.f}}; bf16x8 qf[4];
#pragma unroll
            for (int kk = 0; kk < 4; ++kk) { qf[kk] = *(const LAS bf16x8*)(Qs + (16 * rb + l15) * ML_QSTR + 32 * kk + 8 * lq);
#pragma unroll
                for (int cb = 0; cb < 2; ++cb) { const bf16x8 bfr = *(const LAS bf16x8*)(Ks + (16 * (2 * (w & 1) + cb) + l15) * ML_QSTR + 32 * kk + 8 * lq);
                    sa[cb] = __builtin_amdgcn_mfma_f32_16x16x32_bf16(qf[kk], bfr, sa[cb], 0, 0, 0); } }
#pragma unroll
            for (int i = 0; i < 3; ++i) { inter[i] = (f32x4){0.f, 0.f, 0.f, 0.f}; if (i < neb) {
#pragma unroll
                for (int kk = 0; kk < 4; ++kk) inter[i] = __builtin_amdgcn_mfma_f32_16x16x32_bf16(qf[kk], *(const LAS bf16x8*)(CTs + (16 * (eb0 + i) + l15) * ML_QSTR + 32 * kk + 8 * lq), inter[i], 0, 0, 0); } }
#pragma unroll
            for (int cb = 0; cb < 2; ++cb) { const int s = 16 * (2 * (w & 1) + cb) + l15; const float as = GA[s];
#pragma unroll
                for (int r = 0; r < 4; ++r) { const int j = 16 * rb + 4 * lq + r; const float wv = s <= j ? sa[cb][r] * KSCALE * __expf(as - GG[j]) : 0.f; Ws[j * ML_TSTR + s] = (bf16)f2bf(wv); } } }
        __syncthreads();
        f32x4 num[3]; float em[4];
        { bf16x8 wf[2];
#pragma unroll
            for (int kk = 0; kk < 2; ++kk) wf[kk] = *(const LAS bf16x8*)(Ws + (16 * rb + l15) * ML_TSTR + 32 * kk + 8 * lq);
            float win[4];
#pragma unroll
            for (int r = 0; r < 4; ++r) { win[r] = WIN[16 * rb + 4 * lq + r]; em[r] = EM[16 * rb + 4 * lq + r]; }
#pragma unroll
            for (int i = 0; i < 3; ++i) { if (i < neb) { const int eb = eb0 + i; f32x4 aw = (f32x4){0.f, 0.f, 0.f, 0.f};
#pragma unroll
                for (int kk = 0; kk < 2; ++kk) aw = __builtin_amdgcn_mfma_f32_16x16x32_bf16(wf[kk], *(const LAS bf16x8*)(VTs + (16 * eb + l15) * ML_TSTR + 32 * kk + 8 * lq), aw, 0, 0, 0);
#pragma unroll
                for (int r = 0; r < 4; ++r) num[i][r] = aw[r] + win[r] * inter[i][r];
                if (eb == 4 && l15 == 0) {
#pragma unroll
                    for (int r = 0; r < 4; ++r) DEN[16 * rb + 4 * lq + r] = num[i][r]; } } } }
        { bf16x8 kf[2];
#pragma unroll
            for (int kk = 0; kk < 2; ++kk) kf[kk] = *(const LAS bf16x8*)(KTs + (16 * w + l15) * ML_TSTR + 32 * kk + 8 * lq);
#pragma unroll
            for (int eb = 0; eb < 5; ++eb) { Cacc[eb] = Cacc[eb] * decay;
#pragma unroll
                for (int kk = 0; kk < 2; ++kk) Cacc[eb] = __builtin_amdgcn_mfma_f32_16x16x32_bf16(kf[kk], *(const LAS bf16x8*)(VTs + (16 * eb + l15) * ML_TSTR + 32 * kk + 8 * lq), Cacc[eb], 0, 0, 0);
                v2u o; o.x = pk2(Cacc[eb][0], Cacc[eb][1]); o.y = pk2(Cacc[eb][2], Cacc[eb][3]);
                *(LAS v2u*)(CTs + (16 * eb + l15) * ML_QSTR + 16 * w + 4 * lq) = o; } }
        mst = b63 + g63;
        __syncthreads();
        { float dn[4];
#pragma unroll
            for (int r = 0; r < 4; ++r) dn[r] = 1.0f / fmaxf(fabsf(DEN[16 * rb + 4 * lq + r]), em[r]);
#pragma unroll
            for (int i = 0; i < 3; ++i) { if (i < neb && eb0 + i < 4) { const int e = 64 * half + 16 * (eb0 + i) + l15;
#pragma unroll
                for (int r = 0; r < 4; ++r) { const int j = 16 * rb + 4 * lq + r, tok = base + (dir == 0 ? j : 63 - j); Hout[(size_t)tok * 512 + hd * 128 + e] = (bf16)f2bf(num[i][r] * dn[r]); } } } }
    }
#undef ML_ISSUE_LOADS
}

__device__ __forceinline__ void c0_combine(const Ctx& F, int l, int nrows) {
    const bf16* P = (const bf16*)(F.ws + WS_P); const bf16* HF = (const bf16*)(F.ws + WS_HF); const bf16* HB = (const bf16*)(F.ws + WS_HB); bf16* Y = (bf16*)(F.ws + WS_Y);
    const int gw = F.vcu * NWAVES + F.wave, NGW = F.G * NWAVES, lane = F.lane;
    for (int it = gw; it < nrows * 4; it += NGW) { const int r = it >> 2, hd = it & 3, col = hd * 128 + 2 * lane;
        const unsigned a = *(const unsigned*)(HF + (size_t)r * 512 + col), bq = *(const unsigned*)(HB + (size_t)r * 512 + col), mo = *(const unsigned*)(P + (size_t)r * NP + PMO + col);
#if defined(MK_PROBE_C0)
        float x0 = bflo(mo) + 0.f * (bflo(a) + bflo(bq)) * 0.f, x1 = bfhi(mo);
#else
        float x0 = bflo(a) + bflo(bq), x1 = bfhi(a) + bfhi(bq);
#endif
        const float mean = wave_sum(x0 + x1, lane) * (1.f / 128.f); x0 -= mean; x1 -= mean;
        const float rstd = 1.f / sqrtf(wave_sum(x0 * x0 + x1 * x1, lane) * (1.f / 128.f) + LN_EPS);
        const float g0 = F.in[I_NORMG][l * 512 + col], g1 = F.in[I_NORMG][l * 512 + col + 1];
        *(unsigned*)(Y + (size_t)r * NY + 1024 + col) = pk2(MK_ABL_C * sigmoidf_(bflo(mo)) * x0 * rstd * g0, MK_ABL_C * sigmoidf_(bfhi(mo)) * x1 * rstd * g1); }
}

struct EpiProj {
    static constexpr bool PERM = true, AFTER_DRAIN = false, RESCALE = false;
    bf16* O; int ldc;
    __device__ __forceinline__ void operator()(const pg8::f32x4 (&acc)[2][2][4][2], const pg8::Unit& u, int wr, int wc, int fr, int fq) const {
        const int row0 = u.pm * 256 + wr * 64 + fr, col0 = u.pn * 256 + wc * 32 + 8 * fq;
#pragma unroll
        for (int ai = 0; ai < 2; ++ai)
#pragma unroll
            for (int m = 0; m < 4; ++m) { bf16* rowp = O + (size_t)(row0 + ai * 128 + m * 16) * ldc + col0;
#pragma unroll
                for (int bj = 0; bj < 2; ++bj) { const pg8::f32x4 v0 = acc[ai][bj][m][0], v1 = acc[ai][bj][m][1];
                    v4u w; w.x = pk2(v0[0], v0[1]); w.y = pk2(v0[2], v0[3]); w.z = pk2(v1[0], v1[1]); w.w = pk2(v1[2], v1[3]);
                    *(v4u*)(rowp + bj * 128) = w; } }
    }
};
__device__ __forceinline__ float gate_e(float x) { return __builtin_amdgcn_exp2f(fminf(fmaxf(x, -30.f), 30.f) * -1.44269504f); }
struct EpiMerge {
    static constexpr bool PERM = true, AFTER_DRAIN = false, RESCALE = true;
    const bf16* P; bf16* Z;
    __device__ __forceinline__ void rescale(pg8::f32x4 (&acc)[2][2][4][2], const pg8::Unit& u, int step, int wr, int wc, int fr, int fq) const {
        const int row0 = u.pm * 256 + wr * 64 + fr, col0 = u.pn * 256 + wc * 32 + 8 * fq;
        const int cn = PBG + (step - 1) * 1024, cd = PBG + step * 1024;
#pragma unroll
        for (int ai = 0; ai < 2; ++ai)
#pragma unroll
            for (int m = 0; m < 4; ++m) { const bf16* rowp = P + (size_t)(row0 + ai * 128 + m * 16) * NP + col0;
#pragma unroll
                for (int bj = 0; bj < 2; ++bj) { const v4u xn = *(const v4u*)(rowp + cn + bj * 128), xd = *(const v4u*)(rowp + cd + bj * 128);
                    float a[8], b[8]; unpack8(xn, a); unpack8(xd, b);
#pragma unroll
                    for (int i = 0; i < 8; ++i) { const float ratio = (1.0f + gate_e(b[i])) * __builtin_amdgcn_rcpf(1.0f + gate_e(a[i])); acc[ai][bj][m][i >> 2][i & 3] *= ratio; } }
                asm volatile("" ::: "memory"); }
    }
    __device__ __forceinline__ void operator()(const pg8::f32x4 (&acc)[2][2][4][2], const pg8::Unit& u, int wr, int wc, int fr, int fq) const {
        const int row0 = u.pm * 256 + wr * 64 + fr, col0 = u.pn * 256 + wc * 32 + 8 * fq;
#pragma unroll
        for (int ai = 0; ai < 2; ++ai)
#pragma unroll
            for (int m = 0; m < 4; ++m) { const size_t r = (size_t)(row0 + ai * 128 + m * 16);
#pragma unroll
                for (int bj = 0; bj < 2; ++bj) { const v4u xc = *(const v4u*)(P + r * NP + PBG + 2048 + col0 + bj * 128); float c[8], o[8]; unpack8(xc, c);
#pragma unroll
                    for (int i = 0; i < 8; ++i) o[i] = acc[ai][bj][m][i >> 2][i & 3] * __builtin_amdgcn_rcpf(1.0f + gate_e(c[i]));
                    *(v4u*)(Z + r * D + col0 + bj * 128) = pack8(o); }
                asm volatile("" ::: "memory"); }
    }
};
struct EpiResid {
    static constexpr bool PERM = false, AFTER_DRAIN = false, RESCALE = false;
    float* out; float* hc; const float* mod_l;
    __device__ __forceinline__ void operator()(const pg8::f32x4 (&acc)[2][2][4][2], const pg8::Unit& u, int wr, int wc, int fr, int fq) const {
        const int rt = u.pm * 256; float* hb = rt < M_LAT ? out + (size_t)rt * D : hc + (size_t)(rt - M_LAT) * D;
        const float* g1 = mod_l + (size_t)(rt < M_LAT ? (rt >> 11) : 8) * 6144 + 2048;
        const int rl0 = wr * 64 + fr, col0 = u.pn * 256 + wc * 32 + 4 * fq;
#pragma unroll
        for (int ai = 0; ai < 2; ++ai)
#pragma unroll
            for (int m = 0; m < 4; ++m) { float* rowp = hb + (size_t)(rl0 + ai * 128 + m * 16) * D + col0;
#pragma unroll
                for (int bj = 0; bj < 2; ++bj)
#pragma unroll
                    for (int n = 0; n < 2; ++n) { const pg8::f32x4 g = *(const pg8::f32x4*)(g1 + col0 + bj * 128 + n * 16), h = *(const pg8::f32x4*)(rowp + bj * 128 + n * 16);
                        *(pg8::f32x4*)(rowp + bj * 128 + n * 16) = h * ALPHA + g * acc[ai][bj][m][n]; } }
    }
};
struct EpiSwiGLU {
    static constexpr bool PERM = true, AFTER_DRAIN = false, RESCALE = false;
    bf16* act;
    __device__ __forceinline__ void operator()(const pg8::f32x4 (&acc)[2][2][4][2], const pg8::Unit& u, int wr, int wc, int fr, int fq) const {
        const int row0 = u.pm * 256 + wr * 64 + fr, col0 = (u.pn & 3) * 128 + wc * 32 + 8 * fq;
#pragma unroll
        for (int ai = 0; ai < 2; ++ai)
#pragma unroll
            for (int m = 0; m < 4; ++m) { float o[8];
#pragma unroll
                for (int i = 0; i < 8; ++i) { const float g = acc[ai][0][m][i >> 2][i & 3], uu = acc[ai][1][m][i >> 2][i & 3]; o[i] = g * sigmoidf_(g) * uu; }
                *(v4u*)(act + (size_t)(row0 + ai * 128 + m * 16) * DEXP + col0) = pack8(o); }
    }
};
struct EpiScatter {
    static constexpr bool PERM = true, AFTER_DRAIN = false, RESCALE = false;
    const int* rowmap; const float* roww; bf16* Fo;
    __device__ __forceinline__ void operator()(const pg8::f32x4 (&acc)[2][2][4][2], const pg8::Unit& u, int wr, int wc, int fr, int fq) const {
        const int row0 = u.pm * 256 + wr * 64 + fr, col0 = (u.pn & 3) * 256 + wc * 32 + 8 * fq;
#pragma unroll
        for (int ai = 0; ai < 2; ++ai)
#pragma unroll
            for (int m = 0; m < 4; ++m) { const int sr = row0 + ai * 128 + m * 16, dst = rowmap[sr]; const float wgt = roww[sr];
                if (dst >= 0) {
#pragma unroll
                    for (int bj = 0; bj < 2; ++bj) { pg8::f32x4 v0 = acc[ai][bj][m][0] * wgt, v1 = acc[ai][bj][m][1] * wgt;
#if defined(MK_PROBE_SCATTER) && MK_PROBE_SCATTER == 1
                        v0 = (pg8::f32x4){wgt, wgt, wgt, wgt}; v1 = v0;
#elif defined(MK_PROBE_SCATTER) && MK_PROBE_SCATTER == 2
                        v0 = acc[ai][bj][m][0]; v1 = acc[ai][bj][m][1];
#endif
                        v4u w; w.x = pk2(v0[0], v0[1]); w.y = pk2(v0[2], v0[3]); w.z = pk2(v1[0], v1[1]); w.w = pk2(v1[2], v1[3]);
                        *(v4u*)(Fo + (size_t)dst * D + col0 + bj * 128) = w; } } }
    }
};
struct MoeOrder {
    int G, c; const LAS int* toff;
    __device__ __forceinline__ bool next(int i, pg8::Unit& u) const {
        const long L = (long)i * G + c; const int nt = toff[16]; if (L >= (long)nt * 4) return false;
        const int pm = (int)(L >> 2), ct = (int)(L & 3); int e = 0;
#pragma unroll
        for (int k = 1; k < 16; ++k) e += (pm >= toff[k]) ? 1 : 0;
        u.pm = pm; u.pn = e * 4 + ct; return true;
    }
    __device__ __forceinline__ void a_ready(const pg8::Unit&) const {}
    __device__ __forceinline__ void done(const pg8::Unit&) const {}
};
__device__ __forceinline__ void moe_toff(const Ctx& F, int l, LAS int* toff) {
    if (F.tid == 0) { int acc = 0; const int* tot = (const int*)(F.ws + WS_BCNT) + 2 * 4096 + l * 16;
        for (int e = 0; e < 16; ++e) { toff[e] = acc; acc += (tot[e] + 255) >> 8; }
        toff[16] = acc; }
    __syncthreads();
}

__device__ __forceinline__ void e_ln1_route(const Ctx& F, int l, int nrows) {
    const int rpb = nrows / 256, row0 = F.vcu * rpb;
    LAS int* lcnt = (LAS int*)F.lds; LAS int* rinfo = lcnt + 16; LAS float* rwt = (LAS float*)(lcnt + 16 + 160); LAS int* lrk = lcnt + 16 + 320;
    stage_w16(F, F.in[I_WROUTER], 16, (LAS float*)(F.lds + 4096));
    __syncthreads();
    for (int i = F.wave; i < rpb; i += NWAVES) { const int r = row0 + i;
        f32x4 v[4]; float* hp = hrow(F, r); load_row(hp, F.lane, v); ln_row(v, F.in[I_LN1G] + l * D, F.in[I_LN1B] + l * D, F.lane); store_row(hp, F.lane, v);
        const float* mp = modp(F, l, modrow(r)); f32x4 u[4];
        emit_u(v, mp + 3072, mp + 4096, (bf16*)(F.ws + WS_U) + (size_t)r * D, F.lane, u);
        float lg[16]; dot16(u, (const LAS float*)(F.lds + 4096), F.lane, lg);
        float sc[16], sel[16];
#pragma unroll
        for (int e = 0; e < 16; ++e) { sc[e] = sigmoidf_(lg[e]); sel[e] = sc[e] + F.in[I_BROUTER][e]; }
        int bg = 0; float bgs = -INFINITY;
#pragma unroll
        for (int g = 0; g < 4; ++g) { float m1 = -INFINITY, m2 = -INFINITY;
#pragma unroll
            for (int k = 0; k < 4; ++k) { const float x = sel[4 * g + k]; if (x > m1) { m2 = m1; m1 = x; } else if (x > m2) m2 = x; }
            const float gs = m1 + m2; if (gs > bgs) { bgs = gs; bg = g; } }
        float s4[4], c4[4];
#pragma unroll
        for (int k = 0; k < 4; ++k) { s4[k] = bg == 0 ? sel[k] : bg == 1 ? sel[4 + k] : bg == 2 ? sel[8 + k] : sel[12 + k]; c4[k] = bg == 0 ? sc[k] : bg == 1 ? sc[4 + k] : bg == 2 ? sc[8 + k] : sc[12 + k]; }
        int i1 = 0;
#pragma unroll
        for (int k = 1; k < 4; ++k) if (s4[k] > s4[i1]) i1 = k;
        int i2 = i1 == 0 ? 1 : 0;
#pragma unroll
        for (int k = 0; k < 4; ++k) if (k != i1 && k != i2 && s4[k] > s4[i2]) i2 = k;
        const float w1 = c4[i1], w2 = c4[i2], ws = 1.0f / (w1 + w2);
        if (F.lane == 0) { rinfo[2 * i] = 4 * bg + i1; rinfo[2 * i + 1] = 4 * bg + i2; rwt[2 * i] = w1 * ws; rwt[2 * i + 1] = w2 * ws; }
    }
    __syncthreads();
    if (F.tid < 16) { int c = 0; for (int idx = 0; idx < 2 * rpb; ++idx) if (rinfo[idx] == F.tid) lrk[idx] = c++;
        ((int*)(F.ws + WS_BCNT))[(l * 256 + F.vcu) * 16 + F.tid] = c; }
    __syncthreads();
    for (int idx = F.tid; idx < 2 * rpb; idx += NWAVES * 64) { unsigned* rp = (unsigned*)(F.ws + WS_ROUTE + (size_t)(2 * row0 + idx) * 16);
        rp[0] = (unsigned)rinfo[idx]; rp[1] = (unsigned)lrk[idx]; ((float*)rp)[2] = rwt[idx]; rp[3] = (unsigned)F.vcu; }
    __syncthreads();
}
__device__ __forceinline__ void f_gather(const Ctx& F, int l, int nrows) {
    LAS int* toff = (LAS int*)F.lds; LAS int* cnts = toff + 32; LAS int* csum = toff + 64; LAS int* bbase = toff + 1024;
    const int* bc = (const int*)(F.ws + WS_BCNT) + l * 4096;
    { const int e = F.tid & 15, ch = F.tid >> 4; int s = 0;
#pragma unroll
        for (int k = 0; k < 8; ++k) { const int v = bc[(8 * ch + k) * 16 + e]; bbase[(8 * ch + k) * 16 + e] = s; s += v; }
        csum[ch * 16 + e] = s; }
    __syncthreads();
    { const int e = F.tid & 15, ch = F.tid >> 4; int pre = 0;
        for (int k = 0; k < ch; ++k) pre += csum[k * 16 + e];
#pragma unroll
        for (int k = 0; k < 8; ++k) bbase[(8 * ch + k) * 16 + e] += pre;
        if (ch == 31) { const int tot = pre + csum[31 * 16 + e]; cnts[e] = tot; if (F.vcu == 0) ((int*)(F.ws + WS_BCNT))[2 * 4096 + l * 16 + e] = tot; } }
    __syncthreads();
    if (F.tid == 0) { int acc = 0; for (int e = 0; e < 16; ++e) { toff[e] = acc; acc += (cnts[e] + 255) >> 8; } toff[16] = acc; }
    __syncthreads();
    const int gw = F.vcu * NWAVES + F.wave, NGW = F.G * NWAVES, lane = F.lane;
    const bf16* U = (const bf16*)(F.ws + WS_U); bf16* As = (bf16*)(F.ws + WS_AS); int* rowmap = (int*)(F.ws + WS_ROWMAP); float* roww = (float*)(F.ws + WS_ROWW);
    for (int ts = gw; ts < 2 * nrows; ts += NGW) { const unsigned* rp = (const unsigned*)(F.ws + WS_ROUTE + (size_t)ts * 16); const unsigned re = rp[0], rk = rp[1], rb = rp[3]; const float rwv = ((const float*)rp)[2];
        const int pos = toff[re] * 256 + bbase[rb * 16 + re] + (int)rk;
        const v4u* src = (const v4u*)(U + (size_t)(ts >> 1) * D); v4u* dst = (v4u*)(As + (size_t)pos * D);
        dst[lane] = src[lane]; dst[lane + 64] = src[lane + 64];
        if (lane == 0) { rowmap[pos] = ts; roww[pos] = rwv; } }
    for (int e = 0; e < 16; ++e) { const int cnt = cnts[e], first = toff[e] * 256 + cnt, npad = toff[e + 1] * 256 - first;
        for (int i = gw; i < npad; i += NGW) { v4u* dst = (v4u*)(As + (size_t)(first + i) * D); unsigned z0 = 0u; asm volatile("" : "+v"(z0)); const v4u z = {z0, z0, z0, z0}; dst[lane] = z; dst[lane + 64] = z; if (lane == 0) { rowmap[first + i] = -1; roww[first + i] = 0.f; } } }
    __syncthreads();
}
__device__ __forceinline__ void h_ln2(const Ctx& F, int l, int nrows) {
    const int gw = F.vcu * NWAVES + F.wave, NGW = F.G * NWAVES, lane = F.lane; const bf16* Fs = (const bf16*)(F.ws + WS_F);
    if (l + 1 < DEPTH) { stage_w16(F, F.in[I_WIN] + (size_t)(l + 1) * D * D_IN + SRC_MG, D_IN, (LAS float*)F.lds); __syncthreads(); }
    for (int r = gw; r < nrows; r += NGW) { f32x4 v[4]; float* hp = hrow(F, r); load_row(hp, lane, v); const float* g2 = modp(F, l, modrow(r)) + 5120;
#pragma unroll
        for (int j = 0; j < 4; ++j) { const v2u a = *(const v2u*)(Fs + (size_t)(2 * r) * D + 4 * lane + 256 * j), b = *(const v2u*)(Fs + (size_t)(2 * r + 1) * D + 4 * lane + 256 * j);
            const f32x4 f = (f32x4){bflo(a.x) + bflo(b.x), bfhi(a.x) + bfhi(b.x), bflo(a.y) + bflo(b.y), bfhi(a.y) + bfhi(b.y)}, g = *(const f32x4*)(g2 + 4 * lane + 256 * j);
            v[j] = v[j] * ALPHA + g * f * MK_ABL_F; }
        ln_row(v, F.in[I_LN2G] + l * D, F.in[I_LN2B] + l * D, lane); store_row(hp, lane, v);
        if (l + 1 < DEPTH) emit_layer_input(F, l + 1, r, v); }
}

constexpr int NPHASE = 2 + 10 * DEPTH;
struct Args { const float* in[N_IN]; float* out; unsigned char* ws; int ph_lo, ph_hi, li, pad; };
static_assert(sizeof(Args) == 8 * N_IN + 16 + 16, "no padding bytes in Args");
#ifndef MK_PHASE_MASK
#define MK_PHASE_MASK 0xFFFu
#endif
#define PON(j) (((MK_PHASE_MASK) >> (j)) & 1u)
#ifndef MK_DUP
#define MK_DUP (-1)
#endif
#define REP(k) for (int rep_ = 0; rep_ < (((MK_DUP) == (k)) ? 2 : 1); ++rep_)
#define IN(k) (lo <= (k) && (k) < hi)
#define PCTX(Fp) Ctx Fp = F; Fp.lane = lane_id(); Fp.tid = F.wave * 64 + Fp.lane
#if defined(MK_STAMPS)
#define SEAM(k) do { if (IN(k) && IN((k) + 1)) xcd_barrier(bar); if (blockIdx.x == 0 && F.wave == 0 && lane_id() == 0) ((unsigned long long*)(F.ws + WS_CTL + 16384))[(k) + 1] = __builtin_amdgcn_s_memrealtime(); } while (0)
#else
#define SEAM(k) do { if (IN(k) && IN((k) + 1)) xcd_barrier(bar); } while (0)
#endif
template <int l> __device__ __forceinline__ void run_layer(const Ctx& F, const int lo, const int hi, const XcdBarrier& bar) {
        const int pb = 2 + 10 * l; const bool lastl = (l == DEPTH - 1); const int nrows = lastl ? M_LAT : M_ALL;
        bf16* const Pb = (bf16*)(F.ws + WS_P); bf16* const Ub = (bf16*)(F.ws + WS_U); bf16* const Yb = (bf16*)(F.ws + WS_Y);
        if (PON(2) && IN(pb + 0)) REP(pb + 0) {
            pg8::Gemm g{Ub, wt(F, l, W_IN), M_ALL, NP, D}; pg8::StaticOrder S; S.init(M_ALL, NP, F.G, (int)blockIdx.x);
            EpiProj E{Pb, NP};
            pg8::gemm_phase<EpiProj, pg8::StaticOrder, true, true>(F.lds, g, S, E, F.wave);
            SEAM(pb + 0);
        }
        if (PON(3) && IN(pb + 1)) REP(pb + 1) {
            PCTX(Fp);
            if (F.vcu < 128) { mlstm_chain(Fp, l, F.vcu);
#if defined(MK_DUP_MLSTM)
                mlstm_chain(Fp, l, F.vcu);
#endif
            }
            {
                const int n_attn = lastl ? 256 : 288, n_conv = lastl ? 512 : 576;
                attn_rope_to_lds(Fp);
                volatile LAS int* wq = (volatile LAS int*)(F.lds + LDSCTL_OFF + 512);
                for (;;) {
                    __syncthreads();
                    if (Fp.tid == 0) wq[0] = (int)__hip_atomic_fetch_add(F.ctl + CW_WQ + 256 * l + 128 * (int)(rep_ & 1), 1u, RLX_AGENT);
                    __syncthreads();
                    const int u = wq[0];
                    if (u >= n_attn) break;
                    if (u < 256) attn_unit(Fp, l, 0, u >> 5, (u >> 1) & 15, u & 1); else { const int j = u - 256; attn_unit(Fp, l, 1, j >> 2, (j >> 1) & 1, j & 1); }
                }
                for (;;) {
                    __syncthreads();
                    if (Fp.tid == 0) wq[0] = (int)__hip_atomic_fetch_add(F.ctl + CW_WQ + 256 * l + 128 * (int)(rep_ & 1) + 64, 1u, RLX_AGENT);
                    __syncthreads();
                    const int u = wq[0];
                    if (u >= n_conv) break;
                    conv_unit(Fp, l, u);
                }
            }
            SEAM(pb + 1);
        }
        if (PON(4) && IN(pb + 2)) REP(pb + 2) { PCTX(Fp); c0_combine(Fp, l, nrows); SEAM(pb + 2); }
        if (PON(5) && IN(pb + 3)) REP(pb + 3) {
            pg8::Gemm g{Yb, wt(F, l, W_ABC), nrows, D, NY}; pg8::StaticOrder S; S.init(nrows, D, F.G, (int)blockIdx.x);
            EpiMerge E{Pb, Ub};
            pg8::gemm_phase<EpiMerge, pg8::StaticOrder, true, true>(F.lds, g, S, E, F.wave);
            if (l == 0) { PCTX(Fp); __syncthreads(); convert_layer1_on_idle(Fp, 32); }
            SEAM(pb + 3);
        }
        if (PON(6) && IN(pb + 4)) REP(pb + 4) {
            pg8::Gemm g{Ub, wt(F, l, W_OUT), nrows, D, D}; pg8::StaticOrder S; S.init(nrows, D, F.G, (int)blockIdx.x);
            EpiResid E{F.out, (float*)(F.ws + WS_HC), (const float*)(F.ws + WS_MOD) + (size_t)l * 9 * 6144};
            pg8::gemm_phase<EpiResid, pg8::StaticOrder, true, true>(F.lds, g, S, E, F.wave);
            SEAM(pb + 4);
        }
        if (PON(7) && IN(pb + 5)) REP(pb + 5) { PCTX(Fp); e_ln1_route(Fp, l, nrows); SEAM(pb + 5); }
        if (PON(8) && IN(pb + 6)) REP(pb + 6) { PCTX(Fp); f_gather(Fp, l, nrows); SEAM(pb + 6); }
        if (PON(9) && IN(pb + 7)) REP(pb + 7) {
            LAS int* toff = (LAS int*)(F.lds + LDSCTL_OFF); { PCTX(Fp); moe_toff(Fp, l, toff); }
            pg8::Gemm g{(const bf16*)(F.ws + WS_AS), wt(F, l, W_GU), AS_ROWS, NE * D, D}; MoeOrder S{F.G, (int)blockIdx.x, toff};
            EpiSwiGLU E{(bf16*)(F.ws + WS_ACT)};
            pg8::gemm_phase<EpiSwiGLU, MoeOrder, true, true>(F.lds, g, S, E, F.wave);
            SEAM(pb + 7);
        }
        if (PON(10) && IN(pb + 8)) REP(pb + 8) {
            LAS int* toff = (LAS int*)(F.lds + LDSCTL_OFF); { PCTX(Fp); moe_toff(Fp, l, toff); }
            pg8::Gemm g{(const bf16*)(F.ws + WS_ACT), wt(F, l, W_DN), AS_ROWS, NE * D, DEXP}; MoeOrder S{F.G, (int)blockIdx.x, toff};
            EpiScatter E{(const int*)(F.ws + WS_ROWMAP), (const float*)(F.ws + WS_ROWW), (bf16*)(F.ws + WS_F)};
            pg8::gemm_phase<EpiScatter, MoeOrder, true, true>(F.lds, g, S, E, F.wave);
            SEAM(pb + 8);
        }
        if (PON(11) && IN(pb + 9)) REP(pb + 9) { PCTX(Fp); h_ln2(Fp, l, nrows); SEAM(pb + 9); }
    }
__global__ void __launch_bounds__(NWAVES * 64, 2) mk_fwd(Args args) {
    extern __shared__ __attribute__((aligned(16))) unsigned char lds[];
    Ctx F;
    F.lds = (LAS unsigned char*)lds; F.MISC = (volatile LAS unsigned*)(F.lds + MISC_OFF);
    F.tid = 0; F.lane = 0; F.wave = __builtin_amdgcn_readfirstlane((int)threadIdx.x >> 6);
    F.G = gridDim.x; { const int bx = blockIdx.x; F.vcu = (F.G % 8 == 0) ? (bx % 8) * (F.G / 8) + bx / 8 : bx; }
    F.ws = args.ws; F.out = args.out; F.ctl = (unsigned*)(args.ws + WS_CTL);
    F.in = args.in;
    for (int u = (int)threadIdx.x; u < (LDS_BYTES - LDSCTL_OFF) / 4; u += NWAVES * 64) ((LAS unsigned*)(F.lds + LDSCTL_OFF))[u] = 0u;
    __syncthreads();
    const int lo = args.ph_lo, hi = args.ph_hi;
    XcdBarrier bar; bar.bar = (unsigned*)(F.ctl + CW_BAR) + args.li * XCD_BAR_WORDS; bar.x = 0; bar.st = nullptr; bar.w0 = false;
    if (hi - lo > 1) bar = xcd_barrier_post((unsigned*)(F.ctl + CW_BAR) + args.li * XCD_BAR_WORDS, F.MISC + 8);
    bar.w0 = (F.wave == 0);
#if defined(MK_STAMPS)
    if (blockIdx.x == 0 && F.wave == 0 && lane_id() == 0) ((unsigned long long*)(F.ws + WS_CTL + 16384))[0] = __builtin_amdgcn_s_memrealtime();
#endif
    if (PON(0) && IN(0)) REP(0) { PCTX(Fp); p0_prologue(Fp); SEAM(0); }
    if (PON(1) && IN(1)) REP(1) { PCTX(Fp); p1_ln_in(Fp); SEAM(1); }
    run_layer<0>(F, lo, hi, bar);
    run_layer<1>(F, lo, hi, bar);
#undef IN
#undef SEAM
}


#if defined(MK_DIAG)
constexpr int CW_DIAG = 3072;
__global__ void __launch_bounds__(512, 2) mk_diag(Args args) {
    unsigned char* ws = args.ws; float* acc = (float*)((unsigned*)(ws + WS_CTL) + CW_DIAG);
    const int gt = blockIdx.x * 512 + threadIdx.x, NT = gridDim.x * 512;
    const int* rowmap = (const int*)(ws + WS_ROWMAP); const bf16* As = (const bf16*)(ws + WS_AS); const bf16* act = (const bf16*)(ws + WS_ACT); const bf16* Fs = (const bf16*)(ws + WS_F);
    const unsigned* cnt = (const unsigned*)(ws + WS_CTL) + CW_CNT;
    int ntile = 0; for (int e = 0; e < 16; ++e) ntile += (int)((cnt[64 * e] + 255u) >> 8);
    float s0 = 0.f, s1 = 0.f, s2 = 0.f, s3 = 0.f;
    for (int pos = gt; pos < ntile * 256; pos += NT) { if (rowmap[pos] >= 0) { s0 += 1.f; float a = 0.f, b = 0.f;
        for (int k = 0; k < 1024; k += 37) a += fabsf(bf1(As[(size_t)pos * D + k]));
        for (int k = 0; k < 512; k += 19) b += fabsf(bf1(act[(size_t)pos * DEXP + k]));
        s1 += a * (1.f / 28.f); s2 += b * (1.f / 27.f); } }
    for (int ts = gt; ts < 2 * M_ALL; ts += NT) { float f = 0.f; for (int k = 0; k < 1024; k += 37) f += fabsf(bf1(Fs[(size_t)ts * D + k])); s3 += f * (1.f / 28.f); }
    if (MK_DIAG == 3) { s1 = 0.f; s2 = 0.f; const float* roww = (const float*)(ws + WS_ROWW);
        for (int pos = gt; pos < ntile * 256; pos += NT) if (rowmap[pos] >= 0) s1 += fabsf(roww[pos]);
        for (int ts = gt; ts < 2 * M_ALL; ts += NT) { const v4u rt = *(const v4u*)(ws + WS_ROUTE + (size_t)ts * 16); s2 += fabsf(__builtin_bit_cast(float, rt.z)); } }
    if (MK_DIAG == 6) { s1 = 0.f; s2 = 0.f;
        for (int ts = gt; ts < 2 * M_ALL; ts += NT) { const v4u rt = *(const v4u*)(ws + WS_ROUTE + (size_t)ts * 16); const float wv = __builtin_bit_cast(float, rt.z);
            const bool ok = (wv > 0.f) && (wv < 1.f); if (ok) s2 += wv; else s1 += 1.f; } }
    if (MK_DIAG == 7) { s1 = 0.f; s2 = 0.f;
        for (int ts = gt; ts < 2 * M_ALL; ts += NT) { bool bad = false; for (int k = 0; k < 1024; k += 7) { const float x = bf1(Fs[(size_t)ts * D + k]); if (!(fabsf(x) < 1e4f)) bad = true; } if (bad) s1 += 1.f; }
        for (int pos = gt; pos < ntile * 256; pos += NT) { bool bad = false; for (int k = 0; k < 512; k += 5) { const float x = bf1(act[(size_t)pos * DEXP + k]); if (!(fabsf(x) < 1e4f)) bad = true; }
            for (int k = 0; k < 1024; k += 7) { const float x = bf1(As[(size_t)pos * D + k]); if (!(fabsf(x) < 1e4f)) bad = true; } if (bad) s2 += 1.f; } }
    if (MK_DIAG == 4 || MK_DIAG == 5) { s1 = 0.f; s2 = 0.f; const float* dbg = (const float*)(ws + WS_ROPE + 65536);
        for (int r = gt; r < M_ALL; r += NT) { s1 += fabsf(dbg[4 * r + (MK_DIAG == 4 ? 0 : 2)]); s2 += fabsf(dbg[4 * r + (MK_DIAG == 4 ? 1 : 3)]); } }
    atomicAdd(acc + 0, s0); atomicAdd(acc + 1, s1); atomicAdd(acc + 2, s2); atomicAdd(acc + 3, s3);
}
__global__ void __launch_bounds__(512, 2) mk_diag_out(Args args) {
    const float* acc = (const float*)((const unsigned*)(args.ws + WS_CTL) + CW_DIAG);
    const float cntr = acc[0], mA = acc[1] / fmaxf(cntr, 1.f), mAct = acc[2] / fmaxf(cntr, 1.f), mF = acc[3] / (2.f * M_ALL);
    float st1, st2;
    if (MK_DIAG == 1) { st1 = mA; st2 = mAct; } else if (MK_DIAG == 3) { st1 = mA; st2 = acc[2] / (2.f * M_ALL); } else if (MK_DIAG == 4 || MK_DIAG == 5) { st1 = acc[1] / M_ALL; st2 = acc[2] / M_ALL; } else if (MK_DIAG == 6) { st1 = acc[1] + 1e-3f; st2 = acc[2] / (2.f * M_ALL); } else if (MK_DIAG == 7) { st1 = acc[1] + 1e-3f; st2 = acc[2] + 1e-3f; } else { st1 = cntr / (2.f * M_ALL); st2 = mF; }
    const float v1 = fminf(fmaxf(20.f + log2f(fmaxf(st1, 1e-6f)), 0.f), 60.f), v2 = 100.f * fminf(fmaxf(20.f + log2f(fmaxf(st2, 1e-6f)), 0.f), 60.f);
    const float K = sqrtf(v1);
    for (size_t i = (size_t)blockIdx.x * 512 + threadIdx.x; i < (size_t)M_LAT * D; i += (size_t)gridDim.x * 512) args.out[i] = (i == 12345) ? v2 : ((i & 1) ? K : -K);
}
#endif

#if defined(MK_DIAG)
__global__ void __launch_bounds__(512, 2) mk_copy(Args args) {
    const bf16* HF = (const bf16*)(args.ws + WS_HF); const bf16* HB = (const bf16*)(args.ws + WS_HB); const bf16* P = (const bf16*)(args.ws + WS_P);
    for (size_t i = (size_t)blockIdx.x * 512 + threadIdx.x; i < (size_t)M_LAT * D; i += (size_t)gridDim.x * 512) { const size_t r = i >> 10; const int c = (int)(i & 1023);
        float v;
        if (MK_DIAG == 8) v = c < 512 ? bf1(HF[r * 512 + c]) : bf1(HB[r * 512 + c - 512]);
        else if (MK_DIAG == 9) v = bf1(P[r * NP + PMQ + c]);
        else if (MK_DIAG == 10) v = bf1(P[r * NP + PMV + (c & 511)]);
        else if (MK_DIAG == 11) v = bf1(P[(size_t)(M_LAT + (r & 2047)) * NP + PMQ + c + 512 * ((r >> 11) & 1)]);
        else v = ((const float*)(args.ws + WS_G))[(size_t)(r + ((r >> 13) & 1) * 2048) * 16 + (c & 15)];
        args.out[i] = v; }
}
#endif

#if defined(MK_STAMPS)
__global__ void __launch_bounds__(512, 2) mk_stamp_out(Args args) {
    const unsigned long long* ts = (const unsigned long long*)(args.ws + WS_CTL + 16384);
    const float d1 = (float)(ts[MK_ST_E1] - ts[MK_ST_S1]) * 0.01f, d2 = (float)(ts[MK_ST_E2] - ts[MK_ST_S2]) * 0.01f;
    const float K = sqrtf(d1 * 0.1f);
    for (size_t i = (size_t)blockIdx.x * 512 + threadIdx.x; i < (size_t)M_LAT * D; i += (size_t)gridDim.x * 512) args.out[i] = (i == 12345) ? d2 : ((i & 1) ? K : -K);
}
#endif

#ifndef MK_PER_PHASE
#define MK_PER_PHASE 1
#endif
extern "C" void kernel_launch(void* const* d_in, const int* in_sizes, int n_in, void* d_out, int out_size, void* d_ws, size_t ws_size, hipStream_t stream) {
    static int grid = 0;
    if (grid == 0) {
        if (n_in != N_IN || in_sizes[0] != M_LAT * D || out_size != M_LAT * D || ws_size < WS_END) {
            fprintf(stderr, "kernel_launch: built for %d inputs, x/out of %d floats, >= %zu bytes of workspace; got n_in %d, in0 %d, out %d, ws %zu; nothing launched\n", N_IN, M_LAT * D, (size_t)WS_END, n_in, n_in > 0 ? in_sizes[0] : -1, out_size, ws_size); grid = -1; return; }
        int dev = 0, cus = 0, per_cu = 0;
        if (hipGetDevice(&dev) != hipSuccess || hipDeviceGetAttribute(&cus, hipDeviceAttributeMultiprocessorCount, dev) != hipSuccess) { fprintf(stderr, "kernel_launch: device query failed\n"); grid = -1; return; }
        if (hipFuncSetAttribute((const void*)mk_fwd, hipFuncAttributeMaxDynamicSharedMemorySize, LDS_BYTES) != hipSuccess) { fprintf(stderr, "kernel_launch: hipFuncSetAttribute failed\n"); grid = -1; return; }
        if (hipOccupancyMaxActiveBlocksPerMultiprocessor(&per_cu, (const void*)mk_fwd, NWAVES * 64, LDS_BYTES) != hipSuccess || per_cu < 1) { fprintf(stderr, "kernel_launch: occupancy query reports %d workgroups per CU\n", per_cu); }
        (void)hipGetLastError();
        grid = cus;
        if (grid != 256) { fprintf(stderr, "kernel_launch: %d CUs; this kernel is built for 256\n", grid); grid = -1; return; }
    }
    if (grid < 0) return;
    if (hipMemsetAsync((char*)d_ws + WS_CTL, 0, CTL_ZERO_BYTES, stream) != hipSuccess) { fprintf(stderr, "kernel_launch: memset failed\n"); return; }
    Args a{};
    for (int i = 0; i < N_IN; ++i) a.in[i] = (const float*)d_in[i];
    a.out = (float*)d_out; a.ws = (unsigned char*)d_ws; a.pad = 0;
#if MK_PER_PHASE
    for (int k = 0; k < NPHASE; ++k) { a.ph_lo = k; a.ph_hi = k + 1; a.li = k;
        hipLaunchKernelGGL(mk_fwd, dim3(grid), dim3(NWAVES * 64), LDS_BYTES, stream, a);
#if defined(MK_DIAG)
        if (k == MK_DIAG_AFTER) { if (MK_DIAG >= 8) { hipLaunchKernelGGL(mk_copy, dim3(256), dim3(512), 0, stream, a); } else { hipLaunchKernelGGL(mk_diag, dim3(256), dim3(512), 0, stream, a); hipLaunchKernelGGL(mk_diag_out, dim3(256), dim3(512), 0, stream, a); } break; }
#endif
    }
#else
    a.ph_lo = 0; a.ph_hi = NPHASE; a.li = 0;
    hipLaunchKernelGGL(mk_fwd, dim3(grid), dim3(NWAVES * 64), LDS_BYTES, stream, a);
#if defined(MK_STAMPS)
    hipLaunchKernelGGL(mk_stamp_out, dim3(256), dim3(512), 0, stream, a);
#endif
#endif
    const hipError_t le = hipPeekAtLastError();
    if (le != hipSuccess) fprintf(stderr, "kernel_launch: launch failed: %s\n", hipGetErrorName(le));
}
```

```cpp
#include <hip/hip_runtime.h>
#include <cstdio>
#include <cstdint>
#ifndef MK_PER_PHASE
#define MK_PER_PHASE 0
#endif
namespace pg8 {
#define PG8_LAS __attribute__((address_space(3)))
typedef unsigned short bf16_t;
typedef short bf16x8 __attribute__((ext_vector_type(8)));
typedef float f32x4 __attribute__((ext_vector_type(4)));
typedef unsigned u32x4 __attribute__((ext_vector_type(4)));
constexpr int BM = 256, BK = 64, HALF = 128, HTB = HALF * BK * 2  , STAGE_BYTES = 8 * HTB, NXCD = 8, WGM = 8;

__host__ __device__ __forceinline__ int lds_byte(int r, int c) { const int st = (r >> 4) * 2 + (c >> 5), rr = r & 15, cc = c & 31, ob = rr * 64 + cc * 2; return st * 1024 + (ob ^ (((ob >> 9) & 1) << 5)); }
__host__ __device__ __forceinline__ void stage_rc(int b, int& R, int& C) { const int st = b / 1024, sb = b % 1024, swz = sb ^ (((sb >> 9) & 1) << 5); R = (st >> 1) * 16 + swz / 64; C = (st & 1) * 32 + (swz % 64) / 2; }
__host__ __device__ __forceinline__ int perm32(int rho) { const int n = rho >> 4, i = rho & 15; return 8 * (i >> 2) + 4 * n + (i & 3); }

struct Unit { int pm, pn; };
struct Gemm { const bf16_t* A; const bf16_t* Bt; int M, N, K; };

struct StaticOrder {
    int nM, nN, nwg, G, c;
    __host__ __device__ void init(int M, int N, int G_, int c_) { nM = M / BM; nN = N / BM; nwg = nM * nN; G = G_; c = c_; }
    __host__ __device__ bool next(int i, Unit& u) const {
        const long L = (long)i * G + c; if (L >= nwg) return false;
        int wgid = (int)L; { const int q = nwg / NXCD, r = nwg % NXCD, xcd = wgid % NXCD, off = wgid / NXCD; wgid = (xcd < r ? xcd * (q + 1) : r * (q + 1) + (xcd - r) * q) + off; }
        const int nig = WGM * nN, gid = wgid / nig, fm = gid * WGM, gsz = (nM - fm) < WGM ? (nM - fm) : WGM;
        u.pm = fm + ((wgid % nig) % gsz); u.pn = (wgid % nig) / gsz; return true;
    }
    __device__ __forceinline__ void a_ready(const Unit&) const {}
    __device__ __forceinline__ void done(const Unit&) const {}
};

__device__ __forceinline__ unsigned cvt_pk_bf16(float lo, float hi) { unsigned r; asm volatile("v_cvt_pk_bf16_f32 %0, %1, %2" : "=v"(r) : "v"(lo), "v"(hi)); return r; }
typedef float f32x2 __attribute__((ext_vector_type(2)));
template <class Epi, class Sched, bool ALIGN_EPI = false, bool SP2 = false>
__device__ __forceinline__ void gemm_phase(PG8_LAS unsigned char* lds, const Gemm g, const Sched& S, const Epi& E, const int wid_in) {
    int lid_; asm volatile("v_mbcnt_lo_u32_b32 %0, -1, 0\n\tv_mbcnt_hi_u32_b32 %0, -1, %0" : "=v"(lid_)); const int tid_ = wid_in * 64 + lid_;
    const int tid = tid_, wid = __builtin_amdgcn_readfirstlane(tid >> 6), lane = tid & 63, wr = wid >> 2, wc = wid & 3, fr = lane & 15, fq = lane >> 4;
    const int K = g.K, nt = K / BK;
    unsigned voffA[2], voffB[2];
#pragma unroll
    for (int i = 0; i < 2; ++i) { int R, C; stage_rc(tid * 16 + i * 8192, R, C); const int Rb = Epi::PERM ? ((R & ~31) + perm32(R & 31)) : R;
        voffA[i] = (unsigned)(R * K + C) * 2u; voffB[i] = (unsigned)(Rb * K + C) * 2u; }
    const size_t kstep = (size_t)(BK * 2);
    const size_t hstep = (size_t)HALF * K * 2;
    const size_t tstep = 2 * hstep;
    const unsigned ldsw = (unsigned)wid * 1024u;
    const int aoff = lds_byte(wr * 64 + fr, fq * 8), boff = lds_byte(wc * 32 + fr, fq * 8);
#define PG8_SA(b, h) (((b) * 2 + (h)) * HTB)
#define PG8_SB(b, h) ((4 + (b) * 2 + (h)) * HTB)
#define PG8_STAGE(bufoff, gbase, voff) do { _Pragma("unroll") for (int _i = 0; _i < 2; ++_i) \
        __builtin_amdgcn_global_load_lds((const unsigned*)((const char*)(gbase) + (voff)[_i]), (PG8_LAS unsigned*)(lds + (bufoff) + ldsw + _i * 8192), 16, 0, 0); } while (0)
#define PG8_LDA(dst, b, h) do { _Pragma("unroll") for (int m = 0; m < 4; ++m) _Pragma("unroll") for (int k = 0; k < 2; ++k) dst[m][k] = *(const PG8_LAS bf16x8*)(lds + PG8_SA(b, h) + aoff + m * 2048 + k * 1024); } while (0)
#define PG8_LDB(dst, b, h) do { _Pragma("unroll") for (int n = 0; n < 2; ++n) _Pragma("unroll") for (int k = 0; k < 2; ++k) dst[n][k] = *(const PG8_LAS bf16x8*)(lds + PG8_SB(b, h) + boff + n * 2048 + k * 1024); } while (0)
#define PG8_MMA(ai, bj, At, Bt) do { __builtin_amdgcn_s_setprio(1); _Pragma("unroll") for (int m = 0; m < 4; ++m) _Pragma("unroll") for (int n = 0; n < 2; ++n) _Pragma("unroll") for (int k = 0; k < 2; ++k) \
        acc[ai][bj][m][n] = __builtin_amdgcn_mfma_f32_16x16x32_bf16(Bt[n][k], At[m][k], acc[ai][bj][m][n], 0, 0, 0); __builtin_amdgcn_s_setprio(0); } while (0)
#define PG8_WAIT_V(n) asm volatile("s_waitcnt vmcnt(" #n ")" ::: "memory")
#define PG8_WAIT_L(n) asm volatile("s_waitcnt lgkmcnt(" #n ")" ::: "memory")
#define PG8_BAR __builtin_amdgcn_s_barrier()
#define PG8_SCHED __builtin_amdgcn_sched_barrier(0)
    Unit cur, nxt; int ui = 0;
    if (!S.next(0, cur)) return;
    f32x4 acc[2][2][4][2];
#pragma unroll
    for (int a = 0; a < 2; ++a)
#pragma unroll
        for (int b = 0; b < 2; ++b)
#pragma unroll
            for (int m = 0; m < 4; ++m)
#pragma unroll
                for (int n = 0; n < 2; ++n) acc[a][b][m][n] = (f32x4){0.f, 0.f, 0.f, 0.f};
    bf16x8 At[4][2], B0[2][2], B1[2][2];
    const char* cA = (const char*)g.A + (size_t)cur.pm * tstep; const char* cB = (const char*)g.Bt + (size_t)cur.pn * tstep;
    S.a_ready(cur);
    if constexpr (SP2) {
        PG8_STAGE(PG8_SB(0, 0), cB, voffB); PG8_STAGE(PG8_SB(0, 1), cB + hstep, voffB); PG8_STAGE(PG8_SA(0, 0), cA, voffA); PG8_STAGE(PG8_SA(0, 1), cA + hstep, voffA);
        if (wr == 1) PG8_BAR;
        PG8_WAIT_V(2); PG8_BAR;
        PG8_STAGE(PG8_SB(1, 0), cB + kstep, voffB); PG8_STAGE(PG8_SA(1, 0), cA + kstep, voffA); PG8_STAGE(PG8_SB(1, 1), cB + hstep + kstep, voffB);
        PG8_WAIT_V(6); PG8_BAR;
    } else {
        PG8_STAGE(PG8_SB(0, 0), cB, voffB); PG8_STAGE(PG8_SA(0, 0), cA, voffA); PG8_STAGE(PG8_SB(0, 1), cB + hstep, voffB); PG8_STAGE(PG8_SA(0, 1), cA + hstep, voffA);
        if (wr == 1) PG8_BAR;
        PG8_WAIT_V(4); PG8_BAR;
        PG8_STAGE(PG8_SB(1, 0), cB + kstep, voffB); PG8_STAGE(PG8_SA(1, 0), cA + kstep, voffA); PG8_STAGE(PG8_SB(1, 1), cB + hstep + kstep, voffB);
        PG8_WAIT_V(6); PG8_BAR;
    }
    for (;;) {
        const bool has_next = S.next(ui + 1, nxt);
        const char* nA = has_next ? (const char*)g.A + (size_t)nxt.pm * tstep : cA; const char* nB = has_next ? (const char*)g.Bt + (size_t)nxt.pn * tstep : cB;
        for (int t = 0; t < nt; t += 2) {
            const bool last = (t == nt - 2);
            if constexpr (Epi::RESCALE) { if (t == 8 || t == 16) E.rescale(acc, cur, t >> 3, wr, wc, fr, fq); }
            const char* a1 = cA + (size_t)(t + 1) * kstep;
            const char* a2 = last ? nA : cA + (size_t)(t + 2) * kstep; const char* b2 = last ? nB : cB + (size_t)(t + 2) * kstep;
            const char* a3 = a2 + kstep; const char* b3 = b2 + kstep;
            if (last && has_next) S.a_ready(nxt);
            if constexpr (SP2) {
            PG8_LDB(B0, 0, 0); PG8_LDB(B1, 0, 1); PG8_SCHED; PG8_LDA(At, 0, 0); PG8_STAGE(PG8_SA(1, 1), a1 + hstep, voffA);
            PG8_WAIT_V(8); PG8_WAIT_L(0); PG8_BAR; PG8_MMA(0, 0, At, B0); PG8_MMA(0, 1, At, B1); PG8_BAR; PG8_SCHED;
            PG8_LDA(At, 0, 1); PG8_STAGE(PG8_SB(0, 0), b2, voffB); PG8_STAGE(PG8_SB(0, 1), b2 + hstep, voffB); PG8_STAGE(PG8_SA(0, 0), a2, voffA);
            PG8_WAIT_V(8); PG8_WAIT_L(0); PG8_BAR; PG8_MMA(1, 0, At, B0); PG8_MMA(1, 1, At, B1); PG8_BAR; PG8_SCHED;
            PG8_LDB(B0, 1, 0); PG8_LDB(B1, 1, 1); PG8_SCHED; PG8_LDA(At, 1, 0); PG8_STAGE(PG8_SA(0, 1), a2 + hstep, voffA);
            PG8_WAIT_V(8); PG8_WAIT_L(0); PG8_BAR; PG8_MMA(0, 0, At, B0); PG8_MMA(0, 1, At, B1); PG8_BAR; PG8_SCHED;
            PG8_LDA(At, 1, 1); PG8_STAGE(PG8_SB(1, 0), b3, voffB); PG8_STAGE(PG8_SB(1, 1), b3 + hstep, voffB); PG8_STAGE(PG8_SA(1, 0), a3, voffA);
            PG8_WAIT_V(8); PG8_WAIT_L(0); PG8_BAR; PG8_MMA(1, 0, At, B0); PG8_MMA(1, 1, At, B1); PG8_BAR; PG8_SCHED;
            } else {
            PG8_LDB(B0, 0, 0); PG8_SCHED; PG8_LDA(At, 0, 0); PG8_STAGE(PG8_SA(1, 1), a1 + hstep, voffA);
            PG8_WAIT_L(8); PG8_BAR; PG8_WAIT_L(0); PG8_MMA(0, 0, At, B0); PG8_BAR; PG8_SCHED;
            PG8_LDB(B1, 0, 1); PG8_STAGE(PG8_SB(0, 0), b2, voffB);
            PG8_BAR; PG8_WAIT_L(0); PG8_MMA(0, 1, At, B1); PG8_BAR;
            PG8_LDA(At, 0, 1); PG8_STAGE(PG8_SA(0, 0), a2, voffA);
            PG8_BAR; PG8_WAIT_L(0); PG8_MMA(1, 0, At, B0); PG8_BAR; PG8_SCHED;
            PG8_STAGE(PG8_SB(0, 1), b2 + hstep, voffB);
            PG8_WAIT_V(6); PG8_BAR; PG8_MMA(1, 1, At, B1); PG8_BAR;
            PG8_LDB(B0, 1, 0); PG8_SCHED; PG8_LDA(At, 1, 0); PG8_STAGE(PG8_SA(0, 1), a2 + hstep, voffA);
            PG8_WAIT_L(8); PG8_BAR; PG8_WAIT_L(0); PG8_MMA(0, 0, At, B0); PG8_BAR; PG8_SCHED;
            PG8_LDB(B1, 1, 1); PG8_STAGE(PG8_SB(1, 0), b3, voffB);
            PG8_BAR; PG8_WAIT_L(0); PG8_MMA(0, 1, At, B1); PG8_BAR;
            PG8_LDA(At, 1, 1); PG8_STAGE(PG8_SA(1, 0), a3, voffA);
            PG8_BAR; PG8_WAIT_L(0); PG8_MMA(1, 0, At, B0); PG8_BAR; PG8_SCHED;
            PG8_STAGE(PG8_SB(1, 1), b3 + hstep, voffB);
            PG8_WAIT_V(6); PG8_BAR; PG8_MMA(1, 1, At, B1); PG8_BAR;
            }
        }
        if constexpr (ALIGN_EPI) { if (wr == 0) PG8_BAR; }
        if constexpr (!Epi::AFTER_DRAIN) { E(acc, cur, wr, wc, fr, fq); S.done(cur); }
        if (!has_next) break;
#pragma unroll
        for (int a = 0; a < 2; ++a)
#pragma unroll
            for (int b = 0; b < 2; ++b)
#pragma unroll
                for (int m = 0; m < 4; ++m)
#pragma unroll
                    for (int n = 0; n < 2; ++n) acc[a][b][m][n] = (f32x4){0.f, 0.f, 0.f, 0.f};
        cur = nxt; cA = nA; cB = nB; ++ui;
        if constexpr (ALIGN_EPI) { if (wr == 1) PG8_BAR; }
    }
    PG8_WAIT_V(0);
    if constexpr (!ALIGN_EPI) { if (wr == 0) PG8_BAR; }
    PG8_BAR;
    if constexpr (Epi::AFTER_DRAIN) { E.fused(acc, cur, wr, wc, fr, fq, lds, wid, lane); S.done(cur); }
#undef PG8_SA
#undef PG8_SB
#undef PG8_STAGE
#undef PG8_LDA
#undef PG8_LDB
#undef PG8_MMA
#undef PG8_WAIT_V
#undef PG8_WAIT_L
#undef PG8_BAR
#undef PG8_SCHED
}
}

#ifndef MK_ABL_A
#define MK_ABL_A 1.0f
#endif
#ifndef MK_ABL_B
#define MK_ABL_B 1.0f
#endif
#ifndef MK_ABL_C
#define MK_ABL_C 1.0f
#endif
#ifndef MK_ABL_F
#define MK_ABL_F 1.0f
#endif
constexpr int NWAVES = 8;
constexpr int D = 1024, NBATCH = 8, SEQ = 2048, LCTX = 256, DEPTH = 2;
constexpr int M_LAT = NBATCH * SEQ, M_CTX = NBATCH * LCTX, M_ALL = M_LAT + M_CTX;
constexpr int D_IN = 6928, NP = 6912;
constexpr int PA_VAL = 0, PA_GATE = 512, PQ = 1024, PK = 1536, PV = 1664, PMQ = 1792, PMK = 2304, PMV = 2816, PMO = 3328, PBG = 3840;
constexpr int SRC_MG = 3840;
constexpr int NE = 16, DEXP = 512, NY = 1536;
constexpr float LN_EPS = 1e-5f, ALPHA = 1.41421356237309515f;
constexpr float KSCALE = 0.08838834764831845f;
enum { I_X = 0, I_C, I_CTX, I_CCTX, I_LNIN_G, I_LNIN_B, I_WROUTER, I_BROUTER, I_WMOD, I_BMOD, I_WIN, I_CONVW, I_CONVB, I_CONVLN_G, I_CONVLN_B, I_WA, I_SINK, I_WB, I_GATEB, I_NORMG, I_WC, I_WOUT,
       I_LN1G, I_LN1B, I_WGU, I_WDN, I_LN2G, I_LN2B, N_IN };
static_assert(N_IN == 28, "inputs");

constexpr size_t MiB = 1u << 20;
constexpr size_t WS_CTL = 0, CTL_ZERO_BYTES = 1 * MiB;
constexpr size_t WS_MOD = 1 * MiB;
constexpr size_t WS_ROPE = 1 * MiB + 512 * 1024;
constexpr size_t WS_G = 2 * MiB;
constexpr size_t WS_ROUTE = 4 * MiB;
constexpr size_t WS_BCNT = 4 * MiB + 768 * 1024;
constexpr size_t WS_ROWMAP = 5 * MiB;
constexpr size_t WS_ROWW = 5 * MiB + 256 * 1024;
constexpr size_t WS_HC = 6 * MiB;
constexpr size_t WS_W = 14 * MiB;
constexpr size_t W_IN = 0, W_ABC = W_IN + (size_t)NP * D * 2, W_OUT = W_ABC + (size_t)D * NY * 2, W_GU = W_OUT + (size_t)D * D * 2, W_DN = W_GU + (size_t)NE * D * D * 2, W_LAYER = W_DN + (size_t)NE * D * DEXP * 2;
constexpr size_t WS_P = WS_W + 2 * W_LAYER;
constexpr size_t WS_U = WS_P + (size_t)M_ALL * NP * 2;
constexpr size_t WS_Y = WS_U + (size_t)M_ALL * D * 2;
constexpr size_t WS_END = WS_Y + (size_t)M_ALL * NY * 2;
constexpr int AS_ROWS = 40960;
constexpr size_t WS_AS = WS_P;
constexpr size_t WS_ACT = WS_AS + (size_t)AS_ROWS * D * 2;
constexpr size_t WS_F = WS_ACT + (size_t)AS_ROWS * DEXP * 2;
static_assert(WS_F + (size_t)M_ALL * 2 * D * 2 <= WS_U, "MoE buffers overlay P");
static_assert(W_LAYER == 69730304 && WS_W % 256 == 0 && WS_P % 256 == 0 && WS_U % 256 == 0 && WS_Y % 256 == 0, "map");
constexpr size_t WS_HF = WS_U, WS_HB = WS_U + (size_t)M_ALL * 512 * 2;
constexpr int CW_TMO = 0, CW_CODE = 1;
constexpr int CW_CNT = 256;
constexpr int CW_WQ = 2560;
constexpr int CW_BAR = 4096;

constexpr int RING_BYTES = 131072, LDSCTL_OFF = RING_BYTES, MISC_OFF = LDSCTL_OFF + 320, LDS_BYTES = 147456;

#define GAS __attribute__((address_space(1)))
#define LAS __attribute__((address_space(3)))
typedef unsigned short bf16;
typedef unsigned v4u __attribute__((ext_vector_type(4)));
typedef unsigned v2u __attribute__((ext_vector_type(2)));
typedef float f32x4 __attribute__((ext_vector_type(4)));
typedef float f32x16 __attribute__((ext_vector_type(16)));
typedef short bf16x8 __attribute__((ext_vector_type(8)));
typedef GAS unsigned gu32;
#define RLX_AGENT __ATOMIC_RELAXED, __HIP_MEMORY_SCOPE_AGENT
#define LDS_WAIT() asm volatile("s_waitcnt lgkmcnt(0)" ::: "memory")
#define VM_WAIT() asm volatile("s_waitcnt vmcnt(0)" ::: "memory")
__device__ __forceinline__ unsigned f2bf(float f) { unsigned u = __builtin_bit_cast(unsigned, f); return (u + 0x7fffu + ((u >> 16) & 1u)) >> 16; }
typedef float f32x2_t __attribute__((ext_vector_type(2)));
typedef __bf16 bf16x2_t __attribute__((ext_vector_type(2)));
__device__ __forceinline__ unsigned pk2(float lo, float hi) { const f32x2_t v = {lo, hi}; const bf16x2_t b = __builtin_convertvector(v, bf16x2_t); return __builtin_bit_cast(unsigned, b); }
__device__ __forceinline__ float bflo(unsigned w) { return __builtin_bit_cast(float, w << 16); }
__device__ __forceinline__ float bfhi(unsigned w) { return __builtin_bit_cast(float, w & 0xffff0000u); }
__device__ __forceinline__ float bf1(bf16 v) { return __builtin_bit_cast(float, (unsigned)v << 16); }
__device__ __forceinline__ float sigmoidf_(float x) { return 1.0f / (1.0f + __expf(-x)); }
__device__ __forceinline__ int lane_id() { int l; asm volatile("v_mbcnt_lo_u32_b32 %0, -1, 0\n\tv_mbcnt_hi_u32_b32 %0, -1, %0" : "=v"(l)); return l; }
__device__ __forceinline__ float shidx(float v, int src) { return __builtin_bit_cast(float, __builtin_amdgcn_ds_bpermute(src << 2, __builtin_bit_cast(int, v))); }
__device__ __forceinline__ float shx(float v, int mask, int lane) { return shidx(v, lane ^ mask); }
__device__ __forceinline__ float shup(float v, int o, int lane) { return shidx(v, lane >= o ? lane - o : lane); }
__device__ __forceinline__ float wave_sum(float v, int lane) {
#pragma unroll
    for (int o = 1; o < 64; o <<= 1) v += shx(v, o, lane);
    return v;
}
__device__ __forceinline__ void unpack8(v4u w, float (&f)[8]) { f[0] = bflo(w.x); f[1] = bfhi(w.x); f[2] = bflo(w.y); f[3] = bfhi(w.y); f[4] = bflo(w.z); f[5] = bfhi(w.z); f[6] = bflo(w.w); f[7] = bfhi(w.w); }
__device__ __forceinline__ v4u pack8(const float (&f)[8]) { v4u w; w.x = pk2(f[0], f[1]); w.y = pk2(f[2], f[3]); w.z = pk2(f[4], f[5]); w.w = pk2(f[6], f[7]); return w; }

#define XB_TMO      128
#define XB_XCNT(j)  (256  + 64 * (j))
#define XB_XSUB(j)  (1280 + 64 * (j))
#define XB_XGEN(j)  (2304 + 64 * (j))
#define XB_TOP      3328
#define XB_TOPGEN   3392
#define XCD_BAR_WORDS 3456
#define XB_SPIN_CAP (1u << 18)

__device__ __forceinline__ unsigned xb_ld(unsigned* p)              { return __hip_atomic_load(p, __ATOMIC_RELAXED, __HIP_MEMORY_SCOPE_AGENT); }
__device__ __forceinline__ unsigned xb_add(unsigned* p, unsigned) { unsigned one; asm volatile("v_mov_b32 %0, 1" : "=v"(one));
    return __hip_atomic_fetch_add(p, one, __ATOMIC_RELAXED, __HIP_MEMORY_SCOPE_AGENT); }
__device__ __forceinline__ unsigned xb_xcc_id() { return (unsigned)__builtin_amdgcn_s_getreg((3 << 11) | 20) & 0xFu; }
#define XB_SPIN(cond, bar) do { unsigned _sp = 0; while (cond) { __builtin_amdgcn_s_sleep(1); \
    if ((++_sp & 255u) == 0u) { if (xb_ld(&(bar)[XB_TMO])) break; if (_sp > XB_SPIN_CAP) { (void)xb_add(&(bar)[XB_TMO], 1u); break; } } } } while (0)

struct XcdBarrier {
    bool w0;
    unsigned* bar; unsigned x;
    volatile LAS unsigned* st;
};

__device__ __forceinline__ XcdBarrier xcd_barrier_post(unsigned* bar, volatile LAS unsigned* st) {
    XcdBarrier b; b.w0 = false; b.bar = bar; b.x = xb_xcc_id(); b.st = st;
    if (threadIdx.x == 0) (void)xb_add(&bar[XB_XCNT(b.x)], 1u);
    return b;
}
__device__ __forceinline__ void xcd_barrier_complete(unsigned* bar, unsigned x, unsigned& nloc, unsigned& nx) {
    const unsigned G = gridDim.x * gridDim.y * gridDim.z;
    unsigned sum, cnt, mine, sp = 0u;
    for (;;) {
        sum = 0u; cnt = 0u; mine = 0u;
#pragma unroll
        for (unsigned j = 0; j < 16; ++j) { const unsigned c = xb_ld(&bar[XB_XCNT(j)]); sum += c; cnt += (c > 0u) ? 1u : 0u; mine = (j == x) ? c : mine; }
        if (sum == G) break;
        __builtin_amdgcn_s_sleep(1);
        if ((++sp & 255u) == 0u) { if (xb_ld(&bar[XB_TMO])) break; if (sp > XB_SPIN_CAP) { (void)xb_add(&bar[XB_TMO], 1u); break; } }
    }
    nloc = mine > 0u ? mine : 1u; nx = cnt > 0u ? cnt : 1u;
}

__device__ __forceinline__ void xcd_barrier(const XcdBarrier& b) {
    asm volatile("s_waitcnt vmcnt(0)" ::: "memory");
    __syncthreads();
    if (b.w0 && lane_id() == 0) {
        unsigned* bar = b.bar;
        __builtin_amdgcn_s_waitcnt(0);
        unsigned nloc = b.st[0], nx = b.st[1];
        if (nloc == 0u) { xcd_barrier_complete(bar, b.x, nloc, nx); b.st[0] = nloc; b.st[1] = nx; }
        const unsigned old = xb_add(&bar[XB_XSUB(b.x)], 1u);
        const unsigned gen = old / nloc;
        if (old + 1u == (gen + 1u) * nloc) {
            __builtin_amdgcn_fence(__ATOMIC_RELEASE, "agent");
            asm volatile("s_waitcnt vmcnt(0)" ::: "memory");
            const unsigned og = xb_add(&bar[XB_TOP], 1u);
            const unsigned tg = og / nx;
            if (og + 1u == (tg + 1u) * nx) xb_add(&bar[XB_TOPGEN], 1u);
            else XB_SPIN(xb_ld(&bar[XB_TOPGEN]) == tg, bar);
            __builtin_amdgcn_fence(__ATOMIC_ACQUIRE, "agent");
            xb_add(&bar[XB_XGEN(b.x)], 1u);
            asm volatile("s_waitcnt vmcnt(0)" ::: "memory");
        } else {
            XB_SPIN(xb_ld(&bar[XB_XGEN(b.x)]) == gen, bar);
            __builtin_amdgcn_fence(__ATOMIC_ACQUIRE, "agent");
            asm volatile("s_waitcnt vmcnt(0)" ::: "memory");
        }
    }
    __syncthreads();
}

struct Ctx {
    LAS unsigned char* lds;
    volatile LAS unsigned* MISC;
    unsigned* ctl;
    int tid, lane, wave, vcu, G;
    const float* const* in; float* out; unsigned char* ws;
};
__device__ __forceinline__ bf16* wt(const Ctx& F, int l, size_t off) { return (bf16*)(F.ws + WS_W + (size_t)l * W_LAYER + off); }
__device__ __forceinline__ float* hrow(const Ctx& F, int r) { return r < M_LAT ? F.out + (size_t)r * D : (float*)(F.ws + WS_HC) + (size_t)(r - M_LAT) * D; }
__device__ __forceinline__ const float* xrow(const Ctx& F, int r) { return r < M_LAT ? F.in[I_X] + (size_t)r * D : F.in[I_CTX] + (size_t)(r - M_LAT) * D; }
__device__ __forceinline__ int modrow(int r) { return r < M_LAT ? (r >> 11) : 8; }
__device__ __forceinline__ const float* modp(const Ctx& F, int l, int mr) { return (const float*)(F.ws + WS_MOD) + (size_t)(l * 9 + mr) * 6144; }

__device__ __forceinline__ void load_row(const float* p, int lane, f32x4 (&v)[4]) {
#pragma unroll
    for (int j = 0; j < 4; ++j) v[j] = *(const f32x4*)(p + 4 * lane + 256 * j);
}
__device__ __forceinline__ void store_row(float* p, int lane, const f32x4 (&v)[4]) {
#pragma unroll
    for (int j = 0; j < 4; ++j) *(f32x4*)(p + 4 * lane + 256 * j) = v[j];
}
__device__ __forceinline__ void ln_row(f32x4 (&v)[4], const float* g, const float* b, int lane) {
    float s = 0.f;
#pragma unroll
    for (int j = 0; j < 4; ++j) s += (v[j].x + v[j].y) + (v[j].z + v[j].w);
    const float mean = wave_sum(s, lane) * (1.f / D); float s2 = 0.f;
#pragma unroll
    for (int j = 0; j < 4; ++j) { v[j] = v[j] - mean; s2 += (v[j].x * v[j].x + v[j].y * v[j].y) + (v[j].z * v[j].z + v[j].w * v[j].w); }
    const float rstd = 1.f / sqrtf(wave_sum(s2, lane) * (1.f / D) + LN_EPS);
#pragma unroll
    for (int j = 0; j < 4; ++j) { const f32x4 gg = *(const f32x4*)(g + 4 * lane + 256 * j), bb = *(const f32x4*)(b + 4 * lane + 256 * j); v[j] = v[j] * rstd * gg + bb; }
}
__device__ __forceinline__ void emit_u(const f32x4 (&h)[4], const float* sh, const float* sc, bf16* urow, int lane, f32x4 (&u)[4]) {
#pragma unroll
    for (int j = 0; j < 4; ++j) { const f32x4 s1 = *(const f32x4*)(sc + 4 * lane + 256 * j), s0 = *(const f32x4*)(sh + 4 * lane + 256 * j); u[j] = h[j] * (1.0f + s1) + s0;
        v2u w; w.x = pk2(u[j].x, u[j].y); w.y = pk2(u[j].z, u[j].w); *(v2u*)(urow + 4 * lane + 256 * j) = w; }
}
__device__ __forceinline__ void stage_w16(const Ctx& F, const float* W, int ld, LAS float* Wt) {
    for (int idx = F.tid; idx < 1024 * 16; idx += NWAVES * 64) { const int k = idx >> 4, e = idx & 15; Wt[e * 1024 + k] = W[(size_t)k * ld + e]; }
}
__device__ __forceinline__ int elane(int lane) { return ((lane >> 5) & 1) * 8 + ((lane >> 4) & 1) * 4 + ((lane >> 3) & 1) * 2 + ((lane >> 2) & 1); }
__device__ __forceinline__ float dot16r(const f32x4 (&u)[4], const LAS float* Wt, int lane) {
    const LAS float* wl = Wt + 4 * lane; float o[8]; const bool hi5 = (lane & 32) != 0;
#pragma unroll
    for (int k = 0; k < 8; ++k) { float s0 = 0.f, s1 = 0.f;
#pragma unroll
        for (int j = 0; j < 4; ++j) { const f32x4 w0 = *(const LAS f32x4*)(wl + k * 1024 + 256 * j), w1 = *(const LAS f32x4*)(wl + (k + 8) * 1024 + 256 * j);
            s0 += (u[j].x * w0.x + u[j].y * w0.y) + (u[j].z * w0.z + u[j].w * w0.w); s1 += (u[j].x * w1.x + u[j].y * w1.y) + (u[j].z * w1.z + u[j].w * w1.w); }
        const float send = hi5 ? s0 : s1, keep = hi5 ? s1 : s0; o[k] = keep + shx(send, 32, lane);
        asm volatile("" ::: "memory"); }
    { const bool hi = (lane & 16) != 0;
#pragma unroll
        for (int k = 0; k < 4; ++k) { const float send = hi ? o[k] : o[k + 4], keep = hi ? o[k + 4] : o[k]; o[k] = keep + shx(send, 16, lane); } }
    { const bool hi = (lane & 8) != 0;
#pragma unroll
        for (int k = 0; k < 2; ++k) { const float send = hi ? o[k] : o[k + 2], keep = hi ? o[k + 2] : o[k]; o[k] = keep + shx(send, 8, lane); } }
    { const bool hi = (lane & 4) != 0; const float send = hi ? o[0] : o[1], keep = hi ? o[1] : o[0]; o[0] = keep + shx(send, 4, lane); }
    o[0] += shx(o[0], 2, lane); o[0] += shx(o[0], 1, lane);
    return o[0];
}
__device__ __forceinline__ void emit_layer_input(const Ctx& F, int l, int r, const f32x4 (&h)[4]) {
    const float* mp = modp(F, l, modrow(r)); f32x4 u[4];
    emit_u(h, mp + 0, mp + 1024, (bf16*)(F.ws + WS_U) + (size_t)r * D, F.lane, u);
    const float gv = dot16r(u, (const LAS float*)F.lds, F.lane);
    if ((F.lane & 3) == 0) ((float*)(F.ws + WS_G))[(size_t)r * 16 + elane(F.lane)] = gv;
}

__device__ __forceinline__ void tr_item(const float* W, int ldw, int k0, int n0, bf16* WT, int ldt, int drow0, int dk0, LAS float* scr, int lane) {
#pragma unroll 8
    for (int i = 0; i < 32; ++i) { const int kk = 2 * i + (lane >> 5); scr[kk * 33 + (lane & 31)] = W[(size_t)(k0 + kk) * ldw + n0 + (lane & 31)]; }
    LDS_WAIT(); asm volatile("" ::: "memory");
    const int c = lane & 7;
#pragma unroll
    for (int j = 0; j < 4; ++j) { const int n = (lane >> 3) + 8 * j; const LAS float* s = scr + (8 * c) * 33 + n;
        v4u o; o.x = pk2(s[0 * 33], s[1 * 33]); o.y = pk2(s[2 * 33], s[3 * 33]); o.z = pk2(s[4 * 33], s[5 * 33]); o.w = pk2(s[6 * 33], s[7 * 33]);
        *(v4u*)(WT + (size_t)(drow0 + n) * ldt + dk0 + k0 + 8 * c) = o; }
    LDS_WAIT(); asm volatile("" ::: "memory");
}
constexpr int CV_IN = 16 * (NP / 32), CV_ABC = 3 * 8 * 32, CV_OUT = 16 * 32, CV_GU = NE * 16 * 32, CV_DN = NE * 8 * 32, CV_LAYER = CV_IN + CV_ABC + CV_OUT + CV_GU + CV_DN;
__device__ __forceinline__ void convert_item(const Ctx& F, int l, int it, LAS float* scr) {
    const int lane = F.lane;
    if (it < CV_IN) { const int kb = it / (NP / 32), nb = it % (NP / 32), n0 = 32 * nb;
        tr_item(F.in[I_WIN] + (size_t)l * D * D_IN, D_IN, 64 * kb, n0 < PBG ? n0 : n0 + 16, wt(F, l, W_IN), D, n0, 0, scr, lane); return; }
    it -= CV_IN;
    if (it < CV_ABC) { const int br = it / 256, r = it % 256, kb = r / 32, nb = r % 32;
        if (br == 0) tr_item(F.in[I_WA] + (size_t)l * 512 * D, D, 64 * kb, 32 * nb, wt(F, l, W_ABC), NY, 32 * nb, 0, scr, lane);
        else if (br == 1) tr_item(F.in[I_WB] + (size_t)l * 512 * D, D, 64 * kb, 32 * nb, wt(F, l, W_ABC), NY, 32 * nb, 512, scr, lane);
        else tr_item(F.in[I_WC] + (size_t)l * 512 * D, D, 64 * kb, 32 * nb, wt(F, l, W_ABC), NY, 32 * nb, 1024, scr, lane);
        return; }
    it -= CV_ABC;
    if (it < CV_OUT) { const int kb = it / 32, nb = it % 32; tr_item(F.in[I_WOUT] + (size_t)l * D * D, D, 64 * kb, 32 * nb, wt(F, l, W_OUT), D, 32 * nb, 0, scr, lane); return; }
    it -= CV_OUT;
    if (it < CV_GU) { const int e = it / 512, r = it % 512, kb = r / 32, nb = r % 32, n0 = 32 * nb;
        const int dr = n0 < 512 ? (n0 / 128) * 256 + (n0 % 128) : ((n0 - 512) / 128) * 256 + 128 + ((n0 - 512) % 128);
        tr_item(F.in[I_WGU] + (size_t)(l * NE + e) * D * D, D, 64 * kb, n0, wt(F, l, W_GU) + (size_t)e * D * D, D, dr, 0, scr, lane); return; }
    it -= CV_GU;
    { const int e = it / 256, r = it % 256, kb = r / 32, nb = r % 32;
        tr_item(F.in[I_WDN] + (size_t)(l * NE + e) * DEXP * D, D, 64 * kb, 32 * nb, wt(F, l, W_DN) + (size_t)e * D * DEXP, DEXP, 32 * nb, 0, scr, lane); }
}
__device__ __forceinline__ void p0_prologue(const Ctx& F) {
    if (F.vcu < 192) {
        LAS float* S = (LAS float*)F.lds; LAS float* red = (LAS float*)(F.lds + 36864);
        for (int idx = F.tid; idx < 9 * D; idx += NWAVES * 64) { const int r = idx >> 10, k = idx & 1023; const float v = r < 8 ? F.in[I_C][r * D + k] : F.in[I_CCTX][k]; S[idx] = v * sigmoidf_(v); }
        __syncthreads();
        const int l = F.vcu / 96, n0 = (F.vcu % 96) * 64;
        float acc[9];
#pragma unroll
        for (int r = 0; r < 9; ++r) acc[r] = 0.f;
        const float* wp = F.in[I_WMOD] + ((size_t)l * D + 128 * F.wave) * 6144 + n0 + F.lane;
#pragma unroll 4
        for (int kk = 0; kk < 128; ++kk) { const float wv = wp[(size_t)kk * 6144];
#pragma unroll
            for (int r = 0; r < 9; ++r) acc[r] += S[r * D + 128 * F.wave + kk] * wv; }
#pragma unroll
        for (int r = 0; r < 9; ++r) red[(F.wave * 9 + r) * 64 + F.lane] = acc[r];
        __syncthreads();
        for (int idx = F.tid; idx < 9 * 64; idx += NWAVES * 64) { const int r = idx >> 6, c = idx & 63; float s = 0.f;
#pragma unroll
            for (int w = 0; w < 8; ++w) s += red[(w * 9 + r) * 64 + c];
            ((float*)(F.ws + WS_MOD))[(size_t)(l * 9 + r) * 6144 + n0 + c] = s + F.in[I_BMOD][l * 6144 + n0 + c]; }
        __syncthreads();
    }
    if (F.vcu == 255) for (int idx = F.tid; idx < 1024; idx += NWAVES * 64) { const int pos = idx >> 4, i = idx & 15;
        const float inv = i == 0 ? 1.000000000e+00f : i == 1 ? 5.623413324e-01f : i == 2 ? 3.162277639e-01f : i == 3 ? 1.778279394e-01f : i == 4 ? 1.000000015e-01f : i == 5 ? 5.623413250e-02f : i == 6 ? 3.162277490e-02f : i == 7 ? 1.778279431e-02f :
                          i == 8 ? 9.999999776e-03f : i == 9 ? 5.623413250e-03f : i == 10 ? 3.162277630e-03f : i == 11 ? 1.778279431e-03f : i == 12 ? 1.000000047e-03f : i == 13 ? 5.623413017e-04f : i == 14 ? 3.162277571e-04f : 1.778279402e-04f;
        const float angf = (float)pos * inv; const double x = (double)angf;
        const double kq = __builtin_rint(x * 0.63661977236758134308); const double r = (x - kq * 1.57079632679489655800) - kq * 6.123233995736766036e-17; const int q = ((int)kq) & 3;
        const double r2 = r * r;
        const double sn = r * (1.0 + r2 * (-1.0 / 6 + r2 * (1.0 / 120 + r2 * (-1.0 / 5040 + r2 * (1.0 / 362880 + r2 * (-1.0 / 39916800 + r2 * (1.0 / 6227020800.0)))))));
        const double cs = 1.0 + r2 * (-0.5 + r2 * (1.0 / 24 + r2 * (-1.0 / 720 + r2 * (1.0 / 40320 + r2 * (-1.0 / 3628800 + r2 * (1.0 / 479001600.0 + r2 * (-1.0 / 87178291200.0)))))));
        const double c = q == 0 ? cs : q == 1 ? -sn : q == 2 ? -cs : sn, s_ = q == 0 ? sn : q == 1 ? cs : q == 2 ? -sn : -cs;
        ((float*)(F.ws + WS_ROPE))[2 * idx] = (float)c; ((float*)(F.ws + WS_ROPE))[2 * idx + 1] = (float)s_; }
    LAS float* scr = (LAS float*)(F.lds + F.wave * 16384);
    const int gw = F.vcu * NWAVES + F.wave, NGW = F.G * NWAVES;
    for (int it = gw; it < CV_LAYER; it += NGW) convert_item(F, 0, it, scr);
}
__device__ __forceinline__ void convert_layer1_on_idle(const Ctx& F, int first) {
    LAS float* scr = (LAS float*)(F.lds + F.wave * 16384);
    const int gw = ((int)blockIdx.x - first) * NWAVES + F.wave, NGW = (F.G - first) * NWAVES;
    if ((int)blockIdx.x >= first) for (int it = gw; it < CV_LAYER; it += NGW) convert_item(F, 1, it, scr);
}
__device__ __forceinline__ void p1_ln_in(const Ctx& F) {
    const int gw = F.vcu * NWAVES + F.wave, NGW = F.G * NWAVES;
    stage_w16(F, F.in[I_WIN] + SRC_MG, D_IN, (LAS float*)F.lds); __syncthreads();
    for (int r = gw; r < M_ALL; r += NGW) { f32x4 v[4]; load_row(xrow(F, r), F.lane, v);
        ln_row(v, F.in[I_LNIN_G], F.in[I_LNIN_B], F.lane); store_row(hrow(F, r), F.lane, v); emit_layer_input(F, 0, r, v); }
}

__device__ __forceinline__ void conv_unit(const Ctx& F, int l, int unit) {
    const bf16* P = (const bf16*)(F.ws + WS_P); bf16* Y = (bf16*)(F.ws + WS_Y);
    int seq0, T, t0;
    if (unit < 512) { const int b = unit >> 6; seq0 = b * SEQ; T = SEQ; t0 = (unit & 63) * 32; }
    else { const int j = unit - 512, b = j >> 3; seq0 = M_LAT + b * LCTX; T = LCTX; t0 = (j & 7) * 32; }
    const int c = F.tid;
    LAS bf16* Ut = (LAS bf16*)F.lds;
#pragma unroll 2
    for (int p = F.tid; p < 62 * 64; p += NWAVES * 64) { const int i = p >> 6, c8 = p & 63, t = t0 - 15 + i; v4u o = {0u, 0u, 0u, 0u};
        if (t >= 0 && t < T) { const bf16* pr = P + (size_t)(seq0 + t) * NP + 8 * c8; const v4u xv = *(const v4u*)(pr + PA_VAL), xg = *(const v4u*)(pr + PA_GATE);
            float a[8], g[8], uo[8]; unpack8(xv, a); unpack8(xg, g);
#pragma unroll
            for (int j = 0; j < 8; ++j) uo[j] = a[j] * sigmoidf_(g[j]);
            o = pack8(uo); }
        *(LAS v4u*)(Ut + i * 512 + 8 * c8) = o; }
    float w[31];
#pragma unroll
    for (int j = 0; j < 31; ++j) w[j] = F.in[I_CONVW][(size_t)(l * 31 + j) * 512 + c];
    const float bias = F.in[I_CONVB][l * 512 + c];
    __syncthreads();
    float u[62];
#pragma unroll
    for (int i = 0; i < 62; ++i) u[i] = bf1(Ut[i * 512 + c]);
    LAS float* Yt = (LAS float*)(F.lds + 62 * 512 * 2);
#pragma unroll
    for (int tt = 0; tt < 32; ++tt) { float y = bias;
#pragma unroll
        for (int j = 0; j < 31; ++j) y += w[j] * u[tt + j];
        Yt[tt * 512 + c] = y; }
    __syncthreads();
    const float* lg = F.in[I_CONVLN_G] + l * 512; const float* lb = F.in[I_CONVLN_B] + l * 512;
#pragma unroll
    for (int q = 0; q < 4; ++q) { const int tt = 4 * F.wave + q; float v[8]; float s = 0.f;
#pragma unroll
        for (int jj = 0; jj < 8; ++jj) { v[jj] = Yt[tt * 512 + F.lane + 64 * jj]; s += v[jj]; }
        const float mean = wave_sum(s, F.lane) * (1.f / 512.f); float s2 = 0.f;
#pragma unroll
        for (int jj = 0; jj < 8; ++jj) { v[jj] -= mean; s2 += v[jj] * v[jj]; }
        const float rstd = 1.f / sqrtf(wave_sum(s2, F.lane) * (1.f / 512.f) + LN_EPS);
        bf16* yr = Y + (size_t)(seq0 + t0 + tt) * NY;
#pragma unroll
        for (int jj = 0; jj < 8; ++jj) { const int cc = F.lane + 64 * jj; const float z = v[jj] * rstd * lg[cc] + lb[cc]; yr[cc] = (bf16)f2bf(MK_ABL_A * z * sigmoidf_(z)); } }
    __syncthreads();
}

constexpr int AT_KSTR = 72, AT_VSTR = 136, AT_KS_OFF = 0, AT_VT_OFF = 128 * AT_KSTR * 2;
constexpr int AT_QF_OFF = 36864;
constexpr int AT_ROPE_OFF = LDSCTL_OFF + 1024;
struct AttnTileRegs { v4u k1, k2, v1, v2; };
__device__ __forceinline__ void attn_tile_src(int b, int nb, int ti, int& krow0, int& tok0, bool& rope, int& mode) {
    mode = 0; tok0 = 0; rope = false;
    if (ti < 2) krow0 = M_LAT + b * LCTX + 128 * ti;
    else { const int kb = nb + ti - 3; krow0 = b * SEQ + kb * 128; tok0 = kb * 128; rope = true; mode = ti == 2 ? 1 : ti == 4 ? 2 : 0; }
}
__device__ __forceinline__ void attn_tile_load(const Ctx& F, const bf16* P, int krow0, int hk, AttnTileRegs& R) {
    { const int key = F.tid >> 2, pc = F.tid & 3, c1 = pc < 2 ? pc : pc + 2; const unsigned eo = (unsigned)((krow0 + key) * NP + PK + hk * 64 + 8 * c1);
        R.k1 = *(const v4u*)(P + eo); R.k2 = *(const v4u*)(P + eo + 16); }
    { const int key = F.tid & 127, pc = F.tid >> 7; const unsigned eo = (unsigned)((krow0 + key) * NP + PV + hk * 64 + 16 * pc);
        R.v1 = *(const v4u*)(P + eo); R.v2 = *(const v4u*)(P + eo + 8); }
}
__device__ __forceinline__ void attn_tile_store(const Ctx& F, bool rope, int tok0, const AttnTileRegs& R) {
    LAS bf16* Ks = (LAS bf16*)(F.lds + AT_KS_OFF); LAS bf16* Vt = (LAS bf16*)(F.lds + AT_VT_OFF);
    { const int key = F.tid >> 2, pc = F.tid & 3, c1 = pc < 2 ? pc : pc + 2, c2 = c1 + 2; v4u x1 = R.k1, x2 = R.k2;
        if (rope) { const int tok = tok0 + key, pos = pc < 2 ? (tok >> 6) : (tok & 63), ib = 8 * (pc & 1);
            const LAS float* rt = (const LAS float*)(F.lds + AT_ROPE_OFF) + (pos * 16 + ib) * 2;
            float a[8], b[8], oa[8], ob[8]; unpack8(x1, a); unpack8(x2, b);
#pragma unroll
            for (int j = 0; j < 8; ++j) { const float cs = rt[2 * j], sn = rt[2 * j + 1]; oa[j] = a[j] * cs - b[j] * sn; ob[j] = a[j] * sn + b[j] * cs; }
            x1 = pack8(oa); x2 = pack8(ob); }
        *(LAS v4u*)(Ks + key * AT_KSTR + 8 * c1) = x1; *(LAS v4u*)(Ks + key * AT_KSTR + 8 * c2) = x2; }
    { const int key = F.tid & 127, pc = F.tid >> 7;
        const unsigned ww[8] = {R.v1.x, R.v1.y, R.v1.z, R.v1.w, R.v2.x, R.v2.y, R.v2.z, R.v2.w};
#pragma unroll
        for (int j = 0; j < 8; ++j) { Vt[(16 * pc + 2 * j) * AT_VSTR + key] = (bf16)(ww[j] & 0xffffu); Vt[(16 * pc + 2 * j + 1) * AT_VSTR + key] = (bf16)(ww[j] >> 16); } }
}
__device__ __forceinline__ void attn_rope_to_lds(const Ctx& F) {
    for (int i = F.tid; i < 2048; i += NWAVES * 64) ((LAS float*)(F.lds + AT_ROPE_OFF))[i] = ((const float*)(F.ws + WS_ROPE))[i];
    __syncthreads();
}
__device__ __forceinline__ void attn_unit(const Ctx& F, int l, int kind, int b, int nb, int hk) {
    const bf16* P = (const bf16*)(F.ws + WS_P); bf16* Y = (bf16*)(F.ws + WS_Y);
    const LAS bf16* Ks = (const LAS bf16*)(F.lds + AT_KS_OFF); const LAS bf16* Vt = (const LAS bf16*)(F.lds + AT_VT_OFF);
    const int lane = F.lane, w = F.wave, gi = w >> 1, th = w & 1, g = 4 * hk + gi, l31 = lane & 31, h = lane >> 5;
    int qrow[2];
#pragma unroll
    for (int qb = 0; qb < 2; ++qb) {
        const int iq = 64 * th + 32 * qb + l31, tok = nb * 128 + iq;
        const int row = kind == 0 ? b * SEQ + tok : M_LAT + b * LCTX + tok; qrow[qb] = row;
        const bf16* src = P + (size_t)row * NP + PQ + g * 64 + 8 * h;
        float x[4][8];
#pragma unroll
        for (int s = 0; s < 4; ++s) { const v4u raw = *(const v4u*)(src + 16 * s); unpack8(raw, x[s]); }
        if (kind == 0) {
            const LAS float* rtr = (const LAS float*)(F.lds + AT_ROPE_OFF) + ((tok >> 6) * 16 + 8 * h) * 2; const LAS float* rtc = (const LAS float*)(F.lds + AT_ROPE_OFF) + ((tok & 63) * 16 + 8 * h) * 2;
#pragma unroll
            for (int j = 0; j < 8; ++j) { float cs = rtr[2 * j], sn = rtr[2 * j + 1]; float a = x[0][j], bb = x[1][j]; x[0][j] = a * cs - bb * sn; x[1][j] = a * sn + bb * cs;
                cs = rtc[2 * j]; sn = rtc[2 * j + 1]; a = x[2][j]; bb = x[3][j]; x[2][j] = a * cs - bb * sn; x[3][j] = a * sn + bb * cs; } }
#pragma unroll
        for (int s = 0; s < 4; ++s) {
#pragma unroll
            for (int j = 0; j < 8; ++j) x[s][j] *= 0.125f * 1.44269504f;
            const v4u pk = pack8(x[s]); *(LAS v4u*)(F.lds + AT_QF_OFF + (((w * 2 + qb) * 4 + s) * 64 + lane) * 16) = pk; }
    }
    f32x16 O[2][2];
    float mrun[2], lsum[2];
    const float sink = F.in[I_SINK][l * 8 + g] * 1.44269504f;
#pragma unroll
    for (int qb = 0; qb < 2; ++qb) { mrun[qb] = sink; lsum[qb] = h == 0 ? 1.0f : 0.0f;
#pragma unroll
        for (int db = 0; db < 2; ++db)
#pragma unroll
            for (int r = 0; r < 16; ++r) O[db][qb][r] = 0.f; }
    const int ntile = kind == 0 ? 5 : 2;
    AttnTileRegs TR; int ti = 0;
    { int krow0, tok0, mode; bool rope; attn_tile_src(b, nb, 0, krow0, tok0, rope, mode); attn_tile_load(F, P, krow0, hk, TR); }
    while (ti < ntile) {
        int krow0, tok0, mode; bool rope; attn_tile_src(b, nb, ti, krow0, tok0, rope, mode);
        int tn = ti + 1; if (kind == 0) { if (tn == 2 && nb == 0) tn = 3; if (tn == 4 && nb == SEQ / 128 - 1) tn = 5; }
        __syncthreads();
        attn_tile_store(F, rope, tok0, TR);
        __syncthreads();
        if (tn < ntile) { int kr2, tk2, md2; bool rp2; attn_tile_src(b, nb, tn, kr2, tk2, rp2, md2); attn_tile_load(F, P, kr2, hk, TR); }
        ti = tn;
#pragma unroll 1
        for (int kh = 0; kh < 2; ++kh) {
            if ((mode == 1 && th == 1 && kh == 0) || (mode == 2 && th == 0 && kh == 1)) continue;
#pragma unroll
            for (int qb = 0; qb < 2; ++qb) {
                bf16x8 qfr[4];
#pragma unroll
                for (int s = 0; s < 4; ++s) qfr[s] = *(const LAS bf16x8*)(F.lds + AT_QF_OFF + (((w * 2 + qb) * 4 + s) * 64 + lane) * 16);
                f32x16 st[2];
#pragma unroll
                for (int kb = 0; kb < 2; ++kb) {
#pragma unroll
                    for (int r = 0; r < 16; ++r) st[kb][r] = 0.f;
#pragma unroll
                    for (int s = 0; s < 4; ++s) { const bf16x8 a = *(const LAS bf16x8*)(Ks + (64 * kh + 32 * kb + l31) * AT_KSTR + 16 * s + 8 * h);
                        st[kb] = __builtin_amdgcn_mfma_f32_32x32x16_bf16(a, qfr[s], st[kb], 0, 0, 0); }
                    asm volatile("" ::: "memory"); }
                const int iq = 64 * th + 32 * qb + l31;
                float mx = -INFINITY;
                if (mode != 0) {
#pragma unroll
                    for (int kb = 0; kb < 2; ++kb)
#pragma unroll
                        for (int r = 0; r < 16; ++r) { const int key = 64 * kh + 32 * kb + (r & 3) + 8 * (r >> 2) + 4 * h;
                            const bool valid = mode == 1 ? key >= iq : key <= iq; st[kb][r] = valid ? st[kb][r] : -INFINITY; } }
#pragma unroll
                for (int kb = 0; kb < 2; ++kb)
#pragma unroll
                    for (int r = 0; r < 16; ++r) mx = fmaxf(mx, st[kb][r]);
                mx = fmaxf(mx, shx(mx, 32, lane));
                const float mnew = fmaxf(mrun[qb], mx), alpha = __builtin_amdgcn_exp2f(mrun[qb] - mnew); mrun[qb] = mnew;
                float ps = 0.f;
#pragma unroll
                for (int kb = 0; kb < 2; ++kb)
#pragma unroll
                    for (int r = 0; r < 16; ++r) { const float p = __builtin_amdgcn_exp2f(st[kb][r] - mnew); st[kb][r] = p; ps += p; }
                lsum[qb] = lsum[qb] * alpha + ps;
#pragma unroll
                for (int db = 0; db < 2; ++db)
#pragma unroll
                    for (int r = 0; r < 16; ++r) O[db][qb][r] *= alpha;
#pragma unroll
                for (int kb = 0; kb < 2; ++kb)
#pragma unroll
                    for (int s2 = 0; s2 < 2; ++s2) {
                        v4u pw; pw.x = pk2(st[kb][8 * s2 + 0], st[kb][8 * s2 + 1]); pw.y = pk2(st[kb][8 * s2 + 2], st[kb][8 * s2 + 3]);
                        pw.z = pk2(st[kb][8 * s2 + 4], st[kb][8 * s2 + 5]); pw.w = pk2(st[kb][8 * s2 + 6], st[kb][8 * s2 + 7]);
                        const bf16x8 pf = __builtin_bit_cast(bf16x8, pw);
#pragma unroll
                        for (int db = 0; db < 2; ++db) { const LAS bf16* vp = Vt + (32 * db + l31) * AT_VSTR + 64 * kh + 32 * kb + 16 * s2 + 4 * h;
                            const v2u v0 = *(const LAS v2u*)(vp), v1 = *(const LAS v2u*)(vp + 8);
                            v4u av; av.x = v0.x; av.y = v0.y; av.z = v1.x; av.w = v1.y;
                            O[db][qb] = __builtin_amdgcn_mfma_f32_32x32x16_bf16(__builtin_bit_cast(bf16x8, av), pf, O[db][qb], 0, 0, 0); }
                    }
                asm volatile("" ::: "memory");
            }
        }
    }
#pragma unroll
    for (int qb = 0; qb < 2; ++qb) {
        const float lt = lsum[qb] + shx(lsum[qb], 32, lane), inv = MK_ABL_B / lt;
        bf16* yr = Y + (size_t)qrow[qb] * NY + 512 + g * 64;
#pragma unroll
        for (int db = 0; db < 2; ++db)
#pragma unroll
            for (int gq = 0; gq < 4; ++gq) { v2u o; o.x = pk2(O[db][qb][4 * gq] * inv, O[db][qb][4 * gq + 1] * inv); o.y = pk2(O[db][qb][4 * gq + 2] * inv, O[db][qb][4 * gq + 3] * inv);
                *(v2u*)(yr + 32 * db + 8 * gq + 4 * h) = o; }
    }
}

constexpr int ML_QS = 0, ML_KS = 17408, ML_KTS = 34816, ML_VTS = 53248, ML_WS = 73984, ML_CTS = 83200, ML_SM = 122368;
constexpr int ML_QSTR = 136, ML_TSTR = 72;
static_assert(ML_SM + 5 * 256 <= RING_BYTES, "mLSTM LDS");
__device__ __forceinline__ float log_sigmoid(float x) { return fminf(x, 0.f) - log1pf(__expf(-fabsf(x))); }
__device__ __forceinline__ int ml_chunk_base(int ci, int b, int dir) { const int cc = ci < 4 ? ci : ci - 4, nc = ci < 4 ? 4 : 32, cs = dir == 0 ? cc : nc - 1 - cc; return (ci < 4 ? M_LAT + b * LCTX : b * SEQ) + 64 * cs; }
__device__ __forceinline__ void mlstm_chain(const Ctx& F, int l, int unit) {
    const int chain = unit >> 1, half = unit & 1;
    const bf16* P = (const bf16*)(F.ws + WS_P); const float* G = (const float*)(F.ws + WS_G);
    const int b = chain >> 3, hd = (chain >> 1) & 3, dir = chain & 1, lane = F.lane, w = F.wave, tid = F.tid, l15 = lane & 15, lq = lane >> 4;
    bf16* Hout = (bf16*)(F.ws + (dir == 0 ? WS_HF : WS_HB));
    LAS bf16* Qs = (LAS bf16*)(F.lds + ML_QS); LAS bf16* Ks = (LAS bf16*)(F.lds + ML_KS); LAS bf16* KTs = (LAS bf16*)(F.lds + ML_KTS); LAS bf16* VTs = (LAS bf16*)(F.lds + ML_VTS);
    LAS bf16* Ws = (LAS bf16*)(F.lds + ML_WS); LAS bf16* CTs = (LAS bf16*)(F.lds + ML_CTS);
    LAS float* GA = (LAS float*)(F.lds + ML_SM); LAS float* GG = GA + 64; LAS float* WIN = GA + 128; LAS float* EM = GA + 192; LAS float* DEN = GA + 256;
    const float gbi = F.in[I_GATEB][l * 16 + dir * 8 + hd], gbf = F.in[I_GATEB][l * 16 + dir * 8 + 4 + hd];
    __syncthreads();
#if defined(MK_PROBE_LDSCLR)
    for (int i = tid; i < RING_BYTES / 4; i += NWAVES * 64) ((LAS unsigned*)F.lds)[i] = 0u;
    __syncthreads();
#endif
    for (int i = tid; i < 80 * ML_QSTR / 2; i += NWAVES * 64) ((LAS unsigned*)CTs)[i] = 0u;
    for (int i = tid; i < 16 * ML_TSTR / 2; i += NWAVES * 64) ((LAS unsigned*)(VTs + 64 * ML_TSTR))[i] = (i < ML_TSTR / 2) ? 0x3f803f80u : 0u;
    f32x4 Cacc[5];
#pragma unroll
    for (int e = 0; e < 5; ++e) Cacc[e] = (f32x4){0.f, 0.f, 0.f, 0.f};
    float mst = 0.f;
    const int pr0 = tid & 31, c16 = tid >> 5;
    v4u nq[2], nk[2], nv[2]; float nig, nfg;
#define ML_ISSUE_LOADS(ci_) do { const int base_ = ml_chunk_base((ci_), b, dir); \
        _Pragma("unroll") for (int q = 0; q < 2; ++q) { const int jj = pr0 + 32 * q, tok = base_ + (dir == 0 ? jj : 63 - jj); const bf16* rp = P + (size_t)tok * NP + hd * 128 + 8 * c16; \
            nq[q] = *(const v4u*)(rp + PMQ); nk[q] = *(const v4u*)(rp + PMK); nv[q] = *(const v4u*)(rp + PMV); } \
        { const int tok = base_ + (dir == 0 ? lane : 63 - lane); nig = G[(size_t)tok * 16 + dir * 8 + hd]; nfg = G[(size_t)tok * 16 + dir * 8 + 4 + hd]; } } while (0)
    ML_ISSUE_LOADS(0);
    for (int ci = 0; ci < 36; ++ci) {
        const int base = ml_chunk_base(ci, b, dir);
#if defined(MK_PROBE_NOGATES)
        const float ig = gbi, lf = log_sigmoid(gbf);
#else
        const float ig = nig + gbi, lf = log_sigmoid(nfg + gbf);
#endif
        float bc = lf;
#pragma unroll
        for (int o = 1; o < 64; o <<= 1) { const float t = shup(bc, o, lane); if (lane >= o) bc += t; }
        const float a = ig - bc; float pm = a;
#pragma unroll
        for (int o = 1; o < 64; o <<= 1) { const float t = shup(pm, o, lane); if (lane >= o) pm = fmaxf(pm, t); }
        const float gj = fmaxf(mst, pm), g63 = shidx(gj, 63), b63 = shidx(bc, 63);
        const float wsc = __expf(a - g63) * KSCALE, decay = __expf(mst - g63);
        if (w == 0) { GA[lane] = a; GG[lane] = gj; WIN[lane] = __expf(mst - gj); EM[lane] = __expf(-(bc + gj)); }
#pragma unroll
        for (int q = 0; q < 2; ++q) { const int jj = pr0 + 32 * q;
            *(LAS v4u*)(Qs + jj * ML_QSTR + 8 * c16) = nq[q]; *(LAS v4u*)(Ks + jj * ML_QSTR + 8 * c16) = nk[q];
            const float ws = shidx(wsc, jj); float kf[8]; unpack8(nk[q], kf);
            const unsigned vv[4] = {nv[q].x, nv[q].y, nv[q].z, nv[q].w};
#pragma unroll
            for (int j = 0; j < 8; ++j) KTs[(8 * c16 + j) * ML_TSTR + jj] = (bf16)f2bf(kf[j] * ws);
            if ((c16 >> 3) == half) {
#pragma unroll
            for (int j = 0; j < 4; ++j) { VTs[(8 * (c16 & 7) + 2 * j) * ML_TSTR + jj] = (bf16)(vv[j] & 0xffffu); VTs[(8 * (c16 & 7) + 2 * j + 1) * ML_TSTR + jj] = (bf16)(vv[j] >> 16); } } }
        if (ci + 1 < 36) ML_ISSUE_LOADS(ci + 1);
        __syncthreads();
        const int rb = w >> 1, eb0 = (w & 1) ? 3 : 0, neb = (w & 1) ? 2 : 3;
        f32x4 inter[3];
        { f32x4 sa[2] = {(f32x4){0.f, 0.f, 0.f, 0.f}, (f32x4){0.f, 0.f, 0.f, 0.f}}; bf16x8 qf[4];
#pragma unroll
            for (int kk = 0; kk < 4; ++kk) { qf[kk] = *(const LAS bf16x8*)(Qs + (16 * rb + l15) * ML_QSTR + 32 * kk + 8 * lq);
#pragma unroll
                for (int cb = 0; cb < 2; ++cb) { const bf16x8 bfr = *(const LAS bf16x8*)(Ks + (16 * (2 * (w & 1) + cb) + l15) * ML_QSTR + 32 * kk + 8 * lq);
                    sa[cb] = __builtin_amdgcn_mfma_f32_16x16x32_bf16(qf[kk], bfr, sa[cb], 0, 0, 0); } }
#pragma unroll
            for (int i = 0; i < 3; ++i) { inter[i] = (f32x4){0.f, 0.f, 0.f, 0.f}; if (i < neb) {
#pragma unroll
                for (int kk = 0; kk < 4; ++kk) inter[i] = __builtin_amdgcn_mfma_f32_16x16x32_bf16(qf[kk], *(const LAS bf16x8*)(CTs + (16 * (eb0 + i) + l15) * ML_QSTR + 32 * kk + 8 * lq), inter[i], 0, 0, 0); } }
#pragma unroll
            for (int cb = 0; cb < 2; ++cb) { const int s = 16 * (2 * (w & 1) + cb) + l15; const float as = GA[s];
#pragma unroll
                for (int r = 0; r < 4; ++r) { const int j = 16 * rb + 4 * lq + r; const float wv = s <= j ? sa[cb][r] * KSCALE * __expf(as - GG[j]) : 0.f; Ws[j * ML_TSTR + s] = (bf16)f2bf(wv); } } }
        __syncthreads();
        f32x4 num[3]; float em[4];
        { bf16x8 wf[2];
#pragma unroll
            for (int kk = 0; kk < 2; ++kk) wf[kk] = *(const LAS bf16x8*)(Ws + (16 * rb + l15) * ML_TSTR + 32 * kk + 8 * lq);
            float win[4];
#pragma unroll
            for (int r = 0; r < 4; ++r) { win[r] = WIN[16 * rb + 4 * lq + r]; em[r] = EM[16 * rb + 4 * lq + r]; }
#pragma unroll
            for (int i = 0; i < 3; ++i) { if (i < neb) { const int eb = eb0 + i; f32x4 aw = (f32x4){0.f, 0.f, 0.f, 0.f};
#pragma unroll
                for (int kk = 0; kk < 2; ++kk) aw = __builtin_amdgcn_mfma_f32_16x16x32_bf16(wf[kk], *(const LAS bf16x8*)(VTs + (16 * eb + l15) * ML_TSTR + 32 * kk + 8 * lq), aw, 0, 0, 0);
#pragma unroll
                for (int r = 0; r < 4; ++r) num[i][r] = aw[r] + win[r] * inter[i][r];
                if (eb == 4 && l15 == 0) {
#pragma unroll
                    for (int r = 0; r < 4; ++r) DEN[16 * rb + 4 * lq + r] = num[i][r]; } } } }
        { bf16x8 kf[2];
#pragma unroll
            for (int kk = 0; kk < 2; ++kk) kf[kk] = *(const LAS bf16x8*)(KTs + (16 * w + l15) * ML_TSTR + 32 * kk + 8 * lq);
#pragma unroll
            for (int eb = 0; eb < 5; ++eb) { Cacc[eb] = Cacc[eb] * decay;
#pragma unroll
                for (int kk = 0; kk < 2; ++kk) Cacc[eb] = __builtin_amdgcn_mfma_f32_16x16x32_bf16(kf[kk], *(const LAS bf16x8*)(VTs + (16 * eb + l15) * ML_TSTR + 32 * kk + 8 * lq), Cacc[eb], 0, 0, 0);
                v2u o; o.x = pk2(Cacc[eb][0], Cacc[eb][1]); o.y = pk2(Cacc[eb][2], Cacc[eb][3]);
                *(LAS v2u*)(CTs + (16 * eb + l15) * ML_QSTR + 16 * w + 4 * lq) = o; } }
        mst = b63 + g63;
        __syncthreads();
        { float dn[4];
#pragma unroll
            for (int r = 0; r < 4; ++r) dn[r] = 1.0f / fmaxf(fabsf(DEN[16 * rb + 4 * lq + r]), em[r]);
#pragma unroll
            for (int i = 0; i < 3; ++i) { if (i < neb && eb0 + i < 4) { const int e = 64 * half + 16 * (eb0 + i) + l15;
#pragma unroll
                for (int r = 0; r < 4; ++r) { const int j = 16 * rb + 4 * lq + r, tok = base + (dir == 0 ? j : 63 - j); Hout[(size_t)tok * 512 + hd * 128 + e] = (bf16)f2bf(num[i][r] * dn[r]); } } } }
    }
#undef ML_ISSUE_LOADS
}

__device__ __forceinline__ void c0_combine(const Ctx& F, int l, int nrows) {
    const bf16* P = (const bf16*)(F.ws + WS_P); const bf16* HF = (const bf16*)(F.ws + WS_HF); const bf16* HB = (const bf16*)(F.ws + WS_HB); bf16* Y = (bf16*)(F.ws + WS_Y);
    const int gw = F.vcu * NWAVES + F.wave, NGW = F.G * NWAVES, lane = F.lane;
    for (int it = gw; it < nrows * 4; it += NGW) { const int r = it >> 2, hd = it & 3, col = hd * 128 + 2 * lane;
        const unsigned a = *(const unsigned*)(HF + (size_t)r * 512 + col), bq = *(const unsigned*)(HB + (size_t)r * 512 + col), mo = *(const unsigned*)(P + (size_t)r * NP + PMO + col);
#if defined(MK_PROBE_C0)
        float x0 = bflo(mo) + 0.f * (bflo(a) + bflo(bq)) * 0.f, x1 = bfhi(mo);
#else
        float x0 = bflo(a) + bflo(bq), x1 = bfhi(a) + bfhi(bq);
#endif
        const float mean = wave_sum(x0 + x1, lane) * (1.f / 128.f); x0 -= mean; x1 -= mean;
        const float rstd = 1.f / sqrtf(wave_sum(x0 * x0 + x1 * x1, lane) * (1.f / 128.f) + LN_EPS);
        const float g0 = F.in[I_NORMG][l * 512 + col], g1 = F.in[I_NORMG][l * 512 + col + 1];
        *(unsigned*)(Y + (size_t)r * NY + 1024 + col) = pk2(MK_ABL_C * sigmoidf_(bflo(mo)) * x0 * rstd * g0, MK_ABL_C * sigmoidf_(bfhi(mo)) * x1 * rstd * g1); }
}

struct EpiProj {
    static constexpr bool PERM = true, AFTER_DRAIN = false, RESCALE = false;
    bf16* O; int ldc;
    __device__ __forceinline__ void operator()(const pg8::f32x4 (&acc)[2][2][4][2], const pg8::Unit& u, int wr, int wc, int fr, int fq) const {
        const int row0 = u.pm * 256 + wr * 64 + fr, col0 = u.pn * 256 + wc * 32 + 8 * fq;
#pragma unroll
        for (int ai = 0; ai < 2; ++ai)
#pragma unroll
            for (int m = 0; m < 4; ++m) { bf16* rowp = O + (size_t)(row0 + ai * 128 + m * 16) * ldc + col0;
#pragma unroll
                for (int bj = 0; bj < 2; ++bj) { const pg8::f32x4 v0 = acc[ai][bj][m][0], v1 = acc[ai][bj][m][1];
                    v4u w; w.x = pk2(v0[0], v0[1]); w.y = pk2(v0[2], v0[3]); w.z = pk2(v1[0], v1[1]); w.w = pk2(v1[2], v1[3]);
                    *(v4u*)(rowp + bj * 128) = w; } }
    }
};
__device__ __forceinline__ float gate_e(float x) { return __builtin_amdgcn_exp2f(fminf(fmaxf(x, -30.f), 30.f) * -1.44269504f); }
struct EpiMerge {
    static constexpr bool PERM = true, AFTER_DRAIN = false, RESCALE = true;
    const bf16* P; bf16* Z;
    __device__ __forceinline__ void rescale(pg8::f32x4 (&acc)[2][2][4][2], const pg8::Unit& u, int step, int wr, int wc, int fr, int fq) const {
        const int row0 = u.pm * 256 + wr * 64 + fr, col0 = u.pn * 256 + wc * 32 + 8 * fq;
        const int cn = PBG + (step - 1) * 1024, cd = PBG + step * 1024;
#pragma unroll
        for (int ai = 0; ai < 2; ++ai)
#pragma unroll
            for (int m = 0; m < 4; ++m) { const bf16* rowp = P + (size_t)(row0 + ai * 128 + m * 16) * NP + col0;
#pragma unroll
                for (int bj = 0; bj < 2; ++bj) { const v4u xn = *(const v4u*)(rowp + cn + bj * 128), xd = *(const v4u*)(rowp + cd + bj * 128);
                    float a[8], b[8]; unpack8(xn, a); unpack8(xd, b);
#pragma unroll
                    for (int i = 0; i < 8; ++i) { const float ratio = (1.0f + gate_e(b[i])) * __builtin_amdgcn_rcpf(1.0f + gate_e(a[i])); acc[ai][bj][m][i >> 2][i & 3] *= ratio; } }
                asm volatile("" ::: "memory"); }
    }
    __device__ __forceinline__ void operator()(const pg8::f32x4 (&acc)[2][2][4][2], const pg8::Unit& u, int wr, int wc, int fr, int fq) const {
        const int row0 = u.pm * 256 + wr * 64 + fr, col0 = u.pn * 256 + wc * 32 + 8 * fq;
#pragma unroll
        for (int ai = 0; ai < 2; ++ai)
#pragma unroll
            for (int m = 0; m < 4; ++m) { const size_t r = (size_t)(row0 + ai * 128 + m * 16);
#pragma unroll
                for (int bj = 0; bj < 2; ++bj) { const v4u xc = *(const v4u*)(P + r * NP + PBG + 2048 + col0 + bj * 128); float c[8], o[8]; unpack8(xc, c);
#pragma unroll
                    for (int i = 0; i < 8; ++i) o[i] = acc[ai][bj][m][i >> 2][i & 3] * __builtin_amdgcn_rcpf(1.0f + gate_e(c[i]));
                    *(v4u*)(Z + r * D + col0 + bj * 128) = pack8(o); }
                asm volatile("" ::: "memory"); }
    }
};
struct EpiResid {
    static constexpr bool PERM = false, AFTER_DRAIN = false, RESCALE = false;
    float* out; float* hc; const float* mod_l;
    __device__ __forceinline__ void operator()(const pg8::f32x4 (&acc)[2][2][4][2], const pg8::Unit& u, int wr, int wc, int fr, int fq) const {
        const int rt = u.pm * 256; float* hb = rt < M_LAT ? out + (size_t)rt * D : hc + (size_t)(rt - M_LAT) * D;
        const float* g1 = mod_l + (size_t)(rt < M_LAT ? (rt >> 11) : 8) * 6144 + 2048;
        const int rl0 = wr * 64 + fr, col0 = u.pn * 256 + wc * 32 + 4 * fq;
#pragma unroll
        for (int ai = 0; ai < 2; ++ai)
#pragma unroll
            for (int m = 0; m < 4; ++m) { float* rowp = hb + (size_t)(rl0 + ai * 128 + m * 16) * D + col0;
#pragma unroll
                for (int bj = 0; bj < 2; ++bj)
#pragma unroll
                    for (int n = 0; n < 2; ++n) { const pg8::f32x4 g = *(const pg8::f32x4*)(g1 + col0 + bj * 128 + n * 16), h = *(const pg8::f32x4*)(rowp + bj * 128 + n * 16);
                        *(pg8::f32x4*)(rowp + bj * 128 + n * 16) = h * ALPHA + g * acc[ai][bj][m][n]; } }
    }
};
struct EpiSwiGLU {
    static constexpr bool PERM = true, AFTER_DRAIN = false, RESCALE = false;
    bf16* act;
    __device__ __forceinline__ void operator()(const pg8::f32x4 (&acc)[2][2][4][2], const pg8::Unit& u, int wr, int wc, int fr, int fq) const {
        const int row0 = u.pm * 256 + wr * 64 + fr, col0 = (u.pn & 3) * 128 + wc * 32 + 8 * fq;
#pragma unroll
        for (int ai = 0; ai < 2; ++ai)
#pragma unroll
            for (int m = 0; m < 4; ++m) { float o[8];
#pragma unroll
                for (int i = 0; i < 8; ++i) { const float g = acc[ai][0][m][i >> 2][i & 3], uu = acc[ai][1][m][i >> 2][i & 3]; o[i] = g * sigmoidf_(g) * uu; }
                *(v4u*)(act + (size_t)(row0 + ai * 128 + m * 16) * DEXP + col0) = pack8(o); }
    }
};
struct EpiScatter {
    static constexpr bool PERM = true, AFTER_DRAIN = false, RESCALE = false;
    const int* rowmap; const float* roww; bf16* Fo;
    __device__ __forceinline__ void operator()(const pg8::f32x4 (&acc)[2][2][4][2], const pg8::Unit& u, int wr, int wc, int fr, int fq) const {
        const int row0 = u.pm * 256 + wr * 64 + fr, col0 = (u.pn & 3) * 256 + wc * 32 + 8 * fq;
#pragma unroll
        for (int ai = 0; ai < 2; ++ai)
#pragma unroll
            for (int m = 0; m < 4; ++m) { const int sr = row0 + ai * 128 + m * 16, dst = rowmap[sr]; const float wgt = roww[sr];
                if (dst >= 0) {
#pragma unroll
                    for (int bj = 0; bj < 2; ++bj) { pg8::f32x4 v0 = acc[ai][bj][m][0] * wgt, v1 = acc[ai][bj][m][1] * wgt;
#if defined(MK_PROBE_SCATTER) && MK_PROBE_SCATTER == 1
                        v0 = (pg8::f32x4){wgt, wgt, wgt, wgt}; v1 = v0;
#elif defined(MK_PROBE_SCATTER) && MK_PROBE_SCATTER == 2
                        v0 = acc[ai][bj][m][0]; v1 = acc[ai][bj][m][1];
#endif
                        v4u w; w.x = pk2(v0[0], v0[1]); w.y = pk2(v0[2], v0[3]); w.z = pk2(v1[0], v1[1]); w.w = pk2(v1[2], v1[3]);
                        *(v4u*)(Fo + (size_t)dst * D + col0 + bj * 128) = w; } } }
    }
};
struct ProjOrderLast {
    pg8::StaticOrder lat; int G, c;
    __device__ __forceinline__ void init(int G_, int c_) { lat.init(M_LAT, NP, G_, c_); G = G_; c = c_; }
    __device__ __forceinline__ bool next(int i, pg8::Unit& u) const {
        if (lat.next(i, u)) return true;
        const long L = (long)i * G + c - lat.nwg; if (L < 0 || L >= 8 * 7) return false;
        u.pm = 64 + (int)(L % 8); u.pn = 6 + (int)(L / 8); return true;
    }
    __device__ __forceinline__ void a_ready(const pg8::Unit&) const {}
    __device__ __forceinline__ void done(const pg8::Unit&) const {}
};
struct MoeOrder {
    int G, c; const LAS int* toff;
    __device__ __forceinline__ bool next(int i, pg8::Unit& u) const {
        const long L = (long)i * G + c; const int nt = toff[16]; if (L >= (long)nt * 4) return false;
        const int pm = (int)(L >> 2), ct = (int)(L & 3); int e = 0;
#pragma unroll
        for (int k = 1; k < 16; ++k) e += (pm >= toff[k]) ? 1 : 0;
        u.pm = pm; u.pn = e * 4 + ct; return true;
    }
    __device__ __forceinline__ void a_ready(const pg8::Unit&) const {}
    __device__ __forceinline__ void done(const pg8::Unit&) const {}
};
__device__ __forceinline__ void moe_toff(const Ctx& F, int l, LAS int* toff) {
    if (F.tid == 0) { int acc = 0; const int* tot = (const int*)(F.ws + WS_BCNT) + 2 * 4096 + l * 16;
        for (int e = 0; e < 16; ++e) { toff[e] = acc; acc += (tot[e] + 255) >> 8; }
        toff[16] = acc; }
    __syncthreads();
}

__device__ __forceinline__ void e_ln1_route(const Ctx& F, int l, int nrows) {
    const int rpb = nrows / 256, row0 = F.vcu * rpb;
    LAS int* lcnt = (LAS int*)F.lds; LAS int* rinfo = lcnt + 16; LAS float* rwt = (LAS float*)(lcnt + 16 + 160); LAS int* lrk = lcnt + 16 + 320;
    LAS float* LG = (LAS float*)(F.lds + 2048);
    stage_w16(F, F.in[I_WROUTER], 16, (LAS float*)(F.lds + 8192));
    __syncthreads();
    for (int i = F.wave; i < rpb; i += NWAVES) { const int r = row0 + i;
        f32x4 v[4]; float* hp = hrow(F, r); load_row(hp, F.lane, v);
        ln_row(v, F.in[I_LN1G] + l * D, F.in[I_LN1B] + l * D, F.lane); store_row(hp, F.lane, v);
        const float* mp = modp(F, l, modrow(r)); f32x4 u[4];
        emit_u(v, mp + 3072, mp + 4096, (bf16*)(F.ws + WS_U) + (size_t)r * D, F.lane, u);
        const float lgv = dot16r(u, (const LAS float*)(F.lds + 8192), F.lane);
        if ((F.lane & 3) == 0) LG[i * 16 + elane(F.lane)] = lgv;
    }
    __syncthreads();
    if (F.tid < rpb) { const int i = F.tid;
        float sc[16], sel[16];
#pragma unroll
        for (int e = 0; e < 16; ++e) { sc[e] = sigmoidf_(LG[i * 16 + e]); sel[e] = sc[e] + F.in[I_BROUTER][e]; }
        int bg = 0; float bgs = -INFINITY;
#pragma unroll
        for (int g = 0; g < 4; ++g) { float m1 = -INFINITY, m2 = -INFINITY;
#pragma unroll
            for (int k = 0; k < 4; ++k) { const float x = sel[4 * g + k]; if (x > m1) { m2 = m1; m1 = x; } else if (x > m2) m2 = x; }
            const float gs = m1 + m2; if (gs > bgs) { bgs = gs; bg = g; } }
        float s4[4], c4[4];
#pragma unroll
        for (int k = 0; k < 4; ++k) { s4[k] = bg == 0 ? sel[k] : bg == 1 ? sel[4 + k] : bg == 2 ? sel[8 + k] : sel[12 + k]; c4[k] = bg == 0 ? sc[k] : bg == 1 ? sc[4 + k] : bg == 2 ? sc[8 + k] : sc[12 + k]; }
        int i1 = 0;
#pragma unroll
        for (int k = 1; k < 4; ++k) if (s4[k] > s4[i1]) i1 = k;
        int i2 = i1 == 0 ? 1 : 0;
#pragma unroll
        for (int k = 0; k < 4; ++k) if (k != i1 && k != i2 && s4[k] > s4[i2]) i2 = k;
        const float w1 = c4[i1], w2 = c4[i2], ws = 1.0f / (w1 + w2);
        rinfo[2 * i] = 4 * bg + i1; rinfo[2 * i + 1] = 4 * bg + i2; rwt[2 * i] = w1 * ws; rwt[2 * i + 1] = w2 * ws;
    }
    __syncthreads();
    if (F.tid < 16) { int c = 0; for (int idx = 0; idx < 2 * rpb; ++idx) if (rinfo[idx] == F.tid) lrk[idx] = c++;
        ((int*)(F.ws + WS_BCNT))[(l * 256 + F.vcu) * 16 + F.tid] = c; }
    __syncthreads();
    for (int idx = F.tid; idx < 2 * rpb; idx += NWAVES * 64) { unsigned* rp = (unsigned*)(F.ws + WS_ROUTE + (size_t)(2 * row0 + idx) * 16);
        rp[0] = (unsigned)rinfo[idx]; rp[1] = (unsigned)lrk[idx]; ((float*)rp)[2] = rwt[idx]; rp[3] = (unsigned)F.vcu; }
    __syncthreads();
}
__device__ __forceinline__ void f_gather(const Ctx& F, int l, int nrows) {
    LAS int* toff = (LAS int*)F.lds; LAS int* cnts = toff + 32; LAS int* csum = toff + 64; LAS int* bbase = toff + 1024;
    const int* bc = (const int*)(F.ws + WS_BCNT) + l * 4096;
    { const int e = F.tid & 15, ch = F.tid >> 4; int s = 0;
#pragma unroll
        for (int k = 0; k < 8; ++k) { const int v = bc[(8 * ch + k) * 16 + e]; bbase[(8 * ch + k) * 16 + e] = s; s += v; }
        csum[ch * 16 + e] = s; }
    __syncthreads();
    { const int e = F.tid & 15, ch = F.tid >> 4; int pre = 0;
        for (int k = 0; k < ch; ++k) pre += csum[k * 16 + e];
#pragma unroll
        for (int k = 0; k < 8; ++k) bbase[(8 * ch + k) * 16 + e] += pre;
        if (ch == 31) { const int tot = pre + csum[31 * 16 + e]; cnts[e] = tot; if (F.vcu == 0) ((int*)(F.ws + WS_BCNT))[2 * 4096 + l * 16 + e] = tot; } }
    __syncthreads();
    if (F.tid == 0) { int acc = 0; for (int e = 0; e < 16; ++e) { toff[e] = acc; acc += (cnts[e] + 255) >> 8; } toff[16] = acc; }
    __syncthreads();
    const int gw = F.vcu * NWAVES + F.wave, NGW = F.G * NWAVES, lane = F.lane;
    const bf16* U = (const bf16*)(F.ws + WS_U); bf16* As = (bf16*)(F.ws + WS_AS); int* rowmap = (int*)(F.ws + WS_ROWMAP); float* roww = (float*)(F.ws + WS_ROWW);
    for (int ts = gw; ts < 2 * nrows; ts += NGW) { const unsigned* rp = (const unsigned*)(F.ws + WS_ROUTE + (size_t)ts * 16); const unsigned re = rp[0], rk = rp[1], rb = rp[3]; const float rwv = ((const float*)rp)[2];
        const int pos = toff[re] * 256 + bbase[rb * 16 + re] + (int)rk;
        const v4u* src = (const v4u*)(U + (size_t)(ts >> 1) * D); v4u* dst = (v4u*)(As + (size_t)pos * D);
        dst[lane] = src[lane]; dst[lane + 64] = src[lane + 64];
        if (lane == 0) { rowmap[pos] = ts; roww[pos] = rwv; } }
    for (int e = 0; e < 16; ++e) { const int cnt = cnts[e], first = toff[e] * 256 + cnt, npad = toff[e + 1] * 256 - first;
        for (int i = gw; i < npad; i += NGW) { v4u* dst = (v4u*)(As + (size_t)(first + i) * D); unsigned z0 = 0u; asm volatile("" : "+v"(z0)); const v4u z = {z0, z0, z0, z0}; dst[lane] = z; dst[lane + 64] = z; if (lane == 0) { rowmap[first + i] = -1; roww[first + i] = 0.f; } } }
    __syncthreads();
}
__device__ __forceinline__ void h_ln2(const Ctx& F, int l, int nrows) {
    const int gw = F.vcu * NWAVES + F.wave, NGW = F.G * NWAVES, lane = F.lane; const bf16* Fs = (const bf16*)(F.ws + WS_F);
    if (l + 1 < DEPTH) { stage_w16(F, F.in[I_WIN] + (size_t)(l + 1) * D * D_IN + SRC_MG, D_IN, (LAS float*)F.lds); __syncthreads(); }
    for (int r = gw; r < nrows; r += NGW) { f32x4 v[4]; float* hp = hrow(F, r); load_row(hp, lane, v); const float* g2 = modp(F, l, modrow(r)) + 5120;
#pragma unroll
        for (int j = 0; j < 4; ++j) { const v2u a = *(const v2u*)(Fs + (size_t)(2 * r) * D + 4 * lane + 256 * j), b = *(const v2u*)(Fs + (size_t)(2 * r + 1) * D + 4 * lane + 256 * j);
            const f32x4 f = (f32x4){bflo(a.x) + bflo(b.x), bfhi(a.x) + bfhi(b.x), bflo(a.y) + bflo(b.y), bfhi(a.y) + bfhi(b.y)}, g = *(const f32x4*)(g2 + 4 * lane + 256 * j);
            v[j] = v[j] * ALPHA + g * f * MK_ABL_F; }
        ln_row(v, F.in[I_LN2G] + l * D, F.in[I_LN2B] + l * D, lane); store_row(hp, lane, v);
        if (l + 1 < DEPTH) emit_layer_input(F, l + 1, r, v); }
}

constexpr int NPHASE = 2 + 10 * DEPTH;
struct Args { const float* in[N_IN]; float* out; unsigned char* ws; int ph_lo, ph_hi, li, pad; };
static_assert(sizeof(Args) == 8 * N_IN + 16 + 16, "no padding bytes in Args");
#ifndef MK_PHASE_MASK
#define MK_PHASE_MASK 0xFFFu
#endif
#define PON(j) (((MK_PHASE_MASK) >> (j)) & 1u)
#ifndef MK_DUP
#define MK_DUP (-1)
#endif
#define REP(k) for (int rep_ = 0; rep_ < (((MK_DUP) == (k)) ? 2 : 1); ++rep_)
#define IN(k) (lo <= (k) && (k) < hi)
#define PCTX(Fp) Ctx Fp = F; Fp.lane = lane_id(); Fp.tid = F.wave * 64 + Fp.lane
#if defined(MK_STAMPS)
#define SEAM(k) do { if (IN(k) && IN((k) + 1)) xcd_barrier(bar); if (blockIdx.x == 0 && F.wave == 0 && lane_id() == 0) ((unsigned long long*)(F.ws + WS_CTL + 16384))[(k) + 1] = __builtin_amdgcn_s_memrealtime(); } while (0)
#else
#define SEAM(k) do { if (IN(k) && IN((k) + 1)) xcd_barrier(bar); } while (0)
#endif
template <int l> __device__ __forceinline__ void run_layer(const Ctx& F, const int lo, const int hi, const XcdBarrier& bar) {
        const int pb = 2 + 10 * l; const bool lastl = (l == DEPTH - 1); const int nrows = lastl ? M_LAT : M_ALL;
        bf16* const Pb = (bf16*)(F.ws + WS_P); bf16* const Ub = (bf16*)(F.ws + WS_U); bf16* const Yb = (bf16*)(F.ws + WS_Y);
        if (PON(2) && IN(pb + 0)) REP(pb + 0) {
            pg8::Gemm g{Ub, wt(F, l, W_IN), M_ALL, NP, D}; EpiProj E{Pb, NP};
            if (lastl) { ProjOrderLast S; S.init(F.G, (int)blockIdx.x); pg8::gemm_phase<EpiProj, ProjOrderLast, true, true>(F.lds, g, S, E, F.wave); }
            else { pg8::StaticOrder S; S.init(M_ALL, NP, F.G, (int)blockIdx.x); pg8::gemm_phase<EpiProj, pg8::StaticOrder, true, true>(F.lds, g, S, E, F.wave); }
            SEAM(pb + 0);
        }
        if (PON(3) && IN(pb + 1)) REP(pb + 1) {
            PCTX(Fp);
            if (F.vcu < 128) { mlstm_chain(Fp, l, F.vcu);
#if defined(MK_DUP_MLSTM)
                mlstm_chain(Fp, l, F.vcu);
#endif
            }
            {
                const int n_attn = lastl ? 256 : 288, n_conv = lastl ? 512 : 576;
                attn_rope_to_lds(Fp);
                volatile LAS int* wq = (volatile LAS int*)(F.lds + LDSCTL_OFF + 512);
                for (;;) {
                    __syncthreads();
                    if (Fp.tid == 0) wq[0] = (int)__hip_atomic_fetch_add(F.ctl + CW_WQ + 256 * l + 128 * (int)(rep_ & 1), 1u, RLX_AGENT);
                    __syncthreads();
                    const int u = wq[0];
                    if (u >= n_attn) break;
                    if (u < 256) attn_unit(Fp, l, 0, u >> 5, (u >> 1) & 15, u & 1); else { const int j = u - 256; attn_unit(Fp, l, 1, j >> 2, (j >> 1) & 1, j & 1); }
                }
                for (;;) {
                    __syncthreads();
                    if (Fp.tid == 0) wq[0] = (int)__hip_atomic_fetch_add(F.ctl + CW_WQ + 256 * l + 128 * (int)(rep_ & 1) + 64, 1u, RLX_AGENT);
                    __syncthreads();
                    const int u = wq[0];
                    if (u >= n_conv) break;
                    conv_unit(Fp, l, u);
                }
            }
            SEAM(pb + 1);
        }
        if (PON(4) && IN(pb + 2)) REP(pb + 2) { PCTX(Fp); c0_combine(Fp, l, nrows); SEAM(pb + 2); }
        if (PON(5) && IN(pb + 3)) REP(pb + 3) {
            pg8::Gemm g{Yb, wt(F, l, W_ABC), nrows, D, NY}; pg8::StaticOrder S; S.init(nrows, D, F.G, (int)blockIdx.x);
            EpiMerge E{Pb, Ub};
            pg8::gemm_phase<EpiMerge, pg8::StaticOrder, true, true>(F.lds, g, S, E, F.wave);
            if (l == 0) { PCTX(Fp); __syncthreads(); convert_layer1_on_idle(Fp, 32); }
            SEAM(pb + 3);
        }
        if (PON(6) && IN(pb + 4)) REP(pb + 4) {
            pg8::Gemm g{Ub, wt(F, l, W_OUT), nrows, D, D}; pg8::StaticOrder S; S.init(nrows, D, F.G, (int)blockIdx.x);
            EpiResid E{F.out, (float*)(F.ws + WS_HC), (const float*)(F.ws + WS_MOD) + (size_t)l * 9 * 6144};
            pg8::gemm_phase<EpiResid, pg8::StaticOrder, true, true>(F.lds, g, S, E, F.wave);
            SEAM(pb + 4);
        }
        if (PON(7) && IN(pb + 5)) REP(pb + 5) { PCTX(Fp); e_ln1_route(Fp, l, nrows); SEAM(pb + 5); }
        if (PON(8) && IN(pb + 6)) REP(pb + 6) { PCTX(Fp); f_gather(Fp, l, nrows); SEAM(pb + 6); }
        if (PON(9) && IN(pb + 7)) REP(pb + 7) {
            LAS int* toff = (LAS int*)(F.lds + LDSCTL_OFF); { PCTX(Fp); moe_toff(Fp, l, toff); }
            pg8::Gemm g{(const bf16*)(F.ws + WS_AS), wt(F, l, W_GU), AS_ROWS, NE * D, D}; MoeOrder S{F.G, (int)blockIdx.x, toff};
            EpiSwiGLU E{(bf16*)(F.ws + WS_ACT)};
            pg8::gemm_phase<EpiSwiGLU, MoeOrder, true, true>(F.lds, g, S, E, F.wave);
            SEAM(pb + 7);
        }
        if (PON(10) && IN(pb + 8)) REP(pb + 8) {
            LAS int* toff = (LAS int*)(F.lds + LDSCTL_OFF); { PCTX(Fp); moe_toff(Fp, l, toff); }
            pg8::Gemm g{(const bf16*)(F.ws + WS_ACT), wt(F, l, W_DN), AS_ROWS, NE * D, DEXP}; MoeOrder S{F.G, (int)blockIdx.x, toff};
            EpiScatter E{(const int*)(F.ws + WS_ROWMAP), (const float*)(F.ws + WS_ROWW), (bf16*)(F.ws + WS_F)};
            pg8::gemm_phase<EpiScatter, MoeOrder, true, true>(F.lds, g, S, E, F.wave);
            SEAM(pb + 8);
        }
        if (PON(11) && IN(pb + 9)) REP(pb + 9) { PCTX(Fp); h_ln2(Fp, l, nrows); SEAM(pb + 9); }
    }
__global__ void __launch_bounds__(NWAVES * 64, 2) mk_fwd(Args args) {
    extern __shared__ __attribute__((aligned(16))) unsigned char lds[];
    Ctx F;
    F.lds = (LAS unsigned char*)lds; F.MISC = (volatile LAS unsigned*)(F.lds + MISC_OFF);
    F.tid = 0; F.lane = 0; F.wave = __builtin_amdgcn_readfirstlane((int)threadIdx.x >> 6);
    F.G = gridDim.x; { const int bx = blockIdx.x; F.vcu = (F.G % 8 == 0) ? (bx % 8) * (F.G / 8) + bx / 8 : bx; }
    F.ws = args.ws; F.out = args.out; F.ctl = (unsigned*)(args.ws + WS_CTL);
    F.in = args.in;
    for (int u = (int)threadIdx.x; u < (LDS_BYTES - LDSCTL_OFF) / 4; u += NWAVES * 64) ((LAS unsigned*)(F.lds + LDSCTL_OFF))[u] = 0u;
    __syncthreads();
    const int lo = args.ph_lo, hi = args.ph_hi;
    XcdBarrier bar; bar.bar = (unsigned*)(F.ctl + CW_BAR) + args.li * XCD_BAR_WORDS; bar.x = 0; bar.st = nullptr; bar.w0 = false;
    if (hi - lo > 1) bar = xcd_barrier_post((unsigned*)(F.ctl + CW_BAR) + args.li * XCD_BAR_WORDS, F.MISC + 8);
    bar.w0 = (F.wave == 0);
#if defined(MK_STAMPS)
    if (blockIdx.x == 0 && F.wave == 0 && lane_id() == 0) ((unsigned long long*)(F.ws + WS_CTL + 16384))[0] = __builtin_amdgcn_s_memrealtime();
#endif
    if (PON(0) && IN(0)) REP(0) { PCTX(Fp); p0_prologue(Fp); SEAM(0); }
    if (PON(1) && IN(1)) REP(1) { PCTX(Fp); p1_ln_in(Fp); SEAM(1); }
    run_layer<0>(F, lo, hi, bar);
    run_layer<1>(F, lo, hi, bar);
#undef IN
#undef SEAM
}


#if defined(MK_DIAG)
constexpr int CW_DIAG = 3072;
__global__ void __launch_bounds__(512, 2) mk_diag(Args args) {
    unsigned char* ws = args.ws; float* acc = (float*)((unsigned*)(ws + WS_CTL) + CW_DIAG);
    const int gt = blockIdx.x * 512 + threadIdx.x, NT = gridDim.x * 512;
    const int* rowmap = (const int*)(ws + WS_ROWMAP); const bf16* As = (const bf16*)(ws + WS_AS); const bf16* act = (const bf16*)(ws + WS_ACT); const bf16* Fs = (const bf16*)(ws + WS_F);
    const unsigned* cnt = (const unsigned*)(ws + WS_CTL) + CW_CNT;
    int ntile = 0; for (int e = 0; e < 16; ++e) ntile += (int)((cnt[64 * e] + 255u) >> 8);
    float s0 = 0.f, s1 = 0.f, s2 = 0.f, s3 = 0.f;
    for (int pos = gt; pos < ntile * 256; pos += NT) { if (rowmap[pos] >= 0) { s0 += 1.f; float a = 0.f, b = 0.f;
        for (int k = 0; k < 1024; k += 37) a += fabsf(bf1(As[(size_t)pos * D + k]));
        for (int k = 0; k < 512; k += 19) b += fabsf(bf1(act[(size_t)pos * DEXP + k]));
        s1 += a * (1.f / 28.f); s2 += b * (1.f / 27.f); } }
    for (int ts = gt; ts < 2 * M_ALL; ts += NT) { float f = 0.f; for (int k = 0; k < 1024; k += 37) f += fabsf(bf1(Fs[(size_t)ts * D + k])); s3 += f * (1.f / 28.f); }
    if (MK_DIAG == 3) { s1 = 0.f; s2 = 0.f; const float* roww = (const float*)(ws + WS_ROWW);
        for (int pos = gt; pos < ntile * 256; pos += NT) if (rowmap[pos] >= 0) s1 += fabsf(roww[pos]);
        for (int ts = gt; ts < 2 * M_ALL; ts += NT) { const v4u rt = *(const v4u*)(ws + WS_ROUTE + (size_t)ts * 16); s2 += fabsf(__builtin_bit_cast(float, rt.z)); } }
    if (MK_DIAG == 6) { s1 = 0.f; s2 = 0.f;
        for (int ts = gt; ts < 2 * M_ALL; ts += NT) { const v4u rt = *(const v4u*)(ws + WS_ROUTE + (size_t)ts * 16); const float wv = __builtin_bit_cast(float, rt.z);
            const bool ok = (wv > 0.f) && (wv < 1.f); if (ok) s2 += wv; else s1 += 1.f; } }
    if (MK_DIAG == 7) { s1 = 0.f; s2 = 0.f;
        for (int ts = gt; ts < 2 * M_ALL; ts += NT) { bool bad = false; for (int k = 0; k < 1024; k += 7) { const float x = bf1(Fs[(size_t)ts * D + k]); if (!(fabsf(x) < 1e4f)) bad = true; } if (bad) s1 += 1.f; }
        for (int pos = gt; pos < ntile * 256; pos += NT) { bool bad = false; for (int k = 0; k < 512; k += 5) { const float x = bf1(act[(size_t)pos * DEXP + k]); if (!(fabsf(x) < 1e4f)) bad = true; }
            for (int k = 0; k < 1024; k += 7) { const float x = bf1(As[(size_t)pos * D + k]); if (!(fabsf(x) < 1e4f)) bad = true; } if (bad) s2 += 1.f; } }
    if (MK_DIAG == 4 || MK_DIAG == 5) { s1 = 0.f; s2 = 0.f; const float* dbg = (const float*)(ws + WS_ROPE + 65536);
        for (int r = gt; r < M_ALL; r += NT) { s1 += fabsf(dbg[4 * r + (MK_DIAG == 4 ? 0 : 2)]); s2 += fabsf(dbg[4 * r + (MK_DIAG == 4 ? 1 : 3)]); } }
    atomicAdd(acc + 0, s0); atomicAdd(acc + 1, s1); atomicAdd(acc + 2, s2); atomicAdd(acc + 3, s3);
}
__global__ void __launch_bounds__(512, 2) mk_diag_out(Args args) {
    const float* acc = (const float*)((const unsigned*)(args.ws + WS_CTL) + CW_DIAG);
    const float cntr = acc[0], mA = acc[1] / fmaxf(cntr, 1.f), mAct = acc[2] / fmaxf(cntr, 1.f), mF = acc[3] / (2.f * M_ALL);
    float st1, st2;
    if (MK_DIAG == 1) { st1 = mA; st2 = mAct; } else if (MK_DIAG == 3) { st1 = mA; st2 = acc[2] / (2.f * M_ALL); } else if (MK_DIAG == 4 || MK_DIAG == 5) { st1 = acc[1] / M_ALL; st2 = acc[2] / M_ALL; } else if (MK_DIAG == 6) { st1 = acc[1] + 1e-3f; st2 = acc[2] / (2.f * M_ALL); } else if (MK_DIAG == 7) { st1 = acc[1] + 1e-3f; st2 = acc[2] + 1e-3f; } else { st1 = cntr / (2.f * M_ALL); st2 = mF; }
    const float v1 = fminf(fmaxf(20.f + log2f(fmaxf(st1, 1e-6f)), 0.f), 60.f), v2 = 100.f * fminf(fmaxf(20.f + log2f(fmaxf(st2, 1e-6f)), 0.f), 60.f);
    const float K = sqrtf(v1);
    for (size_t i = (size_t)blockIdx.x * 512 + threadIdx.x; i < (size_t)M_LAT * D; i += (size_t)gridDim.x * 512) args.out[i] = (i == 12345) ? v2 : ((i & 1) ? K : -K);
}
#endif

#if defined(MK_DIAG)
__global__ void __launch_bounds__(512, 2) mk_copy(Args args) {
    const bf16* HF = (const bf16*)(args.ws + WS_HF); const bf16* HB = (const bf16*)(args.ws + WS_HB); const bf16* P = (const bf16*)(args.ws + WS_P);
    for (size_t i = (size_t)blockIdx.x * 512 + threadIdx.x; i < (size_t)M_LAT * D; i += (size_t)gridDim.x * 512) { const size_t r = i >> 10; const int c = (int)(i & 1023);
        float v;
        if (MK_DIAG == 8) v = c < 512 ? bf1(HF[r * 512 + c]) : bf1(HB[r * 512 + c - 512]);
        else if (MK_DIAG == 9) v = bf1(P[r * NP + PMQ + c]);
        else if (MK_DIAG == 10) v = bf1(P[r * NP + PMV + (c & 511)]);
        else if (MK_DIAG == 11) v = bf1(P[(size_t)(M_LAT + (r & 2047)) * NP + PMQ + c + 512 * ((r >> 11) & 1)]);
        else v = ((const float*)(args.ws + WS_G))[(size_t)(r + ((r >> 13) & 1) * 2048) * 16 + (c & 15)];
        args.out[i] = v; }
}
#endif

#if defined(MK_STAMPS)
__global__ void __launch_bounds__(512, 2) mk_stamp_out(Args args) {
    const unsigned long long* ts = (const unsigned long long*)(args.ws + WS_CTL + 16384);
    const float d1 = (float)(ts[MK_ST_E1] - ts[MK_ST_S1]) * 0.01f, d2 = (float)(ts[MK_ST_E2] - ts[MK_ST_S2]) * 0.01f;
    const float K = sqrtf(d1 * 0.1f);
    for (size_t i = (size_t)blockIdx.x * 512 + threadIdx.x; i < (size_t)M_LAT * D; i += (size_t)gridDim.x * 512) args.out[i] = (i == 12345) ? d2 : ((i & 1) ? K : -K);
}
#endif

#ifndef MK_PER_PHASE
#define MK_PER_PHASE 1
#endif
extern "C" void kernel_launch(void* const* d_in, const int* in_sizes, int n_in, void* d_out, int out_size, void* d_ws, size_t ws_size, hipStream_t stream) {
    static int grid = 0;
    if (grid == 0) {
        if (n_in != N_IN || in_sizes[0] != M_LAT * D || out_size != M_LAT * D || ws_size < WS_END) {
            fprintf(stderr, "kernel_launch: built for %d inputs, x/out of %d floats, >= %zu bytes of workspace; got n_in %d, in0 %d, out %d, ws %zu; nothing launched\n", N_IN, M_LAT * D, (size_t)WS_END, n_in, n_in > 0 ? in_sizes[0] : -1, out_size, ws_size); grid = -1; return; }
        int dev = 0, cus = 0, per_cu = 0;
        if (hipGetDevice(&dev) != hipSuccess || hipDeviceGetAttribute(&cus, hipDeviceAttributeMultiprocessorCount, dev) != hipSuccess) { fprintf(stderr, "kernel_launch: device query failed\n"); grid = -1; return; }
        if (hipFuncSetAttribute((const void*)mk_fwd, hipFuncAttributeMaxDynamicSharedMemorySize, LDS_BYTES) != hipSuccess) { fprintf(stderr, "kernel_launch: hipFuncSetAttribute failed\n"); grid = -1; return; }
        if (hipOccupancyMaxActiveBlocksPerMultiprocessor(&per_cu, (const void*)mk_fwd, NWAVES * 64, LDS_BYTES) != hipSuccess || per_cu < 1) { fprintf(stderr, "kernel_launch: occupancy query reports %d workgroups per CU\n", per_cu); }
        (void)hipGetLastError();
        grid = cus;
        if (grid != 256) { fprintf(stderr, "kernel_launch: %d CUs; this kernel is built for 256\n", grid); grid = -1; return; }
    }
    if (grid < 0) return;
    if (hipMemsetAsync((char*)d_ws + WS_CTL, 0, CTL_ZERO_BYTES, stream) != hipSuccess) { fprintf(stderr, "kernel_launch: memset failed\n"); return; }
    Args a{};
    for (int i = 0; i < N_IN; ++i) a.in[i] = (const float*)d_in[i];
    a.out = (float*)d_out; a.ws = (unsigned char*)d_ws; a.pad = 0;
#if MK_PER_PHASE
    for (int k = 0; k < NPHASE; ++k) { a.ph_lo = k; a.ph_hi = k + 1; a.li = k;
        hipLaunchKernelGGL(mk_fwd, dim3(grid), dim3(NWAVES * 64), LDS_BYTES, stream, a);
#if defined(MK_DIAG)
        if (k == MK_DIAG_AFTER) { if (MK_DIAG >= 8) { hipLaunchKernelGGL(mk_copy, dim3(256), dim3(512), 0, stream, a); } else { hipLaunchKernelGGL(mk_diag, dim3(256), dim3(512), 0, stream, a); hipLaunchKernelGGL(mk_diag_out, dim3(256), dim3(512), 0, stream, a); } break; }
#endif
    }
#else
    a.ph_lo = 0; a.ph_hi = NPHASE; a.li = 0;
    hipLaunchKernelGGL(mk_fwd, dim3(grid), dim3(NWAVES * 64), LDS_BYTES, stream, a);
#if defined(MK_STAMPS)
    hipLaunchKernelGGL(mk_stamp_out, dim3(256), dim3(512), 0, stream, a);
#endif
#endif
    const hipError_t le = hipPeekAtLastError();
    if (le != hipSuccess) fprintf(stderr, "kernel_launch: launch failed: %s\n", hipGetErrorName(le));
}
```

```cpp
#include <hip/hip_runtime.h>
#include <cstdio>
#include <cstdint>
#ifndef MK_PER_PHASE
#define MK_PER_PHASE 0
#endif
namespace pg8 {
#define PG8_LAS __attribute__((address_space(3)))
typedef unsigned short bf16_t;
typedef short bf16x8 __attribute__((ext_vector_type(8)));
typedef float f32x4 __attribute__((ext_vector_type(4)));
typedef unsigned u32x4 __attribute__((ext_vector_type(4)));
constexpr int BM = 256, BK = 64, HALF = 128, HTB = HALF * BK * 2  , STAGE_BYTES = 8 * HTB, NXCD = 8, WGM = 8;

__host__ __device__ __forceinline__ int lds_byte(int r, int c) { const int st = (r >> 4) * 2 + (c >> 5), rr = r & 15, cc = c & 31, ob = rr * 64 + cc * 2; return st * 1024 + (ob ^ (((ob >> 9) & 1) << 5)); }
__host__ __device__ __forceinline__ void stage_rc(int b, int& R, int& C) { const int st = b / 1024, sb = b % 1024, swz = sb ^ (((sb >> 9) & 1) << 5); R = (st >> 1) * 16 + swz / 64; C = (st & 1) * 32 + (swz % 64) / 2; }
__host__ __device__ __forceinline__ int perm32(int rho) { const int n = rho >> 4, i = rho & 15; return 8 * (i >> 2) + 4 * n + (i & 3); }

struct Unit { int pm, pn; };
struct Gemm { const bf16_t* A; const bf16_t* Bt; int M, N, K; };

struct StaticOrder {
    int nM, nN, nwg, G, c;
    __host__ __device__ void init(int M, int N, int G_, int c_) { nM = M / BM; nN = N / BM; nwg = nM * nN; G = G_; c = c_; }
    __host__ __device__ bool next(int i, Unit& u) const {
        const long L = (long)i * G + c; if (L >= nwg) return false;
        int wgid = (int)L; { const int q = nwg / NXCD, r = nwg % NXCD, xcd = wgid % NXCD, off = wgid / NXCD; wgid = (xcd < r ? xcd * (q + 1) : r * (q + 1) + (xcd - r) * q) + off; }
        const int nig = WGM * nN, gid = wgid / nig, fm = gid * WGM, gsz = (nM - fm) < WGM ? (nM - fm) : WGM;
        u.pm = fm + ((wgid % nig) % gsz); u.pn = (wgid % nig) / gsz; return true;
    }
    __device__ __forceinline__ void a_ready(const Unit&) const {}
    __device__ __forceinline__ void done(const Unit&) const {}
};

__device__ __forceinline__ unsigned cvt_pk_bf16(float lo, float hi) { unsigned r; asm volatile("v_cvt_pk_bf16_f32 %0, %1, %2" : "=v"(r) : "v"(lo), "v"(hi)); return r; }
typedef float f32x2 __attribute__((ext_vector_type(2)));
template <class Epi, class Sched, bool ALIGN_EPI = false, bool SP2 = false>
__device__ __forceinline__ void gemm_phase(PG8_LAS unsigned char* lds, const Gemm g, const Sched& S, const Epi& E, const int wid_in) {
    int lid_; asm volatile("v_mbcnt_lo_u32_b32 %0, -1, 0\n\tv_mbcnt_hi_u32_b32 %0, -1, %0" : "=v"(lid_)); const int tid_ = wid_in * 64 + lid_;
    const int tid = tid_, wid = __builtin_amdgcn_readfirstlane(tid >> 6), lane = tid & 63, wr = wid >> 2, wc = wid & 3, fr = lane & 15, fq = lane >> 4;
    const int K = g.K, nt = K / BK;
    unsigned voffA[2], voffB[2];
#pragma unroll
    for (int i = 0; i < 2; ++i) { int R, C; stage_rc(tid * 16 + i * 8192, R, C); const int Rb = Epi::PERM ? ((R & ~31) + perm32(R & 31)) : R;
        voffA[i] = (unsigned)(R * K + C) * 2u; voffB[i] = (unsigned)(Rb * K + C) * 2u; }
    const size_t kstep = (size_t)(BK * 2);
    const size_t hstep = (size_t)HALF * K * 2;
    const size_t tstep = 2 * hstep;
    const unsigned ldsw = (unsigned)wid * 1024u;
    const int aoff = lds_byte(wr * 64 + fr, fq * 8), boff = lds_byte(wc * 32 + fr, fq * 8);
#define PG8_SA(b, h) (((b) * 2 + (h)) * HTB)
#define PG8_SB(b, h) ((4 + (b) * 2 + (h)) * HTB)
#define PG8_STAGE(bufoff, gbase, voff) do { _Pragma("unroll") for (int _i = 0; _i < 2; ++_i) \
        __builtin_amdgcn_global_load_lds((const unsigned*)((const char*)(gbase) + (voff)[_i]), (PG8_LAS unsigned*)(lds + (bufoff) + ldsw + _i * 8192), 16, 0, 0); } while (0)
#define PG8_LDA(dst, b, h) do { _Pragma("unroll") for (int m = 0; m < 4; ++m) _Pragma("unroll") for (int k = 0; k < 2; ++k) dst[m][k] = *(const PG8_LAS bf16x8*)(lds + PG8_SA(b, h) + aoff + m * 2048 + k * 1024); } while (0)
#define PG8_LDB(dst, b, h) do { _Pragma("unroll") for (int n = 0; n < 2; ++n) _Pragma("unroll") for (int k = 0; k < 2; ++k) dst[n][k] = *(const PG8_LAS bf16x8*)(lds + PG8_SB(b, h) + boff + n * 2048 + k * 1024); } while (0)
#define PG8_MMA(ai, bj, At, Bt) do { __builtin_amdgcn_s_setprio(1); _Pragma("unroll") for (int m = 0; m < 4; ++m) _Pragma("unroll") for (int n = 0; n < 2; ++n) _Pragma("unroll") for (int k = 0; k < 2; ++k) \
        acc[ai][bj][m][n] = __builtin_amdgcn_mfma_f32_16x16x32_bf16(Bt[n][k], At[m][k], acc[ai][bj][m][n], 0, 0, 0); __builtin_amdgcn_s_setprio(0); } while (0)
#define PG8_WAIT_V(n) asm volatile("s_waitcnt vmcnt(" #n ")" ::: "memory")
#define PG8_WAIT_L(n) asm volatile("s_waitcnt lgkmcnt(" #n ")" ::: "memory")
#define PG8_BAR __builtin_amdgcn_s_barrier()
#define PG8_SCHED __builtin_amdgcn_sched_barrier(0)
    Unit cur, nxt; int ui = 0;
    if (!S.next(0, cur)) return;
    f32x4 acc[2][2][4][2];
#pragma unroll
    for (int a = 0; a < 2; ++a)
#pragma unroll
        for (int b = 0; b < 2; ++b)
#pragma unroll
            for (int m = 0; m < 4; ++m)
#pragma unroll
                for (int n = 0; n < 2; ++n) acc[a][b][m][n] = (f32x4){0.f, 0.f, 0.f, 0.f};
    bf16x8 At[4][2], B0[2][2], B1[2][2];
    const char* cA = (const char*)g.A + (size_t)cur.pm * tstep; const char* cB = (const char*)g.Bt + (size_t)cur.pn * tstep;
    S.a_ready(cur);
    if constexpr (SP2) {
        PG8_STAGE(PG8_SB(0, 0), cB, voffB); PG8_STAGE(PG8_SB(0, 1), cB + hstep, voffB); PG8_STAGE(PG8_SA(0, 0), cA, voffA); PG8_STAGE(PG8_SA(0, 1), cA + hstep, voffA);
        if (wr == 1) PG8_BAR;
        PG8_WAIT_V(2); PG8_BAR;
        PG8_STAGE(PG8_SB(1, 0), cB + kstep, voffB); PG8_STAGE(PG8_SA(1, 0), cA + kstep, voffA); PG8_STAGE(PG8_SB(1, 1), cB + hstep + kstep, voffB);
        PG8_WAIT_V(6); PG8_BAR;
    } else {
        PG8_STAGE(PG8_SB(0, 0), cB, voffB); PG8_STAGE(PG8_SA(0, 0), cA, voffA); PG8_STAGE(PG8_SB(0, 1), cB + hstep, voffB); PG8_STAGE(PG8_SA(0, 1), cA + hstep, voffA);
        if (wr == 1) PG8_BAR;
        PG8_WAIT_V(4); PG8_BAR;
        PG8_STAGE(PG8_SB(1, 0), cB + kstep, voffB); PG8_STAGE(PG8_SA(1, 0), cA + kstep, voffA); PG8_STAGE(PG8_SB(1, 1), cB + hstep + kstep, voffB);
        PG8_WAIT_V(6); PG8_BAR;
    }
    for (;;) {
        const bool has_next = S.next(ui + 1, nxt);
        const char* nA = has_next ? (const char*)g.A + (size_t)nxt.pm * tstep : cA; const char* nB = has_next ? (const char*)g.Bt + (size_t)nxt.pn * tstep : cB;
        for (int t = 0; t < nt; t += 2) {
            const bool last = (t == nt - 2);
            if constexpr (Epi::RESCALE) { if (t == 8 || t == 16) E.rescale(acc, cur, t >> 3, wr, wc, fr, fq); }
            const char* a1 = cA + (size_t)(t + 1) * kstep;
            const char* a2 = last ? nA : cA + (size_t)(t + 2) * kstep; const char* b2 = last ? nB : cB + (size_t)(t + 2) * kstep;
            const char* a3 = a2 + kstep; const char* b3 = b2 + kstep;
            if (last && has_next) S.a_ready(nxt);
            if constexpr (SP2) {
            PG8_LDB(B0, 0, 0); PG8_LDB(B1, 0, 1); PG8_SCHED; PG8_LDA(At, 0, 0); PG8_STAGE(PG8_SA(1, 1), a1 + hstep, voffA);
            PG8_WAIT_V(8); PG8_WAIT_L(0); PG8_BAR; PG8_MMA(0, 0, At, B0); PG8_MMA(0, 1, At, B1); PG8_BAR; PG8_SCHED;
            PG8_LDA(At, 0, 1); PG8_STAGE(PG8_SB(0, 0), b2, voffB); PG8_STAGE(PG8_SB(0, 1), b2 + hstep, voffB); PG8_STAGE(PG8_SA(0, 0), a2, voffA);
            PG8_WAIT_V(8); PG8_WAIT_L(0); PG8_BAR; PG8_MMA(1, 0, At, B0); PG8_MMA(1, 1, At, B1); PG8_BAR; PG8_SCHED;
            PG8_LDB(B0, 1, 0); PG8_LDB(B1, 1, 1); PG8_SCHED; PG8_LDA(At, 1, 0); PG8_STAGE(PG8_SA(0, 1), a2 + hstep, voffA);
            PG8_WAIT_V(8); PG8_WAIT_L(0); PG8_BAR; PG8_MMA(0, 0, At, B0); PG8_MMA(0, 1, At, B1); PG8_BAR; PG8_SCHED;
            PG8_LDA(At, 1, 1); PG8_STAGE(PG8_SB(1, 0), b3, voffB); PG8_STAGE(PG8_SB(1, 1), b3 + hstep, voffB); PG8_STAGE(PG8_SA(1, 0), a3, voffA);
            PG8_WAIT_V(8); PG8_WAIT_L(0); PG8_BAR; PG8_MMA(1, 0, At, B0); PG8_MMA(1, 1, At, B1); PG8_BAR; PG8_SCHED;
            } else {
            PG8_LDB(B0, 0, 0); PG8_SCHED; PG8_LDA(At, 0, 0); PG8_STAGE(PG8_SA(1, 1), a1 + hstep, voffA);
            PG8_WAIT_L(8); PG8_BAR; PG8_WAIT_L(0); PG8_MMA(0, 0, At, B0); PG8_BAR; PG8_SCHED;
            PG8_LDB(B1, 0, 1); PG8_STAGE(PG8_SB(0, 0), b2, voffB);
            PG8_BAR; PG8_WAIT_L(0); PG8_MMA(0, 1, At, B1); PG8_BAR;
            PG8_LDA(At, 0, 1); PG8_STAGE(PG8_SA(0, 0), a2, voffA);
            PG8_BAR; PG8_WAIT_L(0); PG8_MMA(1, 0, At, B0); PG8_BAR; PG8_SCHED;
            PG8_STAGE(PG8_SB(0, 1), b2 + hstep, voffB);
            PG8_WAIT_V(6); PG8_BAR; PG8_MMA(1, 1, At, B1); PG8_BAR;
            PG8_LDB(B0, 1, 0); PG8_SCHED; PG8_LDA(At, 1, 0); PG8_STAGE(PG8_SA(0, 1), a2 + hstep, voffA);
            PG8_WAIT_L(8); PG8_BAR; PG8_WAIT_L(0); PG8_MMA(0, 0, At, B0); PG8_BAR; PG8_SCHED;
            PG8_LDB(B1, 1, 1); PG8_STAGE(PG8_SB(1, 0), b3, voffB);
            PG8_BAR; PG8_WAIT_L(0); PG8_MMA(0, 1, At, B1); PG8_BAR;
            PG8_LDA(At, 1, 1); PG8_STAGE(PG8_SA(1, 0), a3, voffA);
            PG8_BAR; PG8_WAIT_L(0); PG8_MMA(1, 0, At, B0); PG8_BAR; PG8_SCHED;
            PG8_STAGE(PG8_SB(1, 1), b3 + hstep, voffB);
            PG8_WAIT_V(6); PG8_BAR; PG8_MMA(1, 1, At, B1); PG8_BAR;
            }
        }
        if constexpr (ALIGN_EPI) { if (wr == 0) PG8_BAR; }
        if constexpr (!Epi::AFTER_DRAIN) { E(acc, cur, wr, wc, fr, fq); S.done(cur); }
        if (!has_next) break;
#pragma unroll
        for (int a = 0; a < 2; ++a)
#pragma unroll
            for (int b = 0; b < 2; ++b)
#pragma unroll
                for (int m = 0; m < 4; ++m)
#pragma unroll
                    for (int n = 0; n < 2; ++n) acc[a][b][m][n] = (f32x4){0.f, 0.f, 0.f, 0.f};
        cur = nxt; cA = nA; cB = nB; ++ui;
        if constexpr (ALIGN_EPI) { if (wr == 1) PG8_BAR; }
    }
    PG8_WAIT_V(0);
    if constexpr (!ALIGN_EPI) { if (wr == 0) PG8_BAR; }
    PG8_BAR;
    if constexpr (Epi::AFTER_DRAIN) { E.fused(acc, cur, wr, wc, fr, fq, lds, wid, lane); S.done(cur); }
#undef PG8_SA
#undef PG8_SB
#undef PG8_STAGE
#undef PG8_LDA
#undef PG8_LDB
#undef PG8_MMA
#undef PG8_WAIT_V
#undef PG8_WAIT_L
#undef PG8_BAR
#undef PG8_SCHED
}
}

#ifndef MK_ABL_A
#define MK_ABL_A 1.0f
#endif
#ifndef MK_ABL_B
#define MK_ABL_B 1.0f
#endif
#ifndef MK_ABL_C
#define MK_ABL_C 1.0f
#endif
#ifndef MK_ABL_F
#define MK_ABL_F 1.0f
#endif
constexpr int NWAVES = 8;
constexpr int D = 1024, NBATCH = 8, SEQ = 2048, LCTX = 256, DEPTH = 2;
constexpr int M_LAT = NBATCH * SEQ, M_CTX = NBATCH * LCTX, M_ALL = M_LAT + M_CTX;
constexpr int D_IN = 6928, NP = 6912;
constexpr int PA_VAL = 0, PA_GATE = 512, PQ = 1024, PK = 1536, PV = 1664, PMQ = 1792, PMK = 2304, PMV = 2816, PMO = 3328, PBG = 3840;
constexpr int SRC_MG = 3840;
constexpr int NE = 16, DEXP = 512, NY = 1536;
constexpr float LN_EPS = 1e-5f, ALPHA = 1.41421356237309515f;
constexpr float KSCALE = 0.08838834764831845f;
enum { I_X = 0, I_C, I_CTX, I_CCTX, I_LNIN_G, I_LNIN_B, I_WROUTER, I_BROUTER, I_WMOD, I_BMOD, I_WIN, I_CONVW, I_CONVB, I_CONVLN_G, I_CONVLN_B, I_WA, I_SINK, I_WB, I_GATEB, I_NORMG, I_WC, I_WOUT,
       I_LN1G, I_LN1B, I_WGU, I_WDN, I_LN2G, I_LN2B, N_IN };
static_assert(N_IN == 28, "inputs");

constexpr size_t MiB = 1u << 20;
constexpr size_t WS_CTL = 0, CTL_ZERO_BYTES = 1 * MiB;
constexpr size_t WS_MOD = 1 * MiB;
constexpr size_t WS_ROPE = 1 * MiB + 512 * 1024;
constexpr size_t WS_G = 2 * MiB;
constexpr size_t WS_ROUTE = 4 * MiB;
constexpr size_t WS_BCNT = 4 * MiB + 768 * 1024;
constexpr size_t WS_ROWMAP = 5 * MiB;
constexpr size_t WS_ROWW = 5 * MiB + 256 * 1024;
constexpr size_t WS_HC = 6 * MiB;
constexpr size_t WS_W = 14 * MiB;
constexpr size_t W_IN = 0, W_ABC = W_IN + (size_t)NP * D * 2, W_OUT = W_ABC + (size_t)D * NY * 2, W_GU = W_OUT + (size_t)D * D * 2, W_DN = W_GU + (size_t)NE * D * D * 2, W_LAYER = W_DN + (size_t)NE * D * DEXP * 2;
constexpr size_t WS_P = WS_W + 2 * W_LAYER;
constexpr size_t WS_U = WS_P + (size_t)M_ALL * NP * 2;
constexpr size_t WS_Y = WS_U + (size_t)M_ALL * D * 2;
constexpr size_t WS_END = WS_Y + (size_t)M_ALL * NY * 2;
constexpr int AS_ROWS = 40960;
constexpr size_t WS_AS = WS_P;
constexpr size_t WS_ACT = WS_AS + (size_t)AS_ROWS * D * 2;
constexpr size_t WS_F = WS_ACT + (size_t)AS_ROWS * DEXP * 2;
static_assert(WS_F + (size_t)M_ALL * 2 * D * 2 <= WS_U, "MoE buffers overlay P");
static_assert(W_LAYER == 69730304 && WS_W % 256 == 0 && WS_P % 256 == 0 && WS_U % 256 == 0 && WS_Y % 256 == 0, "map");
constexpr size_t WS_HF = WS_U, WS_HB = WS_U + (size_t)M_ALL * 512 * 2;
constexpr int CW_TMO = 0, CW_CODE = 1;
constexpr int CW_CNT = 256;
constexpr int CW_WQ = 2560;
constexpr int CW_BAR = 4096;

constexpr int RING_BYTES = 131072, LDSCTL_OFF = RING_BYTES, MISC_OFF = LDSCTL_OFF + 320, LDS_BYTES = 147456;

#define GAS __attribute__((address_space(1)))
#define LAS __attribute__((address_space(3)))
typedef unsigned short bf16;
typedef unsigned v4u __attribute__((ext_vector_type(4)));
typedef unsigned v2u __attribute__((ext_vector_type(2)));
typedef float f32x4 __attribute__((ext_vector_type(4)));
typedef float f32x16 __attribute__((ext_vector_type(16)));
typedef short bf16x8 __attribute__((ext_vector_type(8)));
typedef GAS unsigned gu32;
#define RLX_AGENT __ATOMIC_RELAXED, __HIP_MEMORY_SCOPE_AGENT
#define LDS_WAIT() asm volatile("s_waitcnt lgkmcnt(0)" ::: "memory")
#define VM_WAIT() asm volatile("s_waitcnt vmcnt(0)" ::: "memory")
__device__ __forceinline__ unsigned f2bf(float f) { unsigned u = __builtin_bit_cast(unsigned, f); return (u + 0x7fffu + ((u >> 16) & 1u)) >> 16; }
typedef float f32x2_t __attribute__((ext_vector_type(2)));
typedef __bf16 bf16x2_t __attribute__((ext_vector_type(2)));
__device__ __forceinline__ unsigned pk2(float lo, float hi) { const f32x2_t v = {lo, hi}; const bf16x2_t b = __builtin_convertvector(v, bf16x2_t); return __builtin_bit_cast(unsigned, b); }
__device__ __forceinline__ float bflo(unsigned w) { return __builtin_bit_cast(float, w << 16); }
__device__ __forceinline__ float bfhi(unsigned w) { return __builtin_bit_cast(float, w & 0xffff0000u); }
__device__ __forceinline__ float bf1(bf16 v) { return __builtin_bit_cast(float, (unsigned)v << 16); }
__device__ __forceinline__ float sigmoidf_(float x) { return 1.0f / (1.0f + __expf(-x)); }
__device__ __forceinline__ int lane_id() { int l; asm volatile("v_mbcnt_lo_u32_b32 %0, -1, 0\n\tv_mbcnt_hi_u32_b32 %0, -1, %0" : "=v"(l)); return l; }
__device__ __forceinline__ float shidx(float v, int src) { return __builtin_bit_cast(float, __builtin_amdgcn_ds_bpermute(src << 2, __builtin_bit_cast(int, v))); }
__device__ __forceinline__ float shx(float v, int mask, int lane) { return shidx(v, lane ^ mask); }
__device__ __forceinline__ float shup(float v, int o, int lane) { return shidx(v, lane >= o ? lane - o : lane); }
__device__ __forceinline__ float wave_sum(float v, int lane) {
#pragma unroll
    for (int o = 1; o < 64; o <<= 1) v += shx(v, o, lane);
    return v;
}
__device__ __forceinline__ void unpack8(v4u w, float (&f)[8]) { f[0] = bflo(w.x); f[1] = bfhi(w.x); f[2] = bflo(w.y); f[3] = bfhi(w.y); f[4] = bflo(w.z); f[5] = bfhi(w.z); f[6] = bflo(w.w); f[7] = bfhi(w.w); }
__device__ __forceinline__ v4u pack8(const float (&f)[8]) { v4u w; w.x = pk2(f[0], f[1]); w.y = pk2(f[2], f[3]); w.z = pk2(f[4], f[5]); w.w = pk2(f[6], f[7]); return w; }

#define XB_TMO      128
#define XB_XCNT(j)  (256  + 64 * (j))
#define XB_XSUB(j)  (1280 + 64 * (j))
#define XB_XGEN(j)  (2304 + 64 * (j))
#define XB_TOP      3328
#define XB_TOPGEN   3392
#define XCD_BAR_WORDS 3456
#define XB_SPIN_CAP (1u << 18)

__device__ __forceinline__ unsigned xb_ld(unsigned* p)              { return __hip_atomic_load(p, __ATOMIC_RELAXED, __HIP_MEMORY_SCOPE_AGENT); }
__device__ __forceinline__ unsigned xb_add(unsigned* p, unsigned) { unsigned one; asm volatile("v_mov_b32 %0, 1" : "=v"(one));
    return __hip_atomic_fetch_add(p, one, __ATOMIC_RELAXED, __HIP_MEMORY_SCOPE_AGENT); }
__device__ __forceinline__ unsigned xb_xcc_id() { return (unsigned)__builtin_amdgcn_s_getreg((3 << 11) | 20) & 0xFu; }
#define XB_SPIN(cond, bar) do { unsigned _sp = 0; while (cond) { __builtin_amdgcn_s_sleep(1); \
    if ((++_sp & 255u) == 0u) { if (xb_ld(&(bar)[XB_TMO])) break; if (_sp > XB_SPIN_CAP) { (void)xb_add(&(bar)[XB_TMO], 1u); break; } } } } while (0)

struct XcdBarrier {
    bool w0;
    unsigned* bar; unsigned x;
    volatile LAS unsigned* st;
};

__device__ __forceinline__ XcdBarrier xcd_barrier_post(unsigned* bar, volatile LAS unsigned* st) {
    XcdBarrier b; b.w0 = false; b.bar = bar; b.x = xb_xcc_id(); b.st = st;
    if (threadIdx.x == 0) (void)xb_add(&bar[XB_XCNT(b.x)], 1u);
    return b;
}
__device__ __forceinline__ void xcd_barrier_complete(unsigned* bar, unsigned x, unsigned& nloc, unsigned& nx) {
    const unsigned G = gridDim.x * gridDim.y * gridDim.z;
    unsigned sum, cnt, mine, sp = 0u;
    for (;;) {
        sum = 0u; cnt = 0u; mine = 0u;
#pragma unroll
        for (unsigned j = 0; j < 16; ++j) { const unsigned c = xb_ld(&bar[XB_XCNT(j)]); sum += c; cnt += (c > 0u) ? 1u : 0u; mine = (j == x) ? c : mine; }
        if (sum == G) break;
        __builtin_amdgcn_s_sleep(1);
        if ((++sp & 255u) == 0u) { if (xb_ld(&bar[XB_TMO])) break; if (sp > XB_SPIN_CAP) { (void)xb_add(&bar[XB_TMO], 1u); break; } }
    }
    nloc = mine > 0u ? mine : 1u; nx = cnt > 0u ? cnt : 1u;
}

__device__ __forceinline__ void xcd_barrier(const XcdBarrier& b) {
    asm volatile("s_waitcnt vmcnt(0)" ::: "memory");
    __syncthreads();
    if (b.w0 && lane_id() == 0) {
        unsigned* bar = b.bar;
        __builtin_amdgcn_s_waitcnt(0);
        unsigned nloc = b.st[0], nx = b.st[1];
        if (nloc == 0u) { xcd_barrier_complete(bar, b.x, nloc, nx); b.st[0] = nloc; b.st[1] = nx; }
        const unsigned old = xb_add(&bar[XB_XSUB(b.x)], 1u);
        const unsigned gen = old / nloc;
        if (old + 1u == (gen + 1u) * nloc) {
            __builtin_amdgcn_fence(__ATOMIC_RELEASE, "agent");
            asm volatile("s_waitcnt vmcnt(0)" ::: "memory");
            const unsigned og = xb_add(&bar[XB_TOP], 1u);
            const unsigned tg = og / nx;
            if (og + 1u == (tg + 1u) * nx) xb_add(&bar[XB_TOPGEN], 1u);
            else XB_SPIN(xb_ld(&bar[XB_TOPGEN]) == tg, bar);
            __builtin_amdgcn_fence(__ATOMIC_ACQUIRE, "agent");
            xb_add(&bar[XB_XGEN(b.x)], 1u);
            asm volatile("s_waitcnt vmcnt(0)" ::: "memory");
        } else {
            XB_SPIN(xb_ld(&bar[XB_XGEN(b.x)]) == gen, bar);
            __builtin_amdgcn_fence(__ATOMIC_ACQUIRE, "agent");
            asm volatile("s_waitcnt vmcnt(0)" ::: "memory");
        }
    }
    __syncthreads();
}

struct Ctx {
    LAS unsigned char* lds;
    volatile LAS unsigned* MISC;
    unsigned* ctl;
    int tid, lane, wave, vcu, G;
    const float* const* in; float* out; unsigned char* ws;
};
__device__ __forceinline__ bf16* wt(const Ctx& F, int l, size_t off) { return (bf16*)(F.ws + WS_W + (size_t)l * W_LAYER + off); }
__device__ __forceinline__ float* hrow(const Ctx& F, int r) { return r < M_LAT ? F.out + (size_t)r * D : (float*)(F.ws + WS_HC) + (size_t)(r - M_LAT) * D; }
__device__ __forceinline__ const float* xrow(const Ctx& F, int r) { return r < M_LAT ? F.in[I_X] + (size_t)r * D : F.in[I_CTX] + (size_t)(r - M_LAT) * D; }
__device__ __forceinline__ int modrow(int r) { return r < M_LAT ? (r >> 11) : 8; }
__device__ __forceinline__ const float* modp(const Ctx& F, int l, int mr) { return (const float*)(F.ws + WS_MOD) + (size_t)(l * 9 + mr) * 6144; }

__device__ __forceinline__ void load_row(const float* p, int lane, f32x4 (&v)[4]) {
#pragma unroll
    for (int j = 0; j < 4; ++j) v[j] = *(const f32x4*)(p + 4 * lane + 256 * j);
}
__device__ __forceinline__ void store_row(float* p, int lane, const f32x4 (&v)[4]) {
#pragma unroll
    for (int j = 0; j < 4; ++j) *(f32x4*)(p + 4 * lane + 256 * j) = v[j];
}
__device__ __forceinline__ void ln_row(f32x4 (&v)[4], const float* g, const float* b, int lane) {
    float s = 0.f;
#pragma unroll
    for (int j = 0; j < 4; ++j) s += (v[j].x + v[j].y) + (v[j].z + v[j].w);
    const float mean = wave_sum(s, lane) * (1.f / D); float s2 = 0.f;
#pragma unroll
    for (int j = 0; j < 4; ++j) { v[j] = v[j] - mean; s2 += (v[j].x * v[j].x + v[j].y * v[j].y) + (v[j].z * v[j].z + v[j].w * v[j].w); }
    const float rstd = 1.f / sqrtf(wave_sum(s2, lane) * (1.f / D) + LN_EPS);
#pragma unroll
    for (int j = 0; j < 4; ++j) { const f32x4 gg = *(const f32x4*)(g + 4 * lane + 256 * j), bb = *(const f32x4*)(b + 4 * lane + 256 * j); v[j] = v[j] * rstd * gg + bb; }
}
__device__ __forceinline__ void emit_u(const f32x4 (&h)[4], const float* sh, const float* sc, bf16* urow, int lane, f32x4 (&u)[4]) {
#pragma unroll
    for (int j = 0; j < 4; ++j) { const f32x4 s1 = *(const f32x4*)(sc + 4 * lane + 256 * j), s0 = *(const f32x4*)(sh + 4 * lane + 256 * j); u[j] = h[j] * (1.0f + s1) + s0;
        v2u w; w.x = pk2(u[j].x, u[j].y); w.y = pk2(u[j].z, u[j].w); *(v2u*)(urow + 4 * lane + 256 * j) = w; }
}
__device__ __forceinline__ void stage_w16(const Ctx& F, const float* W, int ld, LAS float* Wt) {
    for (int idx = F.tid; idx < 1024 * 16; idx += NWAVES * 64) { const int k = idx >> 4, e = idx & 15; Wt[e * 1024 + k] = W[(size_t)k * ld + e]; }
}
__device__ __forceinline__ int elane(int lane) { return ((lane >> 5) & 1) * 8 + ((lane >> 4) & 1) * 4 + ((lane >> 3) & 1) * 2 + ((lane >> 2) & 1); }
__device__ __forceinline__ float dot16r(const f32x4 (&u)[4], const LAS float* Wt, int lane) {
    const LAS float* wl = Wt + 4 * lane; float o[8]; const bool hi5 = (lane & 32) != 0;
#pragma unroll
    for (int k = 0; k < 8; ++k) { float s0 = 0.f, s1 = 0.f;
#pragma unroll
        for (int j = 0; j < 4; ++j) { const f32x4 w0 = *(const LAS f32x4*)(wl + k * 1024 + 256 * j), w1 = *(const LAS f32x4*)(wl + (k + 8) * 1024 + 256 * j);
            s0 += (u[j].x * w0.x + u[j].y * w0.y) + (u[j].z * w0.z + u[j].w * w0.w); s1 += (u[j].x * w1.x + u[j].y * w1.y) + (u[j].z * w1.z + u[j].w * w1.w); }
        const float send = hi5 ? s0 : s1, keep = hi5 ? s1 : s0; o[k] = keep + shx(send, 32, lane);
        asm volatile("" ::: "memory"); }
    { const bool hi = (lane & 16) != 0;
#pragma unroll
        for (int k = 0; k < 4; ++k) { const float send = hi ? o[k] : o[k + 4], keep = hi ? o[k + 4] : o[k]; o[k] = keep + shx(send, 16, lane); } }
    { const bool hi = (lane & 8) != 0;
#pragma unroll
        for (int k = 0; k < 2; ++k) { const float send = hi ? o[k] : o[k + 2], keep = hi ? o[k + 2] : o[k]; o[k] = keep + shx(send, 8, lane); } }
    { const bool hi = (lane & 4) != 0; const float send = hi ? o[0] : o[1], keep = hi ? o[1] : o[0]; o[0] = keep + shx(send, 4, lane); }
    o[0] += shx(o[0], 2, lane); o[0] += shx(o[0], 1, lane);
    return o[0];
}
__device__ __forceinline__ void emit_layer_input(const Ctx& F, int l, int r, const f32x4 (&h)[4]) {
    const float* mp = modp(F, l, modrow(r)); f32x4 u[4];
    emit_u(h, mp + 0, mp + 1024, (bf16*)(F.ws + WS_U) + (size_t)r * D, F.lane, u);
    const float gv = dot16r(u, (const LAS float*)F.lds, F.lane);
    if ((F.lane & 3) == 0) ((float*)(F.ws + WS_G))[(size_t)r * 16 + elane(F.lane)] = gv;
}

__device__ __forceinline__ void tr_item(const float* W, int ldw, int k0, int n0, bf16* WT, int ldt, int drow0, int dk0, LAS float* scr, int lane) {
#pragma unroll 8
    for (int i = 0; i < 32; ++i) { const int kk = 2 * i + (lane >> 5); scr[kk * 33 + (lane & 31)] = W[(size_t)(k0 + kk) * ldw + n0 + (lane & 31)]; }
    LDS_WAIT(); asm volatile("" ::: "memory");
    const int c = lane & 7;
#pragma unroll
    for (int j = 0; j < 4; ++j) { const int n = (lane >> 3) + 8 * j; const LAS float* s = scr + (8 * c) * 33 + n;
        v4u o; o.x = pk2(s[0 * 33], s[1 * 33]); o.y = pk2(s[2 * 33], s[3 * 33]); o.z = pk2(s[4 * 33], s[5 * 33]); o.w = pk2(s[6 * 33], s[7 * 33]);
        *(v4u*)(WT + (size_t)(drow0 + n) * ldt + dk0 + k0 + 8 * c) = o; }
    LDS_WAIT(); asm volatile("" ::: "memory");
}
constexpr int CV_IN = 16 * (NP / 32), CV_ABC = 3 * 8 * 32, CV_OUT = 16 * 32, CV_GU = NE * 16 * 32, CV_DN = NE * 8 * 32, CV_LAYER = CV_IN + CV_ABC + CV_OUT + CV_GU + CV_DN;
__device__ __forceinline__ void convert_item(const Ctx& F, int l, int it, LAS float* scr) {
    const int lane = F.lane;
    if (it < CV_IN) { const int kb = it / (NP / 32), nb = it % (NP / 32), n0 = 32 * nb;
        tr_item(F.in[I_WIN] + (size_t)l * D * D_IN, D_IN, 64 * kb, n0 < PBG ? n0 : n0 + 16, wt(F, l, W_IN), D, n0, 0, scr, lane); return; }
    it -= CV_IN;
    if (it < CV_ABC) { const int br = it / 256, r = it % 256, kb = r / 32, nb = r % 32;
        if (br == 0) tr_item(F.in[I_WA] + (size_t)l * 512 * D, D, 64 * kb, 32 * nb, wt(F, l, W_ABC), NY, 32 * nb, 0, scr, lane);
        else if (br == 1) tr_item(F.in[I_WB] + (size_t)l * 512 * D, D, 64 * kb, 32 * nb, wt(F, l, W_ABC), NY, 32 * nb, 512, scr, lane);
        else tr_item(F.in[I_WC] + (size_t)l * 512 * D, D, 64 * kb, 32 * nb, wt(F, l, W_ABC), NY, 32 * nb, 1024, scr, lane);
        return; }
    it -= CV_ABC;
    if (it < CV_OUT) { const int kb = it / 32, nb = it % 32; tr_item(F.in[I_WOUT] + (size_t)l * D * D, D, 64 * kb, 32 * nb, wt(F, l, W_OUT), D, 32 * nb, 0, scr, lane); return; }
    it -= CV_OUT;
    if (it < CV_GU) { const int e = it / 512, r = it % 512, kb = r / 32, nb = r % 32, n0 = 32 * nb;
        const int dr = n0 < 512 ? (n0 / 128) * 256 + (n0 % 128) : ((n0 - 512) / 128) * 256 + 128 + ((n0 - 512) % 128);
        tr_item(F.in[I_WGU] + (size_t)(l * NE + e) * D * D, D, 64 * kb, n0, wt(F, l, W_GU) + (size_t)e * D * D, D, dr, 0, scr, lane); return; }
    it -= CV_GU;
    { const int e = it / 256, r = it % 256, kb = r / 32, nb = r % 32;
        tr_item(F.in[I_WDN] + (size_t)(l * NE + e) * DEXP * D, D, 64 * kb, 32 * nb, wt(F, l, W_DN) + (size_t)e * D * DEXP, DEXP, 32 * nb, 0, scr, lane); }
}
__device__ __forceinline__ void p0_prologue(const Ctx& F) {
    if (F.vcu < 192) {
        LAS float* S = (LAS float*)F.lds; LAS float* red = (LAS float*)(F.lds + 36864);
        for (int idx = F.tid; idx < 9 * D; idx += NWAVES * 64) { const int r = idx >> 10, k = idx & 1023; const float v = r < 8 ? F.in[I_C][r * D + k] : F.in[I_CCTX][k]; S[idx] = v * sigmoidf_(v); }
        __syncthreads();
        const int l = F.vcu / 96, n0 = (F.vcu % 96) * 64;
        float acc[9];
#pragma unroll
        for (int r = 0; r < 9; ++r) acc[r] = 0.f;
        const float* wp = F.in[I_WMOD] + ((size_t)l * D + 128 * F.wave) * 6144 + n0 + F.lane;
#pragma unroll 4
        for (int kk = 0; kk < 128; ++kk) { const float wv = wp[(size_t)kk * 6144];
#pragma unroll
            for (int r = 0; r < 9; ++r) acc[r] += S[r * D + 128 * F.wave + kk] * wv; }
#pragma unroll
        for (int r = 0; r < 9; ++r) red[(F.wave * 9 + r) * 64 + F.lane] = acc[r];
        __syncthreads();
        for (int idx = F.tid; idx < 9 * 64; idx += NWAVES * 64) { const int r = idx >> 6, c = idx & 63; float s = 0.f;
#pragma unroll
            for (int w = 0; w < 8; ++w) s += red[(w * 9 + r) * 64 + c];
            ((float*)(F.ws + WS_MOD))[(size_t)(l * 9 + r) * 6144 + n0 + c] = s + F.in[I_BMOD][l * 6144 + n0 + c]; }
        __syncthreads();
    }
    if (F.vcu == 255) for (int idx = F.tid; idx < 1024; idx += NWAVES * 64) { const int pos = idx >> 4, i = idx & 15;
        const float inv = i == 0 ? 1.000000000e+00f : i == 1 ? 5.623413324e-01f : i == 2 ? 3.162277639e-01f : i == 3 ? 1.778279394e-01f : i == 4 ? 1.000000015e-01f : i == 5 ? 5.623413250e-02f : i == 6 ? 3.162277490e-02f : i == 7 ? 1.778279431e-02f :
                          i == 8 ? 9.999999776e-03f : i == 9 ? 5.623413250e-03f : i == 10 ? 3.162277630e-03f : i == 11 ? 1.778279431e-03f : i == 12 ? 1.000000047e-03f : i == 13 ? 5.623413017e-04f : i == 14 ? 3.162277571e-04f : 1.778279402e-04f;
        const float angf = (float)pos * inv; const double x = (double)angf;
        const double kq = __builtin_rint(x * 0.63661977236758134308); const double r = (x - kq * 1.57079632679489655800) - kq * 6.123233995736766036e-17; const int q = ((int)kq) & 3;
        const double r2 = r * r;
        const double sn = r * (1.0 + r2 * (-1.0 / 6 + r2 * (1.0 / 120 + r2 * (-1.0 / 5040 + r2 * (1.0 / 362880 + r2 * (-1.0 / 39916800 + r2 * (1.0 / 6227020800.0)))))));
        const double cs = 1.0 + r2 * (-0.5 + r2 * (1.0 / 24 + r2 * (-1.0 / 720 + r2 * (1.0 / 40320 + r2 * (-1.0 / 3628800 + r2 * (1.0 / 479001600.0 + r2 * (-1.0 / 87178291200.0)))))));
        const double c = q == 0 ? cs : q == 1 ? -sn : q == 2 ? -cs : sn, s_ = q == 0 ? sn : q == 1 ? cs : q == 2 ? -sn : -cs;
        ((float*)(F.ws + WS_ROPE))[2 * idx] = (float)c; ((float*)(F.ws + WS_ROPE))[2 * idx + 1] = (float)s_; }
    LAS float* scr = (LAS float*)(F.lds + F.wave * 16384);
    const int gw = F.vcu * NWAVES + F.wave, NGW = F.G * NWAVES;
    for (int it = gw; it < CV_LAYER; it += NGW) convert_item(F, 0, it, scr);
}
__device__ __forceinline__ void convert_layer1_on_idle(const Ctx& F, int first) {
    LAS float* scr = (LAS float*)(F.lds + F.wave * 16384);
    const int gw = ((int)blockIdx.x - first) * NWAVES + F.wave, NGW = (F.G - first) * NWAVES;
    if ((int)blockIdx.x >= first) for (int it = gw; it < CV_LAYER; it += NGW) convert_item(F, 1, it, scr);
}
__device__ __forceinline__ void p1_ln_in(const Ctx& F) {
    const int gw = F.vcu * NWAVES + F.wave, NGW = F.G * NWAVES;
    stage_w16(F, F.in[I_WIN] + SRC_MG, D_IN, (LAS float*)F.lds); __syncthreads();
    for (int r = gw; r < M_ALL; r += NGW) { f32x4 v[4]; load_row(xrow(F, r), F.lane, v);
        ln_row(v, F.in[I_LNIN_G], F.in[I_LNIN_B], F.lane); store_row(hrow(F, r), F.lane, v); emit_layer_input(F, 0, r, v); }
}

__device__ __forceinline__ void conv_unit(const Ctx& F, int l, int unit) {
    const bf16* P = (const bf16*)(F.ws + WS_P); bf16* Y = (bf16*)(F.ws + WS_Y);
    int seq0, T, t0;
    if (unit < 512) { const int b = unit >> 6; seq0 = b * SEQ; T = SEQ; t0 = (unit & 63) * 32; }
    else { const int j = unit - 512, b = j >> 3; seq0 = M_LAT + b * LCTX; T = LCTX; t0 = (j & 7) * 32; }
    const int c = F.tid;
    LAS bf16* Ut = (LAS bf16*)F.lds;
#pragma unroll 2
    for (int p = F.tid; p < 62 * 64; p += NWAVES * 64) { const int i = p >> 6, c8 = p & 63, t = t0 - 15 + i; v4u o = {0u, 0u, 0u, 0u};
        if (t >= 0 && t < T) { const bf16* pr = P + (size_t)(seq0 + t) * NP + 8 * c8; const v4u xv = *(const v4u*)(pr + PA_VAL), xg = *(const v4u*)(pr + PA_GATE);
            float a[8], g[8], uo[8]; unpack8(xv, a); unpack8(xg, g);
#pragma unroll
            for (int j = 0; j < 8; ++j) uo[j] = a[j] * sigmoidf_(g[j]);
            o = pack8(uo); }
        *(LAS v4u*)(Ut + i * 512 + 8 * c8) = o; }
    float w[31];
#pragma unroll
    for (int j = 0; j < 31; ++j) w[j] = F.in[I_CONVW][(size_t)(l * 31 + j) * 512 + c];
    const float bias = F.in[I_CONVB][l * 512 + c];
    __syncthreads();
    float u[62];
#pragma unroll
    for (int i = 0; i < 62; ++i) u[i] = bf1(Ut[i * 512 + c]);
    LAS float* Yt = (LAS float*)(F.lds + 62 * 512 * 2);
#pragma unroll
    for (int tt = 0; tt < 32; ++tt) { float y = bias;
#pragma unroll
        for (int j = 0; j < 31; ++j) y += w[j] * u[tt + j];
        Yt[tt * 512 + c] = y; }
    __syncthreads();
    const float* lg = F.in[I_CONVLN_G] + l * 512; const float* lb = F.in[I_CONVLN_B] + l * 512;
#pragma unroll
    for (int q = 0; q < 4; ++q) { const int tt = 4 * F.wave + q; float v[8]; float s = 0.f;
#pragma unroll
        for (int jj = 0; jj < 8; ++jj) { v[jj] = Yt[tt * 512 + F.lane + 64 * jj]; s += v[jj]; }
        const float mean = wave_sum(s, F.lane) * (1.f / 512.f); float s2 = 0.f;
#pragma unroll
        for (int jj = 0; jj < 8; ++jj) { v[jj] -= mean; s2 += v[jj] * v[jj]; }
        const float rstd = 1.f / sqrtf(wave_sum(s2, F.lane) * (1.f / 512.f) + LN_EPS);
        bf16* yr = Y + (size_t)(seq0 + t0 + tt) * NY;
#pragma unroll
        for (int jj = 0; jj < 8; ++jj) { const int cc = F.lane + 64 * jj; const float z = v[jj] * rstd * lg[cc] + lb[cc]; yr[cc] = (bf16)f2bf(MK_ABL_A * z * sigmoidf_(z)); } }
    __syncthreads();
}

constexpr int AT_KSTR = 72, AT_VSTR = 136, AT_KS_OFF = 0, AT_VT_OFF = 128 * AT_KSTR * 2;
constexpr int AT_QF_OFF = 36864;
constexpr int AT_ROPE_OFF = LDSCTL_OFF + 1024;
struct AttnTileRegs { v4u k1, k2, v1, v2; };
__device__ __forceinline__ void attn_tile_src(int b, int nb, int ti, int& krow0, int& tok0, bool& rope, int& mode) {
    mode = 0; tok0 = 0; rope = false;
    if (ti < 2) krow0 = M_LAT + b * LCTX + 128 * ti;
    else { const int kb = nb + ti - 3; krow0 = b * SEQ + kb * 128; tok0 = kb * 128; rope = true; mode = ti == 2 ? 1 : ti == 4 ? 2 : 0; }
}
__device__ __forceinline__ void attn_tile_load(const Ctx& F, const bf16* P, int krow0, int hk, AttnTileRegs& R) {
    { const int key = F.tid >> 2, pc = F.tid & 3, c1 = pc < 2 ? pc : pc + 2; const unsigned eo = (unsigned)((krow0 + key) * NP + PK + hk * 64 + 8 * c1);
        R.k1 = *(const v4u*)(P + eo); R.k2 = *(const v4u*)(P + eo + 16); }
    { const int key = F.tid & 127, pc = F.tid >> 7; const unsigned eo = (unsigned)((krow0 + key) * NP + PV + hk * 64 + 16 * pc);
        R.v1 = *(const v4u*)(P + eo); R.v2 = *(const v4u*)(P + eo + 8); }
}
__device__ __forceinline__ void attn_tile_store(const Ctx& F, bool rope, int tok0, const AttnTileRegs& R) {
    LAS bf16* Ks = (LAS bf16*)(F.lds + AT_KS_OFF); LAS bf16* Vt = (LAS bf16*)(F.lds + AT_VT_OFF);
    { const int key = F.tid >> 2, pc = F.tid & 3, c1 = pc < 2 ? pc : pc + 2, c2 = c1 + 2; v4u x1 = R.k1, x2 = R.k2;
        if (rope) { const int tok = tok0 + key, pos = pc < 2 ? (tok >> 6) : (tok & 63), ib = 8 * (pc & 1);
            const LAS float* rt = (const LAS float*)(F.lds + AT_ROPE_OFF) + (pos * 16 + ib) * 2;
            float a[8], b[8], oa[8], ob[8]; unpack8(x1, a); unpack8(x2, b);
#pragma unroll
            for (int j = 0; j < 8; ++j) { const float cs = rt[2 * j], sn = rt[2 * j + 1]; oa[j] = a[j] * cs - b[j] * sn; ob[j] = a[j] * sn + b[j] * cs; }
            x1 = pack8(oa); x2 = pack8(ob); }
        *(LAS v4u*)(Ks + key * AT_KSTR + 8 * c1) = x1; *(LAS v4u*)(Ks + key * AT_KSTR + 8 * c2) = x2; }
    { const int key = F.tid & 127, pc = F.tid >> 7;
        const unsigned ww[8] = {R.v1.x, R.v1.y, R.v1.z, R.v1.w, R.v2.x, R.v2.y, R.v2.z, R.v2.w};
#pragma unroll
        for (int j = 0; j < 8; ++j) { Vt[(16 * pc + 2 * j) * AT_VSTR + key] = (bf16)(ww[j] & 0xffffu); Vt[(16 * pc + 2 * j + 1) * AT_VSTR + key] = (bf16)(ww[j] >> 16); } }
}
__device__ __forceinline__ void attn_rope_to_lds(const Ctx& F) {
    for (int i = F.tid; i < 2048; i += NWAVES * 64) ((LAS float*)(F.lds + AT_ROPE_OFF))[i] = ((const float*)(F.ws + WS_ROPE))[i];
    __syncthreads();
}
__device__ __forceinline__ void attn_unit(const Ctx& F, int l, int kind, int b, int nb, int hk) {
    const bf16* P = (const bf16*)(F.ws + WS_P); bf16* Y = (bf16*)(F.ws + WS_Y);
    const LAS bf16* Ks = (const LAS bf16*)(F.lds + AT_KS_OFF); const LAS bf16* Vt = (const LAS bf16*)(F.lds + AT_VT_OFF);
    const int lane = F.lane, w = F.wave, gi = w >> 1, th = w & 1, g = 4 * hk + gi, l31 = lane & 31, h = lane >> 5;
    int qrow[2];
#pragma unroll
    for (int qb = 0; qb < 2; ++qb) {
        const int iq = 64 * th + 32 * qb + l31, tok = nb * 128 + iq;
        const int row = kind == 0 ? b * SEQ + tok : M_LAT + b * LCTX + tok; qrow[qb] = row;
        const bf16* src = P + (size_t)row * NP + PQ + g * 64 + 8 * h;
        float x[4][8];
#pragma unroll
        for (int s = 0; s < 4; ++s) { const v4u raw = *(const v4u*)(src + 16 * s); unpack8(raw, x[s]); }
        if (kind == 0) {
            const LAS float* rtr = (const LAS float*)(F.lds + AT_ROPE_OFF) + ((tok >> 6) * 16 + 8 * h) * 2; const LAS float* rtc = (const LAS float*)(F.lds + AT_ROPE_OFF) + ((tok & 63) * 16 + 8 * h) * 2;
#pragma unroll
            for (int j = 0; j < 8; ++j) { float cs = rtr[2 * j], sn = rtr[2 * j + 1]; float a = x[0][j], bb = x[1][j]; x[0][j] = a * cs - bb * sn; x[1][j] = a * sn + bb * cs;
                cs = rtc[2 * j]; sn = rtc[2 * j + 1]; a = x[2][j]; bb = x[3][j]; x[2][j] = a * cs - bb * sn; x[3][j] = a * sn + bb * cs; } }
#pragma unroll
        for (int s = 0; s < 4; ++s) {
#pragma unroll
            for (int j = 0; j < 8; ++j) x[s][j] *= 0.125f * 1.44269504f;
            const v4u pk = pack8(x[s]); *(LAS v4u*)(F.lds + AT_QF_OFF + (((w * 2 + qb) * 4 + s) * 64 + lane) * 16) = pk; }
    }
    f32x16 O[2][2];
    float mrun[2], lsum[2];
    const float sink = F.in[I_SINK][l * 8 + g] * 1.44269504f;
#pragma unroll
    for (int qb = 0; qb < 2; ++qb) { mrun[qb] = sink; lsum[qb] = h == 0 ? 1.0f : 0.0f;
#pragma unroll
        for (int db = 0; db < 2; ++db)
#pragma unroll
            for (int r = 0; r < 16; ++r) O[db][qb][r] = 0.f; }
    const int ntile = kind == 0 ? 5 : 2;
    AttnTileRegs TR; int ti = 0;
    { int krow0, tok0, mode; bool rope; attn_tile_src(b, nb, 0, krow0, tok0, rope, mode); attn_tile_load(F, P, krow0, hk, TR); }
    while (ti < ntile) {
        int krow0, tok0, mode; bool rope; attn_tile_src(b, nb, ti, krow0, tok0, rope, mode);
        int tn = ti + 1; if (kind == 0) { if (tn == 2 && nb == 0) tn = 3; if (tn == 4 && nb == SEQ / 128 - 1) tn = 5; }
        __syncthreads();
        attn_tile_store(F, rope, tok0, TR);
        __syncthreads();
        if (tn < ntile) { int kr2, tk2, md2; bool rp2; attn_tile_src(b, nb, tn, kr2, tk2, rp2, md2); attn_tile_load(F, P, kr2, hk, TR); }
        ti = tn;
#pragma unroll 1
        for (int kh = 0; kh < 2; ++kh) {
            if ((mode == 1 && th == 1 && kh == 0) || (mode == 2 && th == 0 && kh == 1)) continue;
#pragma unroll
            for (int qb = 0; qb < 2; ++qb) {
                bf16x8 qfr[4];
#pragma unroll
                for (int s = 0; s < 4; ++s) qfr[s] = *(const LAS bf16x8*)(F.lds + AT_QF_OFF + (((w * 2 + qb) * 4 + s) * 64 + lane) * 16);
                f32x16 st[2];
#pragma unroll
                for (int kb = 0; kb < 2; ++kb) {
#pragma unroll
                    for (int r = 0; r < 16; ++r) st[kb][r] = 0.f;
#pragma unroll
                    for (int s = 0; s < 4; ++s) { const bf16x8 a = *(const LAS bf16x8*)(Ks + (64 * kh + 32 * kb + l31) * AT_KSTR + 16 * s + 8 * h);
                        st[kb] = __builtin_amdgcn_mfma_f32_32x32x16_bf16(a, qfr[s], st[kb], 0, 0, 0); }
                    asm volatile("" ::: "memory"); }
                const int iq = 64 * th + 32 * qb + l31;
                float mx = -INFINITY;
                if (mode != 0) {
#pragma unroll
                    for (int kb = 0; kb < 2; ++kb)
#pragma unroll
                        for (int r = 0; r < 16; ++r) { const int key = 64 * kh + 32 * kb + (r & 3) + 8 * (r >> 2) + 4 * h;
                            const bool valid = mode == 1 ? key >= iq : key <= iq; st[kb][r] = valid ? st[kb][r] : -INFINITY; } }
#pragma unroll
                for (int kb = 0; kb < 2; ++kb)
#pragma unroll
                    for (int r = 0; r < 16; ++r) mx = fmaxf(mx, st[kb][r]);
                mx = fmaxf(mx, shx(mx, 32, lane));
                const float mnew = fmaxf(mrun[qb], mx), alpha = __builtin_amdgcn_exp2f(mrun[qb] - mnew); mrun[qb] = mnew;
                float ps = 0.f;
#pragma unroll
                for (int kb = 0; kb < 2; ++kb)
#pragma unroll
                    for (int r = 0; r < 16; ++r) { const float p = __builtin_amdgcn_exp2f(st[kb][r] - mnew); st[kb][r] = p; ps += p; }
                lsum[qb] = lsum[qb] * alpha + ps;
#pragma unroll
                for (int db = 0; db < 2; ++db)
#pragma unroll
                    for (int r = 0; r < 16; ++r) O[db][qb][r] *= alpha;
#pragma unroll
                for (int kb = 0; kb < 2; ++kb)
#pragma unroll
                    for (int s2 = 0; s2 < 2; ++s2) {
                        v4u pw; pw.x = pk2(st[kb][8 * s2 + 0], st[kb][8 * s2 + 1]); pw.y = pk2(st[kb][8 * s2 + 2], st[kb][8 * s2 + 3]);
                        pw.z = pk2(st[kb][8 * s2 + 4], st[kb][8 * s2 + 5]); pw.w = pk2(st[kb][8 * s2 + 6], st[kb][8 * s2 + 7]);
                        const bf16x8 pf = __builtin_bit_cast(bf16x8, pw);
#pragma unroll
                        for (int db = 0; db < 2; ++db) { const LAS bf16* vp = Vt + (32 * db + l31) * AT_VSTR + 64 * kh + 32 * kb + 16 * s2 + 4 * h;
                            const v2u v0 = *(const LAS v2u*)(vp), v1 = *(const LAS v2u*)(vp + 8);
                            v4u av; av.x = v0.x; av.y = v0.y; av.z = v1.x; av.w = v1.y;
                            O[db][qb] = __builtin_amdgcn_mfma_f32_32x32x16_bf16(__builtin_bit_cast(bf16x8, av), pf, O[db][qb], 0, 0, 0); }
                    }
                asm volatile("" ::: "memory");
            }
        }
    }
#pragma unroll
    for (int qb = 0; qb < 2; ++qb) {
        const float lt = lsum[qb] + shx(lsum[qb], 32, lane), inv = MK_ABL_B / lt;
        bf16* yr = Y + (size_t)qrow[qb] * NY + 512 + g * 64;
#pragma unroll
        for (int db = 0; db < 2; ++db)
#pragma unroll
            for (int gq = 0; gq < 4; ++gq) { v2u o; o.x = pk2(O[db][qb][4 * gq] * inv, O[db][qb][4 * gq + 1] * inv); o.y = pk2(O[db][qb][4 * gq + 2] * inv, O[db][qb][4 * gq + 3] * inv);
                *(v2u*)(yr + 32 * db + 8 * gq + 4 * h) = o; }
    }
}

constexpr int ML_QS = 0, ML_KS = 17408, ML_KTS = 34816, ML_VTS = 53248, ML_WS = 73984, ML_CTS = 83200, ML_SM = 122368;
constexpr int ML_QSTR = 136, ML_TSTR = 72;
static_assert(ML_SM + 5 * 256 <= RING_BYTES, "mLSTM LDS");
__device__ __forceinline__ float log_sigmoid(float x) { return fminf(x, 0.f) - __logf(1.0f + __expf(-fabsf(x))); }
__device__ __forceinline__ int ml_chunk_base(int ci, int b, int dir) { const int cc = ci < 4 ? ci : ci - 4, nc = ci < 4 ? 4 : 32, cs = dir == 0 ? cc : nc - 1 - cc; return (ci < 4 ? M_LAT + b * LCTX : b * SEQ) + 64 * cs; }
__device__ __forceinline__ void mlstm_chain(const Ctx& F, int l, int unit) {
    const int chain = unit >> 1, half = unit & 1;
    const bf16* P = (const bf16*)(F.ws + WS_P); const float* G = (const float*)(F.ws + WS_G);
    const int b = chain >> 3, hd = (chain >> 1) & 3, dir = chain & 1, lane = F.lane, w = F.wave, tid = F.tid, l15 = lane & 15, lq = lane >> 4;
    bf16* Hout = (bf16*)(F.ws + (dir == 0 ? WS_HF : WS_HB));
    LAS bf16* Qs = (LAS bf16*)(F.lds + ML_QS); LAS bf16* Ks = (LAS bf16*)(F.lds + ML_KS); LAS bf16* KTs = (LAS bf16*)(F.lds + ML_KTS); LAS bf16* VTs = (LAS bf16*)(F.lds + ML_VTS);
    LAS bf16* Ws = (LAS bf16*)(F.lds + ML_WS); LAS bf16* CTs = (LAS bf16*)(F.lds + ML_CTS);
    LAS float* GA = (LAS float*)(F.lds + ML_SM); LAS float* GG = GA + 64; LAS float* WIN = GA + 128; LAS float* EM = GA + 192; LAS float* DEN = GA + 256;
    const float gbi = F.in[I_GATEB][l * 16 + dir * 8 + hd], gbf = F.in[I_GATEB][l * 16 + dir * 8 + 4 + hd];
    __syncthreads();
#if defined(MK_PROBE_LDSCLR)
    for (int i = tid; i < RING_BYTES / 4; i += NWAVES * 64) ((LAS unsigned*)F.lds)[i] = 0u;
    __syncthreads();
#endif
    for (int i = tid; i < 80 * ML_QSTR / 2; i += NWAVES * 64) ((LAS unsigned*)CTs)[i] = 0u;
    for (int i = tid; i < 16 * ML_TSTR / 2; i += NWAVES * 64) ((LAS unsigned*)(VTs + 64 * ML_TSTR))[i] = (i < ML_TSTR / 2) ? 0x3f803f80u : 0u;
    f32x4 Cacc[5];
#pragma unroll
    for (int e = 0; e < 5; ++e) Cacc[e] = (f32x4){0.f, 0.f, 0.f, 0.f};
    float mst = 0.f;
    const int pr0 = tid & 31, c16 = tid >> 5;
    v4u nq[2], nk[2], nv[2]; float nig, nfg;
#define ML_ISSUE_LOADS(ci_) do { const int base_ = ml_chunk_base((ci_), b, dir); \
        _Pragma("unroll") for (int q = 0; q < 2; ++q) { const int jj = pr0 + 32 * q, tok = base_ + (dir == 0 ? jj : 63 - jj); const bf16* rp = P + (size_t)tok * NP + hd * 128 + 8 * c16; \
            nq[q] = *(const v4u*)(rp + PMQ); nk[q] = *(const v4u*)(rp + PMK); nv[q] = *(const v4u*)(rp + PMV); } \
        { const int tok = base_ + (dir == 0 ? lane : 63 - lane); nig = G[(size_t)tok * 16 + dir * 8 + hd]; nfg = G[(size_t)tok * 16 + dir * 8 + 4 + hd]; } } while (0)
    ML_ISSUE_LOADS(0);
    for (int ci = 0; ci < 36; ++ci) {
        const int base = ml_chunk_base(ci, b, dir);
#if defined(MK_PROBE_NOGATES)
        const float ig = gbi, lf = log_sigmoid(gbf);
#else
        const float ig = nig + gbi, lf = log_sigmoid(nfg + gbf);
#endif
        float bc = lf;
#pragma unroll
        for (int o = 1; o < 64; o <<= 1) { const float t = shup(bc, o, lane); if (lane >= o) bc += t; }
        const float a = ig - bc; float pm = a;
#pragma unroll
        for (int o = 1; o < 64; o <<= 1) { const float t = shup(pm, o, lane); if (lane >= o) pm = fmaxf(pm, t); }
        const float gj = fmaxf(mst, pm), g63 = shidx(gj, 63), b63 = shidx(bc, 63);
        const float wsc = __expf(a - g63) * KSCALE, decay = __expf(mst - g63);
        if (w == 0) { GA[lane] = a; GG[lane] = gj; WIN[lane] = __expf(mst - gj); EM[lane] = __expf(-(bc + gj)); }
#pragma unroll
        for (int q = 0; q < 2; ++q) { const int jj = pr0 + 32 * q;
            *(LAS v4u*)(Qs + jj * ML_QSTR + 8 * c16) = nq[q]; *(LAS v4u*)(Ks + jj * ML_QSTR + 8 * c16) = nk[q];
            const float ws = shidx(wsc, jj); float kf[8]; unpack8(nk[q], kf);
            const unsigned vv[4] = {nv[q].x, nv[q].y, nv[q].z, nv[q].w};
#pragma unroll
            for (int j = 0; j < 4; ++j) { const unsigned pw = pk2(kf[2 * j] * ws, kf[2 * j + 1] * ws); KTs[(8 * c16 + 2 * j) * ML_TSTR + jj] = (bf16)(pw & 0xffffu); KTs[(8 * c16 + 2 * j + 1) * ML_TSTR + jj] = (bf16)(pw >> 16); }
            if ((c16 >> 3) == half) {
#pragma unroll
            for (int j = 0; j < 4; ++j) { VTs[(8 * (c16 & 7) + 2 * j) * ML_TSTR + jj] = (bf16)(vv[j] & 0xffffu); VTs[(8 * (c16 & 7) + 2 * j + 1) * ML_TSTR + jj] = (bf16)(vv[j] >> 16); } } }
        if (ci + 1 < 36) ML_ISSUE_LOADS(ci + 1);
        __syncthreads();
        const int rb = w >> 1, eb0 = (w & 1) ? 3 : 0, neb = (w & 1) ? 2 : 3;
        f32x4 inter[3];
        { f32x4 sa[2] = {(f32x4){0.f, 0.f, 0.f, 0.f}, (f32x4){0.f, 0.f, 0.f, 0.f}}; bf16x8 qf[4];
#pragma unroll
            for (int kk = 0; kk < 4; ++kk) { qf[kk] = *(const LAS bf16x8*)(Qs + (16 * rb + l15) * ML_QSTR + 32 * kk + 8 * lq);
#pragma unroll
                for (int cb = 0; cb < 2; ++cb) { const bf16x8 bfr = *(const LAS bf16x8*)(Ks + (16 * (2 * (w & 1) + cb) + l15) * ML_QSTR + 32 * kk + 8 * lq);
                    sa[cb] = __builtin_amdgcn_mfma_f32_16x16x32_bf16(qf[kk], bfr, sa[cb], 0, 0, 0); } }
#pragma unroll
            for (int i = 0; i < 3; ++i) { inter[i] = (f32x4){0.f, 0.f, 0.f, 0.f}; if (i < neb) {
#pragma unroll
                for (int kk = 0; kk < 4; ++kk) inter[i] = __builtin_amdgcn_mfma_f32_16x16x32_bf16(qf[kk], *(const LAS bf16x8*)(CTs + (16 * (eb0 + i) + l15) * ML_QSTR + 32 * kk + 8 * lq), inter[i], 0, 0, 0); } }
#pragma unroll
            for (int cb = 0; cb < 2; ++cb) { const int s = 16 * (2 * (w & 1) + cb) + l15; const float as = GA[s];
#pragma unroll
                for (int r = 0; r < 4; r += 2) { const int j = 16 * rb + 4 * lq + r;
                    const float a0 = s <= j ? (as - GG[j]) * 1.44269504f : -INFINITY, a1 = s <= j + 1 ? (as - GG[j + 1]) * 1.44269504f : -INFINITY;
                    const unsigned pw = pk2(sa[cb][r] * KSCALE * __builtin_amdgcn_exp2f(a0), sa[cb][r + 1] * KSCALE * __builtin_amdgcn_exp2f(a1));
                    Ws[j * ML_TSTR + s] = (bf16)(pw & 0xffffu); Ws[(j + 1) * ML_TSTR + s] = (bf16)(pw >> 16); } } }
        __syncthreads();
        f32x4 num[3]; float em[4];
        { bf16x8 wf[2];
#pragma unroll
            for (int kk = 0; kk < 2; ++kk) wf[kk] = *(const LAS bf16x8*)(Ws + (16 * rb + l15) * ML_TSTR + 32 * kk + 8 * lq);
            float win[4];
#pragma unroll
            for (int r = 0; r < 4; ++r) { win[r] = WIN[16 * rb + 4 * lq + r]; em[r] = EM[16 * rb + 4 * lq + r]; }
#pragma unroll
            for (int i = 0; i < 3; ++i) { if (i < neb) { const int eb = eb0 + i; f32x4 aw = (f32x4){0.f, 0.f, 0.f, 0.f};
#pragma unroll
                for (int kk = 0; kk < 2; ++kk) aw = __builtin_amdgcn_mfma_f32_16x16x32_bf16(wf[kk], *(const LAS bf16x8*)(VTs + (16 * eb + l15) * ML_TSTR + 32 * kk + 8 * lq), aw, 0, 0, 0);
#pragma unroll
                for (int r = 0; r < 4; ++r) num[i][r] = aw[r] + win[r] * inter[i][r];
                if (eb == 4 && l15 == 0) {
#pragma unroll
                    for (int r = 0; r < 4; ++r) DEN[16 * rb + 4 * lq + r] = num[i][r]; } } } }
        { bf16x8 kf[2];
#pragma unroll
            for (int kk = 0; kk < 2; ++kk) kf[kk] = *(const LAS bf16x8*)(KTs + (16 * w + l15) * ML_TSTR + 32 * kk + 8 * lq);
#pragma unroll
            for (int eb = 0; eb < 5; ++eb) { Cacc[eb] = Cacc[eb] * decay;
#pragma unroll
                for (int kk = 0; kk < 2; ++kk) Cacc[eb] = __builtin_amdgcn_mfma_f32_16x16x32_bf16(kf[kk], *(const LAS bf16x8*)(VTs + (16 * eb + l15) * ML_TSTR + 32 * kk + 8 * lq), Cacc[eb], 0, 0, 0);
                v2u o; o.x = pk2(Cacc[eb][0], Cacc[eb][1]); o.y = pk2(Cacc[eb][2], Cacc[eb][3]);
                *(LAS v2u*)(CTs + (16 * eb + l15) * ML_QSTR + 16 * w + 4 * lq) = o; } }
        mst = b63 + g63;
        __syncthreads();
        { float dn[4];
#pragma unroll
            for (int r = 0; r < 4; ++r) dn[r] = 1.0f / fmaxf(fabsf(DEN[16 * rb + 4 * lq + r]), em[r]);
#pragma unroll
            for (int i = 0; i < 3; ++i) { if (i < neb && eb0 + i < 4) { const int e = 64 * half + 16 * (eb0 + i) + l15;
#pragma unroll
                for (int r = 0; r < 4; r += 2) { const int j = 16 * rb + 4 * lq + r, tok = base + (dir == 0 ? j : 63 - j), tok1 = base + (dir == 0 ? j + 1 : 62 - j);
                    const unsigned pw = pk2(num[i][r] * dn[r], num[i][r + 1] * dn[r + 1]);
                    Hout[(size_t)tok * 512 + hd * 128 + e] = (bf16)(pw & 0xffffu); Hout[(size_t)tok1 * 512 + hd * 128 + e] = (bf16)(pw >> 16); } } } }
    }
#undef ML_ISSUE_LOADS
}

__device__ __forceinline__ void c0_combine(const Ctx& F, int l, int nrows) {
    const bf16* P = (const bf16*)(F.ws + WS_P); const bf16* HF = (const bf16*)(F.ws + WS_HF); const bf16* HB = (const bf16*)(F.ws + WS_HB); bf16* Y = (bf16*)(F.ws + WS_Y);
    const int gw = F.vcu * NWAVES + F.wave, NGW = F.G * NWAVES, lane = F.lane;
    for (int it = gw; it < nrows * 4; it += NGW) { const int r = it >> 2, hd = it & 3, col = hd * 128 + 2 * lane;
        const unsigned a = *(const unsigned*)(HF + (size_t)r * 512 + col), bq = *(const unsigned*)(HB + (size_t)r * 512 + col), mo = *(const unsigned*)(P + (size_t)r * NP + PMO + col);
#if defined(MK_PROBE_C0)
        float x0 = bflo(mo) + 0.f * (bflo(a) + bflo(bq)) * 0.f, x1 = bfhi(mo);
#else
        float x0 = bflo(a) + bflo(bq), x1 = bfhi(a) + bfhi(bq);
#endif
        const float mean = wave_sum(x0 + x1, lane) * (1.f / 128.f); x0 -= mean; x1 -= mean;
        const float rstd = 1.f / sqrtf(wave_sum(x0 * x0 + x1 * x1, lane) * (1.f / 128.f) + LN_EPS);
        const float g0 = F.in[I_NORMG][l * 512 + col], g1 = F.in[I_NORMG][l * 512 + col + 1];
        *(unsigned*)(Y + (size_t)r * NY + 1024 + col) = pk2(MK_ABL_C * sigmoidf_(bflo(mo)) * x0 * rstd * g0, MK_ABL_C * sigmoidf_(bfhi(mo)) * x1 * rstd * g1); }
}

struct EpiProj {
    static constexpr bool PERM = true, AFTER_DRAIN = false, RESCALE = false;
    bf16* O; int ldc;
    __device__ __forceinline__ void operator()(const pg8::f32x4 (&acc)[2][2][4][2], const pg8::Unit& u, int wr, int wc, int fr, int fq) const {
        const int row0 = u.pm * 256 + wr * 64 + fr, col0 = u.pn * 256 + wc * 32 + 8 * fq;
#pragma unroll
        for (int ai = 0; ai < 2; ++ai)
#pragma unroll
            for (int m = 0; m < 4; ++m) { bf16* rowp = O + (size_t)(row0 + ai * 128 + m * 16) * ldc + col0;
#pragma unroll
                for (int bj = 0; bj < 2; ++bj) { const pg8::f32x4 v0 = acc[ai][bj][m][0], v1 = acc[ai][bj][m][1];
                    v4u w; w.x = pk2(v0[0], v0[1]); w.y = pk2(v0[2], v0[3]); w.z = pk2(v1[0], v1[1]); w.w = pk2(v1[2], v1[3]);
                    *(v4u*)(rowp + bj * 128) = w; } }
    }
};
__device__ __forceinline__ float gate_e(float x) { return __builtin_amdgcn_exp2f(fminf(fmaxf(x, -30.f), 30.f) * -1.44269504f); }
struct EpiMerge {
    static constexpr bool PERM = true, AFTER_DRAIN = false, RESCALE = true;
    const bf16* P; bf16* Z;
    __device__ __forceinline__ void rescale(pg8::f32x4 (&acc)[2][2][4][2], const pg8::Unit& u, int step, int wr, int wc, int fr, int fq) const {
        const int row0 = u.pm * 256 + wr * 64 + fr, col0 = u.pn * 256 + wc * 32 + 8 * fq;
        const int cn = PBG + (step - 1) * 1024, cd = PBG + step * 1024;
#pragma unroll
        for (int ai = 0; ai < 2; ++ai)
#pragma unroll
            for (int m = 0; m < 4; ++m) { const bf16* rowp = P + (size_t)(row0 + ai * 128 + m * 16) * NP + col0;
#pragma unroll
                for (int bj = 0; bj < 2; ++bj) { const v4u xn = *(const v4u*)(rowp + cn + bj * 128), xd = *(const v4u*)(rowp + cd + bj * 128);
                    float a[8], b[8]; unpack8(xn, a); unpack8(xd, b);
#pragma unroll
                    for (int i = 0; i < 8; ++i) { const float ratio = (1.0f + gate_e(b[i])) * __builtin_amdgcn_rcpf(1.0f + gate_e(a[i])); acc[ai][bj][m][i >> 2][i & 3] *= ratio; } }
                asm volatile("" ::: "memory"); }
    }
    __device__ __forceinline__ void operator()(const pg8::f32x4 (&acc)[2][2][4][2], const pg8::Unit& u, int wr, int wc, int fr, int fq) const {
        const int row0 = u.pm * 256 + wr * 64 + fr, col0 = u.pn * 256 + wc * 32 + 8 * fq;
#pragma unroll
        for (int ai = 0; ai < 2; ++ai)
#pragma unroll
            for (int m = 0; m < 4; ++m) { const size_t r = (size_t)(row0 + ai * 128 + m * 16);
#pragma unroll
                for (int bj = 0; bj < 2; ++bj) { const v4u xc = *(const v4u*)(P + r * NP + PBG + 2048 + col0 + bj * 128); float c[8], o[8]; unpack8(xc, c);
#pragma unroll
                    for (int i = 0; i < 8; ++i) o[i] = acc[ai][bj][m][i >> 2][i & 3] * __builtin_amdgcn_rcpf(1.0f + gate_e(c[i]));
                    *(v4u*)(Z + r * D + col0 + bj * 128) = pack8(o); }
                asm volatile("" ::: "memory"); }
    }
};
struct EpiResid {
    static constexpr bool PERM = false, AFTER_DRAIN = false, RESCALE = false;
    float* out; float* hc; const float* mod_l;
    __device__ __forceinline__ void operator()(const pg8::f32x4 (&acc)[2][2][4][2], const pg8::Unit& u, int wr, int wc, int fr, int fq) const {
        const int rt = u.pm * 256; float* hb = rt < M_LAT ? out + (size_t)rt * D : hc + (size_t)(rt - M_LAT) * D;
        const float* g1 = mod_l + (size_t)(rt < M_LAT ? (rt >> 11) : 8) * 6144 + 2048;
        const int rl0 = wr * 64 + fr, col0 = u.pn * 256 + wc * 32 + 4 * fq;
#pragma unroll
        for (int ai = 0; ai < 2; ++ai)
#pragma unroll
            for (int m = 0; m < 4; ++m) { float* rowp = hb + (size_t)(rl0 + ai * 128 + m * 16) * D + col0;
#pragma unroll
                for (int bj = 0; bj < 2; ++bj)
#pragma unroll
                    for (int n = 0; n < 2; ++n) { const pg8::f32x4 g = *(const pg8::f32x4*)(g1 + col0 + bj * 128 + n * 16), h = *(const pg8::f32x4*)(rowp + bj * 128 + n * 16);
                        *(pg8::f32x4*)(rowp + bj * 128 + n * 16) = h * ALPHA + g * acc[ai][bj][m][n]; } }
    }
};
struct EpiSwiGLU {
    static constexpr bool PERM = true, AFTER_DRAIN = false, RESCALE = false;
    bf16* act;
    __device__ __forceinline__ void operator()(const pg8::f32x4 (&acc)[2][2][4][2], const pg8::Unit& u, int wr, int wc, int fr, int fq) const {
        const int row0 = u.pm * 256 + wr * 64 + fr, col0 = (u.pn & 3) * 128 + wc * 32 + 8 * fq;
#pragma unroll
        for (int ai = 0; ai < 2; ++ai)
#pragma unroll
            for (int m = 0; m < 4; ++m) { float o[8];
#pragma unroll
                for (int i = 0; i < 8; ++i) { const float g = acc[ai][0][m][i >> 2][i & 3], uu = acc[ai][1][m][i >> 2][i & 3]; o[i] = g * sigmoidf_(g) * uu; }
                *(v4u*)(act + (size_t)(row0 + ai * 128 + m * 16) * DEXP + col0) = pack8(o); }
    }
};
struct EpiScatter {
    static constexpr bool PERM = true, AFTER_DRAIN = false, RESCALE = false;
    const int* rowmap; const float* roww; bf16* Fo;
    __device__ __forceinline__ void operator()(const pg8::f32x4 (&acc)[2][2][4][2], const pg8::Unit& u, int wr, int wc, int fr, int fq) const {
        const int row0 = u.pm * 256 + wr * 64 + fr, col0 = (u.pn & 3) * 256 + wc * 32 + 8 * fq;
#pragma unroll
        for (int ai = 0; ai < 2; ++ai)
#pragma unroll
            for (int m = 0; m < 4; ++m) { const int sr = row0 + ai * 128 + m * 16, dst = rowmap[sr]; const float wgt = roww[sr];
                if (dst >= 0) {
#pragma unroll
                    for (int bj = 0; bj < 2; ++bj) { pg8::f32x4 v0 = acc[ai][bj][m][0] * wgt, v1 = acc[ai][bj][m][1] * wgt;
#if defined(MK_PROBE_SCATTER) && MK_PROBE_SCATTER == 1
                        v0 = (pg8::f32x4){wgt, wgt, wgt, wgt}; v1 = v0;
#elif defined(MK_PROBE_SCATTER) && MK_PROBE_SCATTER == 2
                        v0 = acc[ai][bj][m][0]; v1 = acc[ai][bj][m][1];
#endif
                        v4u w; w.x = pk2(v0[0], v0[1]); w.y = pk2(v0[2], v0[3]); w.z = pk2(v1[0], v1[1]); w.w = pk2(v1[2], v1[3]);
                        *(v4u*)(Fo + (size_t)dst * D + col0 + bj * 128) = w; } } }
    }
};
struct ProjOrderLast {
    pg8::StaticOrder lat; int G, c;
    __device__ __forceinline__ void init(int G_, int c_) { lat.init(M_LAT, NP, G_, c_); G = G_; c = c_; }
    __device__ __forceinline__ bool next(int i, pg8::Unit& u) const {
        if (lat.next(i, u)) return true;
        const long L = (long)i * G + c - lat.nwg; if (L < 0 || L >= 8 * 7) return false;
        u.pm = 64 + (int)(L % 8); u.pn = 6 + (int)(L / 8); return true;
    }
    __device__ __forceinline__ void a_ready(const pg8::Unit&) const {}
    __device__ __forceinline__ void done(const pg8::Unit&) const {}
};
struct MoeOrder {
    int G, c; const LAS int* toff;
    __device__ __forceinline__ bool next(int i, pg8::Unit& u) const {
        const long L = (long)i * G + c; const int nt = toff[16]; if (L >= (long)nt * 4) return false;
        const int pm = (int)(L >> 2), ct = (int)(L & 3); int e = 0;
#pragma unroll
        for (int k = 1; k < 16; ++k) e += (pm >= toff[k]) ? 1 : 0;
        u.pm = pm; u.pn = e * 4 + ct; return true;
    }
    __device__ __forceinline__ void a_ready(const pg8::Unit&) const {}
    __device__ __forceinline__ void done(const pg8::Unit&) const {}
};
__device__ __forceinline__ void moe_toff(const Ctx& F, int l, LAS int* toff) {
    if (F.tid == 0) { int acc = 0; const int* tot = (const int*)(F.ws + WS_BCNT) + 2 * 4096 + l * 16;
        for (int e = 0; e < 16; ++e) { toff[e] = acc; acc += (tot[e] + 255) >> 8; }
        toff[16] = acc; }
    __syncthreads();
}

__device__ __forceinline__ void e_ln1_route(const Ctx& F, int l, int nrows) {
    const int rpb = nrows / 256, row0 = F.vcu * rpb;
    LAS int* lcnt = (LAS int*)F.lds; LAS int* rinfo = lcnt + 16; LAS float* rwt = (LAS float*)(lcnt + 16 + 160); LAS int* lrk = lcnt + 16 + 320;
    LAS float* LG = (LAS float*)(F.lds + 2048);
    stage_w16(F, F.in[I_WROUTER], 16, (LAS float*)(F.lds + 8192));
    __syncthreads();
    for (int i = F.wave; i < rpb; i += NWAVES) { const int r = row0 + i;
        f32x4 v[4]; float* hp = hrow(F, r); load_row(hp, F.lane, v);
        ln_row(v, F.in[I_LN1G] + l * D, F.in[I_LN1B] + l * D, F.lane); store_row(hp, F.lane, v);
        const float* mp = modp(F, l, modrow(r)); f32x4 u[4];
        emit_u(v, mp + 3072, mp + 4096, (bf16*)(F.ws + WS_U) + (size_t)r * D, F.lane, u);
        const float lgv = dot16r(u, (const LAS float*)(F.lds + 8192), F.lane);
        if ((F.lane & 3) == 0) LG[i * 16 + elane(F.lane)] = lgv;
    }
    __syncthreads();
    if (F.tid < rpb) { const int i = F.tid;
        float sc[16], sel[16];
#pragma unroll
        for (int e = 0; e < 16; ++e) { sc[e] = sigmoidf_(LG[i * 16 + e]); sel[e] = sc[e] + F.in[I_BROUTER][e]; }
        int bg = 0; float bgs = -INFINITY;
#pragma unroll
        for (int g = 0; g < 4; ++g) { float m1 = -INFINITY, m2 = -INFINITY;
#pragma unroll
            for (int k = 0; k < 4; ++k) { const float x = sel[4 * g + k]; if (x > m1) { m2 = m1; m1 = x; } else if (x > m2) m2 = x; }
            const float gs = m1 + m2; if (gs > bgs) { bgs = gs; bg = g; } }
        float s4[4], c4[4];
#pragma unroll
        for (int k = 0; k < 4; ++k) { s4[k] = bg == 0 ? sel[k] : bg == 1 ? sel[4 + k] : bg == 2 ? sel[8 + k] : sel[12 + k]; c4[k] = bg == 0 ? sc[k] : bg == 1 ? sc[4 + k] : bg == 2 ? sc[8 + k] : sc[12 + k]; }
        int i1 = 0;
#pragma unroll
        for (int k = 1; k < 4; ++k) if (s4[k] > s4[i1]) i1 = k;
        int i2 = i1 == 0 ? 1 : 0;
#pragma unroll
        for (int k = 0; k < 4; ++k) if (k != i1 && k != i2 && s4[k] > s4[i2]) i2 = k;
        const float w1 = c4[i1], w2 = c4[i2], ws = 1.0f / (w1 + w2);
        rinfo[2 * i] = 4 * bg + i1; rinfo[2 * i + 1] = 4 * bg + i2; rwt[2 * i] = w1 * ws; rwt[2 * i + 1] = w2 * ws;
    }
    __syncthreads();
    if (F.tid < 16) { int c = 0; for (int idx = 0; idx < 2 * rpb; ++idx) if (rinfo[idx] == F.tid) lrk[idx] = c++;
        ((int*)(F.ws + WS_BCNT))[(l * 256 + F.vcu) * 16 + F.tid] = c; }
    __syncthreads();
    for (int idx = F.tid; idx < 2 * rpb; idx += NWAVES * 64) { unsigned* rp = (unsigned*)(F.ws + WS_ROUTE + (size_t)(2 * row0 + idx) * 16);
        rp[0] = (unsigned)rinfo[idx]; rp[1] = (unsigned)lrk[idx]; ((float*)rp)[2] = rwt[idx]; rp[3] = (unsigned)F.vcu; }
    __syncthreads();
}
__device__ __forceinline__ void f_gather(const Ctx& F, int l, int nrows) {
    LAS int* toff = (LAS int*)F.lds; LAS int* cnts = toff + 32; LAS int* csum = toff + 64; LAS int* bbase = toff + 1024;
    const int* bc = (const int*)(F.ws + WS_BCNT) + l * 4096;
    { const int e = F.tid & 15, ch = F.tid >> 4; int s = 0;
#pragma unroll
        for (int k = 0; k < 8; ++k) { const int v = bc[(8 * ch + k) * 16 + e]; bbase[(8 * ch + k) * 16 + e] = s; s += v; }
        csum[ch * 16 + e] = s; }
    __syncthreads();
    { const int e = F.tid & 15, ch = F.tid >> 4; int pre = 0;
        for (int k = 0; k < ch; ++k) pre += csum[k * 16 + e];
#pragma unroll
        for (int k = 0; k < 8; ++k) bbase[(8 * ch + k) * 16 + e] += pre;
        if (ch == 31) { const int tot = pre + csum[31 * 16 + e]; cnts[e] = tot; if (F.vcu == 0) ((int*)(F.ws + WS_BCNT))[2 * 4096 + l * 16 + e] = tot; } }
    __syncthreads();
    if (F.tid == 0) { int acc = 0; for (int e = 0; e < 16; ++e) { toff[e] = acc; acc += (cnts[e] + 255) >> 8; } toff[16] = acc; }
    __syncthreads();
    const int gw = F.vcu * NWAVES + F.wave, NGW = F.G * NWAVES, lane = F.lane;
    const bf16* U = (const bf16*)(F.ws + WS_U); bf16* As = (bf16*)(F.ws + WS_AS); int* rowmap = (int*)(F.ws + WS_ROWMAP); float* roww = (float*)(F.ws + WS_ROWW);
    for (int ts = gw; ts < 2 * nrows; ts += NGW) { const unsigned* rp = (const unsigned*)(F.ws + WS_ROUTE + (size_t)ts * 16); const unsigned re = rp[0], rk = rp[1], rb = rp[3]; const float rwv = ((const float*)rp)[2];
        const int pos = toff[re] * 256 + bbase[rb * 16 + re] + (int)rk;
        const v4u* src = (const v4u*)(U + (size_t)(ts >> 1) * D); v4u* dst = (v4u*)(As + (size_t)pos * D);
        dst[lane] = src[lane]; dst[lane + 64] = src[lane + 64];
        if (lane == 0) { rowmap[pos] = ts; roww[pos] = rwv; } }
    for (int e = 0; e < 16; ++e) { const int cnt = cnts[e], first = toff[e] * 256 + cnt, npad = toff[e + 1] * 256 - first;
        for (int i = gw; i < npad; i += NGW) { v4u* dst = (v4u*)(As + (size_t)(first + i) * D); unsigned z0 = 0u; asm volatile("" : "+v"(z0)); const v4u z = {z0, z0, z0, z0}; dst[lane] = z; dst[lane + 64] = z; if (lane == 0) { rowmap[first + i] = -1; roww[first + i] = 0.f; } } }
    __syncthreads();
}
__device__ __forceinline__ void h_ln2(const Ctx& F, int l, int nrows) {
    const int gw = F.vcu * NWAVES + F.wave, NGW = F.G * NWAVES, lane = F.lane; const bf16* Fs = (const bf16*)(F.ws + WS_F);
    if (l + 1 < DEPTH) { stage_w16(F, F.in[I_WIN] + (size_t)(l + 1) * D * D_IN + SRC_MG, D_IN, (LAS float*)F.lds); __syncthreads(); }
    for (int r = gw; r < nrows; r += NGW) { f32x4 v[4]; float* hp = hrow(F, r); load_row(hp, lane, v); const float* g2 = modp(F, l, modrow(r)) + 5120;
#pragma unroll
        for (int j = 0; j < 4; ++j) { const v2u a = *(const v2u*)(Fs + (size_t)(2 * r) * D + 4 * lane + 256 * j), b = *(const v2u*)(Fs + (size_t)(2 * r + 1) * D + 4 * lane + 256 * j);
            const f32x4 f = (f32x4){bflo(a.x) + bflo(b.x), bfhi(a.x) + bfhi(b.x), bflo(a.y) + bflo(b.y), bfhi(a.y) + bfhi(b.y)}, g = *(const f32x4*)(g2 + 4 * lane + 256 * j);
            v[j] = v[j] * ALPHA + g * f * MK_ABL_F; }
        ln_row(v, F.in[I_LN2G] + l * D, F.in[I_LN2B] + l * D, lane); store_row(hp, lane, v);
        if (l + 1 < DEPTH) emit_layer_input(F, l + 1, r, v); }
}

constexpr int NPHASE = 2 + 10 * DEPTH;
struct Args { const float* in[N_IN]; float* out; unsigned char* ws; int ph_lo, ph_hi, li, pad; };
static_assert(sizeof(Args) == 8 * N_IN + 16 + 16, "no padding bytes in Args");
#ifndef MK_PHASE_MASK
#define MK_PHASE_MASK 0xFFFu
#endif
#define PON(j) (((MK_PHASE_MASK) >> (j)) & 1u)
#ifndef MK_DUP
#define MK_DUP (-1)
#endif
#define REP(k) for (int rep_ = 0; rep_ < (((MK_DUP) == (k)) ? 2 : 1); ++rep_)
#define IN(k) (lo <= (k) && (k) < hi)
#define PCTX(Fp) Ctx Fp = F; Fp.lane = lane_id(); Fp.tid = F.wave * 64 + Fp.lane
#if defined(MK_STAMPS)
#define SEAM(k) do { if (IN(k) && IN((k) + 1)) xcd_barrier(bar); if (blockIdx.x == 0 && F.wave == 0 && lane_id() == 0) ((unsigned long long*)(F.ws + WS_CTL + 16384))[(k) + 1] = __builtin_amdgcn_s_memrealtime(); } while (0)
#else
#define SEAM(k) do { if (IN(k) && IN((k) + 1)) xcd_barrier(bar); } while (0)
#endif
template <int l> __device__ __forceinline__ void run_layer(const Ctx& F, const int lo, const int hi, const XcdBarrier& bar) {
        const int pb = 2 + 10 * l; const bool lastl = (l == DEPTH - 1); const int nrows = lastl ? M_LAT : M_ALL;
        bf16* const Pb = (bf16*)(F.ws + WS_P); bf16* const Ub = (bf16*)(F.ws + WS_U); bf16* const Yb = (bf16*)(F.ws + WS_Y);
        if (PON(2) && IN(pb + 0)) REP(pb + 0) {
            pg8::Gemm g{Ub, wt(F, l, W_IN), M_ALL, NP, D}; EpiProj E{Pb, NP};
            if (lastl) { ProjOrderLast S; S.init(F.G, (int)blockIdx.x); pg8::gemm_phase<EpiProj, ProjOrderLast, true, true>(F.lds, g, S, E, F.wave); }
            else { pg8::StaticOrder S; S.init(M_ALL, NP, F.G, (int)blockIdx.x); pg8::gemm_phase<EpiProj, pg8::StaticOrder, true, true>(F.lds, g, S, E, F.wave); }
            SEAM(pb + 0);
        }
        if (PON(3) && IN(pb + 1)) REP(pb + 1) {
            PCTX(Fp);
            if (F.vcu < 128) { mlstm_chain(Fp, l, F.vcu);
#if defined(MK_DUP_MLSTM)
                mlstm_chain(Fp, l, F.vcu);
#endif
            }
            {
                const int n_attn = lastl ? 256 : 288, n_conv = lastl ? 512 : 576;
                attn_rope_to_lds(Fp);
                volatile LAS int* wq = (volatile LAS int*)(F.lds + LDSCTL_OFF + 512);
                for (;;) {
                    __syncthreads();
                    if (Fp.tid == 0) wq[0] = (int)__hip_atomic_fetch_add(F.ctl + CW_WQ + 256 * l + 128 * (int)(rep_ & 1), 1u, RLX_AGENT);
                    __syncthreads();
                    const int u = wq[0];
                    if (u >= n_attn) break;
                    if (u < 256) attn_unit(Fp, l, 0, u >> 5, (u >> 1) & 15, u & 1); else { const int j = u - 256; attn_unit(Fp, l, 1, j >> 2, (j >> 1) & 1, j & 1); }
                }
                for (;;) {
                    __syncthreads();
                    if (Fp.tid == 0) wq[0] = (int)__hip_atomic_fetch_add(F.ctl + CW_WQ + 256 * l + 128 * (int)(rep_ & 1) + 64, 1u, RLX_AGENT);
                    __syncthreads();
                    const int u = wq[0];
                    if (u >= n_conv) break;
                    conv_unit(Fp, l, u);
                }
            }
            SEAM(pb + 1);
        }
        if (PON(4) && IN(pb + 2)) REP(pb + 2) { PCTX(Fp); c0_combine(Fp, l, nrows); SEAM(pb + 2); }
        if (PON(5) && IN(pb + 3)) REP(pb + 3) {
            pg8::Gemm g{Yb, wt(F, l, W_ABC), nrows, D, NY}; pg8::StaticOrder S; S.init(nrows, D, F.G, (int)blockIdx.x);
            EpiMerge E{Pb, Ub};
            pg8::gemm_phase<EpiMerge, pg8::StaticOrder, true, true>(F.lds, g, S, E, F.wave);
            if (l == 0) { PCTX(Fp); __syncthreads(); convert_layer1_on_idle(Fp, 32); }
            SEAM(pb + 3);
        }
        if (PON(6) && IN(pb + 4)) REP(pb + 4) {
            pg8::Gemm g{Ub, wt(F, l, W_OUT), nrows, D, D}; pg8::StaticOrder S; S.init(nrows, D, F.G, (int)blockIdx.x);
            EpiResid E{F.out, (float*)(F.ws + WS_HC), (const float*)(F.ws + WS_MOD) + (size_t)l * 9 * 6144};
            pg8::gemm_phase<EpiResid, pg8::StaticOrder, true, true>(F.lds, g, S, E, F.wave);
            SEAM(pb + 4);
        }
        if (PON(7) && IN(pb + 5)) REP(pb + 5) { PCTX(Fp); e_ln1_route(Fp, l, nrows); SEAM(pb + 5); }
        if (PON(8) && IN(pb + 6)) REP(pb + 6) { PCTX(Fp); f_gather(Fp, l, nrows); SEAM(pb + 6); }
        if (PON(9) && IN(pb + 7)) REP(pb + 7) {
            LAS int* toff = (LAS int*)(F.lds + LDSCTL_OFF); { PCTX(Fp); moe_toff(Fp, l, toff); }
            pg8::Gemm g{(const bf16*)(F.ws + WS_AS), wt(F, l, W_GU), AS_ROWS, NE * D, D}; MoeOrder S{F.G, (int)blockIdx.x, toff};
            EpiSwiGLU E{(bf16*)(F.ws + WS_ACT)};
            pg8::gemm_phase<EpiSwiGLU, MoeOrder, true, true>(F.lds, g, S, E, F.wave);
            SEAM(pb + 7);
        }
        if (PON(10) && IN(pb + 8)) REP(pb + 8) {
            LAS int* toff = (LAS int*)(F.lds + LDSCTL_OFF); { PCTX(Fp); moe_toff(Fp, l, toff); }
            pg8::Gemm g{(const bf16*)(F.ws + WS_ACT), wt(F, l, W_DN), AS_ROWS, NE * D, DEXP}; MoeOrder S{F.G, (int)blockIdx.x, toff};
            EpiScatter E{(const int*)(F.ws + WS_ROWMAP), (const float*)(F.ws + WS_ROWW), (bf16*)(F.ws + WS_F)};
            pg8::gemm_phase<EpiScatter, MoeOrder, true, true>(F.lds, g, S, E, F.wave);
            SEAM(pb + 8);
        }
        if (PON(11) && IN(pb + 9)) REP(pb + 9) { PCTX(Fp); h_ln2(Fp, l, nrows); SEAM(pb + 9); }
    }
__global__ void __launch_bounds__(NWAVES * 64, 2) mk_fwd(Args args) {
    extern __shared__ __attribute__((aligned(16))) unsigned char lds[];
    Ctx F;
    F.lds = (LAS unsigned char*)lds; F.MISC = (volatile LAS unsigned*)(F.lds + MISC_OFF);
    F.tid = 0; F.lane = 0; F.wave = __builtin_amdgcn_readfirstlane((int)threadIdx.x >> 6);
    F.G = gridDim.x; { const int bx = blockIdx.x; F.vcu = (F.G % 8 == 0) ? (bx % 8) * (F.G / 8) + bx / 8 : bx; }
    F.ws = args.ws; F.out = args.out; F.ctl = (unsigned*)(args.ws + WS_CTL);
    F.in = args.in;
    for (int u = (int)threadIdx.x; u < (LDS_BYTES - LDSCTL_OFF) / 4; u += NWAVES * 64) ((LAS unsigned*)(F.lds + LDSCTL_OFF))[u] = 0u;
    __syncthreads();
    const int lo = args.ph_lo, hi = args.ph_hi;
    XcdBarrier bar; bar.bar = (unsigned*)(F.ctl + CW_BAR) + args.li * XCD_BAR_WORDS; bar.x = 0; bar.st = nullptr; bar.w0 = false;
    if (hi - lo > 1) bar = xcd_barrier_post((unsigned*)(F.ctl + CW_BAR) + args.li * XCD_BAR_WORDS, F.MISC + 8);
    bar.w0 = (F.wave == 0);
#if defined(MK_STAMPS)
    if (blockIdx.x == 0 && F.wave == 0 && lane_id() == 0) ((unsigned long long*)(F.ws + WS_CTL + 16384))[0] = __builtin_amdgcn_s_memrealtime();
#endif
    if (PON(0) && IN(0)) REP(0) { PCTX(Fp); p0_prologue(Fp); SEAM(0); }
    if (PON(1) && IN(1)) REP(1) { PCTX(Fp); p1_ln_in(Fp); SEAM(1); }
    run_layer<0>(F, lo, hi, bar);
    run_layer<1>(F, lo, hi, bar);
#undef IN
#undef SEAM
}


#if defined(MK_DIAG)
constexpr int CW_DIAG = 3072;
__global__ void __launch_bounds__(512, 2) mk_diag(Args args) {
    unsigned char* ws = args.ws; float* acc = (float*)((unsigned*)(ws + WS_CTL) + CW_DIAG);
    const int gt = blockIdx.x * 512 + threadIdx.x, NT = gridDim.x * 512;
    const int* rowmap = (const int*)(ws + WS_ROWMAP); const bf16* As = (const bf16*)(ws + WS_AS); const bf16* act = (const bf16*)(ws + WS_ACT); const bf16* Fs = (const bf16*)(ws + WS_F);
    const unsigned* cnt = (const unsigned*)(ws + WS_CTL) + CW_CNT;
    int ntile = 0; for (int e = 0; e < 16; ++e) ntile += (int)((cnt[64 * e] + 255u) >> 8);
    float s0 = 0.f, s1 = 0.f, s2 = 0.f, s3 = 0.f;
    for (int pos = gt; pos < ntile * 256; pos += NT) { if (rowmap[pos] >= 0) { s0 += 1.f; float a = 0.f, b = 0.f;
        for (int k = 0; k < 1024; k += 37) a += fabsf(bf1(As[(size_t)pos * D + k]));
        for (int k = 0; k < 512; k += 19) b += fabsf(bf1(act[(size_t)pos * DEXP + k]));
        s1 += a * (1.f / 28.f); s2 += b * (1.f / 27.f); } }
    for (int ts = gt; ts < 2 * M_ALL; ts += NT) { float f = 0.f; for (int k = 0; k < 1024; k += 37) f += fabsf(bf1(Fs[(size_t)ts * D + k])); s3 += f * (1.f / 28.f); }
    if (MK_DIAG == 3) { s1 = 0.f; s2 = 0.f; const float* roww = (const float*)(ws + WS_ROWW);
        for (int pos = gt; pos < ntile * 256; pos += NT) if (rowmap[pos] >= 0) s1 += fabsf(roww[pos]);
        for (int ts = gt; ts < 2 * M_ALL; ts += NT) { const v4u rt = *(const v4u*)(ws + WS_ROUTE + (size_t)ts * 16); s2 += fabsf(__builtin_bit_cast(float, rt.z)); } }
    if (MK_DIAG == 6) { s1 = 0.f; s2 = 0.f;
        for (int ts = gt; ts < 2 * M_ALL; ts += NT) { const v4u rt = *(const v4u*)(ws + WS_ROUTE + (size_t)ts * 16); const float wv = __builtin_bit_cast(float, rt.z);
            const bool ok = (wv > 0.f) && (wv < 1.f); if (ok) s2 += wv; else s1 += 1.f; } }
    if (MK_DIAG == 7) { s1 = 0.f; s2 = 0.f;
        for (int ts = gt; ts < 2 * M_ALL; ts += NT) { bool bad = false; for (int k = 0; k < 1024; k += 7) { const float x = bf1(Fs[(size_t)ts * D + k]); if (!(fabsf(x) < 1e4f)) bad = true; } if (bad) s1 += 1.f; }
        for (int pos = gt; pos < ntile * 256; pos += NT) { bool bad = false; for (int k = 0; k < 512; k += 5) { const float x = bf1(act[(size_t)pos * DEXP + k]); if (!(fabsf(x) < 1e4f)) bad = true; }
            for (int k = 0; k < 1024; k += 7) { const float x = bf1(As[(size_t)pos * D + k]); if (!(fabsf(x) < 1e4f)) bad = true; } if (bad) s2 += 1.f; } }
    if (MK_DIAG == 4 || MK_DIAG == 5) { s1 = 0.f; s2 = 0.f; const float* dbg = (const float*)(ws + WS_ROPE + 65536);
        for (int r = gt; r < M_ALL; r += NT) { s1 += fabsf(dbg[4 * r + (MK_DIAG == 4 ? 0 : 2)]); s2 += fabsf(dbg[4 * r + (MK_DIAG == 4 ? 1 : 3)]); } }
    atomicAdd(acc + 0, s0); atomicAdd(acc + 1, s1); atomicAdd(acc + 2, s2); atomicAdd(acc + 3, s3);
}
__global__ void __launch_bounds__(512, 2) mk_diag_out(Args args) {
    const float* acc = (const float*)((const unsigned*)(args.ws + WS_CTL) + CW_DIAG);
    const float cntr = acc[0], mA = acc[1] / fmaxf(cntr, 1.f), mAct = acc[2] / fmaxf(cntr, 1.f), mF = acc[3] / (2.f * M_ALL);
    float st1, st2;
    if (MK_DIAG == 1) { st1 = mA; st2 = mAct; } else if (MK_DIAG == 3) { st1 = mA; st2 = acc[2] / (2.f * M_ALL); } else if (MK_DIAG == 4 || MK_DIAG == 5) { st1 = acc[1] / M_ALL; st2 = acc[2] / M_ALL; } else if (MK_DIAG == 6) { st1 = acc[1] + 1e-3f; st2 = acc[2] / (2.f * M_ALL); } else if (MK_DIAG == 7) { st1 = acc[1] + 1e-3f; st2 = acc[2] + 1e-3f; } else { st1 = cntr / (2.f * M_ALL); st2 = mF; }
    const float v1 = fminf(fmaxf(20.f + log2f(fmaxf(st1, 1e-6f)), 0.f), 60.f), v2 = 100.f * fminf(fmaxf(20.f + log2f(fmaxf(st2, 1e-6f)), 0.f), 60.f);
    const float K = sqrtf(v1);
    for (size_t i = (size_t)blockIdx.x * 512 + threadIdx.x; i < (size_t)M_LAT * D; i += (size_t)gridDim.x * 512) args.out[i] = (i == 12345) ? v2 : ((i & 1) ? K : -K);
}
#endif

#if defined(MK_DIAG)
__global__ void __launch_bounds__(512, 2) mk_copy(Args args) {
    const bf16* HF = (const bf16*)(args.ws + WS_HF); const bf16* HB = (const bf16*)(args.ws + WS_HB); const bf16* P = (const bf16*)(args.ws + WS_P);
    for (size_t i = (size_t)blockIdx.x * 512 + threadIdx.x; i < (size_t)M_LAT * D; i += (size_t)gridDim.x * 512) { const size_t r = i >> 10; const int c = (int)(i & 1023);
        float v;
        if (MK_DIAG == 8) v = c < 512 ? bf1(HF[r * 512 + c]) : bf1(HB[r * 512 + c - 512]);
        else if (MK_DIAG == 9) v = bf1(P[r * NP + PMQ + c]);
        else if (MK_DIAG == 10) v = bf1(P[r * NP + PMV + (c & 511)]);
        else if (MK_DIAG == 11) v = bf1(P[(size_t)(M_LAT + (r & 2047)) * NP + PMQ + c + 512 * ((r >> 11) & 1)]);
        else v = ((const float*)(args.ws + WS_G))[(size_t)(r + ((r >> 13) & 1) * 2048) * 16 + (c & 15)];
        args.out[i] = v; }
}
#endif

#if defined(MK_STAMPS)
__global__ void __launch_bounds__(512, 2) mk_stamp_out(Args args) {
    const unsigned long long* ts = (const unsigned long long*)(args.ws + WS_CTL + 16384);
    const float d1 = (float)(ts[MK_ST_E1] - ts[MK_ST_S1]) * 0.01f, d2 = (float)(ts[MK_ST_E2] - ts[MK_ST_S2]) * 0.01f;
    const float K = sqrtf(d1 * 0.1f);
    for (size_t i = (size_t)blockIdx.x * 512 + threadIdx.x; i < (size_t)M_LAT * D; i += (size_t)gridDim.x * 512) args.out[i] = (i == 12345) ? d2 : ((i & 1) ? K : -K);
}
#endif

#ifndef MK_PER_PHASE
#define MK_PER_PHASE 1
#endif
extern "C" void kernel_launch(void* const* d_in, const int* in_sizes, int n_in, void* d_out, int out_size, void* d_ws, size_t ws_size, hipStream_t stream) {
    static int grid = 0;
    if (grid == 0) {
        if (n_in != N_IN || in_sizes[0] != M_LAT * D || out_size != M_LAT * D || ws_size < WS_END) {
            fprintf(stderr, "kernel_launch: built for %d inputs, x/out of %d floats, >= %zu bytes of workspace; got n_in %d, in0 %d, out %d, ws %zu; nothing launched\n", N_IN, M_LAT * D, (size_t)WS_END, n_in, n_in > 0 ? in_sizes[0] : -1, out_size, ws_size); grid = -1; return; }
        int dev = 0, cus = 0, per_cu = 0;
        if (hipGetDevice(&dev) != hipSuccess || hipDeviceGetAttribute(&cus, hipDeviceAttributeMultiprocessorCount, dev) != hipSuccess) { fprintf(stderr, "kernel_launch: device query failed\n"); grid = -1; return; }
        if (hipFuncSetAttribute((const void*)mk_fwd, hipFuncAttributeMaxDynamicSharedMemorySize, LDS_BYTES) != hipSuccess) { fprintf(stderr, "kernel_launch: hipFuncSetAttribute failed\n"); grid = -1; return; }
        if (hipOccupancyMaxActiveBlocksPerMultiprocessor(&per_cu, (const void*)mk_fwd, NWAVES * 64, LDS_BYTES) != hipSuccess || per_cu < 1) { fprintf(stderr, "kernel_launch: occupancy query reports %d workgroups per CU\n", per_cu); }
        (void)hipGetLastError();
        grid = cus;
        if (grid != 256) { fprintf(stderr, "kernel_launch: %d CUs; this kernel is built for 256\n", grid); grid = -1; return; }
    }
    if (grid < 0) return;
    if (hipMemsetAsync((char*)d_ws + WS_CTL, 0, CTL_ZERO_BYTES, stream) != hipSuccess) { fprintf(stderr, "kernel_launch: memset failed\n"); return; }
    Args a{};
    for (int i = 0; i < N_IN; ++i) a.in[i] = (const float*)d_in[i];
    a.out = (float*)d_out; a.ws = (unsigned char*)d_ws; a.pad = 0;
#if MK_PER_PHASE
    for (int k = 0; k < NPHASE; ++k) { a.ph_lo = k; a.ph_hi = k + 1; a.li = k;
        hipLaunchKernelGGL(mk_fwd, dim3(grid), dim3(NWAVES * 64), LDS_BYTES, stream, a);
#if defined(MK_DIAG)
        if (k == MK_DIAG_AFTER) { if (MK_DIAG >= 8) { hipLaunchKernelGGL(mk_copy, dim3(256), dim3(512), 0, stream, a); } else { hipLaunchKernelGGL(mk_diag, dim3(256), dim3(512), 0, stream, a); hipLaunchKernelGGL(mk_diag_out, dim3(256), dim3(512), 0, stream, a); } break; }
#endif
    }
#else
    a.ph_lo = 0; a.ph_hi = NPHASE; a.li = 0;
    hipLaunchKernelGGL(mk_fwd, dim3(grid), dim3(NWAVES * 64), LDS_BYTES, stream, a);
#if defined(MK_STAMPS)
    hipLaunchKernelGGL(mk_stamp_out, dim3(256), dim3(512), 0, stream, a);
#endif
#endif
    const hipError_t le = hipPeekAtLastError();
    if (le != hipSuccess) fprintf(stderr, "kernel_launch: launch failed: %s\n", hipGetErrorName(le));
}
```

```cpp
#include <hip/hip_runtime.h>
#include <cstdio>
#include <cstdint>
#ifndef MK_PER_PHASE
#define MK_PER_PHASE 0
#endif
namespace pg8 {
#define PG8_LAS __attribute__((address_space(3)))
typedef unsigned short bf16_t;
typedef short bf16x8 __attribute__((ext_vector_type(8)));
typedef float f32x4 __attribute__((ext_vector_type(4)));
typedef unsigned u32x4 __attribute__((ext_vector_type(4)));
constexpr int BM = 256, BK = 64, HALF = 128, HTB = HALF * BK * 2  , STAGE_BYTES = 8 * HTB, NXCD = 8, WGM = 8;

__host__ __device__ __forceinline__ int lds_byte(int r, int c) { const int st = (r >> 4) * 2 + (c >> 5), rr = r & 15, cc = c & 31, ob = rr * 64 + cc * 2; return st * 1024 + (ob ^ (((ob >> 9) & 1) << 5)); }
__host__ __device__ __forceinline__ void stage_rc(int b, int& R, int& C) { const int st = b / 1024, sb = b % 1024, swz = sb ^ (((sb >> 9) & 1) << 5); R = (st >> 1) * 16 + swz / 64; C = (st & 1) * 32 + (swz % 64) / 2; }
__host__ __device__ __forceinline__ int perm32(int rho) { const int n = rho >> 4, i = rho & 15; return 8 * (i >> 2) + 4 * n + (i & 3); }

struct Unit { int pm, pn; };
struct Gemm { const bf16_t* A; const bf16_t* Bt; int M, N, K; };

struct StaticOrder {
    int nM, nN, nwg, G, c;
    __host__ __device__ void init(int M, int N, int G_, int c_) { nM = M / BM; nN = N / BM; nwg = nM * nN; G = G_; c = c_; }
    __host__ __device__ bool next(int i, Unit& u) const {
        const long L = (long)i * G + c; if (L >= nwg) return false;
        int wgid = (int)L; { const int q = nwg / NXCD, r = nwg % NXCD, xcd = wgid % NXCD, off = wgid / NXCD; wgid = (xcd < r ? xcd * (q + 1) : r * (q + 1) + (xcd - r) * q) + off; }
        const int nig = WGM * nN, gid = wgid / nig, fm = gid * WGM, gsz = (nM - fm) < WGM ? (nM - fm) : WGM;
        u.pm = fm + ((wgid % nig) % gsz); u.pn = (wgid % nig) / gsz; return true;
    }
    __device__ __forceinline__ void a_ready(const Unit&) const {}
    __device__ __forceinline__ void done(const Unit&) const {}
};

__device__ __forceinline__ unsigned cvt_pk_bf16(float lo, float hi) { unsigned r; asm volatile("v_cvt_pk_bf16_f32 %0, %1, %2" : "=v"(r) : "v"(lo), "v"(hi)); return r; }
typedef float f32x2 __attribute__((ext_vector_type(2)));
template <class Epi, class Sched, bool ALIGN_EPI = false, bool SP2 = false>
__device__ __forceinline__ void gemm_phase(PG8_LAS unsigned char* lds, const Gemm g, const Sched& S, const Epi& E, const int wid_in) {
    int lid_; asm volatile("v_mbcnt_lo_u32_b32 %0, -1, 0\n\tv_mbcnt_hi_u32_b32 %0, -1, %0" : "=v"(lid_)); const int tid_ = wid_in * 64 + lid_;
    const int tid = tid_, wid = __builtin_amdgcn_readfirstlane(tid >> 6), lane = tid & 63, wr = wid >> 2, wc = wid & 3, fr = lane & 15, fq = lane >> 4;
    const int K = g.K, nt = K / BK;
    unsigned voffA[2], voffB[2];
#pragma unroll
    for (int i = 0; i < 2; ++i) { int R, C; stage_rc(tid * 16 + i * 8192, R, C); const int Rb = Epi::PERM ? ((R & ~31) + perm32(R & 31)) : R;
        voffA[i] = (unsigned)(R * K + C) * 2u; voffB[i] = (unsigned)(Rb * K + C) * 2u; }
    const size_t kstep = (size_t)(BK * 2);
    const size_t hstep = (size_t)HALF * K * 2;
    const size_t tstep = 2 * hstep;
    const unsigned ldsw = (unsigned)wid * 1024u;
    const int aoff = lds_byte(wr * 64 + fr, fq * 8), boff = lds_byte(wc * 32 + fr, fq * 8);
#define PG8_SA(b, h) (((b) * 2 + (h)) * HTB)
#define PG8_SB(b, h) ((4 + (b) * 2 + (h)) * HTB)
#define PG8_STAGE(bufoff, gbase, voff) do { _Pragma("unroll") for (int _i = 0; _i < 2; ++_i) \
        __builtin_amdgcn_global_load_lds((const unsigned*)((const char*)(gbase) + (voff)[_i]), (PG8_LAS unsigned*)(lds + (bufoff) + ldsw + _i * 8192), 16, 0, 0); } while (0)
#define PG8_LDA(dst, b, h) do { _Pragma("unroll") for (int m = 0; m < 4; ++m) _Pragma("unroll") for (int k = 0; k < 2; ++k) dst[m][k] = *(const PG8_LAS bf16x8*)(lds + PG8_SA(b, h) + aoff + m * 2048 + k * 1024); } while (0)
#define PG8_LDB(dst, b, h) do { _Pragma("unroll") for (int n = 0; n < 2; ++n) _Pragma("unroll") for (int k = 0; k < 2; ++k) dst[n][k] = *(const PG8_LAS bf16x8*)(lds + PG8_SB(b, h) + boff + n * 2048 + k * 1024); } while (0)
#define PG8_MMA(ai, bj, At, Bt) do { __builtin_amdgcn_s_setprio(1); _Pragma("unroll") for (int m = 0; m < 4; ++m) _Pragma("unroll") for (int n = 0; n < 2; ++n) _Pragma("unroll") for (int k = 0; k < 2; ++k) \
        acc[ai][bj][m][n] = __builtin_amdgcn_mfma_f32_16x16x32_bf16(Bt[n][k], At[m][k], acc[ai][bj][m][n], 0, 0, 0); __builtin_amdgcn_s_setprio(0); } while (0)
#define PG8_WAIT_V(n) asm volatile("s_waitcnt vmcnt(" #n ")" ::: "memory")
#define PG8_WAIT_L(n) asm volatile("s_waitcnt lgkmcnt(" #n ")" ::: "memory")
#define PG8_BAR __builtin_amdgcn_s_barrier()
#define PG8_SCHED __builtin_amdgcn_sched_barrier(0)
    Unit cur, nxt; int ui = 0;
    if (!S.next(0, cur)) return;
    f32x4 acc[2][2][4][2];
#pragma unroll
    for (int a = 0; a < 2; ++a)
#pragma unroll
        for (int b = 0; b < 2; ++b)
#pragma unroll
            for (int m = 0; m < 4; ++m)
#pragma unroll
                for (int n = 0; n < 2; ++n) acc[a][b][m][n] = (f32x4){0.f, 0.f, 0.f, 0.f};
    bf16x8 At[4][2], B0[2][2], B1[2][2];
    const char* cA = (const char*)g.A + (size_t)cur.pm * tstep; const char* cB = (const char*)g.Bt + (size_t)cur.pn * tstep;
    S.a_ready(cur);
    if constexpr (SP2) {
        PG8_STAGE(PG8_SB(0, 0), cB, voffB); PG8_STAGE(PG8_SB(0, 1), cB + hstep, voffB); PG8_STAGE(PG8_SA(0, 0), cA, voffA); PG8_STAGE(PG8_SA(0, 1), cA + hstep, voffA);
        if (wr == 1) PG8_BAR;
        PG8_WAIT_V(2); PG8_BAR;
        PG8_STAGE(PG8_SB(1, 0), cB + kstep, voffB); PG8_STAGE(PG8_SA(1, 0), cA + kstep, voffA); PG8_STAGE(PG8_SB(1, 1), cB + hstep + kstep, voffB);
        PG8_WAIT_V(6); PG8_BAR;
    } else {
        PG8_STAGE(PG8_SB(0, 0), cB, voffB); PG8_STAGE(PG8_SA(0, 0), cA, voffA); PG8_STAGE(PG8_SB(0, 1), cB + hstep, voffB); PG8_STAGE(PG8_SA(0, 1), cA + hstep, voffA);
        if (wr == 1) PG8_BAR;
        PG8_WAIT_V(4); PG8_BAR;
        PG8_STAGE(PG8_SB(1, 0), cB + kstep, voffB); PG8_STAGE(PG8_SA(1, 0), cA + kstep, voffA); PG8_STAGE(PG8_SB(1, 1), cB + hstep + kstep, voffB);
        PG8_WAIT_V(6); PG8_BAR;
    }
    for (;;) {
        const bool has_next = S.next(ui + 1, nxt);
        const char* nA = has_next ? (const char*)g.A + (size_t)nxt.pm * tstep : cA; const char* nB = has_next ? (const char*)g.Bt + (size_t)nxt.pn * tstep : cB;
        for (int t = 0; t < nt; t += 2) {
            const bool last = (t == nt - 2);
            if constexpr (Epi::RESCALE) { if (t == 8 || t == 16) E.rescale(acc, cur, t >> 3, wr, wc, fr, fq); }
            const char* a1 = cA + (size_t)(t + 1) * kstep;
            const char* a2 = last ? nA : cA + (size_t)(t + 2) * kstep; const char* b2 = last ? nB : cB + (size_t)(t + 2) * kstep;
            const char* a3 = a2 + kstep; const char* b3 = b2 + kstep;
            if (last && has_next) S.a_ready(nxt);
            if constexpr (SP2) {
            PG8_LDB(B0, 0, 0); PG8_LDB(B1, 0, 1); PG8_SCHED; PG8_LDA(At, 0, 0); PG8_STAGE(PG8_SA(1, 1), a1 + hstep, voffA);
            PG8_WAIT_V(8); PG8_WAIT_L(0); PG8_BAR; PG8_MMA(0, 0, At, B0); PG8_MMA(0, 1, At, B1); PG8_BAR; PG8_SCHED;
            PG8_LDA(At, 0, 1); PG8_STAGE(PG8_SB(0, 0), b2, voffB); PG8_STAGE(PG8_SB(0, 1), b2 + hstep, voffB); PG8_STAGE(PG8_SA(0, 0), a2, voffA);
            PG8_WAIT_V(8); PG8_WAIT_L(0); PG8_BAR; PG8_MMA(1, 0, At, B0); PG8_MMA(1, 1, At, B1); PG8_BAR; PG8_SCHED;
            PG8_LDB(B0, 1, 0); PG8_LDB(B1, 1, 1); PG8_SCHED; PG8_LDA(At, 1, 0); PG8_STAGE(PG8_SA(0, 1), a2 + hstep, voffA);
            PG8_WAIT_V(8); PG8_WAIT_L(0); PG8_BAR; PG8_MMA(0, 0, At, B0); PG8_MMA(0, 1, At, B1); PG8_BAR; PG8_SCHED;
            PG8_LDA(At, 1, 1); PG8_STAGE(PG8_SB(1, 0), b3, voffB); PG8_STAGE(PG8_SB(1, 1), b3 + hstep, voffB); PG8_STAGE(PG8_SA(1, 0), a3, voffA);
            PG8_WAIT_V(8); PG8_WAIT_L(0); PG8_BAR; PG8_MMA(1, 0, At, B0); PG8_MMA(1, 1, At, B1); PG8_BAR; PG8_SCHED;
            } else {
            PG8_LDB(B0, 0, 0); PG8_SCHED; PG8_LDA(At, 0, 0); PG8_STAGE(PG8_SA(1, 1), a1 + hstep, voffA);
            PG8_WAIT_L(8); PG8_BAR; PG8_WAIT_L(0); PG8_MMA(0, 0, At, B0); PG8_BAR; PG8_SCHED;
            PG8_LDB(B1, 0, 1); PG8_STAGE(PG8_SB(0, 0), b2, voffB);
            PG8_BAR; PG8_WAIT_L(0); PG8_MMA(0, 1, At, B1); PG8_BAR;
            PG8_LDA(At, 0, 1); PG8_STAGE(PG8_SA(0, 0), a2, voffA);
            PG8_BAR; PG8_WAIT_L(0); PG8_MMA(1, 0, At, B0); PG8_BAR; PG8_SCHED;
            PG8_STAGE(PG8_SB(0, 1), b2 + hstep, voffB);
            PG8_WAIT_V(6); PG8_BAR; PG8_MMA(1, 1, At, B1); PG8_BAR;
            PG8_LDB(B0, 1, 0); PG8_SCHED; PG8_LDA(At, 1, 0); PG8_STAGE(PG8_SA(0, 1), a2 + hstep, voffA);
            PG8_WAIT_L(8); PG8_BAR; PG8_WAIT_L(0); PG8_MMA(0, 0, At, B0); PG8_BAR; PG8_SCHED;
            PG8_LDB(B1, 1, 1); PG8_STAGE(PG8_SB(1, 0), b3, voffB);
            PG8_BAR; PG8_WAIT_L(0); PG8_MMA(0, 1, At, B1); PG8_BAR;
            PG8_LDA(At, 1, 1); PG8_STAGE(PG8_SA(1, 0), a3, voffA);
            PG8_BAR; PG8_WAIT_L(0); PG8_MMA(1, 0, At, B0); PG8_BAR; PG8_SCHED;
            PG8_STAGE(PG8_SB(1, 1), b3 + hstep, voffB);
            PG8_WAIT_V(6); PG8_BAR; PG8_MMA(1, 1, At, B1); PG8_BAR;
            }
        }
        if constexpr (ALIGN_EPI) { if (wr == 0) PG8_BAR; }
        if constexpr (!Epi::AFTER_DRAIN) { E(acc, cur, wr, wc, fr, fq); S.done(cur); }
        if (!has_next) break;
#pragma unroll
        for (int a = 0; a < 2; ++a)
#pragma unroll
            for (int b = 0; b < 2; ++b)
#pragma unroll
                for (int m = 0; m < 4; ++m)
#pragma unroll
                    for (int n = 0; n < 2; ++n) acc[a][b][m][n] = (f32x4){0.f, 0.f, 0.f, 0.f};
        cur = nxt; cA = nA; cB = nB; ++ui;
        if constexpr (ALIGN_EPI) { if (wr == 1) PG8_BAR; }
    }
    PG8_WAIT_V(0);
    if constexpr (!ALIGN_EPI) { if (wr == 0) PG8_BAR; }
    PG8_BAR;
    if constexpr (Epi::AFTER_DRAIN) { E.fused(acc, cur, wr, wc, fr, fq, lds, wid, lane); S.done(cur); }
#undef PG8_SA
#undef PG8_SB
#undef PG8_STAGE
#undef PG8_LDA
#undef PG8_LDB
#undef PG8_MMA
#undef PG8_WAIT_V
#undef PG8_WAIT_L
#undef PG8_BAR
#undef PG8_SCHED
}
}

#ifndef MK_ABL_A
#define MK_ABL_A 1.0f
#endif
#ifndef MK_ABL_B
#define MK_ABL_B 1.0f
#endif
#ifndef MK_ABL_C
#define MK_ABL_C 1.0f
#endif
#ifndef MK_ABL_F
#define MK_ABL_F 1.0f
#endif
constexpr int NWAVES = 8;
constexpr int D = 1024, NBATCH = 8, SEQ = 2048, LCTX = 256, DEPTH = 2;
constexpr int M_LAT = NBATCH * SEQ, M_CTX = NBATCH * LCTX, M_ALL = M_LAT + M_CTX;
constexpr int D_IN = 6928, NP = 6912;
constexpr int PA_VAL = 0, PA_GATE = 512, PQ = 1024, PK = 1536, PV = 1664, PMQ = 1792, PMK = 2304, PMV = 2816, PMO = 3328, PBG = 3840;
constexpr int SRC_MG = 3840;
constexpr int NE = 16, DEXP = 512, NY = 1536;
constexpr float LN_EPS = 1e-5f, ALPHA = 1.41421356237309515f;
constexpr float KSCALE = 0.08838834764831845f;
enum { I_X = 0, I_C, I_CTX, I_CCTX, I_LNIN_G, I_LNIN_B, I_WROUTER, I_BROUTER, I_WMOD, I_BMOD, I_WIN, I_CONVW, I_CONVB, I_CONVLN_G, I_CONVLN_B, I_WA, I_SINK, I_WB, I_GATEB, I_NORMG, I_WC, I_WOUT,
       I_LN1G, I_LN1B, I_WGU, I_WDN, I_LN2G, I_LN2B, N_IN };
static_assert(N_IN == 28, "inputs");

constexpr size_t MiB = 1u << 20;
constexpr size_t WS_CTL = 0, CTL_ZERO_BYTES = 1 * MiB;
constexpr size_t WS_MOD = 1 * MiB;
constexpr size_t WS_ROPE = 1 * MiB + 512 * 1024;
constexpr size_t WS_G = 2 * MiB;
constexpr size_t WS_ROUTE = 4 * MiB;
constexpr size_t WS_BCNT = 4 * MiB + 768 * 1024;
constexpr size_t WS_ROWMAP = 5 * MiB;
constexpr size_t WS_ROWW = 5 * MiB + 256 * 1024;
constexpr size_t WS_HC = 6 * MiB;
constexpr size_t WS_W = 14 * MiB;
constexpr size_t W_IN = 0, W_ABC = W_IN + (size_t)NP * D * 2, W_OUT = W_ABC + (size_t)D * NY * 2, W_GU = W_OUT + (size_t)D * D * 2, W_DN = W_GU + (size_t)NE * D * D * 2, W_LAYER = W_DN + (size_t)NE * D * DEXP * 2;
constexpr size_t WS_P = WS_W + 2 * W_LAYER;
constexpr size_t WS_U = WS_P + (size_t)M_ALL * NP * 2;
constexpr size_t WS_Y = WS_U + (size_t)M_ALL * D * 2;
constexpr size_t WS_END0 = WS_Y + (size_t)M_ALL * NY * 2;
constexpr int AS_ROWS = 40960;
constexpr size_t WS_AS = WS_P;
constexpr size_t WS_ACT = WS_AS + (size_t)AS_ROWS * D * 2;
constexpr size_t WS_F = WS_ACT + (size_t)AS_ROWS * DEXP * 2;
static_assert(WS_F + (size_t)M_ALL * 2 * D * 2 <= WS_U, "MoE buffers overlay P");
static_assert(W_LAYER == 69730304 && WS_W % 256 == 0 && WS_P % 256 == 0 && WS_U % 256 == 0 && WS_Y % 256 == 0, "map");
constexpr size_t WS_HB = WS_END0;
constexpr size_t WS_END = WS_HB + (size_t)M_ALL * 512 * 2;
constexpr int CW_TMO = 0, CW_CODE = 1;
constexpr int CW_CNT = 256;
constexpr int CW_WQ = 2560;
constexpr int CW_BAR = 4096;

constexpr int RING_BYTES = 131072, LDSCTL_OFF = RING_BYTES, MISC_OFF = LDSCTL_OFF + 320, LDS_BYTES = 147456;

#define GAS __attribute__((address_space(1)))
#define LAS __attribute__((address_space(3)))
typedef unsigned short bf16;
typedef unsigned v4u __attribute__((ext_vector_type(4)));
typedef unsigned v2u __attribute__((ext_vector_type(2)));
typedef float f32x4 __attribute__((ext_vector_type(4)));
typedef float f32x16 __attribute__((ext_vector_type(16)));
typedef short bf16x8 __attribute__((ext_vector_type(8)));
typedef GAS unsigned gu32;
#define RLX_AGENT __ATOMIC_RELAXED, __HIP_MEMORY_SCOPE_AGENT
#define LDS_WAIT() asm volatile("s_waitcnt lgkmcnt(0)" ::: "memory")
#define VM_WAIT() asm volatile("s_waitcnt vmcnt(0)" ::: "memory")
__device__ __forceinline__ unsigned f2bf(float f) { unsigned u = __builtin_bit_cast(unsigned, f); return (u + 0x7fffu + ((u >> 16) & 1u)) >> 16; }
typedef float f32x2_t __attribute__((ext_vector_type(2)));
typedef __bf16 bf16x2_t __attribute__((ext_vector_type(2)));
__device__ __forceinline__ unsigned pk2(float lo, float hi) { const f32x2_t v = {lo, hi}; const bf16x2_t b = __builtin_convertvector(v, bf16x2_t); return __builtin_bit_cast(unsigned, b); }
__device__ __forceinline__ float bflo(unsigned w) { return __builtin_bit_cast(float, w << 16); }
__device__ __forceinline__ float bfhi(unsigned w) { return __builtin_bit_cast(float, w & 0xffff0000u); }
__device__ __forceinline__ float bf1(bf16 v) { return __builtin_bit_cast(float, (unsigned)v << 16); }
__device__ __forceinline__ float sigmoidf_(float x) { return 1.0f / (1.0f + __expf(-x)); }
__device__ __forceinline__ int lane_id() { int l; asm volatile("v_mbcnt_lo_u32_b32 %0, -1, 0\n\tv_mbcnt_hi_u32_b32 %0, -1, %0" : "=v"(l)); return l; }
__device__ __forceinline__ float shidx(float v, int src) { return __builtin_bit_cast(float, __builtin_amdgcn_ds_bpermute(src << 2, __builtin_bit_cast(int, v))); }
__device__ __forceinline__ float shx(float v, int mask, int lane) { return shidx(v, lane ^ mask); }
__device__ __forceinline__ float shup(float v, int o, int lane) { return shidx(v, lane >= o ? lane - o : lane); }
__device__ __forceinline__ float wave_sum(float v, int lane) {
#pragma unroll
    for (int o = 1; o < 64; o <<= 1) v += shx(v, o, lane);
    return v;
}
__device__ __forceinline__ void unpack8(v4u w, float (&f)[8]) { f[0] = bflo(w.x); f[1] = bfhi(w.x); f[2] = bflo(w.y); f[3] = bfhi(w.y); f[4] = bflo(w.z); f[5] = bfhi(w.z); f[6] = bflo(w.w); f[7] = bfhi(w.w); }
__device__ __forceinline__ v4u pack8(const float (&f)[8]) { v4u w; w.x = pk2(f[0], f[1]); w.y = pk2(f[2], f[3]); w.z = pk2(f[4], f[5]); w.w = pk2(f[6], f[7]); return w; }

#define XB_TMO      128
#define XB_XCNT(j)  (256  + 64 * (j))
#define XB_XSUB(j)  (1280 + 64 * (j))
#define XB_XGEN(j)  (2304 + 64 * (j))
#define XB_TOP      3328
#define XB_TOPGEN   3392
#define XCD_BAR_WORDS 3456
#define XB_SPIN_CAP (1u << 18)

__device__ __forceinline__ unsigned xb_ld(unsigned* p)              { return __hip_atomic_load(p, __ATOMIC_RELAXED, __HIP_MEMORY_SCOPE_AGENT); }
__device__ __forceinline__ unsigned xb_add(unsigned* p, unsigned) { unsigned one; asm volatile("v_mov_b32 %0, 1" : "=v"(one));
    return __hip_atomic_fetch_add(p, one, __ATOMIC_RELAXED, __HIP_MEMORY_SCOPE_AGENT); }
__device__ __forceinline__ unsigned xb_xcc_id() { return (unsigned)__builtin_amdgcn_s_getreg((3 << 11) | 20) & 0xFu; }
#define XB_SPIN(cond, bar) do { unsigned _sp = 0; while (cond) { __builtin_amdgcn_s_sleep(1); \
    if ((++_sp & 255u) == 0u) { if (xb_ld(&(bar)[XB_TMO])) break; if (_sp > XB_SPIN_CAP) { (void)xb_add(&(bar)[XB_TMO], 1u); break; } } } } while (0)

struct XcdBarrier {
    bool w0;
    unsigned* bar; unsigned x;
    volatile LAS unsigned* st;
};

__device__ __forceinline__ XcdBarrier xcd_barrier_post(unsigned* bar, volatile LAS unsigned* st) {
    XcdBarrier b; b.w0 = false; b.bar = bar; b.x = xb_xcc_id(); b.st = st;
    if (threadIdx.x == 0) (void)xb_add(&bar[XB_XCNT(b.x)], 1u);
    return b;
}
__device__ __forceinline__ void xcd_barrier_complete(unsigned* bar, unsigned x, unsigned& nloc, unsigned& nx) {
    const unsigned G = gridDim.x * gridDim.y * gridDim.z;
    unsigned sum, cnt, mine, sp = 0u;
    for (;;) {
        sum = 0u; cnt = 0u; mine = 0u;
#pragma unroll
        for (unsigned j = 0; j < 16; ++j) { const unsigned c = xb_ld(&bar[XB_XCNT(j)]); sum += c; cnt += (c > 0u) ? 1u : 0u; mine = (j == x) ? c : mine; }
        if (sum == G) break;
        __builtin_amdgcn_s_sleep(1);
        if ((++sp & 255u) == 0u) { if (xb_ld(&bar[XB_TMO])) break; if (sp > XB_SPIN_CAP) { (void)xb_add(&bar[XB_TMO], 1u); break; } }
    }
    nloc = mine > 0u ? mine : 1u; nx = cnt > 0u ? cnt : 1u;
}

__device__ __forceinline__ void xcd_barrier(const XcdBarrier& b) {
    asm volatile("s_waitcnt vmcnt(0)" ::: "memory");
    __syncthreads();
    if (b.w0 && lane_id() == 0) {
        unsigned* bar = b.bar;
        __builtin_amdgcn_s_waitcnt(0);
        unsigned nloc = b.st[0], nx = b.st[1];
        if (nloc == 0u) { xcd_barrier_complete(bar, b.x, nloc, nx); b.st[0] = nloc; b.st[1] = nx; }
        const unsigned old = xb_add(&bar[XB_XSUB(b.x)], 1u);
        const unsigned gen = old / nloc;
        if (old + 1u == (gen + 1u) * nloc) {
            __builtin_amdgcn_fence(__ATOMIC_RELEASE, "agent");
            asm volatile("s_waitcnt vmcnt(0)" ::: "memory");
            const unsigned og = xb_add(&bar[XB_TOP], 1u);
            const unsigned tg = og / nx;
            if (og + 1u == (tg + 1u) * nx) xb_add(&bar[XB_TOPGEN], 1u);
            else XB_SPIN(xb_ld(&bar[XB_TOPGEN]) == tg, bar);
            __builtin_amdgcn_fence(__ATOMIC_ACQUIRE, "agent");
            xb_add(&bar[XB_XGEN(b.x)], 1u);
            asm volatile("s_waitcnt vmcnt(0)" ::: "memory");
        } else {
            XB_SPIN(xb_ld(&bar[XB_XGEN(b.x)]) == gen, bar);
            __builtin_amdgcn_fence(__ATOMIC_ACQUIRE, "agent");
            asm volatile("s_waitcnt vmcnt(0)" ::: "memory");
        }
    }
    __syncthreads();
}

struct Ctx {
    LAS unsigned char* lds;
    volatile LAS unsigned* MISC;
    unsigned* ctl;
    int tid, lane, wave, vcu, G;
    const float* const* in; float* out; unsigned char* ws;
};
__device__ __forceinline__ bf16* wt(const Ctx& F, int l, size_t off) { return (bf16*)(F.ws + WS_W + (size_t)l * W_LAYER + off); }
__device__ __forceinline__ float* hrow(const Ctx& F, int r) { return r < M_LAT ? F.out + (size_t)r * D : (float*)(F.ws + WS_HC) + (size_t)(r - M_LAT) * D; }
__device__ __forceinline__ const float* xrow(const Ctx& F, int r) { return r < M_LAT ? F.in[I_X] + (size_t)r * D : F.in[I_CTX] + (size_t)(r - M_LAT) * D; }
__device__ __forceinline__ int modrow(int r) { return r < M_LAT ? (r >> 11) : 8; }
__device__ __forceinline__ const float* modp(const Ctx& F, int l, int mr) { return (const float*)(F.ws + WS_MOD) + (size_t)(l * 9 + mr) * 6144; }

__device__ __forceinline__ void load_row(const float* p, int lane, f32x4 (&v)[4]) {
#pragma unroll
    for (int j = 0; j < 4; ++j) v[j] = *(const f32x4*)(p + 4 * lane + 256 * j);
}
__device__ __forceinline__ void store_row(float* p, int lane, const f32x4 (&v)[4]) {
#pragma unroll
    for (int j = 0; j < 4; ++j) *(f32x4*)(p + 4 * lane + 256 * j) = v[j];
}
__device__ __forceinline__ void ln_row(f32x4 (&v)[4], const float* g, const float* b, int lane) {
    float s = 0.f;
#pragma unroll
    for (int j = 0; j < 4; ++j) s += (v[j].x + v[j].y) + (v[j].z + v[j].w);
    const float mean = wave_sum(s, lane) * (1.f / D); float s2 = 0.f;
#pragma unroll
    for (int j = 0; j < 4; ++j) { v[j] = v[j] - mean; s2 += (v[j].x * v[j].x + v[j].y * v[j].y) + (v[j].z * v[j].z + v[j].w * v[j].w); }
    const float rstd = 1.f / sqrtf(wave_sum(s2, lane) * (1.f / D) + LN_EPS);
#pragma unroll
    for (int j = 0; j < 4; ++j) { const f32x4 gg = *(const f32x4*)(g + 4 * lane + 256 * j), bb = *(const f32x4*)(b + 4 * lane + 256 * j); v[j] = v[j] * rstd * gg + bb; }
}
__device__ __forceinline__ void emit_u(const f32x4 (&h)[4], const float* sh, const float* sc, bf16* urow, int lane, f32x4 (&u)[4]) {
#pragma unroll
    for (int j = 0; j < 4; ++j) { const f32x4 s1 = *(const f32x4*)(sc + 4 * lane + 256 * j), s0 = *(const f32x4*)(sh + 4 * lane + 256 * j); u[j] = h[j] * (1.0f + s1) + s0;
        v2u w; w.x = pk2(u[j].x, u[j].y); w.y = pk2(u[j].z, u[j].w); *(v2u*)(urow + 4 * lane + 256 * j) = w; }
}
__device__ __forceinline__ void stage_w16(const Ctx& F, const float* W, int ld, LAS float* Wt) {
    for (int idx = F.tid; idx < 1024 * 16; idx += NWAVES * 64) { const int k = idx >> 4, e = idx & 15; Wt[e * 1024 + k] = W[(size_t)k * ld + e]; }
}
__device__ __forceinline__ int elane(int lane) { return ((lane >> 5) & 1) * 8 + ((lane >> 4) & 1) * 4 + ((lane >> 3) & 1) * 2 + ((lane >> 2) & 1); }
__device__ __forceinline__ float dot16r(const f32x4 (&u)[4], const LAS float* Wt, int lane) {
    const LAS float* wl = Wt + 4 * lane; float o[8]; const bool hi5 = (lane & 32) != 0;
#pragma unroll
    for (int k = 0; k < 8; ++k) { float s0 = 0.f, s1 = 0.f;
#pragma unroll
        for (int j = 0; j < 4; ++j) { const f32x4 w0 = *(const LAS f32x4*)(wl + k * 1024 + 256 * j), w1 = *(const LAS f32x4*)(wl + (k + 8) * 1024 + 256 * j);
            s0 += (u[j].x * w0.x + u[j].y * w0.y) + (u[j].z * w0.z + u[j].w * w0.w); s1 += (u[j].x * w1.x + u[j].y * w1.y) + (u[j].z * w1.z + u[j].w * w1.w); }
        const float send = hi5 ? s0 : s1, keep = hi5 ? s1 : s0; o[k] = keep + shx(send, 32, lane);
        asm volatile("" ::: "memory"); }
    { const bool hi = (lane & 16) != 0;
#pragma unroll
        for (int k = 0; k < 4; ++k) { const float send = hi ? o[k] : o[k + 4], keep = hi ? o[k + 4] : o[k]; o[k] = keep + shx(send, 16, lane); } }
    { const bool hi = (lane & 8) != 0;
#pragma unroll
        for (int k = 0; k < 2; ++k) { const float send = hi ? o[k] : o[k + 2], keep = hi ? o[k + 2] : o[k]; o[k] = keep + shx(send, 8, lane); } }
    { const bool hi = (lane & 4) != 0; const float send = hi ? o[0] : o[1], keep = hi ? o[1] : o[0]; o[0] = keep + shx(send, 4, lane); }
    o[0] += shx(o[0], 2, lane); o[0] += shx(o[0], 1, lane);
    return o[0];
}
__device__ __forceinline__ void emit_layer_input(const Ctx& F, int l, int r, const f32x4 (&h)[4]) {
    const float* mp = modp(F, l, modrow(r)); f32x4 u[4];
    emit_u(h, mp + 0, mp + 1024, (bf16*)(F.ws + WS_U) + (size_t)r * D, F.lane, u);
    const float gv = dot16r(u, (const LAS float*)F.lds, F.lane);
    if ((F.lane & 3) == 0) ((float*)(F.ws + WS_G))[(size_t)r * 16 + elane(F.lane)] = gv;
}

__device__ __forceinline__ void tr_item(const float* W, int ldw, int k0, int n0, bf16* WT, int ldt, int drow0, int dk0, LAS float* scr, int lane) {
#pragma unroll 8
    for (int i = 0; i < 32; ++i) { const int kk = 2 * i + (lane >> 5); scr[kk * 33 + (lane & 31)] = W[(size_t)(k0 + kk) * ldw + n0 + (lane & 31)]; }
    LDS_WAIT(); asm volatile("" ::: "memory");
    const int c = lane & 7;
#pragma unroll
    for (int j = 0; j < 4; ++j) { const int n = (lane >> 3) + 8 * j; const LAS float* s = scr + (8 * c) * 33 + n;
        v4u o; o.x = pk2(s[0 * 33], s[1 * 33]); o.y = pk2(s[2 * 33], s[3 * 33]); o.z = pk2(s[4 * 33], s[5 * 33]); o.w = pk2(s[6 * 33], s[7 * 33]);
        *(v4u*)(WT + (size_t)(drow0 + n) * ldt + dk0 + k0 + 8 * c) = o; }
    LDS_WAIT(); asm volatile("" ::: "memory");
}
constexpr int CV_IN = 16 * (NP / 32), CV_ABC = 3 * 8 * 32, CV_OUT = 16 * 32, CV_GU = NE * 16 * 32, CV_DN = NE * 8 * 32, CV_LAYER = CV_IN + CV_ABC + CV_OUT + CV_GU + CV_DN;
__device__ __forceinline__ void convert_item(const Ctx& F, int l, int it, LAS float* scr) {
    const int lane = F.lane;
    if (it < CV_IN) { const int kb = it / (NP / 32), nb = it % (NP / 32), n0 = 32 * nb;
        tr_item(F.in[I_WIN] + (size_t)l * D * D_IN, D_IN, 64 * kb, n0 < PBG ? n0 : n0 + 16, wt(F, l, W_IN), D, n0, 0, scr, lane); return; }
    it -= CV_IN;
    if (it < CV_ABC) { const int br = it / 256, r = it % 256, kb = r / 32, nb = r % 32;
        if (br == 0) tr_item(F.in[I_WA] + (size_t)l * 512 * D, D, 64 * kb, 32 * nb, wt(F, l, W_ABC), NY, 32 * nb, 0, scr, lane);
        else if (br == 1) tr_item(F.in[I_WB] + (size_t)l * 512 * D, D, 64 * kb, 32 * nb, wt(F, l, W_ABC), NY, 32 * nb, 512, scr, lane);
        else tr_item(F.in[I_WC] + (size_t)l * 512 * D, D, 64 * kb, 32 * nb, wt(F, l, W_ABC), NY, 32 * nb, 1024, scr, lane);
        return; }
    it -= CV_ABC;
    if (it < CV_OUT) { const int kb = it / 32, nb = it % 32; tr_item(F.in[I_WOUT] + (size_t)l * D * D, D, 64 * kb, 32 * nb, wt(F, l, W_OUT), D, 32 * nb, 0, scr, lane); return; }
    it -= CV_OUT;
    if (it < CV_GU) { const int e = it / 512, r = it % 512, kb = r / 32, nb = r % 32, n0 = 32 * nb;
        const int dr = n0 < 512 ? (n0 / 128) * 256 + (n0 % 128) : ((n0 - 512) / 128) * 256 + 128 + ((n0 - 512) % 128);
        tr_item(F.in[I_WGU] + (size_t)(l * NE + e) * D * D, D, 64 * kb, n0, wt(F, l, W_GU) + (size_t)e * D * D, D, dr, 0, scr, lane); return; }
    it -= CV_GU;
    { const int e = it / 256, r = it % 256, kb = r / 32, nb = r % 32;
        tr_item(F.in[I_WDN] + (size_t)(l * NE + e) * DEXP * D, D, 64 * kb, 32 * nb, wt(F, l, W_DN) + (size_t)e * D * DEXP, DEXP, 32 * nb, 0, scr, lane); }
}
__device__ __forceinline__ void p0_prologue(const Ctx& F) {
    if (F.vcu < 192) {
        LAS float* S = (LAS float*)F.lds; LAS float* red = (LAS float*)(F.lds + 36864);
        for (int idx = F.tid; idx < 9 * D; idx += NWAVES * 64) { const int r = idx >> 10, k = idx & 1023; const float v = r < 8 ? F.in[I_C][r * D + k] : F.in[I_CCTX][k]; S[idx] = v * sigmoidf_(v); }
        __syncthreads();
        const int l = F.vcu / 96, n0 = (F.vcu % 96) * 64;
        float acc[9];
#pragma unroll
        for (int r = 0; r < 9; ++r) acc[r] = 0.f;
        const float* wp = F.in[I_WMOD] + ((size_t)l * D + 128 * F.wave) * 6144 + n0 + F.lane;
#pragma unroll 4
        for (int kk = 0; kk < 128; ++kk) { const float wv = wp[(size_t)kk * 6144];
#pragma unroll
            for (int r = 0; r < 9; ++r) acc[r] += S[r * D + 128 * F.wave + kk] * wv; }
#pragma unroll
        for (int r = 0; r < 9; ++r) red[(F.wave * 9 + r) * 64 + F.lane] = acc[r];
        __syncthreads();
        for (int idx = F.tid; idx < 9 * 64; idx += NWAVES * 64) { const int r = idx >> 6, c = idx & 63; float s = 0.f;
#pragma unroll
            for (int w = 0; w < 8; ++w) s += red[(w * 9 + r) * 64 + c];
            ((float*)(F.ws + WS_MOD))[(size_t)(l * 9 + r) * 6144 + n0 + c] = s + F.in[I_BMOD][l * 6144 + n0 + c]; }
        __syncthreads();
    }
    if (F.vcu == 255) for (int idx = F.tid; idx < 1024; idx += NWAVES * 64) { const int pos = idx >> 4, i = idx & 15;
        const float inv = i == 0 ? 1.000000000e+00f : i == 1 ? 5.623413324e-01f : i == 2 ? 3.162277639e-01f : i == 3 ? 1.778279394e-01f : i == 4 ? 1.000000015e-01f : i == 5 ? 5.623413250e-02f : i == 6 ? 3.162277490e-02f : i == 7 ? 1.778279431e-02f :
                          i == 8 ? 9.999999776e-03f : i == 9 ? 5.623413250e-03f : i == 10 ? 3.162277630e-03f : i == 11 ? 1.778279431e-03f : i == 12 ? 1.000000047e-03f : i == 13 ? 5.623413017e-04f : i == 14 ? 3.162277571e-04f : 1.778279402e-04f;
        const float angf = (float)pos * inv; const double x = (double)angf;
        const double kq = __builtin_rint(x * 0.63661977236758134308); const double r = (x - kq * 1.57079632679489655800) - kq * 6.123233995736766036e-17; const int q = ((int)kq) & 3;
        const double r2 = r * r;
        const double sn = r * (1.0 + r2 * (-1.0 / 6 + r2 * (1.0 / 120 + r2 * (-1.0 / 5040 + r2 * (1.0 / 362880 + r2 * (-1.0 / 39916800 + r2 * (1.0 / 6227020800.0)))))));
        const double cs = 1.0 + r2 * (-0.5 + r2 * (1.0 / 24 + r2 * (-1.0 / 720 + r2 * (1.0 / 40320 + r2 * (-1.0 / 3628800 + r2 * (1.0 / 479001600.0 + r2 * (-1.0 / 87178291200.0)))))));
        const double c = q == 0 ? cs : q == 1 ? -sn : q == 2 ? -cs : sn, s_ = q == 0 ? sn : q == 1 ? cs : q == 2 ? -sn : -cs;
        ((float*)(F.ws + WS_ROPE))[2 * idx] = (float)c; ((float*)(F.ws + WS_ROPE))[2 * idx + 1] = (float)s_; }
    LAS float* scr = (LAS float*)(F.lds + F.wave * 16384);
    const int gw = F.vcu * NWAVES + F.wave, NGW = F.G * NWAVES;
    for (int it = gw; it < CV_LAYER; it += NGW) convert_item(F, 0, it, scr);
}
__device__ __forceinline__ void convert_layer1_on_idle(const Ctx& F, int first) {
    LAS float* scr = (LAS float*)(F.lds + F.wave * 16384);
    const int gw = ((int)blockIdx.x - first) * NWAVES + F.wave, NGW = (F.G - first) * NWAVES;
    if ((int)blockIdx.x >= first) for (int it = gw; it < CV_LAYER; it += NGW) convert_item(F, 1, it, scr);
}
__device__ __forceinline__ void p1_ln_in(const Ctx& F) {
    const int gw = F.vcu * NWAVES + F.wave, NGW = F.G * NWAVES;
    stage_w16(F, F.in[I_WIN] + SRC_MG, D_IN, (LAS float*)F.lds); __syncthreads();
    for (int r = gw; r < M_ALL; r += NGW) { f32x4 v[4]; load_row(xrow(F, r), F.lane, v);
        ln_row(v, F.in[I_LNIN_G], F.in[I_LNIN_B], F.lane); store_row(hrow(F, r), F.lane, v); emit_layer_input(F, 0, r, v); }
}

__device__ __forceinline__ void conv_unit(const Ctx& F, int l, int unit) {
    const bf16* P = (const bf16*)(F.ws + WS_P); bf16* Y = (bf16*)(F.ws + WS_Y);
    int seq0, T, t0;
    if (unit < 512) { const int b = unit >> 6; seq0 = b * SEQ; T = SEQ; t0 = (unit & 63) * 32; }
    else { const int j = unit - 512, b = j >> 3; seq0 = M_LAT + b * LCTX; T = LCTX; t0 = (j & 7) * 32; }
    const int c = F.tid;
    LAS bf16* Ut = (LAS bf16*)F.lds;
#pragma unroll 2
    for (int p = F.tid; p < 62 * 64; p += NWAVES * 64) { const int i = p >> 6, c8 = p & 63, t = t0 - 15 + i; v4u o = {0u, 0u, 0u, 0u};
        if (t >= 0 && t < T) { const bf16* pr = P + (size_t)(seq0 + t) * NP + 8 * c8; const v4u xv = *(const v4u*)(pr + PA_VAL), xg = *(const v4u*)(pr + PA_GATE);
            float a[8], g[8], uo[8]; unpack8(xv, a); unpack8(xg, g);
#pragma unroll
            for (int j = 0; j < 8; ++j) uo[j] = a[j] * sigmoidf_(g[j]);
            o = pack8(uo); }
        *(LAS v4u*)(Ut + i * 512 + 8 * c8) = o; }
    float w[31];
#pragma unroll
    for (int j = 0; j < 31; ++j) w[j] = F.in[I_CONVW][(size_t)(l * 31 + j) * 512 + c];
    const float bias = F.in[I_CONVB][l * 512 + c];
    __syncthreads();
    float u[62];
#pragma unroll
    for (int i = 0; i < 62; ++i) u[i] = bf1(Ut[i * 512 + c]);
    LAS float* Yt = (LAS float*)(F.lds + 62 * 512 * 2);
#pragma unroll
    for (int tt = 0; tt < 32; ++tt) { float y = bias;
#pragma unroll
        for (int j = 0; j < 31; ++j) y += w[j] * u[tt + j];
        Yt[tt * 512 + c] = y; }
    __syncthreads();
    const float* lg = F.in[I_CONVLN_G] + l * 512; const float* lb = F.in[I_CONVLN_B] + l * 512;
#pragma unroll
    for (int q = 0; q < 4; ++q) { const int tt = 4 * F.wave + q; float v[8]; float s = 0.f;
#pragma unroll
        for (int jj = 0; jj < 8; ++jj) { v[jj] = Yt[tt * 512 + F.lane + 64 * jj]; s += v[jj]; }
        const float mean = wave_sum(s, F.lane) * (1.f / 512.f); float s2 = 0.f;
#pragma unroll
        for (int jj = 0; jj < 8; ++jj) { v[jj] -= mean; s2 += v[jj] * v[jj]; }
        const float rstd = 1.f / sqrtf(wave_sum(s2, F.lane) * (1.f / 512.f) + LN_EPS);
        bf16* yr = Y + (size_t)(seq0 + t0 + tt) * NY;
#pragma unroll
        for (int jj = 0; jj < 8; ++jj) { const int cc = F.lane + 64 * jj; const float z = v[jj] * rstd * lg[cc] + lb[cc]; yr[cc] = (bf16)f2bf(MK_ABL_A * z * sigmoidf_(z)); } }
    __syncthreads();
}

constexpr int AT_KSTR = 72, AT_VSTR = 136, AT_KS_OFF = 0, AT_VT_OFF = 128 * AT_KSTR * 2;
constexpr int AT_QF_OFF = 36864;
constexpr int AT_ROPE_OFF = LDSCTL_OFF + 1024;
struct AttnTileRegs { v4u k1, k2, v1, v2; };
__device__ __forceinline__ void attn_tile_src(int b, int nb, int ti, int& krow0, int& tok0, bool& rope, int& mode) {
    mode = 0; tok0 = 0; rope = false;
    if (ti < 2) krow0 = M_LAT + b * LCTX + 128 * ti;
    else { const int kb = nb + ti - 3; krow0 = b * SEQ + kb * 128; tok0 = kb * 128; rope = true; mode = ti == 2 ? 1 : ti == 4 ? 2 : 0; }
}
__device__ __forceinline__ void attn_tile_load(const Ctx& F, const bf16* P, int krow0, int hk, AttnTileRegs& R) {
    { const int key = F.tid >> 2, pc = F.tid & 3, c1 = pc < 2 ? pc : pc + 2; const unsigned eo = (unsigned)((krow0 + key) * NP + PK + hk * 64 + 8 * c1);
        R.k1 = *(const v4u*)(P + eo); R.k2 = *(const v4u*)(P + eo + 16); }
    { const int key = F.tid & 127, pc = F.tid >> 7; const unsigned eo = (unsigned)((krow0 + key) * NP + PV + hk * 64 + 16 * pc);
        R.v1 = *(const v4u*)(P + eo); R.v2 = *(const v4u*)(P + eo + 8); }
}
__device__ __forceinline__ void attn_tile_store(const Ctx& F, bool rope, int tok0, const AttnTileRegs& R) {
    LAS bf16* Ks = (LAS bf16*)(F.lds + AT_KS_OFF); LAS bf16* Vt = (LAS bf16*)(F.lds + AT_VT_OFF);
    { const int key = F.tid >> 2, pc = F.tid & 3, c1 = pc < 2 ? pc : pc + 2, c2 = c1 + 2; v4u x1 = R.k1, x2 = R.k2;
        if (rope) { const int tok = tok0 + key, pos = pc < 2 ? (tok >> 6) : (tok & 63), ib = 8 * (pc & 1);
            const LAS float* rt = (const LAS float*)(F.lds + AT_ROPE_OFF) + (pos * 16 + ib) * 2;
            float a[8], b[8], oa[8], ob[8]; unpack8(x1, a); unpack8(x2, b);
#pragma unroll
            for (int j = 0; j < 8; ++j) { const float cs = rt[2 * j], sn = rt[2 * j + 1]; oa[j] = a[j] * cs - b[j] * sn; ob[j] = a[j] * sn + b[j] * cs; }
            x1 = pack8(oa); x2 = pack8(ob); }
        *(LAS v4u*)(Ks + key * AT_KSTR + 8 * c1) = x1; *(LAS v4u*)(Ks + key * AT_KSTR + 8 * c2) = x2; }
    { const int key = F.tid & 127, pc = F.tid >> 7;
        const unsigned ww[8] = {R.v1.x, R.v1.y, R.v1.z, R.v1.w, R.v2.x, R.v2.y, R.v2.z, R.v2.w};
#pragma unroll
        for (int j = 0; j < 8; ++j) { Vt[(16 * pc + 2 * j) * AT_VSTR + key] = (bf16)(ww[j] & 0xffffu); Vt[(16 * pc + 2 * j + 1) * AT_VSTR + key] = (bf16)(ww[j] >> 16); } }
}
__device__ __forceinline__ void attn_rope_to_lds(const Ctx& F) {
    for (int i = F.tid; i < 2048; i += NWAVES * 64) ((LAS float*)(F.lds + AT_ROPE_OFF))[i] = ((const float*)(F.ws + WS_ROPE))[i];
    __syncthreads();
}
__device__ __forceinline__ void attn_unit(const Ctx& F, int l, int kind, int b, int nb, int hk) {
    const bf16* P = (const bf16*)(F.ws + WS_P); bf16* Y = (bf16*)(F.ws + WS_Y);
    const LAS bf16* Ks = (const LAS bf16*)(F.lds + AT_KS_OFF); const LAS bf16* Vt = (const LAS bf16*)(F.lds + AT_VT_OFF);
    const int lane = F.lane, w = F.wave, gi = w >> 1, th = w & 1, g = 4 * hk + gi, l31 = lane & 31, h = lane >> 5;
    int qrow[2];
#pragma unroll
    for (int qb = 0; qb < 2; ++qb) {
        const int iq = 64 * th + 32 * qb + l31, tok = nb * 128 + iq;
        const int row = kind == 0 ? b * SEQ + tok : M_LAT + b * LCTX + tok; qrow[qb] = row;
        const bf16* src = P + (size_t)row * NP + PQ + g * 64 + 8 * h;
        float x[4][8];
#pragma unroll
        for (int s = 0; s < 4; ++s) { const v4u raw = *(const v4u*)(src + 16 * s); unpack8(raw, x[s]); }
        if (kind == 0) {
            const LAS float* rtr = (const LAS float*)(F.lds + AT_ROPE_OFF) + ((tok >> 6) * 16 + 8 * h) * 2; const LAS float* rtc = (const LAS float*)(F.lds + AT_ROPE_OFF) + ((tok & 63) * 16 + 8 * h) * 2;
#pragma unroll
            for (int j = 0; j < 8; ++j) { float cs = rtr[2 * j], sn = rtr[2 * j + 1]; float a = x[0][j], bb = x[1][j]; x[0][j] = a * cs - bb * sn; x[1][j] = a * sn + bb * cs;
                cs = rtc[2 * j]; sn = rtc[2 * j + 1]; a = x[2][j]; bb = x[3][j]; x[2][j] = a * cs - bb * sn; x[3][j] = a * sn + bb * cs; } }
#pragma unroll
        for (int s = 0; s < 4; ++s) {
#pragma unroll
            for (int j = 0; j < 8; ++j) x[s][j] *= 0.125f * 1.44269504f;
            const v4u pk = pack8(x[s]); *(LAS v4u*)(F.lds + AT_QF_OFF + (((w * 2 + qb) * 4 + s) * 64 + lane) * 16) = pk; }
    }
    f32x16 O[2][2];
    float mrun[2], lsum[2];
    const float sink = F.in[I_SINK][l * 8 + g] * 1.44269504f;
#pragma unroll
    for (int qb = 0; qb < 2; ++qb) { mrun[qb] = sink; lsum[qb] = h == 0 ? 1.0f : 0.0f;
#pragma unroll
        for (int db = 0; db < 2; ++db)
#pragma unroll
            for (int r = 0; r < 16; ++r) O[db][qb][r] = 0.f; }
    const int ntile = kind == 0 ? 5 : 2;
    AttnTileRegs TR; int ti = 0;
    { int krow0, tok0, mode; bool rope; attn_tile_src(b, nb, 0, krow0, tok0, rope, mode); attn_tile_load(F, P, krow0, hk, TR); }
    while (ti < ntile) {
        int krow0, tok0, mode; bool rope; attn_tile_src(b, nb, ti, krow0, tok0, rope, mode);
        int tn = ti + 1; if (kind == 0) { if (tn == 2 && nb == 0) tn = 3; if (tn == 4 && nb == SEQ / 128 - 1) tn = 5; }
        __syncthreads();
        attn_tile_store(F, rope, tok0, TR);
        __syncthreads();
        if (tn < ntile) { int kr2, tk2, md2; bool rp2; attn_tile_src(b, nb, tn, kr2, tk2, rp2, md2); attn_tile_load(F, P, kr2, hk, TR); }
        ti = tn;
#pragma unroll 1
        for (int kh = 0; kh < 2; ++kh) {
            if ((mode == 1 && th == 1 && kh == 0) || (mode == 2 && th == 0 && kh == 1)) continue;
#pragma unroll
            for (int qb = 0; qb < 2; ++qb) {
                bf16x8 qfr[4];
#pragma unroll
                for (int s = 0; s < 4; ++s) qfr[s] = *(const LAS bf16x8*)(F.lds + AT_QF_OFF + (((w * 2 + qb) * 4 + s) * 64 + lane) * 16);
                f32x16 st[2];
#pragma unroll
                for (int kb = 0; kb < 2; ++kb) {
#pragma unroll
                    for (int r = 0; r < 16; ++r) st[kb][r] = 0.f;
#pragma unroll
                    for (int s = 0; s < 4; ++s) { const bf16x8 a = *(const LAS bf16x8*)(Ks + (64 * kh + 32 * kb + l31) * AT_KSTR + 16 * s + 8 * h);
                        st[kb] = __builtin_amdgcn_mfma_f32_32x32x16_bf16(a, qfr[s], st[kb], 0, 0, 0); }
                    asm volatile("" ::: "memory"); }
                const int iq = 64 * th + 32 * qb + l31;
                float mx = -INFINITY;
                if (mode != 0) {
#pragma unroll
                    for (int kb = 0; kb < 2; ++kb)
#pragma unroll
                        for (int r = 0; r < 16; ++r) { const int key = 64 * kh + 32 * kb + (r & 3) + 8 * (r >> 2) + 4 * h;
                            const bool valid = mode == 1 ? key >= iq : key <= iq; st[kb][r] = valid ? st[kb][r] : -INFINITY; } }
#pragma unroll
                for (int kb = 0; kb < 2; ++kb)
#pragma unroll
                    for (int r = 0; r < 16; ++r) mx = fmaxf(mx, st[kb][r]);
                mx = fmaxf(mx, shx(mx, 32, lane));
                const float mnew = fmaxf(mrun[qb], mx), alpha = __builtin_amdgcn_exp2f(mrun[qb] - mnew); mrun[qb] = mnew;
                float ps = 0.f;
#pragma unroll
                for (int kb = 0; kb < 2; ++kb)
#pragma unroll
                    for (int r = 0; r < 16; ++r) { const float p = __builtin_amdgcn_exp2f(st[kb][r] - mnew); st[kb][r] = p; ps += p; }
                lsum[qb] = lsum[qb] * alpha + ps;
#pragma unroll
                for (int db = 0; db < 2; ++db)
#pragma unroll
                    for (int r = 0; r < 16; ++r) O[db][qb][r] *= alpha;
#pragma unroll
                for (int kb = 0; kb < 2; ++kb)
#pragma unroll
                    for (int s2 = 0; s2 < 2; ++s2) {
                        v4u pw; pw.x = pk2(st[kb][8 * s2 + 0], st[kb][8 * s2 + 1]); pw.y = pk2(st[kb][8 * s2 + 2], st[kb][8 * s2 + 3]);
                        pw.z = pk2(st[kb][8 * s2 + 4], st[kb][8 * s2 + 5]); pw.w = pk2(st[kb][8 * s2 + 6], st[kb][8 * s2 + 7]);
                        const bf16x8 pf = __builtin_bit_cast(bf16x8, pw);
#pragma unroll
                        for (int db = 0; db < 2; ++db) { const LAS bf16* vp = Vt + (32 * db + l31) * AT_VSTR + 64 * kh + 32 * kb + 16 * s2 + 4 * h;
                            const v2u v0 = *(const LAS v2u*)(vp), v1 = *(const LAS v2u*)(vp + 8);
                            v4u av; av.x = v0.x; av.y = v0.y; av.z = v1.x; av.w = v1.y;
                            O[db][qb] = __builtin_amdgcn_mfma_f32_32x32x16_bf16(__builtin_bit_cast(bf16x8, av), pf, O[db][qb], 0, 0, 0); }
                    }
                asm volatile("" ::: "memory");
            }
        }
    }
#pragma unroll
    for (int qb = 0; qb < 2; ++qb) {
        const float lt = lsum[qb] + shx(lsum[qb], 32, lane), inv = MK_ABL_B / lt;
        bf16* yr = Y + (size_t)qrow[qb] * NY + 512 + g * 64;
#pragma unroll
        for (int db = 0; db < 2; ++db)
#pragma unroll
            for (int gq = 0; gq < 4; ++gq) { v2u o; o.x = pk2(O[db][qb][4 * gq] * inv, O[db][qb][4 * gq + 1] * inv); o.y = pk2(O[db][qb][4 * gq + 2] * inv, O[db][qb][4 * gq + 3] * inv);
                *(v2u*)(yr + 32 * db + 8 * gq + 4 * h) = o; }
    }
}

constexpr int ML_QS = 0, ML_KS = 17408, ML_KTS = 34816, ML_VTS = 53248, ML_WS = 73984, ML_CTS = 83200, ML_SM = 122368;
constexpr int ML_QSTR = 136, ML_TSTR = 72;
static_assert(ML_SM + 5 * 256 <= RING_BYTES, "mLSTM LDS");
__device__ __forceinline__ float log_sigmoid(float x) { return fminf(x, 0.f) - __logf(1.0f + __expf(-fabsf(x))); }
__device__ __forceinline__ int ml_chunk_base(int ci, int b, int dir) { const int cc = ci < 4 ? ci : ci - 4, nc = ci < 4 ? 4 : 32, cs = dir == 0 ? cc : nc - 1 - cc; return (ci < 4 ? M_LAT + b * LCTX : b * SEQ) + 64 * cs; }
__device__ __forceinline__ void mlstm_chain(const Ctx& F, int l, int unit) {
    const int chain = unit >> 1, half = unit & 1;
    const bf16* P = (const bf16*)(F.ws + WS_P); const float* G = (const float*)(F.ws + WS_G);
    const int b = chain >> 3, hd = (chain >> 1) & 3, dir = chain & 1, lane = F.lane, w = F.wave, tid = F.tid, l15 = lane & 15, lq = lane >> 4;
    bf16* Hout = dir == 0 ? (bf16*)(F.ws + WS_Y) + 1024 : (bf16*)(F.ws + WS_HB); const int hstride = dir == 0 ? NY : 512;
    LAS bf16* Qs = (LAS bf16*)(F.lds + ML_QS); LAS bf16* Ks = (LAS bf16*)(F.lds + ML_KS); LAS bf16* KTs = (LAS bf16*)(F.lds + ML_KTS); LAS bf16* VTs = (LAS bf16*)(F.lds + ML_VTS);
    LAS bf16* Ws = (LAS bf16*)(F.lds + ML_WS); LAS bf16* CTs = (LAS bf16*)(F.lds + ML_CTS);
    LAS float* GA = (LAS float*)(F.lds + ML_SM); LAS float* GG = GA + 64; LAS float* WIN = GA + 128; LAS float* EM = GA + 192; LAS float* DEN = GA + 256;
    const float gbi = F.in[I_GATEB][l * 16 + dir * 8 + hd], gbf = F.in[I_GATEB][l * 16 + dir * 8 + 4 + hd];
    __syncthreads();
#if defined(MK_PROBE_LDSCLR)
    for (int i = tid; i < RING_BYTES / 4; i += NWAVES * 64) ((LAS unsigned*)F.lds)[i] = 0u;
    __syncthreads();
#endif
    for (int i = tid; i < 80 * ML_QSTR / 2; i += NWAVES * 64) ((LAS unsigned*)CTs)[i] = 0u;
    for (int i = tid; i < 16 * ML_TSTR / 2; i += NWAVES * 64) ((LAS unsigned*)(VTs + 64 * ML_TSTR))[i] = (i < ML_TSTR / 2) ? 0x3f803f80u : 0u;
    f32x4 Cacc[5];
#pragma unroll
    for (int e = 0; e < 5; ++e) Cacc[e] = (f32x4){0.f, 0.f, 0.f, 0.f};
    float mst = 0.f;
    const int pr0 = tid & 31, c16 = tid >> 5;
    v4u nq[2], nk[2], nv[2]; float nig, nfg;
#define ML_ISSUE_LOADS(ci_) do { const int base_ = ml_chunk_base((ci_), b, dir); \
        _Pragma("unroll") for (int q = 0; q < 2; ++q) { const int jj = pr0 + 32 * q, tok = base_ + (dir == 0 ? jj : 63 - jj); const bf16* rp = P + (size_t)tok * NP + hd * 128 + 8 * c16; \
            nq[q] = *(const v4u*)(rp + PMQ); nk[q] = *(const v4u*)(rp + PMK); nv[q] = *(const v4u*)(rp + PMV); } \
        { const int tok = base_ + (dir == 0 ? lane : 63 - lane); nig = G[(size_t)tok * 16 + dir * 8 + hd]; nfg = G[(size_t)tok * 16 + dir * 8 + 4 + hd]; } } while (0)
    ML_ISSUE_LOADS(0);
    for (int ci = 0; ci < 36; ++ci) {
        const int base = ml_chunk_base(ci, b, dir);
#if defined(MK_PROBE_NOGATES)
        const float ig = gbi, lf = log_sigmoid(gbf);
#else
        const float ig = nig + gbi, lf = log_sigmoid(nfg + gbf);
#endif
        float bc = lf;
#pragma unroll
        for (int o = 1; o < 64; o <<= 1) { const float t = shup(bc, o, lane); if (lane >= o) bc += t; }
        const float a = ig - bc; float pm = a;
#pragma unroll
        for (int o = 1; o < 64; o <<= 1) { const float t = shup(pm, o, lane); if (lane >= o) pm = fmaxf(pm, t); }
        const float gj = fmaxf(mst, pm), g63 = shidx(gj, 63), b63 = shidx(bc, 63);
        const float wsc = __expf(a - g63) * KSCALE, decay = __expf(mst - g63);
        if (w == 0) { GA[lane] = a; GG[lane] = gj; WIN[lane] = __expf(mst - gj); EM[lane] = __expf(-(bc + gj)); }
#pragma unroll
        for (int q = 0; q < 2; ++q) { const int jj = pr0 + 32 * q;
            *(LAS v4u*)(Qs + jj * ML_QSTR + 8 * c16) = nq[q]; *(LAS v4u*)(Ks + jj * ML_QSTR + 8 * c16) = nk[q];
            const float ws = shidx(wsc, jj); float kf[8]; unpack8(nk[q], kf);
            const unsigned vv[4] = {nv[q].x, nv[q].y, nv[q].z, nv[q].w};
#pragma unroll
            for (int j = 0; j < 4; ++j) { const unsigned pw = pk2(kf[2 * j] * ws, kf[2 * j + 1] * ws); KTs[(8 * c16 + 2 * j) * ML_TSTR + jj] = (bf16)(pw & 0xffffu); KTs[(8 * c16 + 2 * j + 1) * ML_TSTR + jj] = (bf16)(pw >> 16); }
            if ((c16 >> 3) == half) {
#pragma unroll
            for (int j = 0; j < 4; ++j) { VTs[(8 * (c16 & 7) + 2 * j) * ML_TSTR + jj] = (bf16)(vv[j] & 0xffffu); VTs[(8 * (c16 & 7) + 2 * j + 1) * ML_TSTR + jj] = (bf16)(vv[j] >> 16); } } }
        if (ci + 1 < 36) ML_ISSUE_LOADS(ci + 1);
        __syncthreads();
        const int rb = w >> 1, eb0 = (w & 1) ? 3 : 0, neb = (w & 1) ? 2 : 3;
        f32x4 inter[3];
        { f32x4 sa[2] = {(f32x4){0.f, 0.f, 0.f, 0.f}, (f32x4){0.f, 0.f, 0.f, 0.f}}; bf16x8 qf[4];
#pragma unroll
            for (int kk = 0; kk < 4; ++kk) { qf[kk] = *(const LAS bf16x8*)(Qs + (16 * rb + l15) * ML_QSTR + 32 * kk + 8 * lq);
#pragma unroll
                for (int cb = 0; cb < 2; ++cb) { const bf16x8 bfr = *(const LAS bf16x8*)(Ks + (16 * (2 * (w & 1) + cb) + l15) * ML_QSTR + 32 * kk + 8 * lq);
                    sa[cb] = __builtin_amdgcn_mfma_f32_16x16x32_bf16(qf[kk], bfr, sa[cb], 0, 0, 0); } }
#pragma unroll
            for (int i = 0; i < 3; ++i) { inter[i] = (f32x4){0.f, 0.f, 0.f, 0.f}; if (i < neb) {
#pragma unroll
                for (int kk = 0; kk < 4; ++kk) inter[i] = __builtin_amdgcn_mfma_f32_16x16x32_bf16(qf[kk], *(const LAS bf16x8*)(CTs + (16 * (eb0 + i) + l15) * ML_QSTR + 32 * kk + 8 * lq), inter[i], 0, 0, 0); } }
#pragma unroll
            for (int cb = 0; cb < 2; ++cb) { const int s = 16 * (2 * (w & 1) + cb) + l15; const float as = GA[s];
#pragma unroll
                for (int r = 0; r < 4; r += 2) { const int j = 16 * rb + 4 * lq + r;
                    const float a0 = s <= j ? (as - GG[j]) * 1.44269504f : -INFINITY, a1 = s <= j + 1 ? (as - GG[j + 1]) * 1.44269504f : -INFINITY;
                    const unsigned pw = pk2(sa[cb][r] * KSCALE * __builtin_amdgcn_exp2f(a0), sa[cb][r + 1] * KSCALE * __builtin_amdgcn_exp2f(a1));
                    Ws[j * ML_TSTR + s] = (bf16)(pw & 0xffffu); Ws[(j + 1) * ML_TSTR + s] = (bf16)(pw >> 16); } } }
        __syncthreads();
        f32x4 num[3]; float em[4];
        { bf16x8 wf[2];
#pragma unroll
            for (int kk = 0; kk < 2; ++kk) wf[kk] = *(const LAS bf16x8*)(Ws + (16 * rb + l15) * ML_TSTR + 32 * kk + 8 * lq);
            float win[4];
#pragma unroll
            for (int r = 0; r < 4; ++r) { win[r] = WIN[16 * rb + 4 * lq + r]; em[r] = EM[16 * rb + 4 * lq + r]; }
#pragma unroll
            for (int i = 0; i < 3; ++i) { if (i < neb) { const int eb = eb0 + i; f32x4 aw = (f32x4){0.f, 0.f, 0.f, 0.f};
#pragma unroll
                for (int kk = 0; kk < 2; ++kk) aw = __builtin_amdgcn_mfma_f32_16x16x32_bf16(wf[kk], *(const LAS bf16x8*)(VTs + (16 * eb + l15) * ML_TSTR + 32 * kk + 8 * lq), aw, 0, 0, 0);
#pragma unroll
                for (int r = 0; r < 4; ++r) num[i][r] = aw[r] + win[r] * inter[i][r];
                if (eb == 4 && l15 == 0) {
#pragma unroll
                    for (int r = 0; r < 4; ++r) DEN[16 * rb + 4 * lq + r] = num[i][r]; } } } }
        { bf16x8 kf[2];
#pragma unroll
            for (int kk = 0; kk < 2; ++kk) kf[kk] = *(const LAS bf16x8*)(KTs + (16 * w + l15) * ML_TSTR + 32 * kk + 8 * lq);
#pragma unroll
            for (int eb = 0; eb < 5; ++eb) { Cacc[eb] = Cacc[eb] * decay;
#pragma unroll
                for (int kk = 0; kk < 2; ++kk) Cacc[eb] = __builtin_amdgcn_mfma_f32_16x16x32_bf16(kf[kk], *(const LAS bf16x8*)(VTs + (16 * eb + l15) * ML_TSTR + 32 * kk + 8 * lq), Cacc[eb], 0, 0, 0);
                v2u o; o.x = pk2(Cacc[eb][0], Cacc[eb][1]); o.y = pk2(Cacc[eb][2], Cacc[eb][3]);
                *(LAS v2u*)(CTs + (16 * eb + l15) * ML_QSTR + 16 * w + 4 * lq) = o; } }
        mst = b63 + g63;
        __syncthreads();
        { float dn[4];
#pragma unroll
            for (int r = 0; r < 4; ++r) dn[r] = 1.0f / fmaxf(fabsf(DEN[16 * rb + 4 * lq + r]), em[r]);
#pragma unroll
            for (int i = 0; i < 3; ++i) { if (i < neb && eb0 + i < 4) { const int e = 64 * half + 16 * (eb0 + i) + l15;
#pragma unroll
                for (int r = 0; r < 4; r += 2) { const int j = 16 * rb + 4 * lq + r, tok = base + (dir == 0 ? j : 63 - j), tok1 = base + (dir == 0 ? j + 1 : 62 - j);
                    const unsigned pw = pk2(num[i][r] * dn[r], num[i][r + 1] * dn[r + 1]);
                    Hout[(size_t)tok * hstride + hd * 128 + e] = (bf16)(pw & 0xffffu); Hout[(size_t)tok1 * hstride + hd * 128 + e] = (bf16)(pw >> 16); } } } }
    }
#undef ML_ISSUE_LOADS
}

__device__ __forceinline__ void c0_combine(const Ctx& F, int l, int nrows) {
    const bf16* P = (const bf16*)(F.ws + WS_P); const bf16* HB = (const bf16*)(F.ws + WS_HB); bf16* Y = (bf16*)(F.ws + WS_Y);
    const int gw = F.vcu * NWAVES + F.wave, NGW = F.G * NWAVES, lane = F.lane;
    for (int it = gw; it < nrows * 4; it += NGW) { const int r = it >> 2, hd = it & 3, col = hd * 128 + 2 * lane;
        const unsigned a = *(const unsigned*)(Y + (size_t)r * NY + 1024 + col), bq = *(const unsigned*)(HB + (size_t)r * 512 + col), mo = *(const unsigned*)(P + (size_t)r * NP + PMO + col);
#if defined(MK_PROBE_C0)
        float x0 = bflo(mo) + 0.f * (bflo(a) + bflo(bq)) * 0.f, x1 = bfhi(mo);
#else
        float x0 = bflo(a) + bflo(bq), x1 = bfhi(a) + bfhi(bq);
#endif
        const float mean = wave_sum(x0 + x1, lane) * (1.f / 128.f); x0 -= mean; x1 -= mean;
        const float rstd = 1.f / sqrtf(wave_sum(x0 * x0 + x1 * x1, lane) * (1.f / 128.f) + LN_EPS);
        const float g0 = F.in[I_NORMG][l * 512 + col], g1 = F.in[I_NORMG][l * 512 + col + 1];
        *(unsigned*)(Y + (size_t)r * NY + 1024 + col) = pk2(MK_ABL_C * sigmoidf_(bflo(mo)) * x0 * rstd * g0, MK_ABL_C * sigmoidf_(bfhi(mo)) * x1 * rstd * g1); }
}

struct EpiProj {
    static constexpr bool PERM = true, AFTER_DRAIN = false, RESCALE = false;
    bf16* O; int ldc;
    __device__ __forceinline__ void operator()(const pg8::f32x4 (&acc)[2][2][4][2], const pg8::Unit& u, int wr, int wc, int fr, int fq) const {
        const int row0 = u.pm * 256 + wr * 64 + fr, col0 = u.pn * 256 + wc * 32 + 8 * fq;
#pragma unroll
        for (int ai = 0; ai < 2; ++ai)
#pragma unroll
            for (int m = 0; m < 4; ++m) { bf16* rowp = O + (size_t)(row0 + ai * 128 + m * 16) * ldc + col0;
#pragma unroll
                for (int bj = 0; bj < 2; ++bj) { const pg8::f32x4 v0 = acc[ai][bj][m][0], v1 = acc[ai][bj][m][1];
                    v4u w; w.x = pk2(v0[0], v0[1]); w.y = pk2(v0[2], v0[3]); w.z = pk2(v1[0], v1[1]); w.w = pk2(v1[2], v1[3]);
                    *(v4u*)(rowp + bj * 128) = w; } }
    }
};
__device__ __forceinline__ float gate_e(float x) { return __builtin_amdgcn_exp2f(fminf(fmaxf(x, -30.f), 30.f) * -1.44269504f); }
struct EpiMerge {
    static constexpr bool PERM = true, AFTER_DRAIN = false, RESCALE = true;
    const bf16* P; bf16* Z;
    __device__ __forceinline__ void rescale(pg8::f32x4 (&acc)[2][2][4][2], const pg8::Unit& u, int step, int wr, int wc, int fr, int fq) const {
        const int row0 = u.pm * 256 + wr * 64 + fr, col0 = u.pn * 256 + wc * 32 + 8 * fq;
        const int cn = PBG + (step - 1) * 1024, cd = PBG + step * 1024;
#pragma unroll
        for (int ai = 0; ai < 2; ++ai)
#pragma unroll
            for (int m = 0; m < 4; ++m) { const bf16* rowp = P + (size_t)(row0 + ai * 128 + m * 16) * NP + col0;
#pragma unroll
                for (int bj = 0; bj < 2; ++bj) { const v4u xn = *(const v4u*)(rowp + cn + bj * 128), xd = *(const v4u*)(rowp + cd + bj * 128);
                    float a[8], b[8]; unpack8(xn, a); unpack8(xd, b);
#pragma unroll
                    for (int i = 0; i < 8; ++i) { const float ratio = (1.0f + gate_e(b[i])) * __builtin_amdgcn_rcpf(1.0f + gate_e(a[i])); acc[ai][bj][m][i >> 2][i & 3] *= ratio; } }
                asm volatile("" ::: "memory"); }
    }
    __device__ __forceinline__ void operator()(const pg8::f32x4 (&acc)[2][2][4][2], const pg8::Unit& u, int wr, int wc, int fr, int fq) const {
        const int row0 = u.pm * 256 + wr * 64 + fr, col0 = u.pn * 256 + wc * 32 + 8 * fq;
#pragma unroll
        for (int ai = 0; ai < 2; ++ai)
#pragma unroll
            for (int m = 0; m < 4; ++m) { const size_t r = (size_t)(row0 + ai * 128 + m * 16);
#pragma unroll
                for (int bj = 0; bj < 2; ++bj) { const v4u xc = *(const v4u*)(P + r * NP + PBG + 2048 + col0 + bj * 128); float c[8], o[8]; unpack8(xc, c);
#pragma unroll
                    for (int i = 0; i < 8; ++i) o[i] = acc[ai][bj][m][i >> 2][i & 3] * __builtin_amdgcn_rcpf(1.0f + gate_e(c[i]));
                    *(v4u*)(Z + r * D + col0 + bj * 128) = pack8(o); }
                asm volatile("" ::: "memory"); }
    }
};
struct EpiResid {
    static constexpr bool PERM = false, AFTER_DRAIN = false, RESCALE = false;
    float* out; float* hc; const float* mod_l;
    __device__ __forceinline__ void operator()(const pg8::f32x4 (&acc)[2][2][4][2], const pg8::Unit& u, int wr, int wc, int fr, int fq) const {
        const int rt = u.pm * 256; float* hb = rt < M_LAT ? out + (size_t)rt * D : hc + (size_t)(rt - M_LAT) * D;
        const float* g1 = mod_l + (size_t)(rt < M_LAT ? (rt >> 11) : 8) * 6144 + 2048;
        const int rl0 = wr * 64 + fr, col0 = u.pn * 256 + wc * 32 + 4 * fq;
#pragma unroll
        for (int ai = 0; ai < 2; ++ai)
#pragma unroll
            for (int m = 0; m < 4; ++m) { float* rowp = hb + (size_t)(rl0 + ai * 128 + m * 16) * D + col0;
#pragma unroll
                for (int bj = 0; bj < 2; ++bj)
#pragma unroll
                    for (int n = 0; n < 2; ++n) { const pg8::f32x4 g = *(const pg8::f32x4*)(g1 + col0 + bj * 128 + n * 16), h = *(const pg8::f32x4*)(rowp + bj * 128 + n * 16);
                        *(pg8::f32x4*)(rowp + bj * 128 + n * 16) = h * ALPHA + g * acc[ai][bj][m][n]; } }
    }
};
struct EpiSwiGLU {
    static constexpr bool PERM = true, AFTER_DRAIN = false, RESCALE = false;
    bf16* act;
    __device__ __forceinline__ void operator()(const pg8::f32x4 (&acc)[2][2][4][2], const pg8::Unit& u, int wr, int wc, int fr, int fq) const {
        const int row0 = u.pm * 256 + wr * 64 + fr, col0 = (u.pn & 3) * 128 + wc * 32 + 8 * fq;
#pragma unroll
        for (int ai = 0; ai < 2; ++ai)
#pragma unroll
            for (int m = 0; m < 4; ++m) { float o[8];
#pragma unroll
                for (int i = 0; i < 8; ++i) { const float g = acc[ai][0][m][i >> 2][i & 3], uu = acc[ai][1][m][i >> 2][i & 3]; o[i] = g * sigmoidf_(g) * uu; }
                *(v4u*)(act + (size_t)(row0 + ai * 128 + m * 16) * DEXP + col0) = pack8(o); }
    }
};
struct EpiScatter {
    static constexpr bool PERM = true, AFTER_DRAIN = false, RESCALE = false;
    const int* rowmap; const float* roww; bf16* Fo;
    __device__ __forceinline__ void operator()(const pg8::f32x4 (&acc)[2][2][4][2], const pg8::Unit& u, int wr, int wc, int fr, int fq) const {
        const int row0 = u.pm * 256 + wr * 64 + fr, col0 = (u.pn & 3) * 256 + wc * 32 + 8 * fq;
#pragma unroll
        for (int ai = 0; ai < 2; ++ai)
#pragma unroll
            for (int m = 0; m < 4; ++m) { const int sr = row0 + ai * 128 + m * 16, dst = rowmap[sr]; const float wgt = roww[sr];
                if (dst >= 0) {
#pragma unroll
                    for (int bj = 0; bj < 2; ++bj) { pg8::f32x4 v0 = acc[ai][bj][m][0] * wgt, v1 = acc[ai][bj][m][1] * wgt;
#if defined(MK_PROBE_SCATTER) && MK_PROBE_SCATTER == 1
                        v0 = (pg8::f32x4){wgt, wgt, wgt, wgt}; v1 = v0;
#elif defined(MK_PROBE_SCATTER) && MK_PROBE_SCATTER == 2
                        v0 = acc[ai][bj][m][0]; v1 = acc[ai][bj][m][1];
#endif
                        v4u w; w.x = pk2(v0[0], v0[1]); w.y = pk2(v0[2], v0[3]); w.z = pk2(v1[0], v1[1]); w.w = pk2(v1[2], v1[3]);
                        *(v4u*)(Fo + (size_t)dst * D + col0 + bj * 128) = w; } } }
    }
};
struct ProjOrder {
    pg8::StaticOrder need, gate; int last, first, stride, count, ntot;
    __device__ __forceinline__ void init(bool lastl, int first_, int stride_, int count_) { last = lastl ? 1 : 0; const int M = lastl ? M_LAT : M_ALL;
        need.init(M, 15 * 256, 1, 0); gate.init(M, 12 * 256, 1, 0); first = first_; stride = stride_; count = count_; ntot = need.nwg + (lastl ? 56 : 0) + gate.nwg; }
    __host__ __device__ static constexpr int n_need(bool lastl) { return (lastl ? 64 : 72) * 15 + (lastl ? 56 : 0); }
    __host__ __device__ static constexpr int n_all(bool lastl) { return n_need(lastl) + (lastl ? 64 : 72) * 12; }
    __device__ __forceinline__ bool next(int i, pg8::Unit& u) const {
        if (i >= count) return false; int idx = first + i * stride; if (idx >= ntot) return false;
        if (idx < need.nwg) return need.next(idx, u);
        idx -= need.nwg;
        if (last) { if (idx < 56) { u.pm = 64 + idx % 8; u.pn = 6 + idx / 8; return true; } idx -= 56; }
        gate.next(idx, u); u.pn += 15; return true;
    }
    __device__ __forceinline__ void a_ready(const pg8::Unit&) const {}
    __device__ __forceinline__ void done(const pg8::Unit&) const {}
};
struct MoeOrder {
    int G, c; const LAS int* toff;
    __device__ __forceinline__ bool next(int i, pg8::Unit& u) const {
        const long L = (long)i * G + c; const int nt = toff[16]; if (L >= (long)nt * 4) return false;
        const int pm = (int)(L >> 2), ct = (int)(L & 3); int e = 0;
#pragma unroll
        for (int k = 1; k < 16; ++k) e += (pm >= toff[k]) ? 1 : 0;
        u.pm = pm; u.pn = e * 4 + ct; return true;
    }
    __device__ __forceinline__ void a_ready(const pg8::Unit&) const {}
    __device__ __forceinline__ void done(const pg8::Unit&) const {}
};
__device__ __forceinline__ void moe_toff(const Ctx& F, int l, LAS int* toff) {
    if (F.tid == 0) { int acc = 0; const int* tot = (const int*)(F.ws + WS_BCNT) + 2 * 4096 + l * 16;
        for (int e = 0; e < 16; ++e) { toff[e] = acc; acc += (tot[e] + 255) >> 8; }
        toff[16] = acc; }
    __syncthreads();
}

__device__ __forceinline__ void e_ln1_route(const Ctx& F, int l, int nrows) {
    const int rpb = nrows / 256, row0 = F.vcu * rpb;
    LAS int* lcnt = (LAS int*)F.lds; LAS int* rinfo = lcnt + 16; LAS float* rwt = (LAS float*)(lcnt + 16 + 160); LAS int* lrk = lcnt + 16 + 320;
    LAS float* LG = (LAS float*)(F.lds + 2048);
    stage_w16(F, F.in[I_WROUTER], 16, (LAS float*)(F.lds + 8192));
    __syncthreads();
    for (int i = F.wave; i < rpb; i += NWAVES) { const int r = row0 + i;
        f32x4 v[4]; float* hp = hrow(F, r); load_row(hp, F.lane, v);
        ln_row(v, F.in[I_LN1G] + l * D, F.in[I_LN1B] + l * D, F.lane); store_row(hp, F.lane, v);
        const float* mp = modp(F, l, modrow(r)); f32x4 u[4];
        emit_u(v, mp + 3072, mp + 4096, (bf16*)(F.ws + WS_U) + (size_t)r * D, F.lane, u);
        const float lgv = dot16r(u, (const LAS float*)(F.lds + 8192), F.lane);
        if ((F.lane & 3) == 0) LG[i * 16 + elane(F.lane)] = lgv;
    }
    __syncthreads();
    if (F.tid < rpb) { const int i = F.tid;
        float sc[16], sel[16];
#pragma unroll
        for (int e = 0; e < 16; ++e) { sc[e] = sigmoidf_(LG[i * 16 + e]); sel[e] = sc[e] + F.in[I_BROUTER][e]; }
        int bg = 0; float bgs = -INFINITY;
#pragma unroll
        for (int g = 0; g < 4; ++g) { float m1 = -INFINITY, m2 = -INFINITY;
#pragma unroll
            for (int k = 0; k < 4; ++k) { const float x = sel[4 * g + k]; if (x > m1) { m2 = m1; m1 = x; } else if (x > m2) m2 = x; }
            const float gs = m1 + m2; if (gs > bgs) { bgs = gs; bg = g; } }
        float s4[4], c4[4];
#pragma unroll
        for (int k = 0; k < 4; ++k) { s4[k] = bg == 0 ? sel[k] : bg == 1 ? sel[4 + k] : bg == 2 ? sel[8 + k] : sel[12 + k]; c4[k] = bg == 0 ? sc[k] : bg == 1 ? sc[4 + k] : bg == 2 ? sc[8 + k] : sc[12 + k]; }
        int i1 = 0;
#pragma unroll
        for (int k = 1; k < 4; ++k) if (s4[k] > s4[i1]) i1 = k;
        int i2 = i1 == 0 ? 1 : 0;
#pragma unroll
        for (int k = 0; k < 4; ++k) if (k != i1 && k != i2 && s4[k] > s4[i2]) i2 = k;
        const float w1 = c4[i1], w2 = c4[i2], ws = 1.0f / (w1 + w2);
        rinfo[2 * i] = 4 * bg + i1; rinfo[2 * i + 1] = 4 * bg + i2; rwt[2 * i] = w1 * ws; rwt[2 * i + 1] = w2 * ws;
    }
    __syncthreads();
    if (F.tid < 16) { int c = 0; for (int idx = 0; idx < 2 * rpb; ++idx) if (rinfo[idx] == F.tid) lrk[idx] = c++;
        ((int*)(F.ws + WS_BCNT))[(l * 256 + F.vcu) * 16 + F.tid] = c; }
    __syncthreads();
    for (int idx = F.tid; idx < 2 * rpb; idx += NWAVES * 64) { unsigned* rp = (unsigned*)(F.ws + WS_ROUTE + (size_t)(2 * row0 + idx) * 16);
        rp[0] = (unsigned)rinfo[idx]; rp[1] = (unsigned)lrk[idx]; ((float*)rp)[2] = rwt[idx]; rp[3] = (unsigned)F.vcu; }
    __syncthreads();
}
__device__ __forceinline__ void f_gather(const Ctx& F, int l, int nrows) {
    LAS int* toff = (LAS int*)F.lds; LAS int* cnts = toff + 32; LAS int* csum = toff + 64; LAS int* bbase = toff + 1024;
    const int* bc = (const int*)(F.ws + WS_BCNT) + l * 4096;
    { const int e = F.tid & 15, ch = F.tid >> 4; int s = 0;
#pragma unroll
        for (int k = 0; k < 8; ++k) { const int v = bc[(8 * ch + k) * 16 + e]; bbase[(8 * ch + k) * 16 + e] = s; s += v; }
        csum[ch * 16 + e] = s; }
    __syncthreads();
    { const int e = F.tid & 15, ch = F.tid >> 4; int pre = 0;
        for (int k = 0; k < ch; ++k) pre += csum[k * 16 + e];
#pragma unroll
        for (int k = 0; k < 8; ++k) bbase[(8 * ch + k) * 16 + e] += pre;
        if (ch == 31) { const int tot = pre + csum[31 * 16 + e]; cnts[e] = tot; if (F.vcu == 0) ((int*)(F.ws + WS_BCNT))[2 * 4096 + l * 16 + e] = tot; } }
    __syncthreads();
    if (F.tid == 0) { int acc = 0; for (int e = 0; e < 16; ++e) { toff[e] = acc; acc += (cnts[e] + 255) >> 8; } toff[16] = acc; }
    __syncthreads();
    const int gw = F.vcu * NWAVES + F.wave, NGW = F.G * NWAVES, lane = F.lane;
    const bf16* U = (const bf16*)(F.ws + WS_U); bf16* As = (bf16*)(F.ws + WS_AS); int* rowmap = (int*)(F.ws + WS_ROWMAP); float* roww = (float*)(F.ws + WS_ROWW);
    for (int ts = gw; ts < 2 * nrows; ts += NGW) { const unsigned* rp = (const unsigned*)(F.ws + WS_ROUTE + (size_t)ts * 16); const unsigned re = rp[0], rk = rp[1], rb = rp[3]; const float rwv = ((const float*)rp)[2];
        const int pos = toff[re] * 256 + bbase[rb * 16 + re] + (int)rk;
        const v4u* src = (const v4u*)(U + (size_t)(ts >> 1) * D); v4u* dst = (v4u*)(As + (size_t)pos * D);
        dst[lane] = src[lane]; dst[lane + 64] = src[lane + 64];
        if (lane == 0) { rowmap[pos] = ts; roww[pos] = rwv; } }
    for (int e = 0; e < 16; ++e) { const int cnt = cnts[e], first = toff[e] * 256 + cnt, npad = toff[e + 1] * 256 - first;
        for (int i = gw; i < npad; i += NGW) { v4u* dst = (v4u*)(As + (size_t)(first + i) * D); unsigned z0 = 0u; asm volatile("" : "+v"(z0)); const v4u z = {z0, z0, z0, z0}; dst[lane] = z; dst[lane + 64] = z; if (lane == 0) { rowmap[first + i] = -1; roww[first + i] = 0.f; } } }
    __syncthreads();
}
__device__ __forceinline__ void h_ln2(const Ctx& F, int l, int nrows) {
    const int gw = F.vcu * NWAVES + F.wave, NGW = F.G * NWAVES, lane = F.lane; const bf16* Fs = (const bf16*)(F.ws + WS_F);
    if (l + 1 < DEPTH) { stage_w16(F, F.in[I_WIN] + (size_t)(l + 1) * D * D_IN + SRC_MG, D_IN, (LAS float*)F.lds); __syncthreads(); }
    for (int r = gw; r < nrows; r += NGW) { f32x4 v[4]; float* hp = hrow(F, r); load_row(hp, lane, v); const float* g2 = modp(F, l, modrow(r)) + 5120;
#pragma unroll
        for (int j = 0; j < 4; ++j) { const v2u a = *(const v2u*)(Fs + (size_t)(2 * r) * D + 4 * lane + 256 * j), b = *(const v2u*)(Fs + (size_t)(2 * r + 1) * D + 4 * lane + 256 * j);
            const f32x4 f = (f32x4){bflo(a.x) + bflo(b.x), bfhi(a.x) + bfhi(b.x), bflo(a.y) + bflo(b.y), bfhi(a.y) + bfhi(b.y)}, g = *(const f32x4*)(g2 + 4 * lane + 256 * j);
            v[j] = v[j] * ALPHA + g * f * MK_ABL_F; }
        ln_row(v, F.in[I_LN2G] + l * D, F.in[I_LN2B] + l * D, lane); store_row(hp, lane, v);
        if (l + 1 < DEPTH) emit_layer_input(F, l + 1, r, v); }
}

constexpr int NPHASE = 2 + 10 * DEPTH;
struct Args { const float* in[N_IN]; float* out; unsigned char* ws; int ph_lo, ph_hi, li, pad; };
static_assert(sizeof(Args) == 8 * N_IN + 16 + 16, "no padding bytes in Args");
#ifndef MK_PHASE_MASK
#define MK_PHASE_MASK 0xFFFu
#endif
#define PON(j) (((MK_PHASE_MASK) >> (j)) & 1u)
#ifndef MK_DUP
#define MK_DUP (-1)
#endif
#define REP(k) for (int rep_ = 0; rep_ < (((MK_DUP) == (k)) ? 2 : 1); ++rep_)
#define IN(k) (lo <= (k) && (k) < hi)
#define PCTX(Fp) Ctx Fp = F; Fp.lane = lane_id(); Fp.tid = F.wave * 64 + Fp.lane
#if defined(MK_STAMPS)
#define SEAM(k) do { if (IN(k) && IN((k) + 1)) xcd_barrier(bar); if (blockIdx.x == 0 && F.wave == 0 && lane_id() == 0) ((unsigned long long*)(F.ws + WS_CTL + 16384))[(k) + 1] = __builtin_amdgcn_s_memrealtime(); } while (0)
#else
#define SEAM(k) do { if (IN(k) && IN((k) + 1)) xcd_barrier(bar); } while (0)
#endif
template <int l> __device__ __forceinline__ void run_layer(const Ctx& F, const int lo, const int hi, const XcdBarrier& bar) {
        const int pb = 2 + 10 * l; const bool lastl = (l == DEPTH - 1); const int nrows = lastl ? M_LAT : M_ALL;
        bf16* const Pb = (bf16*)(F.ws + WS_P); bf16* const Ub = (bf16*)(F.ws + WS_U); bf16* const Yb = (bf16*)(F.ws + WS_Y);
        if (PON(2) && IN(pb + 0)) REP(pb + 0) {
            pg8::Gemm g{Ub, wt(F, l, W_IN), M_ALL, NP, D}; EpiProj E{Pb, NP};
            constexpr int NA = 256 * ((ProjOrder::n_need(l == DEPTH - 1) + 255) / 256);
            ProjOrder S; S.init(lastl, (int)blockIdx.x, 256, NA / 256);
            pg8::gemm_phase<EpiProj, ProjOrder, true, true>(F.lds, g, S, E, F.wave);
            SEAM(pb + 0);
        }
        if (PON(3) && IN(pb + 1)) REP(pb + 1) {
            PCTX(Fp);
            {
                constexpr int NA = 256 * ((ProjOrder::n_need(l == DEPTH - 1) + 255) / 256);
                if (F.vcu < 128) { mlstm_chain(Fp, l, F.vcu);
#if defined(MK_DUP_MLSTM)
                    mlstm_chain(Fp, l, F.vcu);
#endif
                    __syncthreads(); }
                pg8::Gemm g{Ub, wt(F, l, W_IN), M_ALL, NP, D}; EpiProj E{Pb, NP};
                ProjOrder S; if (F.vcu >= 128) S.init(lastl, NA + (F.vcu - 128), 128, 4); else S.init(lastl, NA + 512 + F.vcu, 128, 2);
                pg8::gemm_phase<EpiProj, ProjOrder, true, true>(F.lds, g, S, E, F.wave);
                __syncthreads();
            }
            {
                const int n_attn = lastl ? 256 : 288, n_conv = lastl ? 512 : 576;
                attn_rope_to_lds(Fp);
                volatile LAS int* wq = (volatile LAS int*)(F.lds + LDSCTL_OFF + 512);
                for (;;) {
                    __syncthreads();
                    if (Fp.tid == 0) wq[0] = (int)__hip_atomic_fetch_add(F.ctl + CW_WQ + 256 * l + 128 * (int)(rep_ & 1), 1u, RLX_AGENT);
                    __syncthreads();
                    const int u = wq[0];
                    if (u >= n_attn) break;
                    if (u < 256) attn_unit(Fp, l, 0, u >> 5, (u >> 1) & 15, u & 1); else { const int j = u - 256; attn_unit(Fp, l, 1, j >> 2, (j >> 1) & 1, j & 1); }
                }
                for (;;) {
                    __syncthreads();
                    if (Fp.tid == 0) wq[0] = (int)__hip_atomic_fetch_add(F.ctl + CW_WQ + 256 * l + 128 * (int)(rep_ & 1) + 64, 1u, RLX_AGENT);
                    __syncthreads();
                    const int u = wq[0];
                    if (u >= n_conv) break;
                    conv_unit(Fp, l, u);
                }
            }
            SEAM(pb + 1);
        }
        if (PON(4) && IN(pb + 2)) REP(pb + 2) { PCTX(Fp); c0_combine(Fp, l, nrows); SEAM(pb + 2); }
        if (PON(5) && IN(pb + 3)) REP(pb + 3) {
            pg8::Gemm g{Yb, wt(F, l, W_ABC), nrows, D, NY}; pg8::StaticOrder S; S.init(nrows, D, F.G, (int)blockIdx.x);
            EpiMerge E{Pb, Ub};
            pg8::gemm_phase<EpiMerge, pg8::StaticOrder, true, true>(F.lds, g, S, E, F.wave);
            if (l == 0) { PCTX(Fp); __syncthreads(); convert_layer1_on_idle(Fp, 32); }
            SEAM(pb + 3);
        }
        if (PON(6) && IN(pb + 4)) REP(pb + 4) {
            pg8::Gemm g{Ub, wt(F, l, W_OUT), nrows, D, D}; pg8::StaticOrder S; S.init(nrows, D, F.G, (int)blockIdx.x);
            EpiResid E{F.out, (float*)(F.ws + WS_HC), (const float*)(F.ws + WS_MOD) + (size_t)l * 9 * 6144};
            pg8::gemm_phase<EpiResid, pg8::StaticOrder, true, true>(F.lds, g, S, E, F.wave);
            SEAM(pb + 4);
        }
        if (PON(7) && IN(pb + 5)) REP(pb + 5) { PCTX(Fp); e_ln1_route(Fp, l, nrows); SEAM(pb + 5); }
        if (PON(8) && IN(pb + 6)) REP(pb + 6) { PCTX(Fp); f_gather(Fp, l, nrows); SEAM(pb + 6); }
        if (PON(9) && IN(pb + 7)) REP(pb + 7) {
            LAS int* toff = (LAS int*)(F.lds + LDSCTL_OFF); { PCTX(Fp); moe_toff(Fp, l, toff); }
            pg8::Gemm g{(const bf16*)(F.ws + WS_AS), wt(F, l, W_GU), AS_ROWS, NE * D, D}; MoeOrder S{F.G, (int)blockIdx.x, toff};
            EpiSwiGLU E{(bf16*)(F.ws + WS_ACT)};
            pg8::gemm_phase<EpiSwiGLU, MoeOrder, true, true>(F.lds, g, S, E, F.wave);
            SEAM(pb + 7);
        }
        if (PON(10) && IN(pb + 8)) REP(pb + 8) {
            LAS int* toff = (LAS int*)(F.lds + LDSCTL_OFF); { PCTX(Fp); moe_toff(Fp, l, toff); }
            pg8::Gemm g{(const bf16*)(F.ws + WS_ACT), wt(F, l, W_DN), AS_ROWS, NE * D, DEXP}; MoeOrder S{F.G, (int)blockIdx.x, toff};
            EpiScatter E{(const int*)(F.ws + WS_ROWMAP), (const float*)(F.ws + WS_ROWW), (bf16*)(F.ws + WS_F)};
            pg8::gemm_phase<EpiScatter, MoeOrder, true, true>(F.lds, g, S, E, F.wave);
            SEAM(pb + 8);
        }
        if (PON(11) && IN(pb + 9)) REP(pb + 9) { PCTX(Fp); h_ln2(Fp, l, nrows); SEAM(pb + 9); }
    }
__global__ void __launch_bounds__(NWAVES * 64, 2) mk_fwd(Args args) {
    extern __shared__ __attribute__((aligned(16))) unsigned char lds[];
    Ctx F;
    F.lds = (LAS unsigned char*)lds; F.MISC = (volatile LAS unsigned*)(F.lds + MISC_OFF);
    F.tid = 0; F.lane = 0; F.wave = __builtin_amdgcn_readfirstlane((int)threadIdx.x >> 6);
    F.G = gridDim.x; { const int bx = blockIdx.x; F.vcu = (F.G % 8 == 0) ? (bx % 8) * (F.G / 8) + bx / 8 : bx; }
    F.ws = args.ws; F.out = args.out; F.ctl = (unsigned*)(args.ws + WS_CTL);
    F.in = args.in;
    for (int u = (int)threadIdx.x; u < (LDS_BYTES - LDSCTL_OFF) / 4; u += NWAVES * 64) ((LAS unsigned*)(F.lds + LDSCTL_OFF))[u] = 0u;
    __syncthreads();
    const int lo = args.ph_lo, hi = args.ph_hi;
    XcdBarrier bar; bar.bar = (unsigned*)(F.ctl + CW_BAR) + args.li * XCD_BAR_WORDS; bar.x = 0; bar.st = nullptr; bar.w0 = false;
    if (hi - lo > 1) bar = xcd_barrier_post((unsigned*)(F.ctl + CW_BAR) + args.li * XCD_BAR_WORDS, F.MISC + 8);
    bar.w0 = (F.wave == 0);
#if defined(MK_STAMPS)
    if (blockIdx.x == 0 && F.wave == 0 && lane_id() == 0) ((unsigned long long*)(F.ws + WS_CTL + 16384))[0] = __builtin_amdgcn_s_memrealtime();
#endif
    if (PON(0) && IN(0)) REP(0) { PCTX(Fp); p0_prologue(Fp); SEAM(0); }
    if (PON(1) && IN(1)) REP(1) { PCTX(Fp); p1_ln_in(Fp); SEAM(1); }
#if defined(MK_EXTRA_BARRIERS)
    if (hi - lo > 1) for (int xb = 0; xb < MK_EXTRA_BARRIERS; ++xb) xcd_barrier(bar);
#endif
    run_layer<0>(F, lo, hi, bar);
    run_layer<1>(F, lo, hi, bar);
#undef IN
#undef SEAM
}


#if defined(MK_DIAG)
constexpr int CW_DIAG = 3072;
__global__ void __launch_bounds__(512, 2) mk_diag(Args args) {
    unsigned char* ws = args.ws; float* acc = (float*)((unsigned*)(ws + WS_CTL) + CW_DIAG);
    const int gt = blockIdx.x * 512 + threadIdx.x, NT = gridDim.x * 512;
    const int* rowmap = (const int*)(ws + WS_ROWMAP); const bf16* As = (const bf16*)(ws + WS_AS); const bf16* act = (const bf16*)(ws + WS_ACT); const bf16* Fs = (const bf16*)(ws + WS_F);
    const unsigned* cnt = (const unsigned*)(ws + WS_CTL) + CW_CNT;
    int ntile = 0; for (int e = 0; e < 16; ++e) ntile += (int)((cnt[64 * e] + 255u) >> 8);
    float s0 = 0.f, s1 = 0.f, s2 = 0.f, s3 = 0.f;
    for (int pos = gt; pos < ntile * 256; pos += NT) { if (rowmap[pos] >= 0) { s0 += 1.f; float a = 0.f, b = 0.f;
        for (int k = 0; k < 1024; k += 37) a += fabsf(bf1(As[(size_t)pos * D + k]));
        for (int k = 0; k < 512; k += 19) b += fabsf(bf1(act[(size_t)pos * DEXP + k]));
        s1 += a * (1.f / 28.f); s2 += b * (1.f / 27.f); } }
    for (int ts = gt; ts < 2 * M_ALL; ts += NT) { float f = 0.f; for (int k = 0; k < 1024; k += 37) f += fabsf(bf1(Fs[(size_t)ts * D + k])); s3 += f * (1.f / 28.f); }
    if (MK_DIAG == 3) { s1 = 0.f; s2 = 0.f; const float* roww = (const float*)(ws + WS_ROWW);
        for (int pos = gt; pos < ntile * 256; pos += NT) if (rowmap[pos] >= 0) s1 += fabsf(roww[pos]);
        for (int ts = gt; ts < 2 * M_ALL; ts += NT) { const v4u rt = *(const v4u*)(ws + WS_ROUTE + (size_t)ts * 16); s2 += fabsf(__builtin_bit_cast(float, rt.z)); } }
    if (MK_DIAG == 6) { s1 = 0.f; s2 = 0.f;
        for (int ts = gt; ts < 2 * M_ALL; ts += NT) { const v4u rt = *(const v4u*)(ws + WS_ROUTE + (size_t)ts * 16); const float wv = __builtin_bit_cast(float, rt.z);
            const bool ok = (wv > 0.f) && (wv < 1.f); if (ok) s2 += wv; else s1 += 1.f; } }
    if (MK_DIAG == 7) { s1 = 0.f; s2 = 0.f;
        for (int ts = gt; ts < 2 * M_ALL; ts += NT) { bool bad = false; for (int k = 0; k < 1024; k += 7) { const float x = bf1(Fs[(size_t)ts * D + k]); if (!(fabsf(x) < 1e4f)) bad = true; } if (bad) s1 += 1.f; }
        for (int pos = gt; pos < ntile * 256; pos += NT) { bool bad = false; for (int k = 0; k < 512; k += 5) { const float x = bf1(act[(size_t)pos * DEXP + k]); if (!(fabsf(x) < 1e4f)) bad = true; }
            for (int k = 0; k < 1024; k += 7) { const float x = bf1(As[(size_t)pos * D + k]); if (!(fabsf(x) < 1e4f)) bad = true; } if (bad) s2 += 1.f; } }
    if (MK_DIAG == 4 || MK_DIAG == 5) { s1 = 0.f; s2 = 0.f; const float* dbg = (const float*)(ws + WS_ROPE + 65536);
        for (int r = gt; r < M_ALL; r += NT) { s1 += fabsf(dbg[4 * r + (MK_DIAG == 4 ? 0 : 2)]); s2 += fabsf(dbg[4 * r + (MK_DIAG == 4 ? 1 : 3)]); } }
    atomicAdd(acc + 0, s0); atomicAdd(acc + 1, s1); atomicAdd(acc + 2, s2); atomicAdd(acc + 3, s3);
}
__global__ void __launch_bounds__(512, 2) mk_diag_out(Args args) {
    const float* acc = (const float*)((const unsigned*)(args.ws + WS_CTL) + CW_DIAG);
    const float cntr = acc[0], mA = acc[1] / fmaxf(cntr, 1.f), mAct = acc[2] / fmaxf(cntr, 1.f), mF = acc[3] / (2.f * M_ALL);
    float st1, st2;
    if (MK_DIAG == 1) { st1 = mA; st2 = mAct; } else if (MK_DIAG == 3) { st1 = mA; st2 = acc[2] / (2.f * M_ALL); } else if (MK_DIAG == 4 || MK_DIAG == 5) { st1 = acc[1] / M_ALL; st2 = acc[2] / M_ALL; } else if (MK_DIAG == 6) { st1 = acc[1] + 1e-3f; st2 = acc[2] / (2.f * M_ALL); } else if (MK_DIAG == 7) { st1 = acc[1] + 1e-3f; st2 = acc[2] + 1e-3f; } else { st1 = cntr / (2.f * M_ALL); st2 = mF; }
    const float v1 = fminf(fmaxf(20.f + log2f(fmaxf(st1, 1e-6f)), 0.f), 60.f), v2 = 100.f * fminf(fmaxf(20.f + log2f(fmaxf(st2, 1e-6f)), 0.f), 60.f);
    const float K = sqrtf(v1);
    for (size_t i = (size_t)blockIdx.x * 512 + threadIdx.x; i < (size_t)M_LAT * D; i += (size_t)gridDim.x * 512) args.out[i] = (i == 12345) ? v2 : ((i & 1) ? K : -K);
}
#endif

#if defined(MK_DIAG)
__global__ void __launch_bounds__(512, 2) mk_copy(Args args) {
    const bf16* HF = (const bf16*)(args.ws + WS_Y); const bf16* HB = (const bf16*)(args.ws + WS_HB); const bf16* P = (const bf16*)(args.ws + WS_P);
    for (size_t i = (size_t)blockIdx.x * 512 + threadIdx.x; i < (size_t)M_LAT * D; i += (size_t)gridDim.x * 512) { const size_t r = i >> 10; const int c = (int)(i & 1023);
        float v;
        if (MK_DIAG == 8) v = c < 512 ? bf1(HF[r * 512 + c]) : bf1(HB[r * 512 + c - 512]);
        else if (MK_DIAG == 9) v = bf1(P[r * NP + PMQ + c]);
        else if (MK_DIAG == 10) v = bf1(P[r * NP + PMV + (c & 511)]);
        else if (MK_DIAG == 11) v = bf1(P[(size_t)(M_LAT + (r & 2047)) * NP + PMQ + c + 512 * ((r >> 11) & 1)]);
        else v = ((const float*)(args.ws + WS_G))[(size_t)(r + ((r >> 13) & 1) * 2048) * 16 + (c & 15)];
        args.out[i] = v; }
}
#endif

#if defined(MK_STAMPS)
__global__ void __launch_bounds__(512, 2) mk_stamp_out(Args args) {
    const unsigned long long* ts = (const unsigned long long*)(args.ws + WS_CTL + 16384);
    const float d1 = (float)(ts[MK_ST_E1] - ts[MK_ST_S1]) * 0.01f, d2 = (float)(ts[MK_ST_E2] - ts[MK_ST_S2]) * 0.01f;
    const float K = sqrtf(d1 * 0.1f);
    for (size_t i = (size_t)blockIdx.x * 512 + threadIdx.x; i < (size_t)M_LAT * D; i += (size_t)gridDim.x * 512) args.out[i] = (i == 12345) ? d2 : ((i & 1) ? K : -K);
}
#endif

#ifndef MK_PER_PHASE
#define MK_PER_PHASE 1
#endif
extern "C" void kernel_launch(void* const* d_in, const int* in_sizes, int n_in, void* d_out, int out_size, void* d_ws, size_t ws_size, hipStream_t stream) {
    static int grid = 0;
    if (grid == 0) {
        if (n_in != N_IN || in_sizes[0] != M_LAT * D || out_size != M_LAT * D || ws_size < WS_END) {
            fprintf(stderr, "kernel_launch: built for %d inputs, x/out of %d floats, >= %zu bytes of workspace; got n_in %d, in0 %d, out %d, ws %zu; nothing launched\n", N_IN, M_LAT * D, (size_t)WS_END, n_in, n_in > 0 ? in_sizes[0] : -1, out_size, ws_size); grid = -1; return; }
        int dev = 0, cus = 0, per_cu = 0;
        if (hipGetDevice(&dev) != hipSuccess || hipDeviceGetAttribute(&cus, hipDeviceAttributeMultiprocessorCount, dev) != hipSuccess) { fprintf(stderr, "kernel_launch: device query failed\n"); grid = -1; return; }
        if (hipFuncSetAttribute((const void*)mk_fwd, hipFuncAttributeMaxDynamicSharedMemorySize, LDS_BYTES) != hipSuccess) { fprintf(stderr, "kernel_launch: hipFuncSetAttribute failed\n"); grid = -1; return; }
        if (hipOccupancyMaxActiveBlocksPerMultiprocessor(&per_cu, (const void*)mk_fwd, NWAVES * 64, LDS_BYTES) != hipSuccess || per_cu < 1) { fprintf(stderr, "kernel_launch: occupancy query reports %d workgroups per CU\n", per_cu); }
        (void)hipGetLastError();
        grid = cus;
        if (grid != 256) { fprintf(stderr, "kernel_launch: %d CUs; this kernel is built for 256\n", grid); grid = -1; return; }
    }
    if (grid < 0) return;
    if (hipMemsetAsync((char*)d_ws + WS_CTL, 0, CTL_ZERO_BYTES, stream) != hipSuccess) { fprintf(stderr, "kernel_launch: memset failed\n"); return; }
    Args a{};
    for (int i = 0; i < N_IN; ++i) a.in[i] = (const float*)d_in[i];
    a.out = (float*)d_out; a.ws = (unsigned char*)d_ws; a.pad = 0;
#if MK_PER_PHASE
    for (int k = 0; k < NPHASE; ++k) { a.ph_lo = k; a.ph_hi = k + 1; a.li = k;
        hipLaunchKernelGGL(mk_fwd, dim3(grid), dim3(NWAVES * 64), LDS_BYTES, stream, a);
#if defined(MK_DIAG)
        if (k == MK_DIAG_AFTER) { if (MK_DIAG >= 8) { hipLaunchKernelGGL(mk_copy, dim3(256), dim3(512), 0, stream, a); } else { hipLaunchKernelGGL(mk_diag, dim3(256), dim3(512), 0, stream, a); hipLaunchKernelGGL(mk_diag_out, dim3(256), dim3(512), 0, stream, a); } break; }
#endif
    }
#else
    a.ph_lo = 0; a.ph_hi = NPHASE; a.li = 0;
    hipLaunchKernelGGL(mk_fwd, dim3(grid), dim3(NWAVES * 64), LDS_BYTES, stream, a);
#if defined(MK_STAMPS)
    hipLaunchKernelGGL(mk_stamp_out, dim3(256), dim3(512), 0, stream, a);
#endif
#endif
    const hipError_t le = hipPeekAtLastError();
    if (le != hipSuccess) fprintf(stderr, "kernel_launch: launch failed: %s\n", hipGetErrorName(le));
}
```
